# Optimizing an MI355X kernel written in HIP

```python
import math
import jax, jax.numpy as jnp
from jax import lax
import numpy as np

D_MODEL = 1024
BATCH = 32
SEQ = 256
DEPTH = 2
DEC_BATCH = 2
DEC_SEQ = 4096
PAST_LEN = 256

GRID_W = 64
N_EVEN = (DEPTH + 1) // 2
N_ODD = DEPTH // 2
EPS = 1e-6
CONV_W = 3
D_A = D_MODEL
H_A = 16
P_A = D_A // H_A
N_A = 128
G_A = 2
CHUNK = 128
D_XBC = D_A + 2 * G_A * N_A
DT_MIN = 1e-3
DT_MAX = 1e-1
D_B = D_MODEL
HY_EMB = 33
HY_BANDS = (HY_EMB - 1) // 2
HY_HID = 64
HY_TARGET = 1e-2
HY_DECAY_PCT_HI = 0.3
HY_DECAY_PCT_LO = 1.5
D_C = D_MODEL
H_C = 16
HD_C = D_C // H_C
WIN_H = 8
WIN_W = 16
N_IN_E = D_A + D_XBC + 2 * H_A + 3 * D_B + D_B
SPLIT_E = (D_A, D_A + D_XBC, D_A + D_XBC + 2 * H_A, D_A + D_XBC + 2 * H_A + 3 * D_B)
N_IN_O = 4 * D_C

kernel_name = "hybrid_ssd_hyena_natten_diffusion_step"


def rms_norm(x, g):
    xf = x.astype(jnp.float32)
    y = xf * lax.rsqrt(jnp.mean(xf * xf, axis=-1, keepdims=True) + EPS)
    return (y * g.astype(jnp.float32)).astype(x.dtype)


def ada_mod(cvec, w, b):
    m = jax.nn.silu(cvec) @ w + b
    shift, scale, gate = jnp.split(m, 3, axis=-1)
    return shift[:, None], scale[:, None], gate[:, None]


def depthwise_conv(x, w, b):
    L = x.shape[1]
    pad = CONV_W // 2
    xp = jnp.pad(x, ((0, 0), (pad, CONV_W - 1 - pad), (0, 0)))
    out = b
    for j in range(CONV_W):
        out = out + xp[:, j:j + L] * w[j]
    return out


def segsum(x):
    T = x.shape[-1]
    cs = jnp.cumsum(x, axis=-1)
    diff = cs[..., :, None] - cs[..., None, :]
    mask = jnp.tril(jnp.ones((T, T), dtype=bool))
    return jnp.where(mask, diff, -jnp.inf)


def ssd_scan(x, dt, a, bh, ch, init):
    b, L, h, p = x.shape
    n = bh.shape[-1]
    nc = L // CHUNK
    f32 = jnp.float32
    xdt = (x.astype(f32) * dt[..., None]).reshape(b, nc, CHUNK, h, p)
    adt = (a * dt).reshape(b, nc, CHUNK, h).transpose(0, 3, 1, 2)
    bc = bh.astype(f32).reshape(b, nc, CHUNK, h, n)
    cc = ch.astype(f32).reshape(b, nc, CHUNK, h, n)
    acs = jnp.cumsum(adt, axis=-1)
    lmat = jnp.exp(segsum(adt))
    scores = jnp.einsum('bclhn,bcshn->bhcls', cc, bc) * lmat
    y_diag = jnp.einsum('bhcls,bcshp->bclhp', scores, xdt)
    decay_states = jnp.exp(acs[..., -1:] - acs)
    states = jnp.einsum('bclhn,bhcl,bclhp->bchpn', bc, decay_states, xdt)
    states = jnp.concatenate([init.astype(f32)[:, None], states], axis=1)
    chunk_a = jnp.pad(acs[..., -1], ((0, 0), (0, 0), (1, 0)))
    decay_chunk = jnp.exp(segsum(chunk_a))
    new_states = jnp.einsum('bhzc,bchpn->bzhpn', decay_chunk, states)
    y_off = jnp.einsum('bclhn,bchpn->bclhp', cc, new_states[:, :-1]) * jnp.exp(acs).transpose(0, 2, 3, 1)[..., None]
    return (y_diag + y_off).reshape(b, L, h, p), new_states[:, -1]


def hyena_filter(L, w1, b1, w2, b2, w3, freq):
    f32 = jnp.float32
    t = jnp.linspace(0.0, 1.0, L, dtype=f32)[:, None]
    w = 2.0 * math.pi * jnp.arange(L, dtype=f32)[:, None] / L
    f = jnp.linspace(1e-4, HY_BANDS - 1, HY_BANDS, dtype=f32)[None]
    feats = jnp.concatenate([t, jnp.cos(f * w), -jnp.sin(f * w)], axis=-1)
    hdn = jnp.sin(freq * (feats @ w1 + b1))
    hdn = jnp.sin(freq * (hdn @ w2 + b2))
    filt = (hdn @ w3).astype(f32)
    deltas = jnp.linspace(math.log(HY_TARGET) / HY_DECAY_PCT_HI, math.log(HY_TARGET) / HY_DECAY_PCT_LO, D_B, dtype=f32)
    decay = jnp.exp(-t * jnp.abs(deltas)[None])
    h_fwd = filt[:, :D_B] * decay
    h_bwd = filt[:, D_B:] * decay
    return jnp.concatenate([h_fwd, jnp.zeros((1, D_B), f32), h_bwd[:0:-1]], axis=0)


def fft_long_conv(u, k, bias):
    L = u.shape[1]
    n = 2 * L
    uf = jnp.fft.rfft(u.astype(jnp.float32), n=n, axis=1)
    kf = jnp.fft.rfft(k.astype(jnp.float32), n=n, axis=0)
    y = jnp.fft.irfft(uf * kf[None], n=n, axis=1)[:, :L]
    return (y + u.astype(jnp.float32) * bias.astype(jnp.float32)).astype(u.dtype)


def mixer_ssd_hyena(h, init_state, w_in, w_out, conv_a_w, conv_a_b, dt_bias, a_log, d_skip, norm_a_w,
                    conv_b_w, conv_b_b, hf_w1, hf_b1, hf_w2, hf_b2, hf_w3, hf_freq, hy_bias):
    b, L, _ = h.shape
    z_a, xbc, dt_raw, u_b, g_b = jnp.split(h @ w_in, SPLIT_E, axis=-1)
    xbc = jax.nn.silu(depthwise_conv(xbc, conv_a_w, conv_a_b))
    xa, bm, cm = jnp.split(xbc, (D_A, D_A + G_A * N_A), axis=-1)
    xa = xa.reshape(b, L, H_A, P_A)
    bh = jnp.repeat(bm.reshape(b, L, G_A, N_A), H_A // G_A, axis=2)
    ch = jnp.repeat(cm.reshape(b, L, G_A, N_A), H_A // G_A, axis=2)
    dt_raw = dt_raw.astype(jnp.float32).reshape(b, L, 2, H_A)
    ys, finals = [], []
    for d in range(2):
        rev = (lambda t: jnp.flip(t, axis=1)) if d == 1 else (lambda t: t)
        dt = jax.nn.softplus(dt_raw[:, :, d] + dt_bias[d].astype(jnp.float32))
        a = -jnp.exp(a_log[d].astype(jnp.float32))
        y_d, s_d = ssd_scan(rev(xa), rev(dt), a, rev(bh), rev(ch), init_state[:, d])
        ys.append(rev(y_d) + xa.astype(jnp.float32) * d_skip[d].astype(jnp.float32)[:, None])
        finals.append(s_d)
    y_a = (ys[0] + ys[1]).reshape(b, L, D_A).astype(h.dtype)
    y_a = rms_norm(y_a * jax.nn.silu(z_a), norm_a_w)
    u = depthwise_conv(u_b, conv_b_w, conv_b_b)
    x0, x1, v = jnp.split(u, 3, axis=-1)
    k = hyena_filter(L, hf_w1, hf_b1, hf_w2, hf_b2, hf_w3, hf_freq)
    y_b = x0 * fft_long_conv(v * x1, k, hy_bias)
    y_b = (y_b * jax.nn.silu(g_b)).astype(y_a.dtype)
    out = jnp.concatenate([y_a, y_b], axis=-1) @ w_out
    return out, jnp.stack(finals, axis=1).astype(h.dtype)


def na_context(h, w_in, w_out):
    b, L, _ = h.shape
    q, k, v, g = jnp.split(h @ w_in, 4, axis=-1)
    heads = lambda t: t.reshape(b, L, H_C, HD_C).transpose(0, 2, 1, 3)
    q, k, v = heads(q), heads(k), heads(v)
    s = jnp.einsum('bhqd,bhkd->bhqk', q, k).astype(jnp.float32) * (HD_C ** -0.5)
    p = jax.nn.softmax(s, axis=-1).astype(v.dtype)
    o = jnp.einsum('bhqk,bhkd->bhqd', p, v).transpose(0, 2, 1, 3).reshape(b, L, D_C)
    return (o * jax.nn.silu(g)) @ w_out, k, v


def na_latent(h, ck, cv, rpb, w_in, w_out):
    b, L, _ = h.shape
    R = L // GRID_W
    kh = min(WIN_H, R)
    q, k, v, g = jnp.split(h @ w_in, 4, axis=-1)
    grid = lambda t: t.reshape(b, R, GRID_W, H_C, HD_C).transpose(0, 3, 1, 2, 4)
    q, k, v = grid(q), grid(k), grid(v)
    r_idx = jnp.arange(R)
    c_idx = jnp.arange(GRID_W)
    rows = jnp.clip(r_idx - kh // 2, 0, R - kh)[:, None] + jnp.arange(kh)[None]
    col0 = jnp.clip(c_idx - WIN_W // 2, 0, GRID_W - WIN_W)
    col_in = (c_idx[None, :] >= col0[:, None]) & (c_idx[None, :] < col0[:, None] + WIN_W)
    k_rows = k[:, :, rows]
    v_rows = v[:, :, rows]
    s_loc = jnp.einsum('bhrqd,bhrikd->bhrqik', q, k_rows).astype(jnp.float32) * (HD_C ** -0.5)
    dr_idx = rows - r_idx[:, None] + WIN_H - 1
    dc_idx = jnp.clip(c_idx[None, :] - c_idx[:, None] + WIN_W - 1, 0, 2 * WIN_W - 2)
    bias = rpb[:, dr_idx][..., dc_idx]
    s_loc = s_loc + bias.transpose(0, 1, 3, 2, 4)[None].astype(jnp.float32)
    s_loc = jnp.where(col_in[:, None, :], s_loc, -jnp.inf)
    s_ctx = jnp.einsum('bhrqd,bhkd->bhrqk', q, ck).astype(jnp.float32) * (HD_C ** -0.5)
    s = jnp.concatenate([s_loc.reshape(b, H_C, R, GRID_W, kh * GRID_W), s_ctx], axis=-1)
    p = jax.nn.softmax(s, axis=-1).astype(v.dtype)
    p_loc = p[..., :kh * GRID_W].reshape(b, H_C, R, GRID_W, kh, GRID_W)
    p_ctx = p[..., kh * GRID_W:]
    o = jnp.einsum('bhrqik,bhrikd->bhrqd', p_loc, v_rows) + jnp.einsum('bhrqk,bhkd->bhrqd', p_ctx, cv)
    o = o.transpose(0, 2, 3, 1, 4).reshape(b, L, D_C)
    return (o * jax.nn.silu(g)) @ w_out


def setup_inputs(seed: int = 0) -> dict:
    key = jax.random.key(seed)
    ks = iter(jax.random.split(key, 40))

    def nrm(shape, scale):
        return scale * jax.random.normal(next(ks), shape, jnp.float32)

    x_prompt = nrm((BATCH, SEQ, D_MODEL), 1.0)
    x_sample = nrm((DEC_BATCH, DEC_SEQ, D_MODEL), 1.0)
    state_ssd = nrm((DEC_BATCH, N_EVEN, 2, H_A, P_A, N_A), 0.1)
    cache_k = nrm((DEC_BATCH, N_ODD, H_C, PAST_LEN, HD_C), 1.0)
    cache_v = nrm((DEC_BATCH, N_ODD, H_C, PAST_LEN, HD_C), 1.0)
    c = nrm((DEC_BATCH, D_MODEL), 1.0)
    c_ctx = nrm((D_MODEL,), 1.0)
    norm_w = 1.0 + nrm((DEPTH, D_MODEL), 0.02)
    w_ada = nrm((DEPTH, D_MODEL, 3 * D_MODEL), D_MODEL ** -0.5)
    b_ada = nrm((DEPTH, 3 * D_MODEL), 0.02)
    w_in_e = nrm((N_EVEN, D_MODEL, N_IN_E), D_MODEL ** -0.5)
    w_out_e = nrm((N_EVEN, D_A + D_B, D_MODEL), (D_A + D_B) ** -0.5)
    conv_a_w = nrm((N_EVEN, CONV_W, D_XBC), CONV_W ** -0.5)
    conv_a_b = nrm((N_EVEN, D_XBC), 0.02)
    dt0 = jnp.exp(jax.random.uniform(next(ks), (N_EVEN, 2, H_A), jnp.float32, math.log(DT_MIN), math.log(DT_MAX)))
    dt_bias = dt0 + jnp.log(-jnp.expm1(-dt0))
    a_log = jnp.log(jax.random.uniform(next(ks), (N_EVEN, 2, H_A), jnp.float32, 1.0, 16.0))
    d_skip = 1.0 + nrm((N_EVEN, 2, H_A), 0.1)
    norm_a_w = 1.0 + nrm((N_EVEN, D_A), 0.02)
    conv_b_w = nrm((N_EVEN, CONV_W, 3 * D_B), CONV_W ** -0.5)
    conv_b_b = nrm((N_EVEN, 3 * D_B), 0.02)
    hf_w1 = nrm((N_EVEN, HY_EMB, HY_HID), HY_EMB ** -0.5)
    hf_b1 = nrm((N_EVEN, HY_HID), 0.02)
    hf_w2 = nrm((N_EVEN, HY_HID, HY_HID), HY_HID ** -0.5)
    hf_b2 = nrm((N_EVEN, HY_HID), 0.02)
    hf_w3 = nrm((N_EVEN, HY_HID, 2 * D_B), 0.02 * HY_HID ** -0.5)
    hf_freq = 1.0 + nrm((N_EVEN, HY_HID), 0.1)
    hy_bias = nrm((N_EVEN, D_B), 1.0)
    w_in_o = nrm((N_ODD, D_MODEL, N_IN_O), D_MODEL ** -0.5)
    w_out_o = nrm((N_ODD, D_C, D_MODEL), D_C ** -0.5)
    rpb = nrm((N_ODD, H_C, 2 * WIN_H - 1, 2 * WIN_W - 1), 0.05)
    final_norm_w = 1.0 + nrm((D_MODEL,), 0.02)
    return {"x_prompt": x_prompt, "x_sample": x_sample, "state_ssd": state_ssd, "cache_k": cache_k,
            "cache_v": cache_v, "c": c, "c_ctx": c_ctx, "norm_w": norm_w, "w_ada": w_ada, "b_ada": b_ada,
            "w_in_e": w_in_e, "w_out_e": w_out_e, "conv_a_w": conv_a_w, "conv_a_b": conv_a_b,
            "dt_bias": dt_bias, "a_log": a_log, "d_skip": d_skip, "norm_a_w": norm_a_w,
            "conv_b_w": conv_b_w, "conv_b_b": conv_b_b, "hf_w1": hf_w1, "hf_b1": hf_b1, "hf_w2": hf_w2,
            "hf_b2": hf_b2, "hf_w3": hf_w3, "hf_freq": hf_freq, "hy_bias": hy_bias, "w_in_o": w_in_o,
            "w_out_o": w_out_o, "rpb": rpb, "final_norm_w": final_norm_w}


def reference(x_prompt, x_sample, state_ssd, cache_k, cache_v, c, c_ctx, norm_w, w_ada, b_ada,
              w_in_e, w_out_e, conv_a_w, conv_a_b, dt_bias, a_log, d_skip, norm_a_w,
              conv_b_w, conv_b_b, hf_w1, hf_b1, hf_w2, hf_b2, hf_w3, hf_freq, hy_bias,
              w_in_o, w_out_o, rpb, final_norm_w):
    xp, xs = x_prompt, x_sample
    new_ssd, new_k, new_v = [], [], []
    for l in range(DEPTH):
        i = l // 2
        sh_p, sc_p, g_p = ada_mod(c_ctx[None], w_ada[l], b_ada[l])
        sh_s, sc_s, g_s = ada_mod(c, w_ada[l], b_ada[l])
        hp = rms_norm(xp, norm_w[l]) * (1.0 + sc_p) + sh_p
        hs = rms_norm(xs, norm_w[l]) * (1.0 + sc_s) + sh_s
        if l % 2 == 0:
            ep = (w_in_e[i], w_out_e[i], conv_a_w[i], conv_a_b[i], dt_bias[i], a_log[i], d_skip[i], norm_a_w[i],
                  conv_b_w[i], conv_b_b[i], hf_w1[i], hf_b1[i], hf_w2[i], hf_b2[i], hf_w3[i], hf_freq[i], hy_bias[i])
            zeros_state = jnp.zeros((hp.shape[0], 2, H_A, P_A, N_A), hp.dtype)
            op, fin_ctx = mixer_ssd_hyena(hp, zeros_state, *ep)
            os_, _ = mixer_ssd_hyena(hs, state_ssd[:, i], *ep)
            new_ssd.append(fin_ctx)
        else:
            op, k_ctx, v_ctx = na_context(hp, w_in_o[i], w_out_o[i])
            os_ = na_latent(hs, cache_k[:, i], cache_v[:, i], rpb[i], w_in_o[i], w_out_o[i])
            new_k.append(k_ctx)
            new_v.append(v_ctx)
        xp = xp + g_p * op
        xs = xs + g_s * os_
    y_prompt = rms_norm(xp, final_norm_w)
    y_sample = rms_norm(xs, final_norm_w)
    new_state_ssd = jnp.stack(new_ssd, axis=1)
    new_cache_k = jnp.stack(new_k, axis=1)
    new_cache_v = jnp.stack(new_v, axis=1)
    return (y_prompt, y_sample, new_state_ssd, new_cache_k, new_cache_v)
```

```cpp
#include <hip/hip_runtime.h>
#include <hip/hip_cooperative_groups.h>
#include <cstdio>
namespace cg = cooperative_groups;

#ifndef MULTI
#define MULTI 0
#endif

#define NT 512
#define DI __device__ __forceinline__
typedef unsigned short u16;
typedef __attribute__((ext_vector_type(8))) short bf16x8;
typedef __attribute__((ext_vector_type(4))) float f32x4;
typedef __attribute__((ext_vector_type(16))) float f32x16;
typedef __attribute__((ext_vector_type(4))) unsigned u32x4;
typedef __attribute__((ext_vector_type(2))) unsigned u32x2;

#define MFMA16(a, b, c) __builtin_amdgcn_mfma_f32_16x16x32_bf16((a), (b), (c), 0, 0, 0)
#define MFMA32(a, b, c) __builtin_amdgcn_mfma_f32_32x32x16_bf16((a), (b), (c), 0, 0, 0)

#define MROWS 16384
#define NPROMPT 8192
#define LDC0 2592
#define NPAD0 6784
#define SMEM_BYTES 151552

#define OFF_WINE   0ul
#define OFF_WOUTE  13893632ul
#define OFF_WINO   18087936ul
#define OFF_WOUTO  26476544ul
#define OFF_MOD    28573696ul
#define OFF_ROWSS  28647424ul
#define OFF_CDEC   29696000ul
#define OFF_UT     29712384ul
#define OFF_C0A    163930112ul
#define OFF_X1     OFF_UT
#define OFF_C1     96821248ul
#define OFF_H1     231038976ul
#define OUT_H0     0ul
#define OUT_YB     0ul
#define OUT_HF4096 33554432ul
#define OUT_HF256  (33554432ul + 16777216ul)
#define OUT_SBUF   100663296ul
#define O_YP 0ul
#define O_YS 8388608ul
#define O_ST 16777216ul
#define O_NK 25165824ul
#define O_NV 33554432ul

struct Params {
  const float* in[31];
  float* out;
  unsigned char* ws;
};

DI u16 f2bf(float x) { unsigned u = __float_as_uint(x); u += 0x7fffu + ((u >> 16) & 1u); return (u16)(u >> 16); }
DI float bf2f(u16 h) { return __uint_as_float(((unsigned)h) << 16); }
DI unsigned pk2(float a, float b) { return (unsigned)f2bf(a) | ((unsigned)f2bf(b) << 16); }
DI float silu(float x) { return x / (1.f + __expf(-x)); }
DI float bflo(unsigned u) { return __uint_as_float(u << 16); }
DI float bfhi(unsigned u) { return __uint_as_float(u & 0xffff0000u); }
DI void unpack8(const u32x4& v, float* f) {
  f[0] = bflo(v[0]); f[1] = bfhi(v[0]); f[2] = bflo(v[1]); f[3] = bfhi(v[1]);
  f[4] = bflo(v[2]); f[5] = bfhi(v[2]); f[6] = bflo(v[3]); f[7] = bfhi(v[3]);
}
DI u32x4 pack8(const float* f) {
  u32x4 o; o[0] = pk2(f[0], f[1]); o[1] = pk2(f[2], f[3]); o[2] = pk2(f[4], f[5]); o[3] = pk2(f[6], f[7]); return o;
}
DI int row_group(int row) { return row < NPROMPT ? 0 : 1 + ((row - NPROMPT) >> 12); }

DI void phase_ada(const Params& p, int t, unsigned char* smem) {
  float* sc = (float*)smem;
  float* red = sc + 3072;
  const int layer = t / 96, cc = t % 96;
  const int tid = threadIdx.x;
  for (int i = tid; i < 3072; i += NT) {
    int g = i >> 10, k = i & 1023;
    float v = (g == 0) ? p.in[6][k] : p.in[5][(g - 1) * 1024 + k];
    sc[i] = silu(v);
  }
  __syncthreads();
  const int col = tid & 31, kg = tid >> 5;
  const float* w = p.in[8] + (size_t)layer * 1024 * 3072 + cc * 32 + col;
  float a0 = 0.f, a1 = 0.f, a2 = 0.f;
#pragma unroll 8
  for (int k = kg * 64; k < kg * 64 + 64; ++k) {
    float wv = w[(size_t)k * 3072];
    a0 += sc[k] * wv; a1 += sc[1024 + k] * wv; a2 += sc[2048 + k] * wv;
  }
  red[(kg * 3 + 0) * 32 + col] = a0;
  red[(kg * 3 + 1) * 32 + col] = a1;
  red[(kg * 3 + 2) * 32 + col] = a2;
  __syncthreads();
  if (tid < 96) {
    int g = tid >> 5, c = tid & 31;
    float s = 0.f;
    for (int q = 0; q < 16; ++q) s += red[(q * 3 + g) * 32 + c];
    int colg = cc * 32 + c;
    float* mod = (float*)(p.ws + OFF_MOD);
    mod[(layer * 3 + g) * 3072 + colg] = s + p.in[9][layer * 3072 + colg];
  }
  __syncthreads();
}

DI float ld_src(const float* q) { return *q; }
DI float ld_src(const u16* q) { return bf2f(*q); }
template <typename ST>
DI void transpose_tile(const ST* src, int N, int ldsrc, u16* dst, int lddst, int kt, int nt,
                       const float* kscale, int kscale_n, unsigned char* smem) {
  float* tile = (float*)smem;
  const int tid = threadIdx.x;
  const int c = tid & 63, r0 = tid >> 6;
#pragma unroll
  for (int i = 0; i < 8; ++i) {
    int r = r0 + 8 * i;
    int k = kt * 64 + r, n = nt * 64 + c;
    float v = 0.f;
    if (n < N) {
      v = ld_src(src + (size_t)k * ldsrc + n);
      if (kscale != nullptr && k < kscale_n) v *= kscale[k];
    }
    tile[r * 65 + c] = v;
  }
  __syncthreads();
  const int rr = tid >> 3, c8 = (tid & 7) * 8;
  float f[8];
#pragma unroll
  for (int e = 0; e < 8; ++e) f[e] = tile[(c8 + e) * 65 + rr];
  *(u32x4*)(dst + (size_t)(nt * 64 + rr) * lddst + kt * 64 + c8) = pack8(f);
  __syncthreads();
}

DI void phase_filter(const Params& p, int t, unsigned char* smem) {
  const int cfg = t < 512 ? 1 : 0;
  const int L = cfg ? 4096 : 256;
  const int t0 = (cfg ? t : t - 512) * 8;
  float* feats = (float*)smem;
  float* h1 = feats + 8 * 36;
  float* h2 = h1 + 512;
  const float* w1 = p.in[20]; const float* b1 = p.in[21]; const float* w2 = p.in[22];
  const float* b2 = p.in[23]; const float* w3 = p.in[24]; const float* fr = p.in[25];
  const int tid = threadIdx.x;
  if (tid < 8 * 33) {
    int tt = tid / 33, i = tid % 33;
    int tpos = t0 + tt;
    float tv = (float)tpos / (float)(L - 1);
    float wv = 6.283185307179586f * (float)tpos / (float)L;
    float f;
    if (i == 0) f = tv;
    else if (i <= 16) { float fi = 1e-4f + (float)(i - 1) * ((15.f - 1e-4f) / 15.f); f = cosf(fi * wv); }
    else { float fi = 1e-4f + (float)(i - 17) * ((15.f - 1e-4f) / 15.f); f = -sinf(fi * wv); }
    feats[tt * 36 + i] = f;
  }
  __syncthreads();
  {
    int tt = tid >> 6, j = tid & 63;
    float s = b1[j];
    for (int i = 0; i < 33; ++i) s += feats[tt * 36 + i] * w1[i * 64 + j];
    h1[tt * 64 + j] = sinf(fr[j] * s);
  }
  __syncthreads();
  {
    int tt = tid >> 6, j = tid & 63;
    float s = b2[j];
    for (int i = 0; i < 64; ++i) s += h1[tt * 64 + i] * w2[i * 64 + j];
    h2[tt * 64 + j] = sinf(fr[j] * s);
  }
  __syncthreads();
  float acc[4][8];
#pragma unroll
  for (int q = 0; q < 4; ++q)
#pragma unroll
    for (int tt = 0; tt < 8; ++tt) acc[q][tt] = 0.f;
#pragma unroll 2
  for (int k = 0; k < 64; ++k) {
    float wv[4];
#pragma unroll
    for (int q = 0; q < 4; ++q) wv[q] = w3[k * 2048 + tid + 512 * q];
#pragma unroll
    for (int tt = 0; tt < 8; ++tt) {
      float hv = h2[tt * 64 + k];
#pragma unroll
      for (int q = 0; q < 4; ++q) acc[q][tt] += hv * wv[q];
    }
  }
  u16* HF = (u16*)((unsigned char*)p.out + (cfg ? OUT_HF4096 : OUT_HF256));
  const float lo = -15.350567286626973f;
  const float hi = -3.0701134573253945f;
#pragma unroll
  for (int q = 0; q < 4; ++q) {
    int col = tid + 512 * q;
    int dir = col >> 10, c = col & 1023;
    float ad = fabsf(lo + (float)c * ((hi - lo) / 1023.f));
    u16* hc = HF + (size_t)c * (2 * L);
#pragma unroll
    for (int tt = 0; tt < 8; ++tt) {
      int tpos = t0 + tt;
      float tv = (float)tpos / (float)(L - 1);
      float val = acc[q][tt] * expf(-tv * ad);
      if (dir == 0) hc[L - tpos] = f2bf(val);
      else if (tpos > 0) hc[L + tpos] = f2bf(val);
      else hc[0] = 0;
    }
  }
  __syncthreads();
}

DI float wave_sum(float v) {
#pragma unroll
  for (int o = 32; o >= 1; o >>= 1) v += __shfl_xor(v, o);
  return v;
}
DI void phase_norm(const Params& p, int t, int layer, const float* xa, const float* xb, u16* dst) {
  const int lane = threadIdx.x & 63, w = threadIdx.x >> 6;
  const int row = t * 8 + w;
  const float* src = row < NPROMPT ? xa + (size_t)row * 1024 : xb + (size_t)(row - NPROMPT) * 1024;
  const int g = row_group(row);
  float4 v[4];
  float ss = 0.f;
#pragma unroll
  for (int i = 0; i < 4; ++i) {
    v[i] = *(const float4*)(src + i * 256 + lane * 4);
    ss += v[i].x * v[i].x + v[i].y * v[i].y + v[i].z * v[i].z + v[i].w * v[i].w;
  }
  ss = wave_sum(ss);
  const float rstd = rsqrtf(ss * (1.f / 1024.f) + 1e-6f);
  const float* nw = p.in[7] + layer * 1024;
  const float* shift = (const float*)(p.ws + OFF_MOD) + (layer * 3 + g) * 3072;
  const float* scale = shift + 1024;
#pragma unroll
  for (int i = 0; i < 4; ++i) {
    int col = i * 256 + lane * 4;
    float4 nwv = *(const float4*)(nw + col);
    float4 sc = *(const float4*)(scale + col);
    float4 sh = *(const float4*)(shift + col);
    float o0 = v[i].x * rstd * nwv.x * (1.f + sc.x) + sh.x;
    float o1 = v[i].y * rstd * nwv.y * (1.f + sc.y) + sh.y;
    float o2 = v[i].z * rstd * nwv.z * (1.f + sc.z) + sh.z;
    float o3 = v[i].w * rstd * nwv.w * (1.f + sc.w) + sh.w;
    u32x2 o; o[0] = pk2(o0, o1); o[1] = pk2(o2, o3);
    *(u32x2*)(dst + (size_t)row * 1024 + col) = o;
  }
}
DI void phase_final_norm(const Params& p, int t) {
  const int lane = threadIdx.x & 63, w = threadIdx.x >> 6;
  const int row = t * 8 + w;
  float* src = p.out + (size_t)row * 1024;
  float4 v[4];
  float ss = 0.f;
#pragma unroll
  for (int i = 0; i < 4; ++i) {
    v[i] = *(const float4*)(src + i * 256 + lane * 4);
    ss += v[i].x * v[i].x + v[i].y * v[i].y + v[i].z * v[i].z + v[i].w * v[i].w;
  }
  ss = wave_sum(ss);
  const float rstd = rsqrtf(ss * (1.f / 1024.f) + 1e-6f);
  const float* nw = p.in[30];
#pragma unroll
  for (int i = 0; i < 4; ++i) {
    int col = i * 256 + lane * 4;
    float4 nwv = *(const float4*)(nw + col);
    float4 o;
    o.x = v[i].x * rstd * nwv.x; o.y = v[i].y * rstd * nwv.y; o.z = v[i].z * rstd * nwv.z; o.w = v[i].w * rstd * nwv.w;
    *(float4*)(src + col) = o;
  }
}

struct GemmArgs {
  const u16* A1; int lda1;
  const u16* A2; int lda2;
  int ksplit;
  const u16* Bt; int K;
};
template <int EPI>
DI void gemm_tile(const Params& p, const GemmArgs& g, int m0, int n0, unsigned char* smem) {
  u16* As = (u16*)smem;
  u16* Bs = As + 256 * 72;
  float* rs = (float*)(Bs + 128 * 72);
  const int tid = threadIdx.x, lane = tid & 63, w = tid >> 6;
  const int wm = (w >> 1) * 64, wn = (w & 1) * 64;
  const int l15 = lane & 15, l4 = lane >> 4;
  f32x4 acc[4][4];
#pragma unroll
  for (int i = 0; i < 4; ++i)
#pragma unroll
    for (int j = 0; j < 4; ++j) acc[i][j] = (f32x4){0.f, 0.f, 0.f, 0.f};
  if (EPI == 1) {
    if (tid < 256) {
      const float* rss = (const float*)(p.ws + OFF_ROWSS) + (size_t)(m0 + tid) * 16;
      float s = 0.f;
#pragma unroll
      for (int q = 0; q < 16; ++q) s += rss[q];
      rs[tid] = rsqrtf(s * (1.f / 1024.f) + 1e-6f);
    }
  }
  u32x4 ra[4], rb[2];
  const int KT = g.K >> 6;
  auto loadg = [&](int kt) {
    const int k0 = kt << 6;
    const u16* Ab; int lda; int kk;
    if (k0 < g.ksplit) { Ab = g.A1; lda = g.lda1; kk = k0; } else { Ab = g.A2; lda = g.lda2; kk = k0 - g.ksplit; }
#pragma unroll
    for (int i = 0; i < 4; ++i) {
      int id = tid + 512 * i; int r = id >> 3, c = (id & 7) * 8;
      ra[i] = *(const u32x4*)(Ab + (size_t)(m0 + r) * lda + kk + c);
    }
#pragma unroll
    for (int i = 0; i < 2; ++i) {
      int id = tid + 512 * i; int r = id >> 3, c = (id & 7) * 8;
      rb[i] = *(const u32x4*)(g.Bt + (size_t)(n0 + r) * g.K + k0 + c);
    }
  };
  loadg(0);
  for (int kt = 0; kt < KT; ++kt) {
#pragma unroll
    for (int i = 0; i < 4; ++i) {
      int id = tid + 512 * i; int r = id >> 3, c = (id & 7) * 8;
      *(u32x4*)(As + r * 72 + c) = ra[i];
    }
#pragma unroll
    for (int i = 0; i < 2; ++i) {
      int id = tid + 512 * i; int r = id >> 3, c = (id & 7) * 8;
      *(u32x4*)(Bs + r * 72 + c) = rb[i];
    }
    __syncthreads();
    if (kt + 1 < KT) loadg(kt + 1);
    if (EPI == 1) {
      if ((kt << 6) == g.ksplit) {
#pragma unroll
        for (int i = 0; i < 4; ++i)
#pragma unroll
          for (int r = 0; r < 4; ++r) {
            float sc = rs[wm + i * 16 + l4 * 4 + r];
#pragma unroll
            for (int j = 0; j < 4; ++j) acc[i][j][r] *= sc;
          }
      }
    }
#pragma unroll
    for (int ks = 0; ks < 2; ++ks) {
      bf16x8 a[4], b[4];
#pragma unroll
      for (int i = 0; i < 4; ++i) a[i] = *(const bf16x8*)(As + (wm + i * 16 + l15) * 72 + ks * 32 + l4 * 8);
#pragma unroll
      for (int j = 0; j < 4; ++j) b[j] = *(const bf16x8*)(Bs + (wn + j * 16 + l15) * 72 + ks * 32 + l4 * 8);
#pragma unroll
      for (int i = 0; i < 4; ++i)
#pragma unroll
        for (int j = 0; j < 4; ++j) acc[i][j] = MFMA16(a[i], b[j], acc[i][j]);
    }
    __syncthreads();
  }
#pragma unroll
  for (int i = 0; i < 4; ++i) {
    const int rbase = m0 + wm + i * 16 + l4 * 4;
#pragma unroll
    for (int j = 0; j < 4; ++j) {
      const int col = n0 + wn + j * 16 + l15;
      if (EPI == 0) {
        if (col < LDC0) {
          u16* C = (u16*)(p.ws + OFF_C0A);
#pragma unroll
          for (int r = 0; r < 4; ++r) C[(size_t)(rbase + r) * LDC0 + col] = f2bf(acc[i][j][r]);
        } else if (col < 6688) {
          u16* UT = (u16*)(p.ws + OFF_UT);
          u32x2 o; o[0] = pk2(acc[i][j][0], acc[i][j][1]); o[1] = pk2(acc[i][j][2], acc[i][j][3]);
          *(u32x2*)(UT + (size_t)(col - LDC0) * MROWS + rbase) = o;
        }
      } else if (EPI == 1) {
        float* X1 = (float*)(p.ws + OFF_X1);
        const float* mod = (const float*)(p.ws + OFF_MOD);
#pragma unroll
        for (int r = 0; r < 4; ++r) {
          int row = rbase + r;
          const float* xs = row < NPROMPT ? p.in[0] + (size_t)row * 1024 : p.in[1] + (size_t)(row - NPROMPT) * 1024;
          float gate = mod[(0 * 3 + row_group(row)) * 3072 + 2048 + col];
          X1[(size_t)row * 1024 + col] = xs[col] + gate * acc[i][j][r];
        }
      } else if (EPI == 2) {
        u16* C1 = (u16*)(p.ws + OFF_C1);
#pragma unroll
        for (int r = 0; r < 4; ++r) {
          int row = rbase + r;
          C1[(size_t)row * 4096 + col] = f2bf(acc[i][j][r]);
          if (row < NPROMPT && col >= 1024 && col < 3072) {
            int cc = col - 1024; int isv = cc >> 10; cc &= 1023;
            int hh = cc >> 6, d = cc & 63; int b = row >> 8, l = row & 255;
            float* o = p.out + (isv ? O_NV : O_NK);
            o[(((size_t)b * 16 + hh) * 256 + l) * 64 + d] = acc[i][j][r];
          }
        }
      } else {
        const float* X1 = (const float*)(p.ws + OFF_X1);
        const float* mod = (const float*)(p.ws + OFF_MOD);
#pragma unroll
        for (int r = 0; r < 4; ++r) {
          int row = rbase + r;
          float gate = mod[(1 * 3 + row_group(row)) * 3072 + 2048 + col];
          p.out[(size_t)row * 1024 + col] = X1[(size_t)row * 1024 + col] + gate * acc[i][j][r];
        }
      }
    }
  }
}

struct SsdItem { int row0; int h; int has_prev; int has_next; };
DI SsdItem ssd_item(int item) {
  SsdItem s;
  int cgi = item >> 4; s.h = item & 15;
  if (cgi < 64) { int seq = cgi >> 1, c = cgi & 1; s.row0 = seq * 256 + c * 128; s.has_prev = c > 0; s.has_next = c < 1; }
  else { int q = cgi - 64; int seq = q >> 5, c = q & 31; s.row0 = NPROMPT + seq * 4096 + c * 128; s.has_prev = c > 0; s.has_next = c < 31; }
  return s;
}
DI void ssd_prep_dt(const Params& p, int row0, int h, float* sdt, float* scs, float* stot) {
  const int tid = threadIdx.x, lane = tid & 63, w = tid >> 6;
  const u16* C0 = (const u16*)(p.ws + OFF_C0A);
  if (tid < 256) {
    int d = tid >> 7, l = tid & 127;
    float raw = bf2f(C0[(size_t)(row0 + l) * LDC0 + 2560 + d * 16 + h]);
    float x = raw + p.in[14][d * 16 + h];
    float dt = x > 20.f ? x : log1pf(expf(x));
    float a = -expf(p.in[15][d * 16 + h]);
    sdt[d * 128 + l] = dt;
    scs[d * 128 + l] = a * dt;
  }
  __syncthreads();
  if (w < 2) {
    const int d = w;
    int p0 = d == 0 ? 2 * lane : 127 - 2 * lane;
    int p1 = d == 0 ? 2 * lane + 1 : 126 - 2 * lane;
    float v0 = scs[d * 128 + p0], v1 = scs[d * 128 + p1];
    float s = v0 + v1;
#pragma unroll
    for (int off = 1; off < 64; off <<= 1) {
      float tv = __shfl_up(s, off);
      if (lane >= off) s += tv;
    }
    float excl = s - (v0 + v1);
    scs[d * 128 + p0] = excl + v0;
    scs[d * 128 + p1] = excl + v0 + v1;
    if (lane == 63) stot[d] = s;
  }
  __syncthreads();
}
DI void conv_silu8(const Params& p, int row, int ch0, bool hp, bool hn, float* out) {
  const u16* C0 = (const u16*)(p.ws + OFF_C0A);
  const u16* q = C0 + (size_t)row * LDC0 + 1024 + ch0;
  const float* cw = p.in[12]; const float* cb = p.in[13];
  float xm[8], xc[8], xp[8];
  u32x4 vc = *(const u32x4*)q;
  unpack8(vc, xc);
  if (hp) { u32x4 v = *(const u32x4*)(q - LDC0); unpack8(v, xm); } else {
#pragma unroll
    for (int e = 0; e < 8; ++e) xm[e] = 0.f;
  }
  if (hn) { u32x4 v = *(const u32x4*)(q + LDC0); unpack8(v, xp); } else {
#pragma unroll
    for (int e = 0; e < 8; ++e) xp[e] = 0.f;
  }
  float4 w0a = *(const float4*)(cw + ch0), w0b = *(const float4*)(cw + ch0 + 4);
  float4 w1a = *(const float4*)(cw + 1536 + ch0), w1b = *(const float4*)(cw + 1536 + ch0 + 4);
  float4 w2a = *(const float4*)(cw + 3072 + ch0), w2b = *(const float4*)(cw + 3072 + ch0 + 4);
  float4 ba = *(const float4*)(cb + ch0), bb = *(const float4*)(cb + ch0 + 4);
  float w0[8] = {w0a.x, w0a.y, w0a.z, w0a.w, w0b.x, w0b.y, w0b.z, w0b.w};
  float w1[8] = {w1a.x, w1a.y, w1a.z, w1a.w, w1b.x, w1b.y, w1b.z, w1b.w};
  float w2[8] = {w2a.x, w2a.y, w2a.z, w2a.w, w2b.x, w2b.y, w2b.z, w2b.w};
  float bv[8] = {ba.x, ba.y, ba.z, ba.w, bb.x, bb.y, bb.z, bb.w};
#pragma unroll
  for (int e = 0; e < 8; ++e) out[e] = silu(bv[e] + w0[e] * xm[e] + w1[e] * xc[e] + w2[e] * xp[e]);
}

DI void phase_ssd_states(const Params& p, int item, unsigned char* smem) {
  u16* xT = (u16*)smem;
  u16* BTs = xT + 64 * 136;
  float* sdt = (float*)(BTs + 2 * 128 * 136);
  float* scs = sdt + 256;
  float* sw = scs + 256;
  float* stot = sw + 256;
  const int tid = threadIdx.x, lane = tid & 63, w = tid >> 6;
  const int l15 = lane & 15, l4 = lane >> 4;
  const SsdItem it = ssd_item(item);
  const int h = it.h, grp = h >> 3;
  ssd_prep_dt(p, it.row0, h, sdt, scs, stot);
  if (tid < 256) {
    int d = tid >> 7;
    sw[tid] = sdt[tid] * __expf(stot[d] - scs[tid]);
  }
  __syncthreads();
  {
    const int l = tid >> 2;
    const int row = it.row0 + l;
    const bool hp = (l > 0) || it.has_prev, hn = (l < 127) || it.has_next;
    const int pc = (tid & 3) * 16;
#pragma unroll
    for (int v = 0; v < 2; ++v) {
      float o[8];
      conv_silu8(p, row, h * 64 + pc + v * 8, hp, hn, o);
#pragma unroll
      for (int e = 0; e < 8; ++e) xT[(pc + v * 8 + e) * 136 + l] = f2bf(o[e]);
    }
    const int nc0 = (tid & 3) * 32;
    const float s0 = sw[l], s1 = sw[128 + l];
#pragma unroll
    for (int v = 0; v < 4; ++v) {
      float o[8];
      conv_silu8(p, row, 1024 + grp * 128 + nc0 + v * 8, hp, hn, o);
#pragma unroll
      for (int e = 0; e < 8; ++e) {
        BTs[(nc0 + v * 8 + e) * 136 + l] = f2bf(o[e] * s0);
        BTs[128 * 136 + (nc0 + v * 8 + e) * 136 + l] = f2bf(o[e] * s1);
      }
    }
  }
  __syncthreads();
  const int d = w >> 2, nq = w & 3;
  f32x4 acc[4][2];
#pragma unroll
  for (int i = 0; i < 4; ++i) { acc[i][0] = (f32x4){0.f, 0.f, 0.f, 0.f}; acc[i][1] = (f32x4){0.f, 0.f, 0.f, 0.f}; }
#pragma unroll
  for (int ks = 0; ks < 4; ++ks) {
    bf16x8 a[4], b[2];
#pragma unroll
    for (int i = 0; i < 4; ++i) a[i] = *(const bf16x8*)(xT + (i * 16 + l15) * 136 + ks * 32 + l4 * 8);
#pragma unroll
    for (int j = 0; j < 2; ++j) b[j] = *(const bf16x8*)(BTs + d * 128 * 136 + (nq * 32 + j * 16 + l15) * 136 + ks * 32 + l4 * 8);
#pragma unroll
    for (int i = 0; i < 4; ++i)
#pragma unroll
      for (int j = 0; j < 2; ++j) acc[i][j] = MFMA16(a[i], b[j], acc[i][j]);
  }
  u16* S = (u16*)((unsigned char*)p.out + OUT_SBUF) + ((size_t)item * 2 + d) * 8192;
#pragma unroll
  for (int i = 0; i < 4; ++i)
#pragma unroll
    for (int j = 0; j < 2; ++j)
#pragma unroll
      for (int r = 0; r < 4; ++r) {
        int pp = i * 16 + l4 * 4 + r, n = nq * 32 + j * 16 + l15;
        S[pp * 128 + n] = f2bf(acc[i][j][r]);
      }
  if (tid < 2) {
    float* cdec = (float*)(p.ws + OFF_CDEC);
    cdec[item * 2 + tid] = __expf(stot[tid]);
  }
  __syncthreads();
}

DI void phase_scan(const Params& p, int t) {
  const int part = t & 1, d = (t >> 1) & 1, h = (t >> 2) & 15, seq = t >> 6;
  const int tid = threadIdx.x;
  const int e0 = part * 4096 + tid * 8;
  const int nc = seq < 32 ? 2 : 32;
  const int cg0 = seq < 32 ? seq * 2 : 64 + (seq - 32) * 32;
  float st[8];
  if (seq < 32) {
#pragma unroll
    for (int e = 0; e < 8; ++e) st[e] = 0.f;
  } else {
    const float* init = p.in[2] + ((((size_t)(seq - 32) * 1 + 0) * 2 + d) * 16 + h) * 8192 + e0;
    float4 a = *(const float4*)init, b = *(const float4*)(init + 4);
    st[0] = a.x; st[1] = a.y; st[2] = a.z; st[3] = a.w; st[4] = b.x; st[5] = b.y; st[6] = b.z; st[7] = b.w;
  }
  u16* Sb = (u16*)((unsigned char*)p.out + OUT_SBUF);
  const float* cdec = (const float*)(p.ws + OFF_CDEC);
  for (int ci = 0; ci < nc; ++ci) {
    const int c = d == 0 ? ci : nc - 1 - ci;
    const int item = (cg0 + c) * 16 + h;
    u16* q = Sb + ((size_t)item * 2 + d) * 8192 + e0;
    u32x4 v = *(const u32x4*)q;
    float sc[8]; unpack8(v, sc);
    *(u32x4*)q = pack8(st);
    const float dec = cdec[item * 2 + d];
#pragma unroll
    for (int e = 0; e < 8; ++e) st[e] = st[e] * dec + sc[e];
  }
  if (seq < 32) {
    float* o = p.out + O_ST + ((((size_t)seq * 1 + 0) * 2 + d) * 16 + h) * 8192 + e0;
    *(float4*)o = make_float4(st[0], st[1], st[2], st[3]);
    *(float4*)(o + 4) = make_float4(st[4], st[5], st[6], st[7]);
  }
}

DI void phase_ssd_out(const Params& p, int item, unsigned char* smem) {
  u16* Cs = (u16*)smem;
  u16* Bs = Cs + 128 * 136;
  u16* xT = Bs + 128 * 136;
  u16* St = xT + 64 * 136;
  float* sdt = (float*)(St + 2 * 64 * 136);
  float* scs = sdt + 256;
  float* stot = scs + 256;
  const int tid = threadIdx.x, lane = tid & 63, w = tid >> 6;
  const int l15 = lane & 15, l4 = lane >> 4;
  const SsdItem it = ssd_item(item);
  const int h = it.h, grp = h >> 3;
  ssd_prep_dt(p, it.row0, h, sdt, scs, stot);
  {
    const int l = tid >> 2;
    const int row = it.row0 + l;
    const bool hp = (l > 0) || it.has_prev, hn = (l < 127) || it.has_next;
    const int pc = (tid & 3) * 16;
#pragma unroll
    for (int v = 0; v < 2; ++v) {
      float o[8];
      conv_silu8(p, row, h * 64 + pc + v * 8, hp, hn, o);
#pragma unroll
      for (int e = 0; e < 8; ++e) xT[(pc + v * 8 + e) * 136 + l] = f2bf(o[e]);
    }
    const int nc0 = (tid & 3) * 32;
#pragma unroll
    for (int v = 0; v < 4; ++v) {
      float o[8];
      conv_silu8(p, row, 1024 + grp * 128 + nc0 + v * 8, hp, hn, o);
      *(u32x4*)(Bs + l * 136 + nc0 + v * 8) = pack8(o);
      conv_silu8(p, row, 1280 + grp * 128 + nc0 + v * 8, hp, hn, o);
      *(u32x4*)(Cs + l * 136 + nc0 + v * 8) = pack8(o);
    }
    const u16* S = (const u16*)((const unsigned char*)p.out + OUT_SBUF) + (size_t)item * 2 * 8192;
#pragma unroll
    for (int v = 0; v < 4; ++v) {
      int id = tid + 512 * v;
      int dd = id >> 10, pp = (id >> 4) & 63, nv = (id & 15) * 8;
      *(u32x4*)(St + dd * 64 * 136 + pp * 136 + nv) = *(const u32x4*)(S + dd * 8192 + pp * 128 + nv);
    }
  }
  __syncthreads();
  f32x4 cb[8], af[4], ab[4];
#pragma unroll
  for (int j = 0; j < 8; ++j) cb[j] = (f32x4){0.f, 0.f, 0.f, 0.f};
#pragma unroll
  for (int i = 0; i < 4; ++i) { af[i] = (f32x4){0.f, 0.f, 0.f, 0.f}; ab[i] = (f32x4){0.f, 0.f, 0.f, 0.f}; }
#pragma unroll
  for (int ks = 0; ks < 4; ++ks) {
    bf16x8 a = *(const bf16x8*)(Cs + (16 * w + l15) * 136 + ks * 32 + l4 * 8);
#pragma unroll
    for (int j = 0; j < 8; ++j) {
      bf16x8 b = *(const bf16x8*)(Bs + (j * 16 + l15) * 136 + ks * 32 + l4 * 8);
      cb[j] = MFMA16(a, b, cb[j]);
    }
#pragma unroll
    for (int i = 0; i < 4; ++i) {
      bf16x8 b0 = *(const bf16x8*)(St + (i * 16 + l15) * 136 + ks * 32 + l4 * 8);
      bf16x8 b1 = *(const bf16x8*)(St + 64 * 136 + (i * 16 + l15) * 136 + ks * 32 + l4 * 8);
      af[i] = MFMA16(a, b0, af[i]);
      ab[i] = MFMA16(a, b1, ab[i]);
    }
  }
  __syncthreads();
  f32x4 Y[4];
  {
    float cs0l[4], cs1l[4];
#pragma unroll
    for (int r = 0; r < 4; ++r) { int l = 16 * w + l4 * 4 + r; cs0l[r] = scs[l]; cs1l[r] = scs[128 + l]; }
#pragma unroll
    for (int j = 0; j < 8; ++j) {
      const int s = j * 16 + l15;
      const float cs0s = scs[s], cs1s = scs[128 + s], dt0s = sdt[s], dt1s = sdt[128 + s];
#pragma unroll
      for (int r = 0; r < 4; ++r) {
        const int l = 16 * w + l4 * 4 + r;
        float f;
        if (l > s) f = __expf(cs0l[r] - cs0s) * dt0s;
        else if (l < s) f = __expf(cs1l[r] - cs1s) * dt1s;
        else f = dt0s + dt1s;
        Bs[l * 136 + s] = f2bf(cb[j][r] * f);
      }
    }
#pragma unroll
    for (int r = 0; r < 4; ++r) {
      float e0 = __expf(cs0l[r]), e1 = __expf(cs1l[r]);
#pragma unroll
      for (int i = 0; i < 4; ++i) Y[i][r] = af[i][r] * e0 + ab[i][r] * e1;
    }
  }
  __syncthreads();
#pragma unroll
  for (int ks = 0; ks < 4; ++ks) {
    bf16x8 a = *(const bf16x8*)(Bs + (16 * w + l15) * 136 + ks * 32 + l4 * 8);
#pragma unroll
    for (int i = 0; i < 4; ++i) {
      bf16x8 b = *(const bf16x8*)(xT + (i * 16 + l15) * 136 + ks * 32 + l4 * 8);
      Y[i] = MFMA16(a, b, Y[i]);
    }
  }
  {
    u16* C0 = (u16*)(p.ws + OFF_C0A);
    const float dsk = p.in[16][h] + p.in[16][16 + h];
    float ss[4] = {0.f, 0.f, 0.f, 0.f};
#pragma unroll
    for (int i = 0; i < 4; ++i) {
      const int pp = i * 16 + l15;
#pragma unroll
      for (int r = 0; r < 4; ++r) {
        const int l = 16 * w + l4 * 4 + r;
        const size_t off = (size_t)(it.row0 + l) * LDC0 + h * 64 + pp;
        float xv = bf2f(xT[pp * 136 + l]);
        float y = Y[i][r] + xv * dsk;
        float z = bf2f(C0[off]);
        float gv = y * silu(z);
        C0[off] = f2bf(gv);
        ss[r] += gv * gv;
      }
    }
    float* rss = (float*)(p.ws + OFF_ROWSS);
#pragma unroll
    for (int r = 0; r < 4; ++r) {
      float s = ss[r];
      s += __shfl_xor(s, 1); s += __shfl_xor(s, 2); s += __shfl_xor(s, 4); s += __shfl_xor(s, 8);
      if (l15 == 0) rss[(size_t)(it.row0 + 16 * w + l4 * 4 + r) * 16 + h] = s;
    }
  }
  __syncthreads();
}

DI void phase_hyena(const Params& p, int it, unsigned char* smem) {
  const int cfg = it < 256 ? 1 : 0;
  const int c0 = (it & 255) * 4;
  const int L = cfg ? 4096 : 256;
  const int A = L >> 5;
  const int lgA = cfg ? 7 : 3;
  const int rowbase = cfg ? NPROMPT : 0;
  u16* vxs = (u16*)smem;
  u16* hrs = vxs + 4 * 10240;
  const int tid = threadIdx.x, lane = tid & 63, w = tid >> 6;
  const u16* UT = (const u16*)(p.ws + OFF_UT);
  const float* cw = p.in[18]; const float* cbv = p.in[19];
  for (int id = tid; id < 4 * 1024; id += NT) {
    const int ch = id >> 10, blk8 = id & 1023;
    const int c = c0 + ch;
    const int pos = blk8 * 8;
    const int tl = pos & (L - 1);
    float res[8];
#pragma unroll
    for (int e = 0; e < 8; ++e) res[e] = 1.f;
#pragma unroll
    for (int which = 1; which <= 2; ++which) {
      const int uc = which * 1024 + c;
      const u16* q = UT + (size_t)uc * MROWS + rowbase + pos;
      float xv[10];
      u32x4 v = *(const u32x4*)q;
      unpack8(v, xv + 1);
      xv[0] = (tl > 0) ? bf2f(q[-1]) : 0.f;
      xv[9] = (tl + 8 < L) ? bf2f(q[8]) : 0.f;
      const float w0 = cw[uc], w1 = cw[3072 + uc], w2 = cw[6144 + uc], bb = cbv[uc];
#pragma unroll
      for (int e = 0; e < 8; ++e) res[e] *= (bb + w0 * xv[e] + w1 * xv[e + 1] + w2 * xv[e + 2]);
    }
    const int n = pos >> 5, k = pos & 31;
    *(u32x4*)(vxs + ch * 10240 + n * 40 + k) = pack8(res);
  }
  {
    const u16* HF = (const u16*)((const unsigned char*)p.out + (cfg ? OUT_HF4096 : OUT_HF256));
    const int nv = (2 * L) >> 3;
    for (int id = tid; id < 4 * nv; id += NT) {
      int ch = id / nv, v8 = id - ch * nv;
      *(u32x4*)(hrs + ch * 2 * L + v8 * 8) = *(const u32x4*)(HF + (size_t)(c0 + ch) * 2 * L + v8 * 8);
    }
  }
  __syncthreads();
  const int ch = w >> 1, wv = w & 1;
  const int l31 = lane & 31, kh = lane >> 5;
  const u16* vx = vxs + ch * 10240;
  const u16* hr = hrs + ch * 2 * L;
  f32x16 acc[4];
#pragma unroll
  for (int j = 0; j < 4; ++j)
#pragma unroll
    for (int r = 0; r < 16; ++r) acc[j][r] = 0.f;
  int ncol[4], acol[4];
#pragma unroll
  for (int j = 0; j < 4; ++j) { ncol[j] = 128 * wv + 32 * j + l31; acol[j] = ncol[j] & (A - 1); }
  for (int d = -(A - 1); d <= A - 1; ++d) {
#pragma unroll
    for (int khalf = 0; khalf < 2; ++khalf) {
      const int idx0 = L - 32 * d - l31 + 16 * khalf + 8 * kh;
      bf16x8 af;
#pragma unroll
      for (int e = 0; e < 8; ++e) af[e] = (short)hr[idx0 + e];
#pragma unroll
      for (int j = 0; j < 4; ++j) {
        const int asrc = acol[j] - d;
        const bool valid = (asrc >= 0) && (asrc < A);
        if (__builtin_amdgcn_ballot_w64(valid) != 0ull) {
          bf16x8 bfr = (bf16x8){0, 0, 0, 0, 0, 0, 0, 0};
          if (valid) bfr = *(const bf16x8*)(vx + (ncol[j] - d) * 40 + 16 * khalf + 8 * kh);
          acc[j] = MFMA32(af, bfr, acc[j]);
        }
      }
    }
  }
  {
    const int c = c0 + ch;
    const float hb = p.in[26][c];
    const float w0 = cw[c], w1 = cw[3072 + c], w2 = cw[6144 + c], bb = cbv[c];
    const u16* x0row = UT + (size_t)c * MROWS + rowbase;
    u16* grow = (u16*)(p.ws + OFF_UT) + (size_t)(3072 + c) * MROWS + rowbase;
#pragma unroll
    for (int j = 0; j < 4; ++j) {
      const int n = ncol[j];
#pragma unroll
      for (int r = 0; r < 16; ++r) {
        const int i = (r & 3) + 8 * (r >> 2) + 4 * kh;
        const int pos = 32 * n + i;
        const int tl = pos & (L - 1);
        float xm = tl > 0 ? bf2f(x0row[pos - 1]) : 0.f;
        float xc = bf2f(x0row[pos]);
        float xp = tl < L - 1 ? bf2f(x0row[pos + 1]) : 0.f;
        float x0 = bb + w0 * xm + w1 * xc + w2 * xp;
        float vxv = bf2f(vx[n * 40 + i]);
        float gv = bf2f(grow[pos]);
        float y = x0 * (acc[j][r] + vxv * hb) * silu(gv);
        grow[pos] = f2bf(y);
      }
    }
  }
  (void)lgA;
  __syncthreads();
}

#define VTP 776
DI void phase_attn(const Params& p, int item, unsigned char* smem) {
  u16* VT = (u16*)smem;
  u16* Pb = VT + 64 * VTP;
  float* mrg = (float*)(Pb + 8 * 16 * 40);
  float* rp = mrg + 4 * 64 * 24;
  const int tid = threadIdx.x, lane = tid & 63, w = tid >> 6;
  const int l15 = lane & 15, l4 = lane >> 4;
  const u16* C1 = (const u16*)(p.ws + OFF_C1);
  const bool lat = item < 2048;
  int b, h, rr = 0, rows0 = 0, qrow0, keyrow0;
  if (lat) { b = item >> 10; h = (item >> 6) & 15; rr = item & 63; rows0 = min(max(rr - 4, 0), 56);
             qrow0 = NPROMPT + b * 4096 + rr * 64; keyrow0 = NPROMPT + b * 4096 + rows0 * 64; }
  else { int q = item - 2048; b = q >> 6; h = (q >> 2) & 15; int qt = q & 3; qrow0 = b * 256 + qt * 64; keyrow0 = b * 256; }
  {
    const int nloc = lat ? 512 : 256;
    for (int id = tid; id < nloc * 8; id += NT) {
      int key = id >> 3, d0 = (id & 7) * 8;
      u32x4 v = *(const u32x4*)(C1 + (size_t)(keyrow0 + key) * 4096 + 2048 + h * 64 + d0);
      float f[8]; unpack8(v, f);
#pragma unroll
      for (int e = 0; e < 8; ++e) VT[(d0 + e) * VTP + key] = f2bf(f[e]);
    }
    if (lat) {
      const float* cv = p.in[4] + ((size_t)b * 16 + h) * 256 * 64;
      for (int id = tid; id < 256 * 8; id += NT) {
        int key = id >> 3, d0 = (id & 7) * 8;
        float4 a = *(const float4*)(cv + key * 64 + d0), c = *(const float4*)(cv + key * 64 + d0 + 4);
        float f[8] = {a.x, a.y, a.z, a.w, c.x, c.y, c.z, c.w};
#pragma unroll
        for (int e = 0; e < 8; ++e) VT[(d0 + e) * VTP + 512 + key] = f2bf(f[e]);
      }
      for (int id = tid; id < 465; id += NT) rp[id] = p.in[29][h * 465 + id];
    }
  }
  __syncthreads();
  const int jq = w & 3, gk = w >> 2;
  const int qbase = qrow0 + jq * 16;
  bf16x8 qa[2];
#pragma unroll
  for (int ks = 0; ks < 2; ++ks) qa[ks] = *(const bf16x8*)(C1 + (size_t)(qbase + l15) * 4096 + h * 64 + ks * 32 + l4 * 8);
  const int ntile = lat ? 8 : 4;
  const int cstart = min(max(16 * jq - 8, 0), 32);
  const bool fp32k = lat && gk == 1;
  const float* ck = p.in[3] + ((size_t)b * 16 + h) * 256 * 64;
  auto loadk = [&](int tt, bf16x8 (&kb)[2][2]) {
#pragma unroll
    for (int jt = 0; jt < 2; ++jt) {
      if (fp32k) {
        const int key = tt * 32 + jt * 16 + l15;
#pragma unroll
        for (int ks = 0; ks < 2; ++ks) {
          const float* q = ck + key * 64 + ks * 32 + l4 * 8;
          float4 a = *(const float4*)q, c = *(const float4*)(q + 4);
          float f[8] = {a.x, a.y, a.z, a.w, c.x, c.y, c.z, c.w};
          u32x4 pk = pack8(f);
          kb[jt][ks] = __builtin_bit_cast(bf16x8, pk);
        }
      } else {
        int krow;
        if (lat) krow = keyrow0 + tt * 64 + cstart + jt * 16 + l15;
        else krow = keyrow0 + gk * 128 + tt * 32 + jt * 16 + l15;
#pragma unroll
        for (int ks = 0; ks < 2; ++ks)
          kb[jt][ks] = *(const bf16x8*)(C1 + (size_t)krow * 4096 + 1024 + h * 64 + ks * 32 + l4 * 8);
      }
    }
  };
  float mrow[4], lrow[4];
  f32x4 O[4];
#pragma unroll
  for (int r = 0; r < 4; ++r) { mrow[r] = -1e30f; lrow[r] = 0.f; }
#pragma unroll
  for (int i = 0; i < 4; ++i) O[i] = (f32x4){0.f, 0.f, 0.f, 0.f};
  u16* Pw = Pb + w * 16 * 40;
  bf16x8 kn[2][2];
  loadk(0, kn);
  for (int tt = 0; tt < ntile; ++tt) {
    bf16x8 kc[2][2];
#pragma unroll
    for (int jt = 0; jt < 2; ++jt)
#pragma unroll
      for (int ks = 0; ks < 2; ++ks) kc[jt][ks] = kn[jt][ks];
    if (tt + 1 < ntile) loadk(tt + 1, kn);
    f32x4 S[2];
#pragma unroll
    for (int jt = 0; jt < 2; ++jt) {
      S[jt] = (f32x4){0.f, 0.f, 0.f, 0.f};
      S[jt] = MFMA16(qa[0], kc[jt][0], S[jt]);
      S[jt] = MFMA16(qa[1], kc[jt][1], S[jt]);
    }
    float sv[2][4];
#pragma unroll
    for (int jt = 0; jt < 2; ++jt)
#pragma unroll
      for (int r = 0; r < 4; ++r) {
        float s = S[jt][r] * 0.125f;
        if (lat && gk == 0) {
          const int kcn = cstart + jt * 16 + l15;
          const int qc = jq * 16 + l4 * 4 + r;
          const int col0 = min(max(qc - 8, 0), 48);
          const int kr = rows0 + tt;
          const int dr = kr - rr + 7;
          const int dc = min(max(kcn - qc + 15, 0), 30);
          s += rp[dr * 31 + dc];
          if (kcn < col0 || kcn >= col0 + 16) s = -INFINITY;
        }
        sv[jt][r] = s;
      }
    float alpha[4];
#pragma unroll
    for (int r = 0; r < 4; ++r) {
      float mx = fmaxf(sv[0][r], sv[1][r]);
      mx = fmaxf(mx, __shfl_xor(mx, 1)); mx = fmaxf(mx, __shfl_xor(mx, 2));
      mx = fmaxf(mx, __shfl_xor(mx, 4)); mx = fmaxf(mx, __shfl_xor(mx, 8));
      float mn = fmaxf(mrow[r], mx);
      alpha[r] = __expf(mrow[r] - mn);
      mrow[r] = mn;
      float p0 = __expf(sv[0][r] - mn), p1 = __expf(sv[1][r] - mn);
      lrow[r] = lrow[r] * alpha[r] + p0 + p1;
      Pw[(l4 * 4 + r) * 40 + l15] = f2bf(p0);
      Pw[(l4 * 4 + r) * 40 + 16 + l15] = f2bf(p1);
    }
#pragma unroll
    for (int i = 0; i < 4; ++i)
#pragma unroll
      for (int r = 0; r < 4; ++r) O[i][r] *= alpha[r];
    asm volatile("s_waitcnt lgkmcnt(0)" ::: "memory");
    bf16x8 pa = *(const bf16x8*)(Pw + l15 * 40 + l4 * 8);
    int keyoff;
    if (lat) keyoff = gk == 0 ? tt * 64 + cstart : 512 + tt * 32;
    else keyoff = gk * 128 + tt * 32;
#pragma unroll
    for (int i = 0; i < 4; ++i) {
      bf16x8 vb = *(const bf16x8*)(VT + (i * 16 + l15) * VTP + keyoff + l4 * 8);
      O[i] = MFMA16(pa, vb, O[i]);
    }
    asm volatile("s_waitcnt lgkmcnt(0)" ::: "memory");
  }
#pragma unroll
  for (int r = 0; r < 4; ++r) {
    float s = lrow[r];
    s += __shfl_xor(s, 1); s += __shfl_xor(s, 2); s += __shfl_xor(s, 4); s += __shfl_xor(s, 8);
    lrow[r] = s;
  }
  if (gk == 1) {
    float* m = mrg + ((w - 4) * 64 + lane) * 24;
#pragma unroll
    for (int r = 0; r < 4; ++r) { m[r] = mrow[r]; m[4 + r] = lrow[r]; }
#pragma unroll
    for (int i = 0; i < 4; ++i)
#pragma unroll
      for (int r = 0; r < 4; ++r) m[8 + i * 4 + r] = O[i][r];
  }
  __syncthreads();
  if (gk == 0) {
    const float* m = mrg + (w * 64 + lane) * 24;
    u16* C1w = (u16*)(p.ws + OFF_C1);
#pragma unroll
    for (int r = 0; r < 4; ++r) {
      float m1 = m[r], l1 = m[4 + r];
      float mn = fmaxf(mrow[r], m1);
      float e0 = __expf(mrow[r] - mn), e1 = __expf(m1 - mn);
      float inv = 1.f / (lrow[r] * e0 + l1 * e1);
      const int row = qbase + l4 * 4 + r;
#pragma unroll
      for (int i = 0; i < 4; ++i) {
        float o = (O[i][r] * e0 + m[8 + i * 4 + r] * e1) * inv;
        const int dcol = h * 64 + i * 16 + l15;
        float gv = bf2f(C1[(size_t)row * 4096 + 3072 + dcol]);
        C1w[(size_t)row * 4096 + dcol] = f2bf(o * silu(gv));
      }
    }
  }
  __syncthreads();
}

#define NPHASE 12
__global__ void __launch_bounds__(NT) mega(Params p, int ph0, int ph1) {
  __shared__ __attribute__((aligned(16))) unsigned char smem[SMEM_BYTES];
  const int nb = gridDim.x, bid = blockIdx.x;
#define PH_BEGIN(k) if (ph0 <= (k) && (k) < ph1) { if ((k) > ph0) cg::this_grid().sync();
#define PH_END }
  {
    {
      PH_BEGIN(0) {
        for (int t = bid; t < 544 + 192 + 3488; t += nb) {
          if (t < 544) phase_filter(p, t, smem);
          else if (t < 736) phase_ada(p, t - 544, smem);
          else {
            int q = t - 736;
            if (q < 1696) transpose_tile<float>(p.in[10], 6688, 6688, (u16*)(p.ws + OFF_WINE), 1024, q & 15, q >> 4, nullptr, 0, smem);
            else if (q < 2208) { q -= 1696; transpose_tile<float>(p.in[11], 1024, 1024, (u16*)(p.ws + OFF_WOUTE), 2048, q & 31, q >> 5, p.in[17], 1024, smem); }
            else if (q < 3232) { q -= 2208; transpose_tile<float>(p.in[27], 4096, 4096, (u16*)(p.ws + OFF_WINO), 1024, q & 15, q >> 4, nullptr, 0, smem); }
            else { q -= 3232; transpose_tile<float>(p.in[28], 1024, 1024, (u16*)(p.ws + OFF_WOUTO), 1024, q & 15, q >> 4, nullptr, 0, smem); }
          }
        }
      } PH_END
      PH_BEGIN(1) {
        for (int t = bid; t < 2048; t += nb) phase_norm(p, t, 0, p.in[0], p.in[1], (u16*)((unsigned char*)p.out + OUT_H0));
      } PH_END
      PH_BEGIN(2) {
        GemmArgs g; g.A1 = (const u16*)((const unsigned char*)p.out + OUT_H0); g.lda1 = 1024; g.A2 = g.A1; g.lda2 = 1024; g.ksplit = 1 << 30;
        g.Bt = (const u16*)(p.ws + OFF_WINE); g.K = 1024;
        for (int t = bid; t < 64 * 53; t += nb) gemm_tile<0>(p, g, (t & 63) * 256, (t >> 6) * 128, smem);
      } PH_END
      PH_BEGIN(3) {
        for (int t = bid; t < 512 + 2048; t += nb) {
          if (t < 512) phase_hyena(p, t, smem);
          else phase_ssd_states(p, t - 512, smem);
        }
      } PH_END
      PH_BEGIN(4) {
        for (int t = bid; t < 34 * 64; t += nb) phase_scan(p, t);
      } PH_END
      PH_BEGIN(5) {
        for (int t = bid; t < 2048 + 4096; t += nb) {
          if (t < 2048) phase_ssd_out(p, t, smem);
          else {
            int q = t - 2048;
            transpose_tile<u16>((const u16*)(p.ws + OFF_UT) + (size_t)3072 * MROWS, MROWS, MROWS,
                                (u16*)((unsigned char*)p.out + OUT_YB), 1024, q & 15, q >> 4, nullptr, 0, smem);
          }
        }
      } PH_END
      PH_BEGIN(6) {
        GemmArgs g; g.A1 = (const u16*)(p.ws + OFF_C0A); g.lda1 = LDC0;
        g.A2 = (const u16*)((const unsigned char*)p.out + OUT_YB); g.lda2 = 1024; g.ksplit = 1024;
        g.Bt = (const u16*)(p.ws + OFF_WOUTE); g.K = 2048;
        for (int t = bid; t < 64 * 8; t += nb) gemm_tile<1>(p, g, (t & 63) * 256, (t >> 6) * 128, smem);
      } PH_END
      PH_BEGIN(7) {
        const float* x1 = (const float*)(p.ws + OFF_X1);
        for (int t = bid; t < 2048; t += nb) phase_norm(p, t, 1, x1, x1 + (size_t)NPROMPT * 1024, (u16*)(p.ws + OFF_H1));
      } PH_END
      PH_BEGIN(8) {
        GemmArgs g; g.A1 = (const u16*)(p.ws + OFF_H1); g.lda1 = 1024; g.A2 = g.A1; g.lda2 = 1024; g.ksplit = 1 << 30;
        g.Bt = (const u16*)(p.ws + OFF_WINO); g.K = 1024;
        for (int t = bid; t < 64 * 32; t += nb) gemm_tile<2>(p, g, (t & 63) * 256, (t >> 6) * 128, smem);
      } PH_END
      PH_BEGIN(9) {
        for (int t = bid; t < 4096; t += nb) phase_attn(p, t, smem);
      } PH_END
      PH_BEGIN(10) {
        GemmArgs g; g.A1 = (const u16*)(p.ws + OFF_C1); g.lda1 = 4096; g.A2 = g.A1; g.lda2 = 4096; g.ksplit = 1 << 30;
        g.Bt = (const u16*)(p.ws + OFF_WOUTO); g.K = 1024;
        for (int t = bid; t < 64 * 8; t += nb) gemm_tile<3>(p, g, (t & 63) * 256, (t >> 6) * 128, smem);
      } PH_END
      PH_BEGIN(11) {
        for (int t = bid; t < 2048; t += nb) phase_final_norm(p, t);
      } PH_END
    }
  }
}

extern "C" void kernel_launch(void* const* d_in, const int* in_sizes, int n_in, void* d_out, int out_size,
                              void* d_ws, size_t ws_size, hipStream_t stream) {
  static int grid_blocks = 0;
  if (!grid_blocks) {
    int dev = 0, cus = 0, per_cu = 0;
    hipGetDevice(&dev);
    hipDeviceGetAttribute(&cus, hipDeviceAttributeMultiprocessorCount, dev);
    hipOccupancyMaxActiveBlocksPerMultiprocessor(&per_cu, mega, NT, 0);
    if (per_cu < 1) per_cu = 1;
    grid_blocks = cus * per_cu;
  }
  Params p{};
  for (int i = 0; i < 31; ++i) p.in[i] = (const float*)d_in[i];
  p.out = (float*)d_out;
  p.ws = (unsigned char*)d_ws;
#if MULTI
  for (int ph = 0; ph < NPHASE; ++ph) {
    hipLaunchKernelGGL(mega, dim3(grid_blocks), dim3(NT), 0, stream, p, ph, ph + 1);
  }
#else
  int ph0 = 0, ph1 = NPHASE;
  void* args[] = {&p, &ph0, &ph1};
  hipError_t e = hipLaunchCooperativeKernel((void*)mega, dim3(grid_blocks), dim3(NT), args, 0, stream);
  if (e != hipSuccess) fprintf(stderr, "cooperative launch failed: %s (grid %d)\n", hipGetErrorString(e), grid_blocks);
#endif
}
```

```cpp
#include <hip/hip_runtime.h>
#include <hip/hip_cooperative_groups.h>
#include <cstdio>
namespace cg = cooperative_groups;

#ifndef REP_MASK
#define REP_MASK 0
#endif
#define OFF_DUMMY 249126912ul
#ifndef MULTI
#define MULTI 0
#endif

#define NT 512
#define DI __device__ __forceinline__
typedef unsigned short u16;
typedef __attribute__((ext_vector_type(8))) short bf16x8;
typedef __attribute__((ext_vector_type(4))) float f32x4;
typedef __attribute__((ext_vector_type(16))) float f32x16;
typedef __attribute__((ext_vector_type(4))) unsigned u32x4;
typedef __attribute__((ext_vector_type(2))) unsigned u32x2;

#define MFMA16(a, b, c) __builtin_amdgcn_mfma_f32_16x16x32_bf16((a), (b), (c), 0, 0, 0)
#define MFMA32(a, b, c) __builtin_amdgcn_mfma_f32_32x32x16_bf16((a), (b), (c), 0, 0, 0)

#define MROWS 16384
#define NPROMPT 8192
#define LDC0 2592
#define NPAD0 6784
#define SMEM_BYTES 151552

#define OFF_WINE   0ul
#define OFF_WOUTE  14155776ul
#define OFF_WINO   18350080ul
#define OFF_WOUTO  26738688ul
#define OFF_MOD    28835840ul
#define OFF_ROWSS  28909568ul
#define OFF_CDEC   29958144ul
#define OFF_UT     29974528ul
#define OFF_C0A    164192256ul
#define OFF_X1     OFF_UT
#define OFF_C1     97083392ul
#define OFF_H1     231301120ul
#define OUT_H0     0ul
#define OUT_YB     0ul
#define OUT_HF4096 33554432ul
#define OUT_HF256  (33554432ul + 16777216ul)
#define OUT_SBUF   100663296ul
#define O_YP 0ul
#define O_YS 8388608ul
#define O_ST 16777216ul
#define O_NK 25165824ul
#define O_NV 33554432ul

struct Params {
  const float* in[31];
  float* out;
  unsigned char* ws;
};

DI u16 f2bf(float x) { unsigned u = __float_as_uint(x); u += 0x7fffu + ((u >> 16) & 1u); return (u16)(u >> 16); }
DI float bf2f(u16 h) { return __uint_as_float(((unsigned)h) << 16); }
DI unsigned pk2(float a, float b) { return (unsigned)f2bf(a) | ((unsigned)f2bf(b) << 16); }
DI float silu(float x) { return x / (1.f + __expf(-x)); }
DI float bflo(unsigned u) { return __uint_as_float(u << 16); }
DI float bfhi(unsigned u) { return __uint_as_float(u & 0xffff0000u); }
DI void unpack8(const u32x4& v, float* f) {
  f[0] = bflo(v[0]); f[1] = bfhi(v[0]); f[2] = bflo(v[1]); f[3] = bfhi(v[1]);
  f[4] = bflo(v[2]); f[5] = bfhi(v[2]); f[6] = bflo(v[3]); f[7] = bfhi(v[3]);
}
DI u32x4 pack8(const float* f) {
  u32x4 o; o[0] = pk2(f[0], f[1]); o[1] = pk2(f[2], f[3]); o[2] = pk2(f[4], f[5]); o[3] = pk2(f[6], f[7]); return o;
}
DI int row_group(int row) { return row < NPROMPT ? 0 : 1 + ((row - NPROMPT) >> 12); }

DI void phase_ada(const Params& p, int t, unsigned char* smem) {
  float* sc = (float*)smem;
  float* red = sc + 3072;
  const int layer = t / 96, cc = t % 96;
  const int tid = threadIdx.x;
  for (int i = tid; i < 3072; i += NT) {
    int g = i >> 10, k = i & 1023;
    float v = (g == 0) ? p.in[6][k] : p.in[5][(g - 1) * 1024 + k];
    sc[i] = silu(v);
  }
  __syncthreads();
  const int col = tid & 31, kg = tid >> 5;
  const float* w = p.in[8] + (size_t)layer * 1024 * 3072 + cc * 32 + col;
  float a0 = 0.f, a1 = 0.f, a2 = 0.f;
#pragma unroll 8
  for (int k = kg * 64; k < kg * 64 + 64; ++k) {
    float wv = w[(size_t)k * 3072];
    a0 += sc[k] * wv; a1 += sc[1024 + k] * wv; a2 += sc[2048 + k] * wv;
  }
  red[(kg * 3 + 0) * 32 + col] = a0;
  red[(kg * 3 + 1) * 32 + col] = a1;
  red[(kg * 3 + 2) * 32 + col] = a2;
  __syncthreads();
  if (tid < 96) {
    int g = tid >> 5, c = tid & 31;
    float s = 0.f;
    for (int q = 0; q < 16; ++q) s += red[(q * 3 + g) * 32 + c];
    int colg = cc * 32 + c;
    float* mod = (float*)(p.ws + OFF_MOD);
    mod[(layer * 3 + g) * 3072 + colg] = s + p.in[9][layer * 3072 + colg];
  }
  __syncthreads();
}

DI float ld_src(const float* q) { return *q; }
DI float ld_src(const u16* q) { return bf2f(*q); }
template <typename ST>
DI void transpose_tile(const ST* src, int N, int ldsrc, u16* dst, int lddst, int kt, int nt,
                       const float* kscale, int kscale_n, unsigned char* smem) {
  float* tile = (float*)smem;
  const int tid = threadIdx.x;
  const int c = tid & 63, r0 = tid >> 6;
#pragma unroll
  for (int i = 0; i < 8; ++i) {
    int r = r0 + 8 * i;
    int k = kt * 64 + r, n = nt * 64 + c;
    float v = 0.f;
    if (n < N) {
      v = ld_src(src + (size_t)k * ldsrc + n);
      if (kscale != nullptr && k < kscale_n) v *= kscale[k];
    }
    tile[r * 65 + c] = v;
  }
  __syncthreads();
  const int rr = tid >> 3, c8 = (tid & 7) * 8;
  float f[8];
#pragma unroll
  for (int e = 0; e < 8; ++e) f[e] = tile[(c8 + e) * 65 + rr];
  *(u32x4*)(dst + (size_t)(nt * 64 + rr) * lddst + kt * 64 + c8) = pack8(f);
  __syncthreads();
}

DI void phase_filter(const Params& p, int t, unsigned char* smem) {
  const int cfg = t < 512 ? 1 : 0;
  const int L = cfg ? 4096 : 256;
  const int t0 = (cfg ? t : t - 512) * 8;
  float* feats = (float*)smem;
  float* h1 = feats + 8 * 36;
  float* h2 = h1 + 512;
  const float* w1 = p.in[20]; const float* b1 = p.in[21]; const float* w2 = p.in[22];
  const float* b2 = p.in[23]; const float* w3 = p.in[24]; const float* fr = p.in[25];
  const int tid = threadIdx.x;
  if (tid < 8 * 33) {
    int tt = tid / 33, i = tid % 33;
    int tpos = t0 + tt;
    float tv = (float)tpos / (float)(L - 1);
    float wv = 6.283185307179586f * (float)tpos / (float)L;
    float f;
    if (i == 0) f = tv;
    else if (i <= 16) { float fi = 1e-4f + (float)(i - 1) * ((15.f - 1e-4f) / 15.f); f = cosf(fi * wv); }
    else { float fi = 1e-4f + (float)(i - 17) * ((15.f - 1e-4f) / 15.f); f = -sinf(fi * wv); }
    feats[tt * 36 + i] = f;
  }
  __syncthreads();
  {
    int tt = tid >> 6, j = tid & 63;
    float s = b1[j];
#pragma unroll 4
    for (int i = 0; i < 33; ++i) s += feats[tt * 36 + i] * w1[i * 64 + j];
    h1[tt * 64 + j] = sinf(fr[j] * s);
  }
  __syncthreads();
  {
    int tt = tid >> 6, j = tid & 63;
    float s = b2[j];
#pragma unroll 8
    for (int i = 0; i < 64; ++i) s += h1[tt * 64 + i] * w2[i * 64 + j];
    h2[tt * 64 + j] = sinf(fr[j] * s);
  }
  __syncthreads();
  float acc[4][8];
#pragma unroll
  for (int q = 0; q < 4; ++q)
#pragma unroll
    for (int tt = 0; tt < 8; ++tt) acc[q][tt] = 0.f;
#pragma unroll 2
  for (int k = 0; k < 64; ++k) {
    float wv[4];
#pragma unroll
    for (int q = 0; q < 4; ++q) wv[q] = w3[k * 2048 + tid + 512 * q];
#pragma unroll
    for (int tt = 0; tt < 8; ++tt) {
      float hv = h2[tt * 64 + k];
#pragma unroll
      for (int q = 0; q < 4; ++q) acc[q][tt] += hv * wv[q];
    }
  }
  u16* HF = (u16*)((unsigned char*)p.out + (cfg ? OUT_HF4096 : OUT_HF256));
  const float lo = -15.350567286626973f;
  const float hi = -3.0701134573253945f;
#pragma unroll
  for (int q = 0; q < 4; ++q) {
    int col = tid + 512 * q;
    int dir = col >> 10, c = col & 1023;
    float ad = fabsf(lo + (float)c * ((hi - lo) / 1023.f));
    u16* hc = HF + (size_t)c * (2 * L);
#pragma unroll
    for (int tt = 0; tt < 8; ++tt) {
      int tpos = t0 + tt;
      float tv = (float)tpos / (float)(L - 1);
      float val = acc[q][tt] * expf(-tv * ad);
      if (dir == 0) hc[L - tpos] = f2bf(val);
      else if (tpos > 0) hc[L + tpos] = f2bf(val);
      else hc[0] = 0;
    }
  }
  __syncthreads();
}

DI float wave_sum(float v) {
#pragma unroll
  for (int o = 32; o >= 1; o >>= 1) v += __shfl_xor(v, o);
  return v;
}
DI void phase_norm(const Params& p, int t, int layer, const float* xa, const float* xb, u16* dst) {
  const int lane = threadIdx.x & 63, w = threadIdx.x >> 6;
  const int row = t * 8 + w;
  const float* src = row < NPROMPT ? xa + (size_t)row * 1024 : xb + (size_t)(row - NPROMPT) * 1024;
  const int g = row_group(row);
  float4 v[4];
  float ss = 0.f;
#pragma unroll
  for (int i = 0; i < 4; ++i) {
    v[i] = *(const float4*)(src + i * 256 + lane * 4);
    ss += v[i].x * v[i].x + v[i].y * v[i].y + v[i].z * v[i].z + v[i].w * v[i].w;
  }
  ss = wave_sum(ss);
  const float rstd = rsqrtf(ss * (1.f / 1024.f) + 1e-6f);
  const float* nw = p.in[7] + layer * 1024;
  const float* shift = (const float*)(p.ws + OFF_MOD) + (layer * 3 + g) * 3072;
  const float* scale = shift + 1024;
#pragma unroll
  for (int i = 0; i < 4; ++i) {
    int col = i * 256 + lane * 4;
    float4 nwv = *(const float4*)(nw + col);
    float4 sc = *(const float4*)(scale + col);
    float4 sh = *(const float4*)(shift + col);
    float o0 = v[i].x * rstd * nwv.x * (1.f + sc.x) + sh.x;
    float o1 = v[i].y * rstd * nwv.y * (1.f + sc.y) + sh.y;
    float o2 = v[i].z * rstd * nwv.z * (1.f + sc.z) + sh.z;
    float o3 = v[i].w * rstd * nwv.w * (1.f + sc.w) + sh.w;
    u32x2 o; o[0] = pk2(o0, o1); o[1] = pk2(o2, o3);
    *(u32x2*)(dst + (size_t)row * 1024 + col) = o;
  }
}
DI void phase_final_norm(const Params& p, int t) {
  const int lane = threadIdx.x & 63, w = threadIdx.x >> 6;
  const int row = t * 8 + w;
  float* src = p.out + (size_t)row * 1024;
  float4 v[4];
  float ss = 0.f;
#pragma unroll
  for (int i = 0; i < 4; ++i) {
    v[i] = *(const float4*)(src + i * 256 + lane * 4);
    ss += v[i].x * v[i].x + v[i].y * v[i].y + v[i].z * v[i].z + v[i].w * v[i].w;
  }
  ss = wave_sum(ss);
  const float rstd = rsqrtf(ss * (1.f / 1024.f) + 1e-6f);
  const float* nw = p.in[30];
#pragma unroll
  for (int i = 0; i < 4; ++i) {
    int col = i * 256 + lane * 4;
    float4 nwv = *(const float4*)(nw + col);
    float4 o;
    o.x = v[i].x * rstd * nwv.x; o.y = v[i].y * rstd * nwv.y; o.z = v[i].z * rstd * nwv.z; o.w = v[i].w * rstd * nwv.w;
    *(float4*)(src + col) = o;
  }
}

struct GemmArgs {
  const u16* A1; int lda1;
  const u16* A2; int lda2;
  int ksplit;
  const u16* Bt; int K;
};
template <int EPI>
DI void gemm_tile(const Params& p, const GemmArgs& g, int m0, int n0, unsigned char* smem) {
  u16* As = (u16*)smem;
  u16* Bs = As + 256 * 72;
  float* rs = (float*)(Bs + 128 * 72);
  const int tid = threadIdx.x, lane = tid & 63, w = tid >> 6;
  const int wm = (w >> 1) * 64, wn = (w & 1) * 64;
  const int l15 = lane & 15, l4 = lane >> 4;
  f32x4 acc[4][4];
#pragma unroll
  for (int i = 0; i < 4; ++i)
#pragma unroll
    for (int j = 0; j < 4; ++j) acc[i][j] = (f32x4){0.f, 0.f, 0.f, 0.f};
  if (EPI == 1) {
    if (tid < 256) {
      const float* rss = (const float*)(p.ws + OFF_ROWSS) + (size_t)(m0 + tid) * 16;
      float s = 0.f;
#pragma unroll
      for (int q = 0; q < 16; ++q) s += rss[q];
      rs[tid] = rsqrtf(s * (1.f / 1024.f) + 1e-6f);
    }
  }
  u32x4 ra[4], rb[2];
  const int KT = g.K >> 6;
  auto loadg = [&](int kt) {
    const int k0 = kt << 6;
    const u16* Ab; int lda; int kk;
    if (k0 < g.ksplit) { Ab = g.A1; lda = g.lda1; kk = k0; } else { Ab = g.A2; lda = g.lda2; kk = k0 - g.ksplit; }
#pragma unroll
    for (int i = 0; i < 4; ++i) {
      int id = tid + 512 * i; int r = id >> 3, c = (id & 7) * 8;
      ra[i] = *(const u32x4*)(Ab + (size_t)(m0 + r) * lda + kk + c);
    }
#pragma unroll
    for (int i = 0; i < 2; ++i) {
      int id = tid + 512 * i; int r = id >> 3, c = (id & 7) * 8;
      rb[i] = *(const u32x4*)(g.Bt + (size_t)(n0 + r) * g.K + k0 + c);
    }
  };
  loadg(0);
  for (int kt = 0; kt < KT; ++kt) {
#pragma unroll
    for (int i = 0; i < 4; ++i) {
      int id = tid + 512 * i; int r = id >> 3, c = (id & 7) * 8;
      *(u32x4*)(As + r * 72 + c) = ra[i];
    }
#pragma unroll
    for (int i = 0; i < 2; ++i) {
      int id = tid + 512 * i; int r = id >> 3, c = (id & 7) * 8;
      *(u32x4*)(Bs + r * 72 + c) = rb[i];
    }
    __syncthreads();
    if (kt + 1 < KT) loadg(kt + 1);
    if (EPI == 1) {
      if ((kt << 6) == g.ksplit) {
#pragma unroll
        for (int i = 0; i < 4; ++i)
#pragma unroll
          for (int r = 0; r < 4; ++r) {
            float sc = rs[wm + i * 16 + l4 * 4 + r];
#pragma unroll
            for (int j = 0; j < 4; ++j) acc[i][j][r] *= sc;
          }
      }
    }
#pragma unroll
    for (int ks = 0; ks < 2; ++ks) {
      bf16x8 a[4], b[4];
#pragma unroll
      for (int i = 0; i < 4; ++i) a[i] = *(const bf16x8*)(As + (wm + i * 16 + l15) * 72 + ks * 32 + l4 * 8);
#pragma unroll
      for (int j = 0; j < 4; ++j) b[j] = *(const bf16x8*)(Bs + (wn + j * 16 + l15) * 72 + ks * 32 + l4 * 8);
#pragma unroll
      for (int i = 0; i < 4; ++i)
#pragma unroll
        for (int j = 0; j < 4; ++j) acc[i][j] = MFMA16(a[i], b[j], acc[i][j]);
    }
    __syncthreads();
  }
#pragma unroll
  for (int i = 0; i < 4; ++i) {
    const int rbase = m0 + wm + i * 16 + l4 * 4;
#pragma unroll
    for (int j = 0; j < 4; ++j) {
      const int col = n0 + wn + j * 16 + l15;
      if (EPI == 0) {
        if (col < LDC0) {
          u16* C = (u16*)(p.ws + OFF_C0A);
#pragma unroll
          for (int r = 0; r < 4; ++r) C[(size_t)(rbase + r) * LDC0 + col] = f2bf(acc[i][j][r]);
        } else if (col < 6688) {
          u16* UT = (u16*)(p.ws + OFF_UT);
          u32x2 o; o[0] = pk2(acc[i][j][0], acc[i][j][1]); o[1] = pk2(acc[i][j][2], acc[i][j][3]);
          *(u32x2*)(UT + (size_t)(col - LDC0) * MROWS + rbase) = o;
        }
      } else if (EPI == 1) {
        float* X1 = (float*)(p.ws + OFF_X1);
        const float* mod = (const float*)(p.ws + OFF_MOD);
#pragma unroll
        for (int r = 0; r < 4; ++r) {
          int row = rbase + r;
          const float* xs = row < NPROMPT ? p.in[0] + (size_t)row * 1024 : p.in[1] + (size_t)(row - NPROMPT) * 1024;
          float gate = mod[(0 * 3 + row_group(row)) * 3072 + 2048 + col];
          X1[(size_t)row * 1024 + col] = xs[col] + gate * acc[i][j][r];
        }
      } else if (EPI == 2) {
        u16* C1 = (u16*)(p.ws + OFF_C1);
#pragma unroll
        for (int r = 0; r < 4; ++r) {
          int row = rbase + r;
          C1[(size_t)row * 4096 + col] = f2bf(acc[i][j][r]);
          if (row < NPROMPT && col >= 1024 && col < 3072) {
            int cc = col - 1024; int isv = cc >> 10; cc &= 1023;
            int hh = cc >> 6, d = cc & 63; int b = row >> 8, l = row & 255;
            float* o = p.out + (isv ? O_NV : O_NK);
            o[(((size_t)b * 16 + hh) * 256 + l) * 64 + d] = acc[i][j][r];
          }
        }
      } else {
        const float* X1 = (const float*)(p.ws + OFF_X1);
        const float* mod = (const float*)(p.ws + OFF_MOD);
#pragma unroll
        for (int r = 0; r < 4; ++r) {
          int row = rbase + r;
          float gate = mod[(1 * 3 + row_group(row)) * 3072 + 2048 + col];
          p.out[(size_t)row * 1024 + col] = X1[(size_t)row * 1024 + col] + gate * acc[i][j][r];
        }
      }
    }
  }
}


DI int lds_byte(int r, int c) {
  int st = (r >> 4) * 2 + (c >> 5), rr = r & 15, cc = c & 31, ob = rr * 64 + cc * 2;
  return st * 1024 + (ob ^ (((ob >> 9) & 1) << 5));
}
DI void stage_rc(int b, int& R, int& C) {
  int st = b / 1024, sb = b % 1024, swz = sb ^ (((sb >> 9) & 1) << 5);
  R = (st >> 1) * 16 + swz / 64; C = (st & 1) * 32 + (swz % 64) / 2;
}
template <int EPI>
DI void epi_store(const Params& p, int rbase, int col, const f32x4& v) {
  if (EPI == 0) {
    if (col < LDC0) {
      u16* C = (u16*)(p.ws + OFF_C0A);
#pragma unroll
      for (int r = 0; r < 4; ++r) C[(size_t)(rbase + r) * LDC0 + col] = f2bf(v[r]);
    } else if (col < 6688) {
      u16* UT = (u16*)(p.ws + OFF_UT);
      u32x2 o; o[0] = pk2(v[0], v[1]); o[1] = pk2(v[2], v[3]);
      *(u32x2*)(UT + (size_t)(col - LDC0) * MROWS + rbase) = o;
    }
  } else if (EPI == 1) {
    float* X1 = (float*)(p.ws + OFF_X1);
    const float* mod = (const float*)(p.ws + OFF_MOD);
#pragma unroll
    for (int r = 0; r < 4; ++r) {
      int row = rbase + r;
      const float* xs = row < NPROMPT ? p.in[0] + (size_t)row * 1024 : p.in[1] + (size_t)(row - NPROMPT) * 1024;
      float gate = mod[(0 * 3 + row_group(row)) * 3072 + 2048 + col];
      X1[(size_t)row * 1024 + col] = xs[col] + gate * v[r];
    }
  } else if (EPI == 2) {
    u16* C1 = (u16*)(p.ws + OFF_C1);
#pragma unroll
    for (int r = 0; r < 4; ++r) {
      int row = rbase + r;
      C1[(size_t)row * 4096 + col] = f2bf(v[r]);
      if (row < NPROMPT && col >= 1024 && col < 3072) {
        int cc = col - 1024; int isv = cc >> 10; cc &= 1023;
        int hh = cc >> 6, d = cc & 63; int b = row >> 8, l = row & 255;
        float* o = p.out + (isv ? O_NV : O_NK);
        o[(((size_t)b * 16 + hh) * 256 + l) * 64 + d] = v[r];
      }
    }
  } else {
    const float* X1 = (const float*)(p.ws + OFF_X1);
    const float* mod = (const float*)(p.ws + OFF_MOD);
#pragma unroll
    for (int r = 0; r < 4; ++r) {
      int row = rbase + r;
      float gate = mod[(1 * 3 + row_group(row)) * 3072 + 2048 + col];
      p.out[(size_t)row * 1024 + col] = X1[(size_t)row * 1024 + col] + gate * v[r];
    }
  }
}

template <int EPI>
DI void gemm256(const Params& p, const GemmArgs& g, int brow, int bcol, unsigned char* smem) {
  constexpr int HT = 128 * 64;
  u16* shm = (u16*)smem;
  float* rs = (float*)(smem + 131072);
  const int K = g.K;
#define SA(b, h) (shm + ((b) * 2 + (h)) * HT)
#define SB(b, h) (shm + (4 + (b) * 2 + (h)) * HT)
#define STAGE_A(P, br, kt) do { const u16* _ub = g.A1 + (long)(br) * g.lda1 + (long)(kt) * 64; \
    for (int _i = 0; _i < 2; ++_i) { \
      __builtin_amdgcn_global_load_lds((const unsigned*)((const char*)(_ub + (long)_i * 64 * g.lda1) + aoff1), \
        (__attribute__((address_space(3))) unsigned*)((char*)(P) + threadIdx.x * 16 + _i * 8192), 16, 0, 0); } } while (0)
#define STAGE_B(P, bc, kt) do { const u16* _ub = g.Bt + (long)(bc) * K + (long)(kt) * 64; \
    for (int _i = 0; _i < 2; ++_i) { \
      __builtin_amdgcn_global_load_lds((const unsigned*)((const char*)(_ub + (long)_i * 64 * K) + boff), \
        (__attribute__((address_space(3))) unsigned*)((char*)(P) + threadIdx.x * 16 + _i * 8192), 16, 0, 0); } } while (0)
#define LDA(dst, b, h) for (int m = 0; m < 4; ++m) for (int k = 0; k < 2; ++k) \
    dst[m][k] = *reinterpret_cast<const bf16x8*>((char*)SA(b, h) + lds_byte(wr * 64 + m * 16 + fr, k * 32 + fq * 8))
#define LDB(dst, b, h) for (int n = 0; n < 2; ++n) for (int k = 0; k < 2; ++k) \
    dst[n][k] = *reinterpret_cast<const bf16x8*>((char*)SB(b, h) + lds_byte(wc * 32 + n * 16 + fr, k * 32 + fq * 8))
#define MMA(ai, bj, At_, Bt_) do { __builtin_amdgcn_s_setprio(1); \
    for (int m = 0; m < 4; ++m) for (int n = 0; n < 2; ++n) for (int k = 0; k < 2; ++k) \
      acc[ai][bj][m][n] = __builtin_amdgcn_mfma_f32_16x16x32_bf16(At_[m][k], Bt_[n][k], acc[ai][bj][m][n], 0, 0, 0); \
    __builtin_amdgcn_s_setprio(0); } while (0)
#define WAIT_V(n) asm volatile("s_waitcnt vmcnt(" #n ")" ::: "memory")
#define WAIT_L(n) asm volatile("s_waitcnt lgkmcnt(" #n ")" ::: "memory")
#define BAR __builtin_amdgcn_s_barrier()
#define SCHED __builtin_amdgcn_sched_barrier(0)
  const int wid = threadIdx.x >> 6, lane = threadIdx.x & 63, wr = wid >> 2, wc = wid & 3, fr = lane & 15, fq = lane >> 4;
  unsigned aoff1, boff;
  {
    int r_, c_; stage_rc(threadIdx.x * 16, r_, c_);
    aoff1 = (unsigned)(r_ * g.lda1 + c_) * 2u;
    boff = (unsigned)(r_ * K + c_) * 2u;
  }
  if (EPI == 1) {
    if (threadIdx.x < 256) {
      const float* rss = (const float*)(p.ws + OFF_ROWSS) + (size_t)(brow + threadIdx.x) * 16;
      float s = 0.f;
#pragma unroll
      for (int q = 0; q < 16; ++q) s += rss[q];
      rs[threadIdx.x] = rsqrtf(s * (1.f / 1024.f) + 1e-6f);
    }
  }
  WAIT_V(0);
  __syncthreads();
  f32x4 acc[2][2][4][2];
#pragma unroll
  for (int a = 0; a < 2; ++a)
#pragma unroll
    for (int b = 0; b < 2; ++b)
#pragma unroll
      for (int m = 0; m < 4; ++m)
#pragma unroll
        for (int n = 0; n < 2; ++n) acc[a][b][m][n] = (f32x4){0.f, 0.f, 0.f, 0.f};
  bf16x8 At[4][2], B0[2][2], B1[2][2];
  const int nt = K / 64;
  const int tscale = (EPI == 1) ? (g.ksplit >> 6) : -1;
  STAGE_B(SB(0, 0), bcol, 0); STAGE_A(SA(0, 0), brow, 0);
  STAGE_B(SB(0, 1), bcol + 128, 0); STAGE_A(SA(0, 1), brow + 128, 0);
  if (wr == 1) BAR;
  WAIT_V(4); BAR;
  STAGE_B(SB(1, 0), bcol, 1); STAGE_A(SA(1, 0), brow, 1); STAGE_B(SB(1, 1), bcol + 128, 1);
  WAIT_V(6); BAR;
  for (int t = 0; t < nt - 2; t += 2) {
    if (EPI == 1) {
      if (t == tscale) {
#pragma unroll
        for (int a = 0; a < 2; ++a)
#pragma unroll
          for (int m = 0; m < 4; ++m)
#pragma unroll
            for (int j = 0; j < 4; ++j) {
              float sc = rs[a * 128 + wr * 64 + m * 16 + fq * 4 + j];
#pragma unroll
              for (int b = 0; b < 2; ++b)
#pragma unroll
                for (int n = 0; n < 2; ++n) acc[a][b][m][n][j] *= sc;
            }
      }
    }
    LDB(B0, 0, 0); SCHED; LDA(At, 0, 0); STAGE_A(SA(1, 1), brow + 128, t + 1);
    WAIT_L(8); BAR; WAIT_L(0); MMA(0, 0, At, B0); BAR; SCHED;
    LDB(B1, 0, 1); STAGE_B(SB(0, 0), bcol, t + 2);
    BAR; WAIT_L(0); MMA(0, 1, At, B1); BAR;
    LDA(At, 0, 1); STAGE_A(SA(0, 0), brow, t + 2);
    BAR; WAIT_L(0); MMA(1, 0, At, B0); BAR; SCHED;
    STAGE_B(SB(0, 1), bcol + 128, t + 2);
    WAIT_V(6); BAR; MMA(1, 1, At, B1); BAR;
    LDB(B0, 1, 0); SCHED; LDA(At, 1, 0); STAGE_A(SA(0, 1), brow + 128, t + 2);
    WAIT_L(8); BAR; WAIT_L(0); MMA(0, 0, At, B0); BAR; SCHED;
    LDB(B1, 1, 1); STAGE_B(SB(1, 0), bcol, t + 3);
    BAR; WAIT_L(0); MMA(0, 1, At, B1); BAR;
    LDA(At, 1, 1); STAGE_A(SA(1, 0), brow, t + 3);
    BAR; WAIT_L(0); MMA(1, 0, At, B0); BAR; SCHED;
    STAGE_B(SB(1, 1), bcol + 128, t + 3);
    WAIT_V(6); BAR; MMA(1, 1, At, B1); BAR;
  }
  { LDB(B0, 0, 0); LDA(At, 0, 0); STAGE_A(SA(1, 1), brow + 128, nt - 1);
    BAR; WAIT_L(0); MMA(0, 0, At, B0); BAR;
    LDB(B1, 0, 1); BAR; WAIT_L(0); MMA(0, 1, At, B1); BAR;
    LDA(At, 0, 1); WAIT_V(4); BAR; WAIT_L(0); MMA(1, 0, At, B0); MMA(1, 1, At, B1); BAR; }
  { LDB(B0, 1, 0); LDA(At, 1, 0); WAIT_V(2); BAR; WAIT_L(0); MMA(0, 0, At, B0); BAR;
    LDB(B1, 1, 1); WAIT_V(0); BAR; WAIT_L(0); MMA(0, 1, At, B1); BAR;
    LDA(At, 1, 1); BAR; WAIT_L(0); MMA(1, 0, At, B0); MMA(1, 1, At, B1); BAR; }
  if (wr == 0) BAR;
  int e_tid = threadIdx.x, e_brow = brow, e_bcol = bcol;
  asm volatile("" : "+v"(e_tid), "+s"(e_brow), "+s"(e_bcol));
  const int e_row = e_brow + ((e_tid >> 8) & 1) * 64 + ((e_tid >> 4) & 3) * 4;
  const int e_col = e_bcol + ((e_tid >> 6) & 3) * 32 + (e_tid & 15);
#pragma unroll
  for (int ai = 0; ai < 2; ++ai)
#pragma unroll
    for (int bj = 0; bj < 2; ++bj)
#pragma unroll
      for (int m = 0; m < 4; ++m)
#pragma unroll
        for (int n = 0; n < 2; ++n)
          epi_store<EPI>(p, e_row + ai * 128 + m * 16, e_col + bj * 128 + n * 16, acc[ai][bj][m][n]);
  __syncthreads();
#undef SA
#undef SB
#undef STAGE_A
#undef STAGE_B
#undef LDA
#undef LDB
#undef MMA
#undef WAIT_V
#undef WAIT_L
#undef BAR
#undef SCHED
}
DI bool gemm_tile_coord(int round, int NN, int ntiles, int& pm, int& pn) {
  const int b = blockIdx.x;
  const int v = round * 256 + (b & 7) * 32 + (b >> 3);
  if (v >= ntiles) return false;
  pm = (v / (8 * NN)) * 8 + (v & 7);
  pn = (v >> 3) % NN;
  return true;
}
struct SsdItem { int row0; int h; int has_prev; int has_next; };
DI SsdItem ssd_item(int item) {
  SsdItem s;
  int cgi = item >> 4; s.h = item & 15;
  if (cgi < 64) { int seq = cgi >> 1, c = cgi & 1; s.row0 = seq * 256 + c * 128; s.has_prev = c > 0; s.has_next = c < 1; }
  else { int q = cgi - 64; int seq = q >> 5, c = q & 31; s.row0 = NPROMPT + seq * 4096 + c * 128; s.has_prev = c > 0; s.has_next = c < 31; }
  return s;
}
DI void ssd_prep_dt(const Params& p, int row0, int h, float* sdt, float* scs, float* stot) {
  const int tid = threadIdx.x, lane = tid & 63, w = tid >> 6;
  const u16* C0 = (const u16*)(p.ws + OFF_C0A);
  if (tid < 256) {
    int d = tid >> 7, l = tid & 127;
    float raw = bf2f(C0[(size_t)(row0 + l) * LDC0 + 2560 + d * 16 + h]);
    float x = raw + p.in[14][d * 16 + h];
    float dt = x > 20.f ? x : log1pf(expf(x));
    float a = -expf(p.in[15][d * 16 + h]);
    sdt[d * 128 + l] = dt;
    scs[d * 128 + l] = a * dt;
  }
  __syncthreads();
  if (w < 2) {
    const int d = w;
    int p0 = d == 0 ? 2 * lane : 127 - 2 * lane;
    int p1 = d == 0 ? 2 * lane + 1 : 126 - 2 * lane;
    float v0 = scs[d * 128 + p0], v1 = scs[d * 128 + p1];
    float s = v0 + v1;
#pragma unroll
    for (int off = 1; off < 64; off <<= 1) {
      float tv = __shfl_up(s, off);
      if (lane >= off) s += tv;
    }
    float excl = s - (v0 + v1);
    scs[d * 128 + p0] = excl + v0;
    scs[d * 128 + p1] = excl + v0 + v1;
    if (lane == 63) stot[d] = s;
  }
  __syncthreads();
}
DI void conv_silu8(const Params& p, int row, int ch0, bool hp, bool hn, float* out) {
  const u16* C0 = (const u16*)(p.ws + OFF_C0A);
  const u16* q = C0 + (size_t)row * LDC0 + 1024 + ch0;
  const float* cw = p.in[12]; const float* cb = p.in[13];
  float xm[8], xc[8], xp[8];
  u32x4 vc = *(const u32x4*)q;
  unpack8(vc, xc);
  if (hp) { u32x4 v = *(const u32x4*)(q - LDC0); unpack8(v, xm); } else {
#pragma unroll
    for (int e = 0; e < 8; ++e) xm[e] = 0.f;
  }
  if (hn) { u32x4 v = *(const u32x4*)(q + LDC0); unpack8(v, xp); } else {
#pragma unroll
    for (int e = 0; e < 8; ++e) xp[e] = 0.f;
  }
  float4 w0a = *(const float4*)(cw + ch0), w0b = *(const float4*)(cw + ch0 + 4);
  float4 w1a = *(const float4*)(cw + 1536 + ch0), w1b = *(const float4*)(cw + 1536 + ch0 + 4);
  float4 w2a = *(const float4*)(cw + 3072 + ch0), w2b = *(const float4*)(cw + 3072 + ch0 + 4);
  float4 ba = *(const float4*)(cb + ch0), bb = *(const float4*)(cb + ch0 + 4);
  float w0[8] = {w0a.x, w0a.y, w0a.z, w0a.w, w0b.x, w0b.y, w0b.z, w0b.w};
  float w1[8] = {w1a.x, w1a.y, w1a.z, w1a.w, w1b.x, w1b.y, w1b.z, w1b.w};
  float w2[8] = {w2a.x, w2a.y, w2a.z, w2a.w, w2b.x, w2b.y, w2b.z, w2b.w};
  float bv[8] = {ba.x, ba.y, ba.z, ba.w, bb.x, bb.y, bb.z, bb.w};
#pragma unroll
  for (int e = 0; e < 8; ++e) out[e] = silu(bv[e] + w0[e] * xm[e] + w1[e] * xc[e] + w2[e] * xp[e]);
}

DI void phase_ssd_states(const Params& p, int item, unsigned char* smem) {
  u16* xT = (u16*)smem;
  u16* BTs = xT + 64 * 136;
  float* sdt = (float*)(BTs + 2 * 128 * 136);
  float* scs = sdt + 256;
  float* sw = scs + 256;
  float* stot = sw + 256;
  const int tid = threadIdx.x, lane = tid & 63, w = tid >> 6;
  const int l15 = lane & 15, l4 = lane >> 4;
  const SsdItem it = ssd_item(item);
  const int h = it.h, grp = h >> 3;
  ssd_prep_dt(p, it.row0, h, sdt, scs, stot);
  if (tid < 256) {
    int d = tid >> 7;
    sw[tid] = sdt[tid] * __expf(stot[d] - scs[tid]);
  }
  __syncthreads();
  {
    const int l = tid >> 2;
    const int row = it.row0 + l;
    const bool hp = (l > 0) || it.has_prev, hn = (l < 127) || it.has_next;
    const int pc = (tid & 3) * 16;
#pragma unroll
    for (int v = 0; v < 2; ++v) {
      float o[8];
      conv_silu8(p, row, h * 64 + pc + v * 8, hp, hn, o);
#pragma unroll
      for (int e = 0; e < 8; ++e) xT[(pc + v * 8 + e) * 136 + l] = f2bf(o[e]);
    }
    const int nc0 = (tid & 3) * 32;
    const float s0 = sw[l], s1 = sw[128 + l];
#pragma unroll
    for (int v = 0; v < 4; ++v) {
      float o[8];
      conv_silu8(p, row, 1024 + grp * 128 + nc0 + v * 8, hp, hn, o);
#pragma unroll
      for (int e = 0; e < 8; ++e) {
        BTs[(nc0 + v * 8 + e) * 136 + l] = f2bf(o[e] * s0);
        BTs[128 * 136 + (nc0 + v * 8 + e) * 136 + l] = f2bf(o[e] * s1);
      }
    }
  }
  __syncthreads();
  const int d = w >> 2, nq = w & 3;
  f32x4 acc[4][2];
#pragma unroll
  for (int i = 0; i < 4; ++i) { acc[i][0] = (f32x4){0.f, 0.f, 0.f, 0.f}; acc[i][1] = (f32x4){0.f, 0.f, 0.f, 0.f}; }
#pragma unroll
  for (int ks = 0; ks < 4; ++ks) {
    bf16x8 a[4], b[2];
#pragma unroll
    for (int i = 0; i < 4; ++i) a[i] = *(const bf16x8*)(xT + (i * 16 + l15) * 136 + ks * 32 + l4 * 8);
#pragma unroll
    for (int j = 0; j < 2; ++j) b[j] = *(const bf16x8*)(BTs + d * 128 * 136 + (nq * 32 + j * 16 + l15) * 136 + ks * 32 + l4 * 8);
#pragma unroll
    for (int i = 0; i < 4; ++i)
#pragma unroll
      for (int j = 0; j < 2; ++j) acc[i][j] = MFMA16(a[i], b[j], acc[i][j]);
  }
  u16* S = (u16*)((unsigned char*)p.out + OUT_SBUF) + ((size_t)item * 2 + d) * 8192;
#pragma unroll
  for (int i = 0; i < 4; ++i)
#pragma unroll
    for (int j = 0; j < 2; ++j)
#pragma unroll
      for (int r = 0; r < 4; ++r) {
        int pp = i * 16 + l4 * 4 + r, n = nq * 32 + j * 16 + l15;
        S[pp * 128 + n] = f2bf(acc[i][j][r]);
      }
  if (tid < 2) {
    float* cdec = (float*)(p.ws + OFF_CDEC);
    cdec[item * 2 + tid] = __expf(stot[tid]);
  }
  __syncthreads();
}

DI void phase_scan(const Params& p, int t) {
  const int part = t & 1, d = (t >> 1) & 1, h = (t >> 2) & 15, seq = t >> 6;
  const int tid = threadIdx.x;
  const int e0 = part * 4096 + tid * 8;
  const int nc = seq < 32 ? 2 : 32;
  const int cg0 = seq < 32 ? seq * 2 : 64 + (seq - 32) * 32;
  float st[8];
  if (seq < 32) {
#pragma unroll
    for (int e = 0; e < 8; ++e) st[e] = 0.f;
  } else {
    const float* init = p.in[2] + ((((size_t)(seq - 32) * 1 + 0) * 2 + d) * 16 + h) * 8192 + e0;
    float4 a = *(const float4*)init, b = *(const float4*)(init + 4);
    st[0] = a.x; st[1] = a.y; st[2] = a.z; st[3] = a.w; st[4] = b.x; st[5] = b.y; st[6] = b.z; st[7] = b.w;
  }
  u16* Sb = (u16*)((unsigned char*)p.out + OUT_SBUF);
  const float* cdec = (const float*)(p.ws + OFF_CDEC);
  for (int ci = 0; ci < nc; ++ci) {
    const int c = d == 0 ? ci : nc - 1 - ci;
    const int item = (cg0 + c) * 16 + h;
    u16* q = Sb + ((size_t)item * 2 + d) * 8192 + e0;
    u32x4 v = *(const u32x4*)q;
    float sc[8]; unpack8(v, sc);
    *(u32x4*)q = pack8(st);
    const float dec = cdec[item * 2 + d];
#pragma unroll
    for (int e = 0; e < 8; ++e) st[e] = st[e] * dec + sc[e];
  }
  if (seq < 32) {
    float* o = p.out + O_ST + ((((size_t)seq * 1 + 0) * 2 + d) * 16 + h) * 8192 + e0;
    *(float4*)o = make_float4(st[0], st[1], st[2], st[3]);
    *(float4*)(o + 4) = make_float4(st[4], st[5], st[6], st[7]);
  }
}

DI void phase_ssd_out(const Params& p, int item, unsigned char* smem, bool dry) {
  u16* Cs = (u16*)smem;
  u16* Bs = Cs + 128 * 136;
  u16* xT = Bs + 128 * 136;
  u16* St = xT + 64 * 136;
  float* sdt = (float*)(St + 2 * 64 * 136);
  float* scs = sdt + 256;
  float* stot = scs + 256;
  const int tid = threadIdx.x, lane = tid & 63, w = tid >> 6;
  const int l15 = lane & 15, l4 = lane >> 4;
  const SsdItem it = ssd_item(item);
  const int h = it.h, grp = h >> 3;
  ssd_prep_dt(p, it.row0, h, sdt, scs, stot);
  {
    const int l = tid >> 2;
    const int row = it.row0 + l;
    const bool hp = (l > 0) || it.has_prev, hn = (l < 127) || it.has_next;
    const int pc = (tid & 3) * 16;
#pragma unroll
    for (int v = 0; v < 2; ++v) {
      float o[8];
      conv_silu8(p, row, h * 64 + pc + v * 8, hp, hn, o);
#pragma unroll
      for (int e = 0; e < 8; ++e) xT[(pc + v * 8 + e) * 136 + l] = f2bf(o[e]);
    }
    const int nc0 = (tid & 3) * 32;
#pragma unroll
    for (int v = 0; v < 4; ++v) {
      float o[8];
      conv_silu8(p, row, 1024 + grp * 128 + nc0 + v * 8, hp, hn, o);
      *(u32x4*)(Bs + l * 136 + nc0 + v * 8) = pack8(o);
      conv_silu8(p, row, 1280 + grp * 128 + nc0 + v * 8, hp, hn, o);
      *(u32x4*)(Cs + l * 136 + nc0 + v * 8) = pack8(o);
    }
    const u16* S = (const u16*)((const unsigned char*)p.out + OUT_SBUF) + (size_t)item * 2 * 8192;
#pragma unroll
    for (int v = 0; v < 4; ++v) {
      int id = tid + 512 * v;
      int dd = id >> 10, pp = (id >> 4) & 63, nv = (id & 15) * 8;
      *(u32x4*)(St + dd * 64 * 136 + pp * 136 + nv) = *(const u32x4*)(S + dd * 8192 + pp * 128 + nv);
    }
  }
  __syncthreads();
  f32x4 cb[8], af[4], ab[4];
#pragma unroll
  for (int j = 0; j < 8; ++j) cb[j] = (f32x4){0.f, 0.f, 0.f, 0.f};
#pragma unroll
  for (int i = 0; i < 4; ++i) { af[i] = (f32x4){0.f, 0.f, 0.f, 0.f}; ab[i] = (f32x4){0.f, 0.f, 0.f, 0.f}; }
#pragma unroll
  for (int ks = 0; ks < 4; ++ks) {
    bf16x8 a = *(const bf16x8*)(Cs + (16 * w + l15) * 136 + ks * 32 + l4 * 8);
#pragma unroll
    for (int j = 0; j < 8; ++j) {
      bf16x8 b = *(const bf16x8*)(Bs + (j * 16 + l15) * 136 + ks * 32 + l4 * 8);
      cb[j] = MFMA16(a, b, cb[j]);
    }
#pragma unroll
    for (int i = 0; i < 4; ++i) {
      bf16x8 b0 = *(const bf16x8*)(St + (i * 16 + l15) * 136 + ks * 32 + l4 * 8);
      bf16x8 b1 = *(const bf16x8*)(St + 64 * 136 + (i * 16 + l15) * 136 + ks * 32 + l4 * 8);
      af[i] = MFMA16(a, b0, af[i]);
      ab[i] = MFMA16(a, b1, ab[i]);
    }
  }
  __syncthreads();
  f32x4 Y[4];
  {
    float cs0l[4], cs1l[4];
#pragma unroll
    for (int r = 0; r < 4; ++r) { int l = 16 * w + l4 * 4 + r; cs0l[r] = scs[l]; cs1l[r] = scs[128 + l]; }
#pragma unroll
    for (int j = 0; j < 8; ++j) {
      const int s = j * 16 + l15;
      const float cs0s = scs[s], cs1s = scs[128 + s], dt0s = sdt[s], dt1s = sdt[128 + s];
#pragma unroll
      for (int r = 0; r < 4; ++r) {
        const int l = 16 * w + l4 * 4 + r;
        float f;
        if (l > s) f = __expf(cs0l[r] - cs0s) * dt0s;
        else if (l < s) f = __expf(cs1l[r] - cs1s) * dt1s;
        else f = dt0s + dt1s;
        Bs[l * 136 + s] = f2bf(cb[j][r] * f);
      }
    }
#pragma unroll
    for (int r = 0; r < 4; ++r) {
      float e0 = __expf(cs0l[r]), e1 = __expf(cs1l[r]);
#pragma unroll
      for (int i = 0; i < 4; ++i) Y[i][r] = af[i][r] * e0 + ab[i][r] * e1;
    }
  }
  __syncthreads();
#pragma unroll
  for (int ks = 0; ks < 4; ++ks) {
    bf16x8 a = *(const bf16x8*)(Bs + (16 * w + l15) * 136 + ks * 32 + l4 * 8);
#pragma unroll
    for (int i = 0; i < 4; ++i) {
      bf16x8 b = *(const bf16x8*)(xT + (i * 16 + l15) * 136 + ks * 32 + l4 * 8);
      Y[i] = MFMA16(a, b, Y[i]);
    }
  }
  {
    const u16* C0 = (const u16*)(p.ws + OFF_C0A);
    u16* YAB = dry ? (u16*)(p.ws + OFF_DUMMY) + (size_t)(blockIdx.x & 15) * 400000 - (size_t)it.row0 * 2048 : (u16*)((unsigned char*)p.out + OUT_YB);
    const float dsk = p.in[16][h] + p.in[16][16 + h];
    float ss[4] = {0.f, 0.f, 0.f, 0.f};
#pragma unroll
    for (int i = 0; i < 4; ++i) {
      const int pp = i * 16 + l15;
#pragma unroll
      for (int r = 0; r < 4; ++r) {
        const int l = 16 * w + l4 * 4 + r;
        const size_t off = (size_t)(it.row0 + l) * LDC0 + h * 64 + pp;
        float xv = bf2f(xT[pp * 136 + l]);
        float y = Y[i][r] + xv * dsk;
        float z = bf2f(C0[off]);
        float gv = y * silu(z);
        YAB[(size_t)(it.row0 + l) * 2048 + h * 64 + pp] = f2bf(gv);
        ss[r] += gv * gv;
      }
    }
    float* rss = (float*)(p.ws + OFF_ROWSS);
#pragma unroll
    for (int r = 0; r < 4; ++r) {
      float s = ss[r];
      s += __shfl_xor(s, 1); s += __shfl_xor(s, 2); s += __shfl_xor(s, 4); s += __shfl_xor(s, 8);
      if (l15 == 0) rss[(size_t)(it.row0 + 16 * w + l4 * 4 + r) * 16 + h] = s;
    }
  }
  __syncthreads();
}

DI void phase_hyena(const Params& p, int it, unsigned char* smem, bool dry) {
  const int cfg = it < 256 ? 1 : 0;
  const int c0 = (it & 255) * 4;
  const int L = cfg ? 4096 : 256;
  const int A = L >> 5;
  const int lgA = cfg ? 7 : 3;
  const int rowbase = cfg ? NPROMPT : 0;
  u16* vxs = (u16*)smem;
  u16* hrs = vxs + 4 * 10240;
  const int tid = threadIdx.x, lane = tid & 63, w = tid >> 6;
  const u16* UT = (const u16*)(p.ws + OFF_UT);
  const float* cw = p.in[18]; const float* cbv = p.in[19];
  for (int id = tid; id < 4 * 1024; id += NT) {
    const int ch = id >> 10, blk8 = id & 1023;
    const int c = c0 + ch;
    const int pos = blk8 * 8;
    const int tl = pos & (L - 1);
    float res[8];
#pragma unroll
    for (int e = 0; e < 8; ++e) res[e] = 1.f;
#pragma unroll
    for (int which = 1; which <= 2; ++which) {
      const int uc = which * 1024 + c;
      const u16* q = UT + (size_t)uc * MROWS + rowbase + pos;
      float xv[10];
      u32x4 v = *(const u32x4*)q;
      unpack8(v, xv + 1);
      xv[0] = (tl > 0) ? bf2f(q[-1]) : 0.f;
      xv[9] = (tl + 8 < L) ? bf2f(q[8]) : 0.f;
      const float w0 = cw[uc], w1 = cw[3072 + uc], w2 = cw[6144 + uc], bb = cbv[uc];
#pragma unroll
      for (int e = 0; e < 8; ++e) res[e] *= (bb + w0 * xv[e] + w1 * xv[e + 1] + w2 * xv[e + 2]);
    }
    const int n = pos >> 5, k = pos & 31;
    *(u32x4*)(vxs + ch * 10240 + n * 40 + k) = pack8(res);
  }
  {
    const u16* HF = (const u16*)((const unsigned char*)p.out + (cfg ? OUT_HF4096 : OUT_HF256));
    const int nv = (2 * L) >> 3;
    for (int id = tid; id < 4 * nv; id += NT) {
      int ch = id / nv, v8 = id - ch * nv;
      *(u32x4*)(hrs + ch * 2 * L + v8 * 8) = *(const u32x4*)(HF + (size_t)(c0 + ch) * 2 * L + v8 * 8);
    }
  }
  __syncthreads();
  const int ch = w >> 1, wv = w & 1;
  const int l31 = lane & 31, kh = lane >> 5;
  const u16* vx = vxs + ch * 10240;
  const u16* hr = hrs + ch * 2 * L;
  f32x16 acc[4];
#pragma unroll
  for (int j = 0; j < 4; ++j)
#pragma unroll
    for (int r = 0; r < 16; ++r) acc[j][r] = 0.f;
  int ncol[4], acol[4];
#pragma unroll
  for (int j = 0; j < 4; ++j) { ncol[j] = 128 * wv + 32 * j + l31; acol[j] = ncol[j] & (A - 1); }
  for (int d = -(A - 1); d <= A - 1; ++d) {
#pragma unroll
    for (int khalf = 0; khalf < 2; ++khalf) {
      const int idx0 = L - 32 * d - l31 + 16 * khalf + 8 * kh;
      bf16x8 af;
#pragma unroll
      for (int e = 0; e < 8; ++e) af[e] = (short)hr[idx0 + e];
#pragma unroll
      for (int j = 0; j < 4; ++j) {
        const int asrc = acol[j] - d;
        const bool valid = (asrc >= 0) && (asrc < A);
        if (__builtin_amdgcn_ballot_w64(valid) != 0ull) {
          bf16x8 bfr = (bf16x8){0, 0, 0, 0, 0, 0, 0, 0};
          if (valid) bfr = *(const bf16x8*)(vx + (ncol[j] - d) * 40 + 16 * khalf + 8 * kh);
          acc[j] = MFMA32(af, bfr, acc[j]);
        }
      }
    }
  }
  {
    const int c = c0 + ch;
    const float hb = p.in[26][c];
    const float w0 = cw[c], w1 = cw[3072 + c], w2 = cw[6144 + c], bb = cbv[c];
    const u16* x0row = UT + (size_t)c * MROWS + rowbase;
    const u16* grow = (const u16*)(p.ws + OFF_UT) + (size_t)(3072 + c) * MROWS + rowbase;
    u16* groww = dry ? (u16*)(p.ws + OFF_DUMMY) + (size_t)blockIdx.x * 32768 + ch * 8192
                     : (u16*)(p.ws + OFF_UT) + (size_t)(3072 + c) * MROWS + rowbase;
#pragma unroll
    for (int j = 0; j < 4; ++j) {
      const int n = ncol[j];
#pragma unroll
      for (int r = 0; r < 16; ++r) {
        const int i = (r & 3) + 8 * (r >> 2) + 4 * kh;
        const int pos = 32 * n + i;
        const int tl = pos & (L - 1);
        float xm = tl > 0 ? bf2f(x0row[pos - 1]) : 0.f;
        float xc = bf2f(x0row[pos]);
        float xp = tl < L - 1 ? bf2f(x0row[pos + 1]) : 0.f;
        float x0 = bb + w0 * xm + w1 * xc + w2 * xp;
        float vxv = bf2f(vx[n * 40 + i]);
        float gv = bf2f(grow[pos]);
        float y = x0 * (acc[j][r] + vxv * hb) * silu(gv);
        groww[pos] = f2bf(y);
      }
    }
  }
  (void)lgA;
  __syncthreads();
}

#define VTP 776
DI void phase_attn(const Params& p, int item, unsigned char* smem, bool dry) {
  u16* VT = (u16*)smem;
  u16* Pb = VT + 64 * VTP;
  float* mrg = (float*)(Pb + 8 * 16 * 40);
  float* rp = mrg + 4 * 64 * 24;
  const int tid = threadIdx.x, lane = tid & 63, w = tid >> 6;
  const int l15 = lane & 15, l4 = lane >> 4;
  const u16* C1 = (const u16*)(p.ws + OFF_C1);
  const bool lat = item < 2048;
  int b, h, rr = 0, rows0 = 0, qrow0, keyrow0;
  if (lat) { b = item >> 10; h = (item >> 6) & 15; rr = item & 63; rows0 = min(max(rr - 4, 0), 56);
             qrow0 = NPROMPT + b * 4096 + rr * 64; keyrow0 = NPROMPT + b * 4096 + rows0 * 64; }
  else { int q = item - 2048; b = q >> 6; h = (q >> 2) & 15; int qt = q & 3; qrow0 = b * 256 + qt * 64; keyrow0 = b * 256; }
  {
    const int nloc = lat ? 512 : 256;
    for (int id = tid; id < nloc * 8; id += NT) {
      int key = id >> 3, d0 = (id & 7) * 8;
      u32x4 v = *(const u32x4*)(C1 + (size_t)(keyrow0 + key) * 4096 + 2048 + h * 64 + d0);
      float f[8]; unpack8(v, f);
#pragma unroll
      for (int e = 0; e < 8; ++e) VT[(d0 + e) * VTP + key] = f2bf(f[e]);
    }
    if (lat) {
      const float* cv = p.in[4] + ((size_t)b * 16 + h) * 256 * 64;
      for (int id = tid; id < 256 * 8; id += NT) {
        int key = id >> 3, d0 = (id & 7) * 8;
        float4 a = *(const float4*)(cv + key * 64 + d0), c = *(const float4*)(cv + key * 64 + d0 + 4);
        float f[8] = {a.x, a.y, a.z, a.w, c.x, c.y, c.z, c.w};
#pragma unroll
        for (int e = 0; e < 8; ++e) VT[(d0 + e) * VTP + 512 + key] = f2bf(f[e]);
      }
      for (int id = tid; id < 465; id += NT) rp[id] = p.in[29][h * 465 + id];
    }
  }
  __syncthreads();
  const int jq = w & 3, gk = w >> 2;
  const int qbase = qrow0 + jq * 16;
  bf16x8 qa[2];
#pragma unroll
  for (int ks = 0; ks < 2; ++ks) qa[ks] = *(const bf16x8*)(C1 + (size_t)(qbase + l15) * 4096 + h * 64 + ks * 32 + l4 * 8);
  const int ntile = lat ? 8 : 4;
  const int cstart = min(max(16 * jq - 8, 0), 32);
  const bool fp32k = lat && gk == 1;
  const float* ck = p.in[3] + ((size_t)b * 16 + h) * 256 * 64;
  auto loadk = [&](int tt, bf16x8 (&kb)[2][2]) {
#pragma unroll
    for (int jt = 0; jt < 2; ++jt) {
      if (fp32k) {
        const int key = tt * 32 + jt * 16 + l15;
#pragma unroll
        for (int ks = 0; ks < 2; ++ks) {
          const float* q = ck + key * 64 + ks * 32 + l4 * 8;
          float4 a = *(const float4*)q, c = *(const float4*)(q + 4);
          float f[8] = {a.x, a.y, a.z, a.w, c.x, c.y, c.z, c.w};
          u32x4 pk = pack8(f);
          kb[jt][ks] = __builtin_bit_cast(bf16x8, pk);
        }
      } else {
        int krow;
        if (lat) krow = keyrow0 + tt * 64 + cstart + jt * 16 + l15;
        else krow = keyrow0 + gk * 128 + tt * 32 + jt * 16 + l15;
#pragma unroll
        for (int ks = 0; ks < 2; ++ks)
          kb[jt][ks] = *(const bf16x8*)(C1 + (size_t)krow * 4096 + 1024 + h * 64 + ks * 32 + l4 * 8);
      }
    }
  };
  float mrow[4], lrow[4];
  f32x4 O[4];
#pragma unroll
  for (int r = 0; r < 4; ++r) { mrow[r] = -1e30f; lrow[r] = 0.f; }
#pragma unroll
  for (int i = 0; i < 4; ++i) O[i] = (f32x4){0.f, 0.f, 0.f, 0.f};
  u16* Pw = Pb + w * 16 * 40;
  bf16x8 kn[2][2];
  loadk(0, kn);
  for (int tt = 0; tt < ntile; ++tt) {
    bf16x8 kc[2][2];
#pragma unroll
    for (int jt = 0; jt < 2; ++jt)
#pragma unroll
      for (int ks = 0; ks < 2; ++ks) kc[jt][ks] = kn[jt][ks];
    if (tt + 1 < ntile) loadk(tt + 1, kn);
    f32x4 S[2];
#pragma unroll
    for (int jt = 0; jt < 2; ++jt) {
      S[jt] = (f32x4){0.f, 0.f, 0.f, 0.f};
      S[jt] = MFMA16(qa[0], kc[jt][0], S[jt]);
      S[jt] = MFMA16(qa[1], kc[jt][1], S[jt]);
    }
    float sv[2][4];
#pragma unroll
    for (int jt = 0; jt < 2; ++jt)
#pragma unroll
      for (int r = 0; r < 4; ++r) {
        float s = S[jt][r] * 0.125f;
        if (lat && gk == 0) {
          const int kcn = cstart + jt * 16 + l15;
          const int qc = jq * 16 + l4 * 4 + r;
          const int col0 = min(max(qc - 8, 0), 48);
          const int kr = rows0 + tt;
          const int dr = kr - rr + 7;
          const int dc = min(max(kcn - qc + 15, 0), 30);
          s += rp[dr * 31 + dc];
          if (kcn < col0 || kcn >= col0 + 16) s = -INFINITY;
        }
        sv[jt][r] = s;
      }
    float alpha[4];
#pragma unroll
    for (int r = 0; r < 4; ++r) {
      float mx = fmaxf(sv[0][r], sv[1][r]);
      mx = fmaxf(mx, __shfl_xor(mx, 1)); mx = fmaxf(mx, __shfl_xor(mx, 2));
      mx = fmaxf(mx, __shfl_xor(mx, 4)); mx = fmaxf(mx, __shfl_xor(mx, 8));
      float mn = fmaxf(mrow[r], mx);
      alpha[r] = __expf(mrow[r] - mn);
      mrow[r] = mn;
      float p0 = __expf(sv[0][r] - mn), p1 = __expf(sv[1][r] - mn);
      lrow[r] = lrow[r] * alpha[r] + p0 + p1;
      Pw[(l4 * 4 + r) * 40 + l15] = f2bf(p0);
      Pw[(l4 * 4 + r) * 40 + 16 + l15] = f2bf(p1);
    }
#pragma unroll
    for (int i = 0; i < 4; ++i)
#pragma unroll
      for (int r = 0; r < 4; ++r) O[i][r] *= alpha[r];
    asm volatile("s_waitcnt lgkmcnt(0)" ::: "memory");
    bf16x8 pa = *(const bf16x8*)(Pw + l15 * 40 + l4 * 8);
    int keyoff;
    if (lat) keyoff = gk == 0 ? tt * 64 + cstart : 512 + tt * 32;
    else keyoff = gk * 128 + tt * 32;
#pragma unroll
    for (int i = 0; i < 4; ++i) {
      bf16x8 vb = *(const bf16x8*)(VT + (i * 16 + l15) * VTP + keyoff + l4 * 8);
      O[i] = MFMA16(pa, vb, O[i]);
    }
    asm volatile("s_waitcnt lgkmcnt(0)" ::: "memory");
  }
#pragma unroll
  for (int r = 0; r < 4; ++r) {
    float s = lrow[r];
    s += __shfl_xor(s, 1); s += __shfl_xor(s, 2); s += __shfl_xor(s, 4); s += __shfl_xor(s, 8);
    lrow[r] = s;
  }
  if (gk == 1) {
    float* m = mrg + ((w - 4) * 64 + lane) * 24;
#pragma unroll
    for (int r = 0; r < 4; ++r) { m[r] = mrow[r]; m[4 + r] = lrow[r]; }
#pragma unroll
    for (int i = 0; i < 4; ++i)
#pragma unroll
      for (int r = 0; r < 4; ++r) m[8 + i * 4 + r] = O[i][r];
  }
  __syncthreads();
  if (gk == 0) {
    const float* m = mrg + (w * 64 + lane) * 24;
    u16* C1w = dry ? (u16*)(p.ws + OFF_DUMMY) + (size_t)(blockIdx.x & 15) * 300000 - (size_t)qrow0 * 4096 : (u16*)(p.ws + OFF_C1);
#pragma unroll
    for (int r = 0; r < 4; ++r) {
      float m1 = m[r], l1 = m[4 + r];
      float mn = fmaxf(mrow[r], m1);
      float e0 = __expf(mrow[r] - mn), e1 = __expf(m1 - mn);
      float inv = 1.f / (lrow[r] * e0 + l1 * e1);
      const int row = qbase + l4 * 4 + r;
#pragma unroll
      for (int i = 0; i < 4; ++i) {
        float o = (O[i][r] * e0 + m[8 + i * 4 + r] * e1) * inv;
        const int dcol = h * 64 + i * 16 + l15;
        float gv = bf2f(C1[(size_t)row * 4096 + 3072 + dcol]);
        C1w[(size_t)row * 4096 + dcol] = f2bf(o * silu(gv));
      }
    }
  }
  __syncthreads();
}

#define NPHASE 12
__global__ void __launch_bounds__(NT) mega(Params p, int ph0, int ph1) {
  __shared__ __attribute__((aligned(16))) unsigned char smem[SMEM_BYTES];
  const int nb = gridDim.x, bid = blockIdx.x;
#define PH_BEGIN(k) if (ph0 <= (k) && (k) < ph1) { if ((k) > ph0) cg::this_grid().sync(); \
  for (int rep = (REP_MASK >> (k)) & 1; rep >= 0; --rep) { const bool dry = rep > 0; (void)dry;
#define PH_END if (rep > 0) cg::this_grid().sync(); } }
  {
    {
      PH_BEGIN(0) {
        for (int t = bid; t < 544 + 192 + 3520; t += nb) {
          if (t < 544) phase_filter(p, t, smem);
          else if (t < 736) phase_ada(p, t - 544, smem);
          else {
            int q = t - 736;
            if (q < 1728) transpose_tile<float>(p.in[10], 6688, 6688, (u16*)(p.ws + OFF_WINE), 1024, q & 15, q >> 4, nullptr, 0, smem);
            else if (q < 2240) { q -= 1728; transpose_tile<float>(p.in[11], 1024, 1024, (u16*)(p.ws + OFF_WOUTE), 2048, q & 31, q >> 5, p.in[17], 1024, smem); }
            else if (q < 3264) { q -= 2240; transpose_tile<float>(p.in[27], 4096, 4096, (u16*)(p.ws + OFF_WINO), 1024, q & 15, q >> 4, nullptr, 0, smem); }
            else { q -= 3264; transpose_tile<float>(p.in[28], 1024, 1024, (u16*)(p.ws + OFF_WOUTO), 1024, q & 15, q >> 4, nullptr, 0, smem); }
          }
        }
      } PH_END
      PH_BEGIN(1) {
        for (int t = bid; t < 2048; t += nb) phase_norm(p, t, 0, p.in[0], p.in[1], (u16*)((unsigned char*)p.out + OUT_H0));
      } PH_END
      PH_BEGIN(2) {
        GemmArgs g; g.A1 = (const u16*)((const unsigned char*)p.out + OUT_H0); g.lda1 = 1024; g.A2 = g.A1; g.lda2 = 1024; g.ksplit = 1 << 30;
        g.Bt = (const u16*)(p.ws + OFF_WINE); g.K = 1024;
        for (int rd = 0; rd * 256 < 64 * 27; ++rd) { int pm, pn; if (gemm_tile_coord(rd, 27, 64 * 27, pm, pn)) gemm256<0>(p, g, pm * 256, pn * 256, smem); }
      } PH_END
      PH_BEGIN(3) {
        for (int t = bid; t < 512 + 2048; t += nb) {
          if (t < 512) phase_hyena(p, t, smem, dry);
          else phase_ssd_states(p, t - 512, smem);
        }
      } PH_END
      PH_BEGIN(4) {
        for (int t = bid; t < 34 * 64; t += nb) phase_scan(p, t);
      } PH_END
      PH_BEGIN(5) {
        for (int t = bid; t < 2048 + 4096; t += nb) {
          if (t < 2048) phase_ssd_out(p, t, smem, dry);
          else {
            int q = t - 2048;
            transpose_tile<u16>((const u16*)(p.ws + OFF_UT) + (size_t)3072 * MROWS, MROWS, MROWS,
                                (u16*)((unsigned char*)p.out + OUT_YB) + 1024, 2048, q & 15, q >> 4, nullptr, 0, smem);
          }
        }
      } PH_END
      PH_BEGIN(6) {
        GemmArgs g; g.A1 = (const u16*)((const unsigned char*)p.out + OUT_YB); g.lda1 = 2048;
        g.A2 = g.A1; g.lda2 = 2048; g.ksplit = 1024;
        g.Bt = (const u16*)(p.ws + OFF_WOUTE); g.K = 2048;
        for (int rd = 0; rd * 256 < 64 * 4; ++rd) { int pm, pn; if (gemm_tile_coord(rd, 4, 64 * 4, pm, pn)) gemm256<1>(p, g, pm * 256, pn * 256, smem); }
      } PH_END
      PH_BEGIN(7) {
        const float* x1 = (const float*)(p.ws + OFF_X1);
        for (int t = bid; t < 2048; t += nb) phase_norm(p, t, 1, x1, x1 + (size_t)NPROMPT * 1024, (u16*)(p.ws + OFF_H1));
      } PH_END
      PH_BEGIN(8) {
        GemmArgs g; g.A1 = (const u16*)(p.ws + OFF_H1); g.lda1 = 1024; g.A2 = g.A1; g.lda2 = 1024; g.ksplit = 1 << 30;
        g.Bt = (const u16*)(p.ws + OFF_WINO); g.K = 1024;
        for (int rd = 0; rd * 256 < 64 * 16; ++rd) { int pm, pn; if (gemm_tile_coord(rd, 16, 64 * 16, pm, pn)) gemm256<2>(p, g, pm * 256, pn * 256, smem); }
      } PH_END
      PH_BEGIN(9) {
        for (int t = bid; t < 4096; t += nb) phase_attn(p, t, smem, dry);
      } PH_END
      PH_BEGIN(10) {
        GemmArgs g; g.A1 = (const u16*)(p.ws + OFF_C1); g.lda1 = 4096; g.A2 = g.A1; g.lda2 = 4096; g.ksplit = 1 << 30;
        g.Bt = (const u16*)(p.ws + OFF_WOUTO); g.K = 1024;
        for (int rd = 0; rd * 256 < 64 * 4; ++rd) { int pm, pn; if (gemm_tile_coord(rd, 4, 64 * 4, pm, pn)) gemm256<3>(p, g, pm * 256, pn * 256, smem); }
      } PH_END
      PH_BEGIN(11) {
        for (int t = bid; t < 2048; t += nb) phase_final_norm(p, t);
      } PH_END
    }
  }
}

extern "C" void kernel_launch(void* const* d_in, const int* in_sizes, int n_in, void* d_out, int out_size,
                              void* d_ws, size_t ws_size, hipStream_t stream) {
  static int grid_blocks = 0;
  if (!grid_blocks) {
    int dev = 0, cus = 0, per_cu = 0;
    hipGetDevice(&dev);
    hipDeviceGetAttribute(&cus, hipDeviceAttributeMultiprocessorCount, dev);
    hipOccupancyMaxActiveBlocksPerMultiprocessor(&per_cu, mega, NT, 0);
    if (per_cu < 1) per_cu = 1;
    grid_blocks = cus * per_cu;
  }
  Params p{};
  for (int i = 0; i < 31; ++i) p.in[i] = (const float*)d_in[i];
  p.out = (float*)d_out;
  p.ws = (unsigned char*)d_ws;
#if MULTI
  for (int ph = 0; ph < NPHASE; ++ph) {
    hipLaunchKernelGGL(mega, dim3(grid_blocks), dim3(NT), 0, stream, p, ph, ph + 1);
  }
#else
  int ph0 = 0, ph1 = NPHASE;
  void* args[] = {&p, &ph0, &ph1};
  hipError_t e = hipLaunchCooperativeKernel((void*)mega, dim3(grid_blocks), dim3(NT), args, 0, stream);
  if (e != hipSuccess) fprintf(stderr, "cooperative launch failed: %s (grid %d)\n", hipGetErrorString(e), grid_blocks);
#endif
}
```

```cpp
#include <hip/hip_runtime.h>
#include <hip/hip_cooperative_groups.h>
#include <cstdio>
namespace cg = cooperative_groups;

#ifndef REP_MASK
#define REP_MASK 0
#endif
#ifndef REP_SUB
#define REP_SUB 0
#endif
#define OFF_DUMMY 249651200ul
#ifndef MULTI
#define MULTI 0
#endif

#define NT 512
#define DI __device__ __forceinline__
typedef unsigned short u16;
typedef __attribute__((ext_vector_type(8))) short bf16x8;
typedef __attribute__((ext_vector_type(4))) float f32x4;
typedef __attribute__((ext_vector_type(16))) float f32x16;
typedef __attribute__((ext_vector_type(4))) unsigned u32x4;
typedef __attribute__((ext_vector_type(2))) unsigned u32x2;

#define MFMA16(a, b, c) __builtin_amdgcn_mfma_f32_16x16x32_bf16((a), (b), (c), 0, 0, 0)
#define MFMA32(a, b, c) __builtin_amdgcn_mfma_f32_32x32x16_bf16((a), (b), (c), 0, 0, 0)

#define MROWS 16384
#define NPROMPT 8192
#define UTP 16448
#define LDC1 4160
#define LDC0 2592
#define NPAD0 6784
#define SMEM_BYTES 151552

#define OFF_WINE   0ul
#define OFF_WOUTE  14155776ul
#define OFF_WINO   18350080ul
#define OFF_WOUTO  26738688ul
#define OFF_MOD    28835840ul
#define OFF_ROWSS  28909568ul
#define OFF_CDEC   29958144ul
#define OFF_UT     29974528ul
#define OFF_C0A    164716544ul
#define OFF_X1     OFF_UT
#define OFF_C1     97083392ul
#define OFF_H1     233398272ul
#define OUT_H0     0ul
#define OUT_YB     0ul
#define OUT_HF4096 33554432ul
#define OUT_HF256  (33554432ul + 16777216ul)
#define OUT_SBUF   100663296ul
#define O_YP 0ul
#define O_YS 8388608ul
#define O_ST 16777216ul
#define O_NK 25165824ul
#define O_NV 33554432ul

struct Params {
  const float* in[31];
  float* out;
  unsigned char* ws;
};

DI u16 f2bf(float x) { unsigned u = __float_as_uint(x); u += 0x7fffu + ((u >> 16) & 1u); return (u16)(u >> 16); }
DI float bf2f(u16 h) { return __uint_as_float(((unsigned)h) << 16); }
DI unsigned pk2(float a, float b) { return (unsigned)f2bf(a) | ((unsigned)f2bf(b) << 16); }
DI float silu(float x) { return x / (1.f + __expf(-x)); }
DI float bflo(unsigned u) { return __uint_as_float(u << 16); }
DI float bfhi(unsigned u) { return __uint_as_float(u & 0xffff0000u); }
DI void unpack8(const u32x4& v, float* f) {
  f[0] = bflo(v[0]); f[1] = bfhi(v[0]); f[2] = bflo(v[1]); f[3] = bfhi(v[1]);
  f[4] = bflo(v[2]); f[5] = bfhi(v[2]); f[6] = bflo(v[3]); f[7] = bfhi(v[3]);
}
DI u32x4 pack8(const float* f) {
  u32x4 o; o[0] = pk2(f[0], f[1]); o[1] = pk2(f[2], f[3]); o[2] = pk2(f[4], f[5]); o[3] = pk2(f[6], f[7]); return o;
}
DI int row_group(int row) { return row < NPROMPT ? 0 : 1 + ((row - NPROMPT) >> 12); }

DI void phase_ada(const Params& p, int t, unsigned char* smem) {
  float* sc = (float*)smem;
  float* red = sc + 3072;
  const int layer = t / 96, cc = t % 96;
  const int tid = threadIdx.x;
  for (int i = tid; i < 3072; i += NT) {
    int g = i >> 10, k = i & 1023;
    float v = (g == 0) ? p.in[6][k] : p.in[5][(g - 1) * 1024 + k];
    sc[i] = silu(v);
  }
  __syncthreads();
  const int col = tid & 31, kg = tid >> 5;
  const float* w = p.in[8] + (size_t)layer * 1024 * 3072 + cc * 32 + col;
  float a0 = 0.f, a1 = 0.f, a2 = 0.f;
#pragma unroll 8
  for (int k = kg * 64; k < kg * 64 + 64; ++k) {
    float wv = w[(size_t)k * 3072];
    a0 += sc[k] * wv; a1 += sc[1024 + k] * wv; a2 += sc[2048 + k] * wv;
  }
  red[(kg * 3 + 0) * 32 + col] = a0;
  red[(kg * 3 + 1) * 32 + col] = a1;
  red[(kg * 3 + 2) * 32 + col] = a2;
  __syncthreads();
  if (tid < 96) {
    int g = tid >> 5, c = tid & 31;
    float s = 0.f;
    for (int q = 0; q < 16; ++q) s += red[(q * 3 + g) * 32 + c];
    int colg = cc * 32 + c;
    float* mod = (float*)(p.ws + OFF_MOD);
    mod[(layer * 3 + g) * 3072 + colg] = s + p.in[9][layer * 3072 + colg];
  }
  __syncthreads();
}

DI float ld_src(const float* q) { return *q; }
DI float ld_src(const u16* q) { return bf2f(*q); }
template <typename ST>
DI void transpose_tile(const ST* src, int N, int ldsrc, u16* dst, int lddst, int kt, int nt4,
                       const float* kscale, int kscale_n, unsigned char* smem) {
  float* tile = (float*)smem;
  const int tid = threadIdx.x;
  const int c = tid & 63, r0 = tid >> 6;
  float v[4][8];
#pragma unroll
  for (int q = 0; q < 4; ++q)
#pragma unroll
    for (int i = 0; i < 8; ++i) {
      int r = r0 + 8 * i;
      int k = kt * 64 + r, n = (nt4 * 4 + q) * 64 + c;
      v[q][i] = 0.f;
      if (n < N) v[q][i] = ld_src(src + (size_t)k * ldsrc + n);
    }
#pragma unroll
  for (int q = 0; q < 4; ++q)
#pragma unroll
    for (int i = 0; i < 8; ++i) {
      int r = r0 + 8 * i;
      int k = kt * 64 + r;
      float x = v[q][i];
      if (kscale != nullptr && k < kscale_n) x *= kscale[k];
      tile[q * 4160 + r * 65 + c] = x;
    }
  __syncthreads();
  const int rr = tid >> 3, c8 = (tid & 7) * 8;
#pragma unroll
  for (int q = 0; q < 4; ++q) {
    float f[8];
#pragma unroll
    for (int e = 0; e < 8; ++e) f[e] = tile[q * 4160 + (c8 + e) * 65 + rr];
    *(u32x4*)(dst + (size_t)((nt4 * 4 + q) * 64 + rr) * lddst + kt * 64 + c8) = pack8(f);
  }
  __syncthreads();
}

DI void phase_filter(const Params& p, int t, unsigned char* smem) {
  const int cfg = t < 512 ? 1 : 0;
  const int L = cfg ? 4096 : 256;
  const int t0 = (cfg ? t : t - 512) * 8;
  float* feats = (float*)smem;
  float* h1 = feats + 8 * 36;
  float* h2 = h1 + 512;
  const float* w1 = p.in[20]; const float* b1 = p.in[21]; const float* w2 = p.in[22];
  const float* b2 = p.in[23]; const float* w3 = p.in[24]; const float* fr = p.in[25];
  const int tid = threadIdx.x;
  if (tid < 8 * 33) {
    int tt = tid / 33, i = tid % 33;
    int tpos = t0 + tt;
    float tv = (float)tpos / (float)(L - 1);
    float wv = 6.283185307179586f * (float)tpos / (float)L;
    float f;
    if (i == 0) f = tv;
    else if (i <= 16) { float fi = 1e-4f + (float)(i - 1) * ((15.f - 1e-4f) / 15.f); f = cosf(fi * wv); }
    else { float fi = 1e-4f + (float)(i - 17) * ((15.f - 1e-4f) / 15.f); f = -sinf(fi * wv); }
    feats[tt * 36 + i] = f;
  }
  __syncthreads();
  {
    int tt = tid >> 6, j = tid & 63;
    float s = b1[j];
#pragma unroll 4
    for (int i = 0; i < 33; ++i) s += feats[tt * 36 + i] * w1[i * 64 + j];
    h1[tt * 64 + j] = sinf(fr[j] * s);
  }
  __syncthreads();
  {
    int tt = tid >> 6, j = tid & 63;
    float s = b2[j];
#pragma unroll 8
    for (int i = 0; i < 64; ++i) s += h1[tt * 64 + i] * w2[i * 64 + j];
    h2[tt * 64 + j] = sinf(fr[j] * s);
  }
  __syncthreads();
  float acc[4][8];
#pragma unroll
  for (int q = 0; q < 4; ++q)
#pragma unroll
    for (int tt = 0; tt < 8; ++tt) acc[q][tt] = 0.f;
#pragma unroll 16
  for (int k = 0; k < 64; ++k) {
    float wv[4];
#pragma unroll
    for (int q = 0; q < 4; ++q) wv[q] = w3[k * 2048 + tid + 512 * q];
#pragma unroll
    for (int tt = 0; tt < 8; ++tt) {
      float hv = h2[tt * 64 + k];
#pragma unroll
      for (int q = 0; q < 4; ++q) acc[q][tt] += hv * wv[q];
    }
  }
  u16* HF = (u16*)((unsigned char*)p.out + (cfg ? OUT_HF4096 : OUT_HF256));
  const float lo = -15.350567286626973f;
  const float hi = -3.0701134573253945f;
#pragma unroll
  for (int q = 0; q < 4; ++q) {
    int col = tid + 512 * q;
    int dir = col >> 10, c = col & 1023;
    float ad = fabsf(lo + (float)c * ((hi - lo) / 1023.f));
    u16* hc = HF + (size_t)c * (2 * L);
#pragma unroll
    for (int tt = 0; tt < 8; ++tt) {
      int tpos = t0 + tt;
      float tv = (float)tpos / (float)(L - 1);
      float val = acc[q][tt] * expf(-tv * ad);
      if (dir == 0) hc[L - tpos] = f2bf(val);
      else if (tpos > 0) hc[L + tpos] = f2bf(val);
      else hc[0] = 0;
    }
  }
  __syncthreads();
}

DI float wave_sum(float v) {
#pragma unroll
  for (int o = 32; o >= 1; o >>= 1) v += __shfl_xor(v, o);
  return v;
}
DI void phase_norm(const Params& p, int t, int layer, const float* xa, const float* xb, u16* dst) {
  const int lane = threadIdx.x & 63, w = threadIdx.x >> 6;
  const int row0 = t * 32 + w * 4;
  float4 v[4][4];
#pragma unroll
  for (int rr = 0; rr < 4; ++rr) {
    const int row = row0 + rr;
    const float* src = row < NPROMPT ? xa + (size_t)row * 1024 : xb + (size_t)(row - NPROMPT) * 1024;
#pragma unroll
    for (int i = 0; i < 4; ++i) v[rr][i] = *(const float4*)(src + i * 256 + lane * 4);
  }
  const float* nw = p.in[7] + layer * 1024;
#pragma unroll
  for (int rr = 0; rr < 4; ++rr) {
    const int row = row0 + rr;
    const int g = row_group(row);
    float ss = 0.f;
#pragma unroll
    for (int i = 0; i < 4; ++i) ss += v[rr][i].x * v[rr][i].x + v[rr][i].y * v[rr][i].y + v[rr][i].z * v[rr][i].z + v[rr][i].w * v[rr][i].w;
    ss = wave_sum(ss);
    const float rstd = rsqrtf(ss * (1.f / 1024.f) + 1e-6f);
    const float* shift = (const float*)(p.ws + OFF_MOD) + (layer * 3 + g) * 3072;
    const float* scale = shift + 1024;
#pragma unroll
    for (int i = 0; i < 4; ++i) {
      int col = i * 256 + lane * 4;
      float4 nwv = *(const float4*)(nw + col);
      float4 sc = *(const float4*)(scale + col);
      float4 sh = *(const float4*)(shift + col);
      float o0 = v[rr][i].x * rstd * nwv.x * (1.f + sc.x) + sh.x;
      float o1 = v[rr][i].y * rstd * nwv.y * (1.f + sc.y) + sh.y;
      float o2 = v[rr][i].z * rstd * nwv.z * (1.f + sc.z) + sh.z;
      float o3 = v[rr][i].w * rstd * nwv.w * (1.f + sc.w) + sh.w;
      u32x2 o; o[0] = pk2(o0, o1); o[1] = pk2(o2, o3);
      *(u32x2*)(dst + (size_t)row * 1024 + col) = o;
    }
  }
}
DI void phase_final_norm(const Params& p, int t) {
  const int lane = threadIdx.x & 63, w = threadIdx.x >> 6;
  const int row0 = t * 32 + w * 4;
  float4 v[4][4];
#pragma unroll
  for (int rr = 0; rr < 4; ++rr) {
    const float* src = p.out + (size_t)(row0 + rr) * 1024;
#pragma unroll
    for (int i = 0; i < 4; ++i) v[rr][i] = *(const float4*)(src + i * 256 + lane * 4);
  }
  const float* nw = p.in[30];
#pragma unroll
  for (int rr = 0; rr < 4; ++rr) {
    float* src = p.out + (size_t)(row0 + rr) * 1024;
    float ss = 0.f;
#pragma unroll
    for (int i = 0; i < 4; ++i) ss += v[rr][i].x * v[rr][i].x + v[rr][i].y * v[rr][i].y + v[rr][i].z * v[rr][i].z + v[rr][i].w * v[rr][i].w;
    ss = wave_sum(ss);
    const float rstd = rsqrtf(ss * (1.f / 1024.f) + 1e-6f);
#pragma unroll
    for (int i = 0; i < 4; ++i) {
      int col = i * 256 + lane * 4;
      float4 nwv = *(const float4*)(nw + col);
      float4 o;
      o.x = v[rr][i].x * rstd * nwv.x; o.y = v[rr][i].y * rstd * nwv.y; o.z = v[rr][i].z * rstd * nwv.z; o.w = v[rr][i].w * rstd * nwv.w;
      *(float4*)(src + col) = o;
    }
  }
}

struct GemmArgs {
  const u16* A1; int lda1;
  const u16* A2; int lda2;
  int ksplit;
  const u16* Bt; int K;
};
template <int EPI>
DI void gemm_tile(const Params& p, const GemmArgs& g, int m0, int n0, unsigned char* smem) {
  u16* As = (u16*)smem;
  u16* Bs = As + 256 * 72;
  float* rs = (float*)(Bs + 128 * 72);
  const int tid = threadIdx.x, lane = tid & 63, w = tid >> 6;
  const int wm = (w >> 1) * 64, wn = (w & 1) * 64;
  const int l15 = lane & 15, l4 = lane >> 4;
  f32x4 acc[4][4];
#pragma unroll
  for (int i = 0; i < 4; ++i)
#pragma unroll
    for (int j = 0; j < 4; ++j) acc[i][j] = (f32x4){0.f, 0.f, 0.f, 0.f};
  if (EPI == 1) {
    if (tid < 256) {
      const float* rss = (const float*)(p.ws + OFF_ROWSS) + (size_t)(m0 + tid) * 16;
      float s = 0.f;
#pragma unroll
      for (int q = 0; q < 16; ++q) s += rss[q];
      rs[tid] = rsqrtf(s * (1.f / 1024.f) + 1e-6f);
    }
  }
  u32x4 ra[4], rb[2];
  const int KT = g.K >> 6;
  auto loadg = [&](int kt) {
    const int k0 = kt << 6;
    const u16* Ab; int lda; int kk;
    if (k0 < g.ksplit) { Ab = g.A1; lda = g.lda1; kk = k0; } else { Ab = g.A2; lda = g.lda2; kk = k0 - g.ksplit; }
#pragma unroll
    for (int i = 0; i < 4; ++i) {
      int id = tid + 512 * i; int r = id >> 3, c = (id & 7) * 8;
      ra[i] = *(const u32x4*)(Ab + (size_t)(m0 + r) * lda + kk + c);
    }
#pragma unroll
    for (int i = 0; i < 2; ++i) {
      int id = tid + 512 * i; int r = id >> 3, c = (id & 7) * 8;
      rb[i] = *(const u32x4*)(g.Bt + (size_t)(n0 + r) * g.K + k0 + c);
    }
  };
  loadg(0);
  for (int kt = 0; kt < KT; ++kt) {
#pragma unroll
    for (int i = 0; i < 4; ++i) {
      int id = tid + 512 * i; int r = id >> 3, c = (id & 7) * 8;
      *(u32x4*)(As + r * 72 + c) = ra[i];
    }
#pragma unroll
    for (int i = 0; i < 2; ++i) {
      int id = tid + 512 * i; int r = id >> 3, c = (id & 7) * 8;
      *(u32x4*)(Bs + r * 72 + c) = rb[i];
    }
    __syncthreads();
    if (kt + 1 < KT) loadg(kt + 1);
    if (EPI == 1) {
      if ((kt << 6) == g.ksplit) {
#pragma unroll
        for (int i = 0; i < 4; ++i)
#pragma unroll
          for (int r = 0; r < 4; ++r) {
            float sc = rs[wm + i * 16 + l4 * 4 + r];
#pragma unroll
            for (int j = 0; j < 4; ++j) acc[i][j][r] *= sc;
          }
      }
    }
#pragma unroll
    for (int ks = 0; ks < 2; ++ks) {
      bf16x8 a[4], b[4];
#pragma unroll
      for (int i = 0; i < 4; ++i) a[i] = *(const bf16x8*)(As + (wm + i * 16 + l15) * 72 + ks * 32 + l4 * 8);
#pragma unroll
      for (int j = 0; j < 4; ++j) b[j] = *(const bf16x8*)(Bs + (wn + j * 16 + l15) * 72 + ks * 32 + l4 * 8);
#pragma unroll
      for (int i = 0; i < 4; ++i)
#pragma unroll
        for (int j = 0; j < 4; ++j) acc[i][j] = MFMA16(a[i], b[j], acc[i][j]);
    }
    __syncthreads();
  }
#pragma unroll
  for (int i = 0; i < 4; ++i) {
    const int rbase = m0 + wm + i * 16 + l4 * 4;
#pragma unroll
    for (int j = 0; j < 4; ++j) {
      const int col = n0 + wn + j * 16 + l15;
      if (EPI == 0) {
        if (col < LDC0) {
          u16* C = (u16*)(p.ws + OFF_C0A);
#pragma unroll
          for (int r = 0; r < 4; ++r) C[(size_t)(rbase + r) * LDC0 + col] = f2bf(acc[i][j][r]);
        } else if (col < 6688) {
          u16* UT = (u16*)(p.ws + OFF_UT);
          u32x2 o; o[0] = pk2(acc[i][j][0], acc[i][j][1]); o[1] = pk2(acc[i][j][2], acc[i][j][3]);
          *(u32x2*)(UT + (size_t)(col - LDC0) * UTP + rbase) = o;
        }
      } else if (EPI == 1) {
        float* X1 = (float*)(p.ws + OFF_X1);
        const float* mod = (const float*)(p.ws + OFF_MOD);
#pragma unroll
        for (int r = 0; r < 4; ++r) {
          int row = rbase + r;
          const float* xs = row < NPROMPT ? p.in[0] + (size_t)row * 1024 : p.in[1] + (size_t)(row - NPROMPT) * 1024;
          float gate = mod[(0 * 3 + row_group(row)) * 3072 + 2048 + col];
          X1[(size_t)row * 1024 + col] = xs[col] + gate * acc[i][j][r];
        }
      } else if (EPI == 2) {
        u16* C1 = (u16*)(p.ws + OFF_C1);
#pragma unroll
        for (int r = 0; r < 4; ++r) {
          int row = rbase + r;
          C1[(size_t)row * LDC1 + col] = f2bf(acc[i][j][r]);
          if (row < NPROMPT && col >= 1024 && col < 3072) {
            int cc = col - 1024; int isv = cc >> 10; cc &= 1023;
            int hh = cc >> 6, d = cc & 63; int b = row >> 8, l = row & 255;
            float* o = p.out + (isv ? O_NV : O_NK);
            o[(((size_t)b * 16 + hh) * 256 + l) * 64 + d] = acc[i][j][r];
          }
        }
      } else {
        const float* X1 = (const float*)(p.ws + OFF_X1);
        const float* mod = (const float*)(p.ws + OFF_MOD);
#pragma unroll
        for (int r = 0; r < 4; ++r) {
          int row = rbase + r;
          float gate = mod[(1 * 3 + row_group(row)) * 3072 + 2048 + col];
          p.out[(size_t)row * 1024 + col] = X1[(size_t)row * 1024 + col] + gate * acc[i][j][r];
        }
      }
    }
  }
}


DI int lds_byte(int r, int c) {
  int st = (r >> 4) * 2 + (c >> 5), rr = r & 15, cc = c & 31, ob = rr * 64 + cc * 2;
  return st * 1024 + (ob ^ (((ob >> 9) & 1) << 5));
}
DI void stage_rc(int b, int& R, int& C) {
  int st = b / 1024, sb = b % 1024, swz = sb ^ (((sb >> 9) & 1) << 5);
  R = (st >> 1) * 16 + swz / 64; C = (st & 1) * 32 + (swz % 64) / 2;
}
template <int EPI>
DI void epi_store(const Params& p, int rbase, int col, const f32x4& v) {
  if (EPI == 0) {
    if (col < LDC0) {
      u16* C = (u16*)(p.ws + OFF_C0A);
#pragma unroll
      for (int r = 0; r < 4; ++r) C[(size_t)(rbase + r) * LDC0 + col] = f2bf(v[r]);
    } else if (col < 6688) {
      u16* UT = (u16*)(p.ws + OFF_UT);
      u32x2 o; o[0] = pk2(v[0], v[1]); o[1] = pk2(v[2], v[3]);
      *(u32x2*)(UT + (size_t)(col - LDC0) * UTP + rbase) = o;
    }
  } else if (EPI == 1) {
    float* X1 = (float*)(p.ws + OFF_X1);
    const float* mod = (const float*)(p.ws + OFF_MOD);
#pragma unroll
    for (int r = 0; r < 4; ++r) {
      int row = rbase + r;
      const float* xs = row < NPROMPT ? p.in[0] + (size_t)row * 1024 : p.in[1] + (size_t)(row - NPROMPT) * 1024;
      float gate = mod[(0 * 3 + row_group(row)) * 3072 + 2048 + col];
      X1[(size_t)row * 1024 + col] = xs[col] + gate * v[r];
    }
  } else if (EPI == 2) {
    u16* C1 = (u16*)(p.ws + OFF_C1);
#pragma unroll
    for (int r = 0; r < 4; ++r) {
      int row = rbase + r;
      C1[(size_t)row * LDC1 + col] = f2bf(v[r]);
      if (row < NPROMPT && col >= 1024 && col < 3072) {
        int cc = col - 1024; int isv = cc >> 10; cc &= 1023;
        int hh = cc >> 6, d = cc & 63; int b = row >> 8, l = row & 255;
        float* o = p.out + (isv ? O_NV : O_NK);
        o[(((size_t)b * 16 + hh) * 256 + l) * 64 + d] = v[r];
      }
    }
  } else {
    const float* X1 = (const float*)(p.ws + OFF_X1);
    const float* mod = (const float*)(p.ws + OFF_MOD);
#pragma unroll
    for (int r = 0; r < 4; ++r) {
      int row = rbase + r;
      float gate = mod[(1 * 3 + row_group(row)) * 3072 + 2048 + col];
      p.out[(size_t)row * 1024 + col] = X1[(size_t)row * 1024 + col] + gate * v[r];
    }
  }
}

template <int EPI>
DI void gemm256(const Params& p, const GemmArgs& g, int brow, int bcol, unsigned char* smem) {
  constexpr int HT = 128 * 64;
  u16* shm = (u16*)smem;
  float* rs = (float*)(smem + 131072);
  const int K = g.K;
#define SA(b, h) (shm + ((b) * 2 + (h)) * HT)
#define SB(b, h) (shm + (4 + (b) * 2 + (h)) * HT)
#define STAGE_A(P, br, kt) do { const u16* _ub = g.A1 + (long)(br) * g.lda1 + (long)(kt) * 64; \
    for (int _i = 0; _i < 2; ++_i) { \
      __builtin_amdgcn_global_load_lds((const unsigned*)((const char*)(_ub + (long)_i * 64 * g.lda1) + aoff1), \
        (__attribute__((address_space(3))) unsigned*)((char*)(P) + threadIdx.x * 16 + _i * 8192), 16, 0, 0); } } while (0)
#define STAGE_B(P, bc, kt) do { const u16* _ub = g.Bt + (long)(bc) * K + (long)(kt) * 64; \
    for (int _i = 0; _i < 2; ++_i) { \
      __builtin_amdgcn_global_load_lds((const unsigned*)((const char*)(_ub + (long)_i * 64 * K) + boff), \
        (__attribute__((address_space(3))) unsigned*)((char*)(P) + threadIdx.x * 16 + _i * 8192), 16, 0, 0); } } while (0)
#define LDA(dst, b, h) for (int m = 0; m < 4; ++m) for (int k = 0; k < 2; ++k) \
    dst[m][k] = *reinterpret_cast<const bf16x8*>((char*)SA(b, h) + lds_byte(wr * 64 + m * 16 + fr, k * 32 + fq * 8))
#define LDB(dst, b, h) for (int n = 0; n < 2; ++n) for (int k = 0; k < 2; ++k) \
    dst[n][k] = *reinterpret_cast<const bf16x8*>((char*)SB(b, h) + lds_byte(wc * 32 + n * 16 + fr, k * 32 + fq * 8))
#define MMA(ai, bj, At_, Bt_) do { __builtin_amdgcn_s_setprio(1); \
    for (int m = 0; m < 4; ++m) for (int n = 0; n < 2; ++n) for (int k = 0; k < 2; ++k) \
      acc[ai][bj][m][n] = __builtin_amdgcn_mfma_f32_16x16x32_bf16(At_[m][k], Bt_[n][k], acc[ai][bj][m][n], 0, 0, 0); \
    __builtin_amdgcn_s_setprio(0); } while (0)
#define WAIT_V(n) asm volatile("s_waitcnt vmcnt(" #n ")" ::: "memory")
#define WAIT_L(n) asm volatile("s_waitcnt lgkmcnt(" #n ")" ::: "memory")
#define BAR __builtin_amdgcn_s_barrier()
#define SCHED __builtin_amdgcn_sched_barrier(0)
  const int wid = threadIdx.x >> 6, lane = threadIdx.x & 63, wr = wid >> 2, wc = wid & 3, fr = lane & 15, fq = lane >> 4;
  unsigned aoff1, boff;
  {
    int r_, c_; stage_rc(threadIdx.x * 16, r_, c_);
    aoff1 = (unsigned)(r_ * g.lda1 + c_) * 2u;
    boff = (unsigned)(r_ * K + c_) * 2u;
  }
  if (EPI == 1) {
    if (threadIdx.x < 256) {
      const float* rss = (const float*)(p.ws + OFF_ROWSS) + (size_t)(brow + threadIdx.x) * 16;
      float s = 0.f;
#pragma unroll
      for (int q = 0; q < 16; ++q) s += rss[q];
      rs[threadIdx.x] = rsqrtf(s * (1.f / 1024.f) + 1e-6f);
    }
  }
  WAIT_V(0);
  __syncthreads();
  f32x4 acc[2][2][4][2];
#pragma unroll
  for (int a = 0; a < 2; ++a)
#pragma unroll
    for (int b = 0; b < 2; ++b)
#pragma unroll
      for (int m = 0; m < 4; ++m)
#pragma unroll
        for (int n = 0; n < 2; ++n) acc[a][b][m][n] = (f32x4){0.f, 0.f, 0.f, 0.f};
  bf16x8 At[4][2], B0[2][2], B1[2][2];
  const int nt = K / 64;
  const int tscale = (EPI == 1) ? (g.ksplit >> 6) : -1;
  STAGE_B(SB(0, 0), bcol, 0); STAGE_A(SA(0, 0), brow, 0);
  STAGE_B(SB(0, 1), bcol + 128, 0); STAGE_A(SA(0, 1), brow + 128, 0);
  if (wr == 1) BAR;
  WAIT_V(4); BAR;
  STAGE_B(SB(1, 0), bcol, 1); STAGE_A(SA(1, 0), brow, 1); STAGE_B(SB(1, 1), bcol + 128, 1);
  WAIT_V(6); BAR;
  for (int t = 0; t < nt - 2; t += 2) {
    if (EPI == 1) {
      if (t == tscale) {
#pragma unroll
        for (int a = 0; a < 2; ++a)
#pragma unroll
          for (int m = 0; m < 4; ++m)
#pragma unroll
            for (int j = 0; j < 4; ++j) {
              float sc = rs[a * 128 + wr * 64 + m * 16 + fq * 4 + j];
#pragma unroll
              for (int b = 0; b < 2; ++b)
#pragma unroll
                for (int n = 0; n < 2; ++n) acc[a][b][m][n][j] *= sc;
            }
      }
    }
    LDB(B0, 0, 0); SCHED; LDA(At, 0, 0); STAGE_A(SA(1, 1), brow + 128, t + 1);
    WAIT_L(8); BAR; WAIT_L(0); MMA(0, 0, At, B0); BAR; SCHED;
    LDB(B1, 0, 1); STAGE_B(SB(0, 0), bcol, t + 2);
    BAR; WAIT_L(0); MMA(0, 1, At, B1); BAR;
    LDA(At, 0, 1); STAGE_A(SA(0, 0), brow, t + 2);
    BAR; WAIT_L(0); MMA(1, 0, At, B0); BAR; SCHED;
    STAGE_B(SB(0, 1), bcol + 128, t + 2);
    WAIT_V(6); BAR; MMA(1, 1, At, B1); BAR;
    LDB(B0, 1, 0); SCHED; LDA(At, 1, 0); STAGE_A(SA(0, 1), brow + 128, t + 2);
    WAIT_L(8); BAR; WAIT_L(0); MMA(0, 0, At, B0); BAR; SCHED;
    LDB(B1, 1, 1); STAGE_B(SB(1, 0), bcol, t + 3);
    BAR; WAIT_L(0); MMA(0, 1, At, B1); BAR;
    LDA(At, 1, 1); STAGE_A(SA(1, 0), brow, t + 3);
    BAR; WAIT_L(0); MMA(1, 0, At, B0); BAR; SCHED;
    STAGE_B(SB(1, 1), bcol + 128, t + 3);
    WAIT_V(6); BAR; MMA(1, 1, At, B1); BAR;
  }
  { LDB(B0, 0, 0); LDA(At, 0, 0); STAGE_A(SA(1, 1), brow + 128, nt - 1);
    BAR; WAIT_L(0); MMA(0, 0, At, B0); BAR;
    LDB(B1, 0, 1); BAR; WAIT_L(0); MMA(0, 1, At, B1); BAR;
    LDA(At, 0, 1); WAIT_V(4); BAR; WAIT_L(0); MMA(1, 0, At, B0); MMA(1, 1, At, B1); BAR; }
  { LDB(B0, 1, 0); LDA(At, 1, 0); WAIT_V(2); BAR; WAIT_L(0); MMA(0, 0, At, B0); BAR;
    LDB(B1, 1, 1); WAIT_V(0); BAR; WAIT_L(0); MMA(0, 1, At, B1); BAR;
    LDA(At, 1, 1); BAR; WAIT_L(0); MMA(1, 0, At, B0); MMA(1, 1, At, B1); BAR; }
  if (wr == 0) BAR;
  int e_tid = threadIdx.x, e_brow = brow, e_bcol = bcol;
  asm volatile("" : "+v"(e_tid), "+s"(e_brow), "+s"(e_bcol));
  const int e_row = e_brow + ((e_tid >> 8) & 1) * 64 + ((e_tid >> 4) & 3) * 4;
  const int e_col = e_bcol + ((e_tid >> 6) & 3) * 32 + (e_tid & 15);
#pragma unroll
  for (int ai = 0; ai < 2; ++ai)
#pragma unroll
    for (int bj = 0; bj < 2; ++bj)
#pragma unroll
      for (int m = 0; m < 4; ++m)
#pragma unroll
        for (int n = 0; n < 2; ++n)
          epi_store<EPI>(p, e_row + ai * 128 + m * 16, e_col + bj * 128 + n * 16, acc[ai][bj][m][n]);
  __syncthreads();
#undef SA
#undef SB
#undef STAGE_A
#undef STAGE_B
#undef LDA
#undef LDB
#undef MMA
#undef WAIT_V
#undef WAIT_L
#undef BAR
#undef SCHED
}
DI bool gemm_tile_coord(int round, int NN, int ntiles, int& pm, int& pn) {
  const int b = blockIdx.x;
  const int v = round * 256 + (b & 7) * 32 + (b >> 3);
  if (v >= ntiles) return false;
  pm = (v / (8 * NN)) * 8 + (v & 7);
  pn = (v >> 3) % NN;
  return true;
}
struct SsdItem { int row0; int h; int has_prev; int has_next; };
DI SsdItem ssd_item(int item) {
  SsdItem s;
  int cgi = item >> 4; s.h = item & 15;
  if (cgi < 64) { int seq = cgi >> 1, c = cgi & 1; s.row0 = seq * 256 + c * 128; s.has_prev = c > 0; s.has_next = c < 1; }
  else { int q = cgi - 64; int seq = q >> 5, c = q & 31; s.row0 = NPROMPT + seq * 4096 + c * 128; s.has_prev = c > 0; s.has_next = c < 31; }
  return s;
}
DI float ssd_load_dt(const Params& p, int row0, int h) {
  const int tid = threadIdx.x;
  const u16* C0 = (const u16*)(p.ws + OFF_C0A);
  float raw = 0.f;
  if (tid < 256) { int d = tid >> 7, l = tid & 127; raw = bf2f(C0[(size_t)(row0 + l) * LDC0 + 2560 + d * 16 + h]); }
  return raw;
}
DI void ssd_prep_dt(const Params& p, float raw, int h, float* sdt, float* scs, float* stot) {
  const int tid = threadIdx.x, lane = tid & 63, w = tid >> 6;
  if (tid < 256) {
    int d = tid >> 7, l = tid & 127;
    float x = raw + p.in[14][d * 16 + h];
    float dt = x > 20.f ? x : log1pf(expf(x));
    float a = -expf(p.in[15][d * 16 + h]);
    sdt[d * 128 + l] = dt;
    scs[d * 128 + l] = a * dt;
  }
  __syncthreads();
  if (w < 2) {
    const int d = w;
    int p0 = d == 0 ? 2 * lane : 127 - 2 * lane;
    int p1 = d == 0 ? 2 * lane + 1 : 126 - 2 * lane;
    float v0 = scs[d * 128 + p0], v1 = scs[d * 128 + p1];
    float s = v0 + v1;
#pragma unroll
    for (int off = 1; off < 64; off <<= 1) {
      float tv = __shfl_up(s, off);
      if (lane >= off) s += tv;
    }
    float excl = s - (v0 + v1);
    scs[d * 128 + p0] = excl + v0;
    scs[d * 128 + p1] = excl + v0 + v1;
    if (lane == 63) stot[d] = s;
  }
  __syncthreads();
}
DI void conv_silu8(const Params& p, int row, int ch0, bool hp, bool hn, float* out) {
  const u16* C0 = (const u16*)(p.ws + OFF_C0A);
  const u16* q = C0 + (size_t)row * LDC0 + 1024 + ch0;
  const float* cw = p.in[12]; const float* cb = p.in[13];
  float xm[8], xc[8], xp[8];
  u32x4 vc = *(const u32x4*)q;
  unpack8(vc, xc);
  if (hp) { u32x4 v = *(const u32x4*)(q - LDC0); unpack8(v, xm); } else {
#pragma unroll
    for (int e = 0; e < 8; ++e) xm[e] = 0.f;
  }
  if (hn) { u32x4 v = *(const u32x4*)(q + LDC0); unpack8(v, xp); } else {
#pragma unroll
    for (int e = 0; e < 8; ++e) xp[e] = 0.f;
  }
  float4 w0a = *(const float4*)(cw + ch0), w0b = *(const float4*)(cw + ch0 + 4);
  float4 w1a = *(const float4*)(cw + 1536 + ch0), w1b = *(const float4*)(cw + 1536 + ch0 + 4);
  float4 w2a = *(const float4*)(cw + 3072 + ch0), w2b = *(const float4*)(cw + 3072 + ch0 + 4);
  float4 ba = *(const float4*)(cb + ch0), bb = *(const float4*)(cb + ch0 + 4);
  float w0[8] = {w0a.x, w0a.y, w0a.z, w0a.w, w0b.x, w0b.y, w0b.z, w0b.w};
  float w1[8] = {w1a.x, w1a.y, w1a.z, w1a.w, w1b.x, w1b.y, w1b.z, w1b.w};
  float w2[8] = {w2a.x, w2a.y, w2a.z, w2a.w, w2b.x, w2b.y, w2b.z, w2b.w};
  float bv[8] = {ba.x, ba.y, ba.z, ba.w, bb.x, bb.y, bb.z, bb.w};
#pragma unroll
  for (int e = 0; e < 8; ++e) out[e] = silu(bv[e] + w0[e] * xm[e] + w1[e] * xc[e] + w2[e] * xp[e]);
}


template <int R>
DI void conv_load(const Params& p, int row0, int l0, int ch0, bool prev_chunk, bool next_chunk, u32x4 (&raw)[R + 2]) {
  const u16* C0 = (const u16*)(p.ws + OFF_C0A);
  const u16* q = C0 + (size_t)(row0 + l0) * LDC0 + 1024 + ch0;
  const bool hp = (l0 > 0) || prev_chunk;
  const bool hn = (l0 + R < 128) || next_chunk;
#pragma unroll
  for (int i = 0; i < R + 2; ++i) {
    const bool ok = (i == 0) ? hp : ((i == R + 1) ? hn : true);
    raw[i] = (u32x4){0u, 0u, 0u, 0u};
    if (ok) raw[i] = *(const u32x4*)(q + (long)(i - 1) * LDC0);
  }
}
template <int R>
DI void conv_compute(const Params& p, int ch0, const u32x4 (&raw)[R + 2], float (&out)[R][8]) {
  const float* cw = p.in[12]; const float* cb = p.in[13];
  float4 w0a = *(const float4*)(cw + ch0), w0b = *(const float4*)(cw + ch0 + 4);
  float4 w1a = *(const float4*)(cw + 1536 + ch0), w1b = *(const float4*)(cw + 1536 + ch0 + 4);
  float4 w2a = *(const float4*)(cw + 3072 + ch0), w2b = *(const float4*)(cw + 3072 + ch0 + 4);
  float4 ba = *(const float4*)(cb + ch0), bb = *(const float4*)(cb + ch0 + 4);
  const float w0[8] = {w0a.x, w0a.y, w0a.z, w0a.w, w0b.x, w0b.y, w0b.z, w0b.w};
  const float w1[8] = {w1a.x, w1a.y, w1a.z, w1a.w, w1b.x, w1b.y, w1b.z, w1b.w};
  const float w2[8] = {w2a.x, w2a.y, w2a.z, w2a.w, w2b.x, w2b.y, w2b.z, w2b.w};
  const float bv[8] = {ba.x, ba.y, ba.z, ba.w, bb.x, bb.y, bb.z, bb.w};
  float xm[8], xc[8], xp[8];
  unpack8(raw[0], xm); unpack8(raw[1], xc);
#pragma unroll
  for (int i = 0; i < R; ++i) {
    unpack8(raw[i + 2], xp);
#pragma unroll
    for (int e = 0; e < 8; ++e) {
      out[i][e] = silu(bv[e] + w0[e] * xm[e] + w1[e] * xc[e] + w2[e] * xp[e]);
      xm[e] = xc[e]; xc[e] = xp[e];
    }
  }
}
DI void phase_ssd_states(const Params& p, int item, unsigned char* smem) {
  u16* xT = (u16*)smem;
  u16* BTs = xT + 64 * 136;
  float* sdt = (float*)(BTs + 2 * 128 * 136);
  float* scs = sdt + 256;
  float* sw = scs + 256;
  float* stot = sw + 256;
  const int tid = threadIdx.x, lane = tid & 63, w = tid >> 6;
  const int l15 = lane & 15, l4 = lane >> 4;
  const SsdItem it = ssd_item(item);
  const int h = it.h, grp = h >> 3;
  const int xchunk = tid & 7, xrg = tid >> 3;
  const int bchunk = tid & 15, brg = tid >> 4;
  u32x4 rawx[4], rawb[6];
  const float rawdt = ssd_load_dt(p, it.row0, h);
  conv_load<2>(p, it.row0, xrg * 2, h * 64 + xchunk * 8, it.has_prev, it.has_next, rawx);
  conv_load<4>(p, it.row0, brg * 4, 1024 + grp * 128 + bchunk * 8, it.has_prev, it.has_next, rawb);
  ssd_prep_dt(p, rawdt, h, sdt, scs, stot);
  if (tid < 256) {
    int d = tid >> 7;
    sw[tid] = sdt[tid] * __expf(stot[d] - scs[tid]);
  }
  __syncthreads();
  {
    {
      float o[2][8];
      conv_compute<2>(p, h * 64 + xchunk * 8, rawx, o);
#pragma unroll
      for (int e = 0; e < 8; ++e) *(unsigned*)(xT + (xchunk * 8 + e) * 136 + xrg * 2) = pk2(o[0][e], o[1][e]);
    }
    {
      float o[4][8];
      conv_compute<4>(p, 1024 + grp * 128 + bchunk * 8, rawb, o);
#pragma unroll
      for (int dd = 0; dd < 2; ++dd) {
        const float s0 = sw[dd * 128 + brg * 4], s1 = sw[dd * 128 + brg * 4 + 1], s2 = sw[dd * 128 + brg * 4 + 2], s3 = sw[dd * 128 + brg * 4 + 3];
#pragma unroll
        for (int e = 0; e < 8; ++e) {
          u32x2 v; v[0] = pk2(o[0][e] * s0, o[1][e] * s1); v[1] = pk2(o[2][e] * s2, o[3][e] * s3);
          *(u32x2*)(BTs + dd * 128 * 136 + (bchunk * 8 + e) * 136 + brg * 4) = v;
        }
      }
    }
  }
  __syncthreads();
  const int d = w >> 2, nq = w & 3;
  f32x4 acc[4][2];
#pragma unroll
  for (int i = 0; i < 4; ++i) { acc[i][0] = (f32x4){0.f, 0.f, 0.f, 0.f}; acc[i][1] = (f32x4){0.f, 0.f, 0.f, 0.f}; }
#pragma unroll
  for (int ks = 0; ks < 4; ++ks) {
    bf16x8 a[4], b[2];
#pragma unroll
    for (int i = 0; i < 4; ++i) a[i] = *(const bf16x8*)(xT + (i * 16 + l15) * 136 + ks * 32 + l4 * 8);
#pragma unroll
    for (int j = 0; j < 2; ++j) b[j] = *(const bf16x8*)(BTs + d * 128 * 136 + (nq * 32 + j * 16 + l15) * 136 + ks * 32 + l4 * 8);
#pragma unroll
    for (int i = 0; i < 4; ++i)
#pragma unroll
      for (int j = 0; j < 2; ++j) acc[i][j] = MFMA16(a[i], b[j], acc[i][j]);
  }
  u16* S = (u16*)((unsigned char*)p.out + OUT_SBUF) + ((size_t)item * 2 + d) * 8192;
#pragma unroll
  for (int i = 0; i < 4; ++i)
#pragma unroll
    for (int j = 0; j < 2; ++j)
#pragma unroll
      for (int r = 0; r < 4; ++r) {
        int pp = i * 16 + l4 * 4 + r, n = nq * 32 + j * 16 + l15;
        S[pp * 128 + n] = f2bf(acc[i][j][r]);
      }
  if (tid < 2) {
    float* cdec = (float*)(p.ws + OFF_CDEC);
    cdec[item * 2 + tid] = __expf(stot[tid]);
  }
  __syncthreads();
}

DI void phase_scan(const Params& p, int t) {
  const int part = t & 1, d = (t >> 1) & 1, h = (t >> 2) & 15, seq = t >> 6;
  const int tid = threadIdx.x;
  const int e0 = part * 4096 + tid * 8;
  const int nc = seq < 32 ? 2 : 32;
  const int cg0 = seq < 32 ? seq * 2 : 64 + (seq - 32) * 32;
  float st[8];
  if (seq < 32) {
#pragma unroll
    for (int e = 0; e < 8; ++e) st[e] = 0.f;
  } else {
    const float* init = p.in[2] + ((((size_t)(seq - 32) * 1 + 0) * 2 + d) * 16 + h) * 8192 + e0;
    float4 a = *(const float4*)init, b = *(const float4*)(init + 4);
    st[0] = a.x; st[1] = a.y; st[2] = a.z; st[3] = a.w; st[4] = b.x; st[5] = b.y; st[6] = b.z; st[7] = b.w;
  }
  u16* Sb = (u16*)((unsigned char*)p.out + OUT_SBUF);
  const float* cdec = (const float*)(p.ws + OFF_CDEC);
  for (int cb0 = 0; cb0 < nc; cb0 += 8) {
    u32x4 vv[8]; float dec[8];
#pragma unroll
    for (int i = 0; i < 8; ++i) {
      if (cb0 + i < nc) {
        const int ci = cb0 + i;
        const int c = d == 0 ? ci : nc - 1 - ci;
        const int item = (cg0 + c) * 16 + h;
        vv[i] = *(const u32x4*)(Sb + ((size_t)item * 2 + d) * 8192 + e0);
        dec[i] = cdec[item * 2 + d];
      }
    }
#pragma unroll
    for (int i = 0; i < 8; ++i) {
      if (cb0 + i < nc) {
        const int ci = cb0 + i;
        const int c = d == 0 ? ci : nc - 1 - ci;
        const int item = (cg0 + c) * 16 + h;
        float sc[8]; unpack8(vv[i], sc);
        *(u32x4*)(Sb + ((size_t)item * 2 + d) * 8192 + e0) = pack8(st);
#pragma unroll
        for (int e = 0; e < 8; ++e) st[e] = st[e] * dec[i] + sc[e];
      }
    }
  }
  if (seq < 32) {
    float* o = p.out + O_ST + ((((size_t)seq * 1 + 0) * 2 + d) * 16 + h) * 8192 + e0;
    *(float4*)o = make_float4(st[0], st[1], st[2], st[3]);
    *(float4*)(o + 4) = make_float4(st[4], st[5], st[6], st[7]);
  }
}

DI void phase_ssd_out(const Params& p, int item, unsigned char* smem, bool dry) {
  u16* Cs = (u16*)smem;
  u16* Bs = Cs + 128 * 136;
  u16* xT = Bs + 128 * 136;
  u16* St = xT + 64 * 136;
  float* sdt = (float*)(St + 2 * 64 * 136);
  float* scs = sdt + 256;
  float* stot = scs + 256;
  const int tid = threadIdx.x, lane = tid & 63, w = tid >> 6;
  const int l15 = lane & 15, l4 = lane >> 4;
  const SsdItem it = ssd_item(item);
  const int h = it.h, grp = h >> 3;
  const int xchunk = tid & 7, xrg = tid >> 3;
  const int bchunk = tid & 15, brg = tid >> 4;
  u32x4 rawx[4], rawb[6], rawc[6], rawst[4];
  u16 zraw[4][4];
  const float rawdt = ssd_load_dt(p, it.row0, h);
  conv_load<2>(p, it.row0, xrg * 2, h * 64 + xchunk * 8, it.has_prev, it.has_next, rawx);
  conv_load<4>(p, it.row0, brg * 4, 1024 + grp * 128 + bchunk * 8, it.has_prev, it.has_next, rawb);
  conv_load<4>(p, it.row0, brg * 4, 1280 + grp * 128 + bchunk * 8, it.has_prev, it.has_next, rawc);
  {
    const u16* S = (const u16*)((const unsigned char*)p.out + OUT_SBUF) + (size_t)item * 2 * 8192;
#pragma unroll
    for (int v = 0; v < 4; ++v) {
      int id = tid + 512 * v;
      int dd = id >> 10, pp = (id >> 4) & 63, nv = (id & 15) * 8;
      rawst[v] = *(const u32x4*)(S + dd * 8192 + pp * 128 + nv);
    }
  }
  ssd_prep_dt(p, rawdt, h, sdt, scs, stot);
  {
    {
      float o[2][8];
      conv_compute<2>(p, h * 64 + xchunk * 8, rawx, o);
#pragma unroll
      for (int e = 0; e < 8; ++e) *(unsigned*)(xT + (xchunk * 8 + e) * 136 + xrg * 2) = pk2(o[0][e], o[1][e]);
    }
    {
      float o[4][8];
      conv_compute<4>(p, 1024 + grp * 128 + bchunk * 8, rawb, o);
#pragma unroll
      for (int i = 0; i < 4; ++i) *(u32x4*)(Bs + (brg * 4 + i) * 136 + bchunk * 8) = pack8(o[i]);
      conv_compute<4>(p, 1280 + grp * 128 + bchunk * 8, rawc, o);
#pragma unroll
      for (int i = 0; i < 4; ++i) *(u32x4*)(Cs + (brg * 4 + i) * 136 + bchunk * 8) = pack8(o[i]);
    }
#pragma unroll
    for (int v = 0; v < 4; ++v) {
      int id = tid + 512 * v;
      int dd = id >> 10, pp = (id >> 4) & 63, nv = (id & 15) * 8;
      *(u32x4*)(St + dd * 64 * 136 + pp * 136 + nv) = rawst[v];
    }
  }
  __syncthreads();
  {
    const u16* C0z = (const u16*)(p.ws + OFF_C0A);
#pragma unroll
    for (int i = 0; i < 4; ++i)
#pragma unroll
      for (int r = 0; r < 4; ++r)
        zraw[i][r] = C0z[(size_t)(it.row0 + 16 * w + l4 * 4 + r) * LDC0 + h * 64 + i * 16 + l15];
  }
  f32x4 cb[8], af[4], ab[4];
#pragma unroll
  for (int j = 0; j < 8; ++j) cb[j] = (f32x4){0.f, 0.f, 0.f, 0.f};
#pragma unroll
  for (int i = 0; i < 4; ++i) { af[i] = (f32x4){0.f, 0.f, 0.f, 0.f}; ab[i] = (f32x4){0.f, 0.f, 0.f, 0.f}; }
#pragma unroll
  for (int ks = 0; ks < 4; ++ks) {
    bf16x8 a = *(const bf16x8*)(Cs + (16 * w + l15) * 136 + ks * 32 + l4 * 8);
#pragma unroll
    for (int j = 0; j < 8; ++j) {
      bf16x8 b = *(const bf16x8*)(Bs + (j * 16 + l15) * 136 + ks * 32 + l4 * 8);
      cb[j] = MFMA16(a, b, cb[j]);
    }
#pragma unroll
    for (int i = 0; i < 4; ++i) {
      bf16x8 b0 = *(const bf16x8*)(St + (i * 16 + l15) * 136 + ks * 32 + l4 * 8);
      bf16x8 b1 = *(const bf16x8*)(St + 64 * 136 + (i * 16 + l15) * 136 + ks * 32 + l4 * 8);
      af[i] = MFMA16(a, b0, af[i]);
      ab[i] = MFMA16(a, b1, ab[i]);
    }
  }
  __syncthreads();
  f32x4 Y[4];
  {
    float cs0l[4], cs1l[4];
#pragma unroll
    for (int r = 0; r < 4; ++r) { int l = 16 * w + l4 * 4 + r; cs0l[r] = scs[l]; cs1l[r] = scs[128 + l]; }
#pragma unroll
    for (int j = 0; j < 8; ++j) {
      const int s = j * 16 + l15;
      const float cs0s = scs[s], cs1s = scs[128 + s], dt0s = sdt[s], dt1s = sdt[128 + s];
#pragma unroll
      for (int r = 0; r < 4; ++r) {
        const int l = 16 * w + l4 * 4 + r;
        float f;
        if (l > s) f = __expf(cs0l[r] - cs0s) * dt0s;
        else if (l < s) f = __expf(cs1l[r] - cs1s) * dt1s;
        else f = dt0s + dt1s;
        Bs[l * 136 + s] = f2bf(cb[j][r] * f);
      }
    }
#pragma unroll
    for (int r = 0; r < 4; ++r) {
      float e0 = __expf(cs0l[r]), e1 = __expf(cs1l[r]);
#pragma unroll
      for (int i = 0; i < 4; ++i) Y[i][r] = af[i][r] * e0 + ab[i][r] * e1;
    }
  }
  __syncthreads();
#pragma unroll
  for (int ks = 0; ks < 4; ++ks) {
    bf16x8 a = *(const bf16x8*)(Bs + (16 * w + l15) * 136 + ks * 32 + l4 * 8);
#pragma unroll
    for (int i = 0; i < 4; ++i) {
      bf16x8 b = *(const bf16x8*)(xT + (i * 16 + l15) * 136 + ks * 32 + l4 * 8);
      Y[i] = MFMA16(a, b, Y[i]);
    }
  }
  {
    const u16* C0 = (const u16*)(p.ws + OFF_C0A);
    u16* YAB = dry ? (u16*)(p.ws + OFF_DUMMY) + (size_t)(blockIdx.x & 15) * 400000 - (size_t)it.row0 * 2048 : (u16*)((unsigned char*)p.out + OUT_YB);
    const float dsk = p.in[16][h] + p.in[16][16 + h];
    float ss[4] = {0.f, 0.f, 0.f, 0.f};
#pragma unroll
    for (int i = 0; i < 4; ++i) {
      const int pp = i * 16 + l15;
#pragma unroll
      for (int r = 0; r < 4; ++r) {
        const int l = 16 * w + l4 * 4 + r;
        const size_t off = (size_t)(it.row0 + l) * LDC0 + h * 64 + pp;
        float xv = bf2f(xT[pp * 136 + l]);
        float y = Y[i][r] + xv * dsk;
        float z = bf2f(zraw[i][r]);
        float gv = y * silu(z);
        YAB[(size_t)(it.row0 + l) * 2048 + h * 64 + pp] = f2bf(gv);
        ss[r] += gv * gv;
      }
    }
    float* rss = (float*)(p.ws + OFF_ROWSS);
#pragma unroll
    for (int r = 0; r < 4; ++r) {
      float s = ss[r];
      s += __shfl_xor(s, 1); s += __shfl_xor(s, 2); s += __shfl_xor(s, 4); s += __shfl_xor(s, 8);
      if (l15 == 0) rss[(size_t)(it.row0 + 16 * w + l4 * 4 + r) * 16 + h] = s;
    }
  }
  __syncthreads();
}


template <int MASK>
DI void hy_seg(int dlo, int dhi, int L, int A, const u16* hr, const u16* vx, const int (&ncol)[4], const int (&acol)[4],
               int l31, int kh, f32x16 (&acc)[4]) {
  int oz = 0;
  asm volatile("" : "+v"(oz));
#pragma unroll 1
  for (int d = dlo; d <= dhi; ++d) {
    bf16x8 af[2];
#pragma unroll
    for (int khalf = 0; khalf < 2; ++khalf) {
      const int idx0 = L - 32 * d - l31 + 16 * khalf + 8 * kh;
#pragma unroll
      for (int e = 0; e < 8; ++e) af[khalf][e] = (short)hr[idx0 + e + oz * (e + 1)];
    }
    bf16x8 bfr[4][2];
#pragma unroll
    for (int j = 0; j < 4; ++j) {
      if (MASK & (1 << j)) {
        const int asrc = acol[j] - d;
        const bool valid = (asrc >= 0) && (asrc < A);
        const int nsrc = valid ? (ncol[j] - d) : ncol[j];
#pragma unroll
        for (int khalf = 0; khalf < 2; ++khalf) {
          bf16x8 t = *(const bf16x8*)(vx + nsrc * 40 + 16 * khalf + 8 * kh);
          if (!valid) t = (bf16x8){0, 0, 0, 0, 0, 0, 0, 0};
          bfr[j][khalf] = t;
        }
      }
    }
#pragma unroll
    for (int khalf = 0; khalf < 2; ++khalf)
#pragma unroll
      for (int j = 0; j < 4; ++j)
        if (MASK & (1 << j)) acc[j] = MFMA32(af[khalf], bfr[j][khalf], acc[j]);
  }
}
DI void phase_hyena(const Params& p, int it, unsigned char* smem, bool dry) {
  const int cfg = it < 256 ? 1 : 0;
  const int c0 = (it & 255) * 4;
  const int L = cfg ? 4096 : 256;
  const int A = L >> 5;
  const int lgA = cfg ? 7 : 3;
  const int rowbase = cfg ? NPROMPT : 0;
  u16* vxs = (u16*)smem;
  u16* hrs = vxs + 4 * 10240;
  const int tid = threadIdx.x, lane = tid & 63, w = tid >> 6;
  const u16* UT = (const u16*)(p.ws + OFF_UT);
  const float* cw = p.in[18]; const float* cbv = p.in[19];
  {
    const u16* HF = (const u16*)((const unsigned char*)p.out + (cfg ? OUT_HF4096 : OUT_HF256));
    const int nv = (2 * L) >> 3;
    const int lgnv = cfg ? 10 : 6;
    {
      u32x4 fv[8];
#pragma unroll
      for (int it8 = 0; it8 < 8; ++it8) {
        const int id = tid + it8 * NT;
        fv[it8] = (u32x4){0u, 0u, 0u, 0u};
        if (id < 4 * nv) { int chh = id >> lgnv, v8 = id & (nv - 1); fv[it8] = *(const u32x4*)(HF + (size_t)(c0 + chh) * 2 * L + v8 * 8); }
      }
#pragma unroll
      for (int it8 = 0; it8 < 8; ++it8) {
        const int id = tid + it8 * NT;
        if (id < 4 * nv) { int chh = id >> lgnv, v8 = id & (nv - 1); *(u32x4*)(hrs + chh * 2 * L + v8 * 8) = fv[it8]; }
      }
    }
#pragma unroll 1
    for (int hb4 = 0; hb4 < 2; ++hb4) {
    u32x4 rv[4][2]; float hm[4][2], hp[4][2];
#pragma unroll
    for (int it8 = 0; it8 < 4; ++it8) {
      const int id = tid + (hb4 * 4 + it8) * NT;
      const int chh = id >> 10, blk8 = id & 1023;
      const int pos = blk8 * 8, tl = pos & (L - 1);
#pragma unroll
      for (int which = 1; which <= 2; ++which) {
        const u16* q = UT + (size_t)(which * 1024 + c0 + chh) * UTP + rowbase + pos;
        rv[it8][which - 1] = *(const u32x4*)q;
        hm[it8][which - 1] = (tl > 0) ? bf2f(q[-1]) : 0.f;
        hp[it8][which - 1] = (tl + 8 < L) ? bf2f(q[8]) : 0.f;
      }
    }
#pragma unroll
    for (int it8 = 0; it8 < 4; ++it8) {
      const int id = tid + (hb4 * 4 + it8) * NT;
      const int chh = id >> 10, blk8 = id & 1023;
      const int pos = blk8 * 8;
      float res[8];
#pragma unroll
      for (int e = 0; e < 8; ++e) res[e] = 1.f;
#pragma unroll
      for (int which = 1; which <= 2; ++which) {
        const int uc = which * 1024 + c0 + chh;
        float xv[10];
        unpack8(rv[it8][which - 1], xv + 1);
        xv[0] = hm[it8][which - 1]; xv[9] = hp[it8][which - 1];
        const float w0 = cw[uc], w1 = cw[3072 + uc], w2 = cw[6144 + uc], bb = cbv[uc];
#pragma unroll
        for (int e = 0; e < 8; ++e) res[e] *= (bb + w0 * xv[e] + w1 * xv[e + 1] + w2 * xv[e + 2]);
      }
      const int n = pos >> 5, k = pos & 31;
      *(u32x4*)(vxs + chh * 10240 + n * 40 + k) = pack8(res);
    }
    }
  }
  __syncthreads();
  const int ch = w >> 1, wv = w & 1;
  const int l31 = lane & 31, kh = lane >> 5;
  const u16* vx = vxs + ch * 10240;
  const u16* hr = hrs + ch * 2 * L;
  f32x16 acc[4];
#pragma unroll
  for (int j = 0; j < 4; ++j)
#pragma unroll
    for (int r = 0; r < 16; ++r) acc[j][r] = 0.f;
  int ncol[4], acol[4];
#pragma unroll
  for (int j = 0; j < 4; ++j) { ncol[j] = 128 * wv + 32 * j + l31; acol[j] = ncol[j] & (A - 1); }
  if (!(dry && REP_SUB == 4)) {
  if (cfg) {
    hy_seg<1>(-127, -96, L, A, hr, vx, ncol, acol, l31, kh, acc);
    hy_seg<3>(-95, -64, L, A, hr, vx, ncol, acol, l31, kh, acc);
    hy_seg<7>(-63, -32, L, A, hr, vx, ncol, acol, l31, kh, acc);
    hy_seg<15>(-31, 31, L, A, hr, vx, ncol, acol, l31, kh, acc);
    hy_seg<14>(32, 63, L, A, hr, vx, ncol, acol, l31, kh, acc);
    hy_seg<12>(64, 95, L, A, hr, vx, ncol, acol, l31, kh, acc);
    hy_seg<8>(96, 127, L, A, hr, vx, ncol, acol, l31, kh, acc);
  } else {
    hy_seg<15>(-7, 7, L, A, hr, vx, ncol, acol, l31, kh, acc);
  }
  }
  {
    const int c = c0 + ch;
    const float hb = p.in[26][c];
    const float w0 = cw[c], w1 = cw[3072 + c], w2 = cw[6144 + c], bb = cbv[c];
    const u16* x0row = UT + (size_t)c * UTP + rowbase;
    const u16* grow = (const u16*)(p.ws + OFF_UT) + (size_t)(3072 + c) * UTP + rowbase;
    u16* groww = dry ? (u16*)(p.ws + OFF_DUMMY) + (size_t)blockIdx.x * 32768 + ch * 8192
                     : (u16*)(p.ws + OFF_UT) + (size_t)(3072 + c) * UTP + rowbase;
#pragma unroll
    for (int jh = 0; jh < 4; ++jh) {
    __builtin_amdgcn_sched_barrier(0);
    u32x2 xr[4][4], gr[4][4]; float xm[4][4], xp[4][4];
#pragma unroll
    for (int j = jh; j < jh + 1; ++j) {
      const int n = ncol[j];
#pragma unroll
      for (int q = 0; q < 4; ++q) {
        const int pos = 32 * n + 8 * q + 4 * kh;
        const int tl = pos & (L - 1);
        xr[j][q] = *(const u32x2*)(x0row + pos);
        gr[j][q] = *(const u32x2*)(grow + pos);
        xm[j][q] = tl > 0 ? bf2f(x0row[pos - 1]) : 0.f;
        xp[j][q] = (tl + 4 < L) ? bf2f(x0row[pos + 4]) : 0.f;
      }
    }
#pragma unroll
    for (int j = jh; j < jh + 1; ++j) {
      const int n = ncol[j];
#pragma unroll
      for (int q = 0; q < 4; ++q) {
        const int pos = 32 * n + 8 * q + 4 * kh;
        u32x2 vr = *(const u32x2*)(vx + n * 40 + 8 * q + 4 * kh);
        float xv[6] = {xm[j][q], bflo(xr[j][q][0]), bfhi(xr[j][q][0]), bflo(xr[j][q][1]), bfhi(xr[j][q][1]), xp[j][q]};
        float gv[4] = {bflo(gr[j][q][0]), bfhi(gr[j][q][0]), bflo(gr[j][q][1]), bfhi(gr[j][q][1])};
        float vv[4] = {bflo(vr[0]), bfhi(vr[0]), bflo(vr[1]), bfhi(vr[1])};
        float y[4];
#pragma unroll
        for (int e = 0; e < 4; ++e) {
          float x0 = bb + w0 * xv[e] + w1 * xv[e + 1] + w2 * xv[e + 2];
          y[e] = x0 * (acc[j][4 * q + e] + vv[e] * hb) * silu(gv[e]);
        }
        u32x2 o; o[0] = pk2(y[0], y[1]); o[1] = pk2(y[2], y[3]);
        *(u32x2*)(groww + pos) = o;
        __builtin_amdgcn_sched_barrier(0);
      }
    }
    }
  }
  (void)lgA;
  __syncthreads();
}

#define VSP 72
typedef __attribute__((ext_vector_type(4))) short v4i16_t;
DI float dpp_rowmax(float v) {
  v = fmaxf(v, __builtin_bit_cast(float, __builtin_amdgcn_update_dpp(0, __builtin_bit_cast(int, v), 0x128, 0xf, 0xf, false)));
  v = fmaxf(v, __builtin_bit_cast(float, __builtin_amdgcn_update_dpp(0, __builtin_bit_cast(int, v), 0x124, 0xf, 0xf, false)));
  v = fmaxf(v, __builtin_bit_cast(float, __builtin_amdgcn_update_dpp(0, __builtin_bit_cast(int, v), 0x122, 0xf, 0xf, false)));
  v = fmaxf(v, __builtin_bit_cast(float, __builtin_amdgcn_update_dpp(0, __builtin_bit_cast(int, v), 0x121, 0xf, 0xf, false)));
  return v;
}
DI float dpp_rowsum(float v) {
  v += __builtin_bit_cast(float, __builtin_amdgcn_update_dpp(0, __builtin_bit_cast(int, v), 0x128, 0xf, 0xf, false));
  v += __builtin_bit_cast(float, __builtin_amdgcn_update_dpp(0, __builtin_bit_cast(int, v), 0x124, 0xf, 0xf, false));
  v += __builtin_bit_cast(float, __builtin_amdgcn_update_dpp(0, __builtin_bit_cast(int, v), 0x122, 0xf, 0xf, false));
  v += __builtin_bit_cast(float, __builtin_amdgcn_update_dpp(0, __builtin_bit_cast(int, v), 0x121, 0xf, 0xf, false));
  return v;
}
DI void phase_attn(const Params& p, int item, unsigned char* smem, bool dry) {
  u16* VS = (u16*)smem;
  u16* Pb = VS + 768 * VSP;
  float* rp = (float*)(Pb + 8 * 16 * 72);
  float* mrg = (float*)smem;
  const int tid = threadIdx.x, lane = tid & 63, w = tid >> 6;
  const int l15 = lane & 15, l4 = lane >> 4;
  const u16* C1 = (const u16*)(p.ws + OFF_C1);
  const bool lat = item < 2048;
  int b, h, rr = 0, rows0 = 0, qrow0, keyrow0;
  if (lat) { b = item >> 10; h = (item >> 6) & 15; rr = item & 63; rows0 = min(max(rr - 4, 0), 56);
             qrow0 = NPROMPT + b * 4096 + rr * 64; keyrow0 = NPROMPT + b * 4096 + rows0 * 64; }
  else { int q = item - 2048; b = q >> 6; h = (q >> 2) & 15; int qt = q & 3; qrow0 = b * 256 + qt * 64; keyrow0 = b * 256; }
  const int jq = w & 3, gk = w >> 2;
  const int qbase = qrow0 + jq * 16;
  bf16x8 qa[2];
#pragma unroll
  for (int ks = 0; ks < 2; ++ks) qa[ks] = *(const bf16x8*)(C1 + (size_t)(qbase + l15) * LDC1 + h * 64 + ks * 32 + l4 * 8);
  const int ntile = lat ? 4 : 2;
  const int cstart = min(max(16 * jq - 8, 0), 32);
  const bool fp32k = lat && gk == 1;
  const bool local = lat && gk == 0;
  const float* ck = p.in[3] + ((size_t)b * 16 + h) * 256 * 64;
  auto loadk = [&](int tt, bf16x8 (&kb)[4][2]) {
#pragma unroll
    for (int jt = 0; jt < 4; ++jt) {
      if (fp32k) {
        const int key = tt * 64 + jt * 16 + l15;
#pragma unroll
        for (int ks = 0; ks < 2; ++ks) {
          const float* q = ck + key * 64 + ks * 32 + l4 * 8;
          float4 a = *(const float4*)q, c = *(const float4*)(q + 4);
          float f[8] = {a.x, a.y, a.z, a.w, c.x, c.y, c.z, c.w};
          u32x4 pk = pack8(f);
          kb[jt][ks] = __builtin_bit_cast(bf16x8, pk);
        }
      } else {
        int krow;
        if (lat) krow = keyrow0 + (tt * 2 + (jt >> 1)) * 64 + cstart + (jt & 1) * 16 + l15;
        else krow = keyrow0 + gk * 128 + tt * 64 + jt * 16 + l15;
#pragma unroll
        for (int ks = 0; ks < 2; ++ks)
          kb[jt][ks] = *(const bf16x8*)(C1 + (size_t)krow * LDC1 + 1024 + h * 64 + ks * 32 + l4 * 8);
      }
    }
  };
  bf16x8 kn[4][2], kn2[4][2];
  loadk(0, kn);
  if (ntile > 1) loadk(1, kn2);
  u16 graw[4][4];
  if (gk == 0) {
#pragma unroll
    for (int r = 0; r < 4; ++r)
#pragma unroll
      for (int i = 0; i < 4; ++i)
        graw[r][i] = C1[(size_t)(qbase + l4 * 4 + r) * LDC1 + 3072 + h * 64 + i * 16 + l15];
  }
  if (!(dry && REP_SUB == 7)) {
    const int nloc = lat ? 512 : 256;
    u32x4 vv[8];
#pragma unroll
    for (int i = 0; i < 8; ++i) {
      const int id = tid + i * NT;
      vv[i] = (u32x4){0u, 0u, 0u, 0u};
      if (id < nloc * 8) { int key = id >> 3, d0 = (id & 7) * 8; vv[i] = *(const u32x4*)(C1 + (size_t)(keyrow0 + key) * LDC1 + 2048 + h * 64 + d0); }
    }
    float4 cva[4], cvb[4];
    const float* cv = p.in[4] + ((size_t)b * 16 + h) * 256 * 64;
    if (lat) {
#pragma unroll
      for (int i = 0; i < 4; ++i) {
        const int id = tid + i * NT; int key = id >> 3, d0 = (id & 7) * 8;
        cva[i] = *(const float4*)(cv + key * 64 + d0); cvb[i] = *(const float4*)(cv + key * 64 + d0 + 4);
      }
    }
#pragma unroll
    for (int i = 0; i < 8; ++i) {
      const int id = tid + i * NT;
      if (id < nloc * 8) { int key = id >> 3, d0 = (id & 7) * 8; *(u32x4*)(VS + key * VSP + d0) = vv[i]; }
    }
    if (lat) {
#pragma unroll
      for (int i = 0; i < 4; ++i) {
        const int id = tid + i * NT; int key = id >> 3, d0 = (id & 7) * 8;
        float f[8] = {cva[i].x, cva[i].y, cva[i].z, cva[i].w, cvb[i].x, cvb[i].y, cvb[i].z, cvb[i].w};
        *(u32x4*)(VS + (512 + key) * VSP + d0) = pack8(f);
      }
      for (int id = tid; id < 465; id += NT) rp[id] = p.in[29][h * 465 + id];
    }
  }
  __syncthreads();
  float mrow[4], lrow[4];
  f32x4 O[4];
#pragma unroll
  for (int r = 0; r < 4; ++r) { mrow[r] = -1e30f; lrow[r] = 0.f; }
#pragma unroll
  for (int i = 0; i < 4; ++i) O[i] = (f32x4){0.f, 0.f, 0.f, 0.f};
  u16* Pw = Pb + w * 16 * 72;
  const __attribute__((address_space(3))) char* vs3 = (const __attribute__((address_space(3))) char*)VS;
  const int ntile_run = (dry && REP_SUB == 6) ? 0 : ntile;
#pragma unroll 1
  for (int tt = 0; tt < ntile_run; ++tt) {
    bf16x8 kc[4][2];
#pragma unroll
    for (int jt = 0; jt < 4; ++jt)
#pragma unroll
      for (int ks = 0; ks < 2; ++ks) { kc[jt][ks] = kn[jt][ks]; kn[jt][ks] = kn2[jt][ks]; }
    if (tt + 2 < ntile) loadk(tt + 2, kn2);
    f32x4 S[4];
#pragma unroll
    for (int jt = 0; jt < 4; ++jt) {
      S[jt] = (f32x4){0.f, 0.f, 0.f, 0.f};
      S[jt] = MFMA16(qa[0], kc[jt][0], S[jt]);
      S[jt] = MFMA16(qa[1], kc[jt][1], S[jt]);
    }
    float sv[4][4];
#pragma unroll
    for (int jt = 0; jt < 4; ++jt)
#pragma unroll
      for (int r = 0; r < 4; ++r) {
        float s = S[jt][r] * 0.125f;
        if (local) {
          const int kcn = cstart + (jt & 1) * 16 + l15;
          const int qc = jq * 16 + l4 * 4 + r;
          const int col0 = min(max(qc - 8, 0), 48);
          const int kr = rows0 + tt * 2 + (jt >> 1);
          const int dr = kr - rr + 7;
          const int dc = min(max(kcn - qc + 15, 0), 30);
          s += rp[dr * 31 + dc];
          if (kcn < col0 || kcn >= col0 + 16) s = -INFINITY;
        }
        sv[jt][r] = s;
      }
    float alpha[4];
#pragma unroll
    for (int r = 0; r < 4; ++r) {
      float mx = fmaxf(fmaxf(sv[0][r], sv[1][r]), fmaxf(sv[2][r], sv[3][r]));
      mx = dpp_rowmax(mx);
      float mn = fmaxf(mrow[r], mx);
      alpha[r] = __expf(mrow[r] - mn);
      mrow[r] = mn;
      float ps = 0.f;
#pragma unroll
      for (int jt = 0; jt < 4; ++jt) {
        float pv = __expf(sv[jt][r] - mn);
        ps += pv;
        Pw[(l4 * 4 + r) * 72 + jt * 16 + l15] = f2bf(pv);
      }
      lrow[r] = lrow[r] * alpha[r] + ps;
    }
#pragma unroll
    for (int i = 0; i < 4; ++i)
#pragma unroll
      for (int r = 0; r < 4; ++r) O[i][r] *= alpha[r];
    asm volatile("s_waitcnt lgkmcnt(0)" ::: "memory");
#pragma unroll
    for (int ks2 = 0; ks2 < 2; ++ks2) {
      bf16x8 pa = *(const bf16x8*)(Pw + l15 * 72 + ks2 * 32 + l4 * 8);
      int keyoff;
      if (lat) keyoff = gk == 0 ? (tt * 2 + ks2) * 64 + cstart : 512 + tt * 64 + ks2 * 32;
      else keyoff = gk * 128 + tt * 64 + ks2 * 32;
#pragma unroll
      for (int i = 0; i < 4; ++i) {
        const int rowa = keyoff + 8 * l4 + (l15 >> 2);
        const int cola = i * 16 + 4 * (l15 & 3);
        v4i16_t lo = __builtin_amdgcn_ds_read_tr16_b64_v4i16((__attribute__((address_space(3))) v4i16_t*)(vs3 + (rowa * VSP + cola) * 2));
        v4i16_t hi = __builtin_amdgcn_ds_read_tr16_b64_v4i16((__attribute__((address_space(3))) v4i16_t*)(vs3 + ((rowa + 4) * VSP + cola) * 2));
        bf16x8 vb = __builtin_shufflevector(lo, hi, 0, 1, 2, 3, 4, 5, 6, 7);
        O[i] = MFMA16(pa, vb, O[i]);
      }
    }
    asm volatile("s_waitcnt lgkmcnt(0)" ::: "memory");
  }
#pragma unroll
  for (int r = 0; r < 4; ++r) lrow[r] = dpp_rowsum(lrow[r]);
  __syncthreads();
  if (gk == 1) {
    float* m = mrg + ((w - 4) * 64 + lane) * 24;
#pragma unroll
    for (int r = 0; r < 4; ++r) { m[r] = mrow[r]; m[4 + r] = lrow[r]; }
#pragma unroll
    for (int i = 0; i < 4; ++i)
#pragma unroll
      for (int r = 0; r < 4; ++r) m[8 + i * 4 + r] = O[i][r];
  }
  __syncthreads();
  if (gk == 0) {
    const float* m = mrg + (w * 64 + lane) * 24;
    u16* C1w = dry ? (u16*)(p.ws + OFF_DUMMY) + (size_t)(blockIdx.x & 15) * 300000 - (size_t)qrow0 * LDC1 : (u16*)(p.ws + OFF_C1);
#pragma unroll
    for (int r = 0; r < 4; ++r) {
      float m1 = m[r], l1 = m[4 + r];
      float mn = fmaxf(mrow[r], m1);
      float e0 = __expf(mrow[r] - mn), e1 = __expf(m1 - mn);
      float inv = 1.f / (lrow[r] * e0 + l1 * e1);
      const int row = qbase + l4 * 4 + r;
#pragma unroll
      for (int i = 0; i < 4; ++i) {
        float o = (O[i][r] * e0 + m[8 + i * 4 + r] * e1) * inv;
        const int dcol = h * 64 + i * 16 + l15;
        float gv = bf2f(graw[r][i]);
        C1w[(size_t)row * LDC1 + dcol] = f2bf(o * silu(gv));
      }
    }
  }
  __syncthreads();
}


#define OFF_BAR 268419072ul
#define XB_TMO      128
#define XB_XCNT(j)  (256  + 64 * (j))
#define XB_XSUB(j)  (1280 + 64 * (j))
#define XB_XGEN(j)  (2304 + 64 * (j))
#define XB_TOP      3328
#define XB_TOPGEN   3392
#define XCD_BAR_WORDS 3456
#define XB_SPIN_CAP (1u << 18)
#define LAS __attribute__((address_space(3)))
DI unsigned xb_ld(unsigned* p) { return __hip_atomic_load(p, __ATOMIC_RELAXED, __HIP_MEMORY_SCOPE_AGENT); }
DI unsigned xb_add(unsigned* p, unsigned v) { return __hip_atomic_fetch_add(p, v, __ATOMIC_RELAXED, __HIP_MEMORY_SCOPE_AGENT); }
DI unsigned xb_xcc_id() { return (unsigned)__builtin_amdgcn_s_getreg((3 << 11) | 20) & 0xFu; }
#define XB_SPIN(cond, bar) do { unsigned _sp = 0; while (cond) { __builtin_amdgcn_s_sleep(1); \
    if ((++_sp & 255u) == 0u) { if (xb_ld(&(bar)[XB_TMO])) break; if (_sp > XB_SPIN_CAP) { atomicAdd(&(bar)[XB_TMO], 1u); break; } } } } while (0)
struct XcdBarrier { unsigned* bar; unsigned x; volatile LAS unsigned* st; };
DI XcdBarrier xcd_barrier_post(unsigned* bar, volatile LAS unsigned* st) {
  XcdBarrier b; b.bar = bar; b.x = xb_xcc_id(); b.st = st;
  if (threadIdx.x == 0) (void)xb_add(&bar[XB_XCNT(b.x)], 1u);
  return b;
}
DI void xcd_barrier_complete(unsigned* bar, unsigned x, unsigned& nloc, unsigned& nx) {
  const unsigned G = gridDim.x * gridDim.y * gridDim.z;
  unsigned sum, cnt, mine, sp = 0u;
  for (;;) {
    sum = 0u; cnt = 0u; mine = 0u;
#pragma unroll
    for (unsigned j = 0; j < 16; ++j) { const unsigned c = xb_ld(&bar[XB_XCNT(j)]); sum += c; cnt += (c > 0u) ? 1u : 0u; mine = (j == x) ? c : mine; }
    if (sum == G) break;
    __builtin_amdgcn_s_sleep(1);
    if ((++sp & 255u) == 0u) { if (xb_ld(&bar[XB_TMO])) break; if (sp > XB_SPIN_CAP) { atomicAdd(&bar[XB_TMO], 1u); break; } }
  }
  nloc = mine > 0u ? mine : 1u; nx = cnt > 0u ? cnt : 1u;
}
DI void xcd_barrier(const XcdBarrier& b) {
  asm volatile("s_waitcnt vmcnt(0)" ::: "memory");
  __syncthreads();
  if (threadIdx.x == 0) {
    unsigned* bar = b.bar;
    __builtin_amdgcn_s_waitcnt(0);
    unsigned nloc = b.st[0], nx = b.st[1];
    if (nloc == 0u) { xcd_barrier_complete(bar, b.x, nloc, nx); b.st[0] = nloc; b.st[1] = nx; }
    const unsigned old = xb_add(&bar[XB_XSUB(b.x)], 1u);
    const unsigned gen = old / nloc;
    if (old + 1u == (gen + 1u) * nloc) {
      __builtin_amdgcn_fence(__ATOMIC_RELEASE, "agent");
      asm volatile("s_waitcnt vmcnt(0)" ::: "memory");
      const unsigned og = xb_add(&bar[XB_TOP], 1u);
      const unsigned tg = og / nx;
      if (og + 1u == (tg + 1u) * nx) xb_add(&bar[XB_TOPGEN], 1u);
      else XB_SPIN(xb_ld(&bar[XB_TOPGEN]) == tg, bar);
      __builtin_amdgcn_fence(__ATOMIC_ACQUIRE, "agent");
      xb_add(&bar[XB_XGEN(b.x)], 1u);
      asm volatile("s_waitcnt vmcnt(0)" ::: "memory");
    } else {
      XB_SPIN(xb_ld(&bar[XB_XGEN(b.x)]) == gen, bar);
      __builtin_amdgcn_fence(__ATOMIC_ACQUIRE, "agent");
      asm volatile("s_waitcnt vmcnt(0)" ::: "memory");
    }
  }
  __syncthreads();
}
#define NPHASE 12
__global__ void __launch_bounds__(NT) mega(Params p, int ph0, int ph1) {
  __shared__ __attribute__((aligned(16))) unsigned char smem[SMEM_BYTES];
  __shared__ __attribute__((aligned(16))) unsigned xb_st[4];
  const int nb = gridDim.x, bid = blockIdx.x;
  if (threadIdx.x < 4) xb_st[threadIdx.x] = 0u;
  __syncthreads();
  const XcdBarrier xb = xcd_barrier_post((unsigned*)(p.ws + OFF_BAR), (volatile LAS unsigned*)xb_st);
  if (ph1 > 4096) cg::this_grid().sync();
#define PH_BEGIN(k) if (ph0 <= (k) && (k) < ph1) { if ((k) > ph0) xcd_barrier(xb); \
  for (int rep = (REP_MASK >> (k)) & 1; rep >= 0; --rep) { const bool dry = rep > 0; (void)dry;
#define PH_END if (rep > 0) xcd_barrier(xb); } }
  {
    {
      PH_BEGIN(0) {
        for (int t = bid; t < 544 + 192 + 880; t += nb) {
          if (t < 544) phase_filter(p, t, smem);
          else if (t < 736) phase_ada(p, t - 544, smem);
          else {
            int q = t - 736;
            if (q < 432) transpose_tile<float>(p.in[10], 6688, 6688, (u16*)(p.ws + OFF_WINE), 1024, q & 15, q >> 4, nullptr, 0, smem);
            else if (q < 560) { q -= 432; transpose_tile<float>(p.in[11], 1024, 1024, (u16*)(p.ws + OFF_WOUTE), 2048, q & 31, q >> 5, p.in[17], 1024, smem); }
            else if (q < 816) { q -= 560; transpose_tile<float>(p.in[27], 4096, 4096, (u16*)(p.ws + OFF_WINO), 1024, q & 15, q >> 4, nullptr, 0, smem); }
            else { q -= 816; transpose_tile<float>(p.in[28], 1024, 1024, (u16*)(p.ws + OFF_WOUTO), 1024, q & 15, q >> 4, nullptr, 0, smem); }
          }
        }
      } PH_END
      PH_BEGIN(1) {
        for (int t = bid; t < 512; t += nb) phase_norm(p, t, 0, p.in[0], p.in[1], (u16*)((unsigned char*)p.out + OUT_H0));
      } PH_END
      PH_BEGIN(2) {
        GemmArgs g; g.A1 = (const u16*)((const unsigned char*)p.out + OUT_H0); g.lda1 = 1024; g.A2 = g.A1; g.lda2 = 1024; g.ksplit = 1 << 30;
        g.Bt = (const u16*)(p.ws + OFF_WINE); g.K = 1024;
        for (int rd = 0; rd * 256 < 64 * 27; ++rd) { int pm, pn; if (gemm_tile_coord(rd, 27, 64 * 27, pm, pn)) gemm256<0>(p, g, pm * 256, pn * 256, smem); }
      } PH_END
      PH_BEGIN(3) {
        for (int t = bid; t < 512 + 2048; t += nb) {
          if (dry && (REP_SUB == 1 || REP_SUB == 4) && t >= 256) continue;
          if (dry && REP_SUB == 2 && (t < 256 || t >= 512)) continue;
          if (dry && REP_SUB == 3 && t < 512) continue;
          if (t < 512) phase_hyena(p, t, smem, dry);
          else phase_ssd_states(p, t - 512, smem);
        }
      } PH_END
      PH_BEGIN(4) {
        for (int t = bid; t < 34 * 64; t += nb) phase_scan(p, t);
      } PH_END
      PH_BEGIN(5) {
        for (int t = bid; t < 2048 + 1024; t += nb) {
          if (t < 2048) phase_ssd_out(p, t, smem, dry);
          else {
            int q = t - 2048;
            transpose_tile<u16>((const u16*)(p.ws + OFF_UT) + (size_t)3072 * UTP, MROWS, UTP,
                                (u16*)((unsigned char*)p.out + OUT_YB) + 1024, 2048, q & 15, q >> 4, nullptr, 0, smem);
          }
        }
      } PH_END
      PH_BEGIN(6) {
        GemmArgs g; g.A1 = (const u16*)((const unsigned char*)p.out + OUT_YB); g.lda1 = 2048;
        g.A2 = g.A1; g.lda2 = 2048; g.ksplit = 1024;
        g.Bt = (const u16*)(p.ws + OFF_WOUTE); g.K = 2048;
        for (int rd = 0; rd * 256 < 64 * 4; ++rd) { int pm, pn; if (gemm_tile_coord(rd, 4, 64 * 4, pm, pn)) gemm256<1>(p, g, pm * 256, pn * 256, smem); }
      } PH_END
      PH_BEGIN(7) {
        const float* x1 = (const float*)(p.ws + OFF_X1);
        for (int t = bid; t < 512; t += nb) phase_norm(p, t, 1, x1, x1 + (size_t)NPROMPT * 1024, (u16*)(p.ws + OFF_H1));
      } PH_END
      PH_BEGIN(8) {
        GemmArgs g; g.A1 = (const u16*)(p.ws + OFF_H1); g.lda1 = 1024; g.A2 = g.A1; g.lda2 = 1024; g.ksplit = 1 << 30;
        g.Bt = (const u16*)(p.ws + OFF_WINO); g.K = 1024;
        for (int rd = 0; rd * 256 < 64 * 16; ++rd) { int pm, pn; if (gemm_tile_coord(rd, 16, 64 * 16, pm, pn)) gemm256<2>(p, g, pm * 256, pn * 256, smem); }
      } PH_END
      PH_BEGIN(9) {
        for (int t = bid; t < 4096; t += nb) phase_attn(p, t, smem, dry);
      } PH_END
      PH_BEGIN(10) {
        GemmArgs g; g.A1 = (const u16*)(p.ws + OFF_C1); g.lda1 = LDC1; g.A2 = g.A1; g.lda2 = LDC1; g.ksplit = 1 << 30;
        g.Bt = (const u16*)(p.ws + OFF_WOUTO); g.K = 1024;
        for (int rd = 0; rd * 256 < 64 * 4; ++rd) { int pm, pn; if (gemm_tile_coord(rd, 4, 64 * 4, pm, pn)) gemm256<3>(p, g, pm * 256, pn * 256, smem); }
      } PH_END
      PH_BEGIN(11) {
        for (int t = bid; t < 512; t += nb) phase_final_norm(p, t);
      } PH_END
    }
  }
}

extern "C" void kernel_launch(void* const* d_in, const int* in_sizes, int n_in, void* d_out, int out_size,
                              void* d_ws, size_t ws_size, hipStream_t stream) {
  static int grid_blocks = 0;
  if (!grid_blocks) {
    int dev = 0, cus = 0, per_cu = 0;
    hipGetDevice(&dev);
    hipDeviceGetAttribute(&cus, hipDeviceAttributeMultiprocessorCount, dev);
    hipOccupancyMaxActiveBlocksPerMultiprocessor(&per_cu, mega, NT, 0);
    if (per_cu < 1) per_cu = 1;
    grid_blocks = cus * per_cu;
  }
  Params p{};
  for (int i = 0; i < 31; ++i) p.in[i] = (const float*)d_in[i];
  p.out = (float*)d_out;
  p.ws = (unsigned char*)d_ws;
#if MULTI
  for (int ph = 0; ph < NPHASE; ++ph) {
    hipLaunchKernelGGL(mega, dim3(grid_blocks), dim3(NT), 0, stream, p, ph, ph + 1);
  }
#else
  hipMemsetAsync((unsigned char*)d_ws + OFF_BAR, 0, XCD_BAR_WORDS * sizeof(unsigned), stream);
  int ph0 = 0, ph1 = NPHASE;
  void* args[] = {&p, &ph0, &ph1};
  hipError_t e = hipLaunchCooperativeKernel((void*)mega, dim3(grid_blocks), dim3(NT), args, 0, stream);
  if (e != hipSuccess) fprintf(stderr, "cooperative launch failed: %s (grid %d)\n", hipGetErrorString(e), grid_blocks);
#endif
}
```

```cpp
#include <hip/hip_runtime.h>
#include <hip/hip_cooperative_groups.h>
#include <cstdio>
namespace cg = cooperative_groups;

#ifndef REP_MASK
#define REP_MASK 0
#endif
#ifndef REP_SUB
#define REP_SUB 0
#endif
#define OFF_DUMMY 249651200ul
#ifndef MULTI
#define MULTI 0
#endif

#define NT 512
#define DI __device__ __forceinline__
typedef unsigned short u16;
typedef __attribute__((ext_vector_type(8))) short bf16x8;
typedef __attribute__((ext_vector_type(4))) float f32x4;
typedef __attribute__((ext_vector_type(16))) float f32x16;
typedef __attribute__((ext_vector_type(4))) unsigned u32x4;
typedef __attribute__((ext_vector_type(2))) unsigned u32x2;

#define MFMA16(a, b, c) __builtin_amdgcn_mfma_f32_16x16x32_bf16((a), (b), (c), 0, 0, 0)
#define MFMA32(a, b, c) __builtin_amdgcn_mfma_f32_32x32x16_bf16((a), (b), (c), 0, 0, 0)

#define MROWS 16384
#define NPROMPT 8192
#define UTP 16448
#define LDC1 4160
#define LDC0 2592
#define NPAD0 6784
#define SMEM_BYTES 151552

#define OFF_WINE   0ul
#define OFF_WOUTE  14155776ul
#define OFF_WINO   18350080ul
#define OFF_WOUTO  26738688ul
#define OFF_MOD    28835840ul
#define OFF_ROWSS  28909568ul
#define OFF_CDEC   29958144ul
#define OFF_UT     29974528ul
#define OFF_C0A    164716544ul
#define OFF_X1     OFF_UT
#define OFF_C1     97083392ul
#define OFF_H1     233398272ul
#define OUT_H0     0ul
#define OUT_YB     0ul
#define OUT_HF4096 33554432ul
#define OUT_HF256  (33554432ul + 16777216ul)
#define OUT_SBUF   100663296ul
#define O_YP 0ul
#define O_YS 8388608ul
#define O_ST 16777216ul
#define O_NK 25165824ul
#define O_NV 33554432ul

struct Params {
  const float* in[31];
  float* out;
  unsigned char* ws;
};

typedef float f32x2_t __attribute__((ext_vector_type(2)));
typedef __bf16 bf16x2_t __attribute__((ext_vector_type(2)));
DI unsigned pk2(float a, float b) {
  f32x2_t v = {a, b};
  bf16x2_t r = __builtin_convertvector(v, bf16x2_t);
  return __builtin_bit_cast(unsigned, r);
}
DI u16 f2bf(float x) { return (u16)(pk2(x, x) & 0xffffu); }
DI float bf2f(u16 h) { return __uint_as_float(((unsigned)h) << 16); }
DI float silu(float x) { return x * __builtin_amdgcn_rcpf(1.f + __expf(-x)); }
DI float bflo(unsigned u) { return __uint_as_float(u << 16); }
DI float bfhi(unsigned u) { return __uint_as_float(u & 0xffff0000u); }
DI void unpack8(const u32x4& v, float* f) {
  f[0] = bflo(v[0]); f[1] = bfhi(v[0]); f[2] = bflo(v[1]); f[3] = bfhi(v[1]);
  f[4] = bflo(v[2]); f[5] = bfhi(v[2]); f[6] = bflo(v[3]); f[7] = bfhi(v[3]);
}
DI u32x4 pack8(const float* f) {
  u32x4 o; o[0] = pk2(f[0], f[1]); o[1] = pk2(f[2], f[3]); o[2] = pk2(f[4], f[5]); o[3] = pk2(f[6], f[7]); return o;
}
DI int row_group(int row) { return row < NPROMPT ? 0 : 1 + ((row - NPROMPT) >> 12); }

DI void phase_ada(const Params& p, int t, unsigned char* smem) {
  float* sc = (float*)smem;
  float* red = sc + 3072;
  const int layer = t / 96, cc = t % 96;
  const int tid = threadIdx.x;
  for (int i = tid; i < 3072; i += NT) {
    int g = i >> 10, k = i & 1023;
    float v = (g == 0) ? p.in[6][k] : p.in[5][(g - 1) * 1024 + k];
    sc[i] = silu(v);
  }
  __syncthreads();
  const int col = tid & 31, kg = tid >> 5;
  const float* w = p.in[8] + (size_t)layer * 1024 * 3072 + cc * 32 + col;
  float a0 = 0.f, a1 = 0.f, a2 = 0.f;
#pragma unroll 8
  for (int k = kg * 64; k < kg * 64 + 64; ++k) {
    float wv = w[(size_t)k * 3072];
    a0 += sc[k] * wv; a1 += sc[1024 + k] * wv; a2 += sc[2048 + k] * wv;
  }
  red[(kg * 3 + 0) * 32 + col] = a0;
  red[(kg * 3 + 1) * 32 + col] = a1;
  red[(kg * 3 + 2) * 32 + col] = a2;
  __syncthreads();
  if (tid < 96) {
    int g = tid >> 5, c = tid & 31;
    float s = 0.f;
    for (int q = 0; q < 16; ++q) s += red[(q * 3 + g) * 32 + c];
    int colg = cc * 32 + c;
    float* mod = (float*)(p.ws + OFF_MOD);
    mod[(layer * 3 + g) * 3072 + colg] = s + p.in[9][layer * 3072 + colg];
  }
  __syncthreads();
}

DI float ld_src(const float* q) { return *q; }
DI float ld_src(const u16* q) { return bf2f(*q); }
template <typename ST>
DI void transpose_tile(const ST* src, int N, int ldsrc, u16* dst, int lddst, int kt, int nt4,
                       const float* kscale, int kscale_n, unsigned char* smem) {
  float* tile = (float*)smem;
  const int tid = threadIdx.x;
  const int c = tid & 63, r0 = tid >> 6;
  float v[4][8];
#pragma unroll
  for (int q = 0; q < 4; ++q)
#pragma unroll
    for (int i = 0; i < 8; ++i) {
      int r = r0 + 8 * i;
      int k = kt * 64 + r, n = (nt4 * 4 + q) * 64 + c;
      v[q][i] = 0.f;
      if (n < N) v[q][i] = ld_src(src + (size_t)k * ldsrc + n);
    }
#pragma unroll
  for (int q = 0; q < 4; ++q)
#pragma unroll
    for (int i = 0; i < 8; ++i) {
      int r = r0 + 8 * i;
      int k = kt * 64 + r;
      float x = v[q][i];
      if (kscale != nullptr && k < kscale_n) x *= kscale[k];
      tile[q * 4160 + r * 65 + c] = x;
    }
  __syncthreads();
  const int rr = tid >> 3, c8 = (tid & 7) * 8;
#pragma unroll
  for (int q = 0; q < 4; ++q) {
    float f[8];
#pragma unroll
    for (int e = 0; e < 8; ++e) f[e] = tile[q * 4160 + (c8 + e) * 65 + rr];
    *(u32x4*)(dst + (size_t)((nt4 * 4 + q) * 64 + rr) * lddst + kt * 64 + c8) = pack8(f);
  }
  __syncthreads();
}

DI void phase_filter(const Params& p, int t, unsigned char* smem) {
  const int cfg = t < 512 ? 1 : 0;
  const int L = cfg ? 4096 : 256;
  const int t0 = (cfg ? t : t - 512) * 8;
  float* feats = (float*)smem;
  float* h1 = feats + 8 * 36;
  float* h2 = h1 + 512;
  const float* w1 = p.in[20]; const float* b1 = p.in[21]; const float* w2 = p.in[22];
  const float* b2 = p.in[23]; const float* w3 = p.in[24]; const float* fr = p.in[25];
  const int tid = threadIdx.x;
  if (tid < 8 * 33) {
    int tt = tid / 33, i = tid % 33;
    int tpos = t0 + tt;
    float tv = (float)tpos / (float)(L - 1);
    float wv = 6.283185307179586f * (float)tpos / (float)L;
    float f;
    if (i == 0) f = tv;
    else if (i <= 16) { float fi = 1e-4f + (float)(i - 1) * ((15.f - 1e-4f) / 15.f); f = cosf(fi * wv); }
    else { float fi = 1e-4f + (float)(i - 17) * ((15.f - 1e-4f) / 15.f); f = -sinf(fi * wv); }
    feats[tt * 36 + i] = f;
  }
  __syncthreads();
  {
    int tt = tid >> 6, j = tid & 63;
    float s = b1[j];
#pragma unroll 4
    for (int i = 0; i < 33; ++i) s += feats[tt * 36 + i] * w1[i * 64 + j];
    h1[tt * 64 + j] = sinf(fr[j] * s);
  }
  __syncthreads();
  {
    int tt = tid >> 6, j = tid & 63;
    float s = b2[j];
#pragma unroll 8
    for (int i = 0; i < 64; ++i) s += h1[tt * 64 + i] * w2[i * 64 + j];
    h2[tt * 64 + j] = sinf(fr[j] * s);
  }
  __syncthreads();
  float acc[4][8];
#pragma unroll
  for (int q = 0; q < 4; ++q)
#pragma unroll
    for (int tt = 0; tt < 8; ++tt) acc[q][tt] = 0.f;
#pragma unroll 16
  for (int k = 0; k < 64; ++k) {
    float wv[4];
#pragma unroll
    for (int q = 0; q < 4; ++q) wv[q] = w3[k * 2048 + tid + 512 * q];
#pragma unroll
    for (int tt = 0; tt < 8; ++tt) {
      float hv = h2[tt * 64 + k];
#pragma unroll
      for (int q = 0; q < 4; ++q) acc[q][tt] += hv * wv[q];
    }
  }
  u16* HF = (u16*)((unsigned char*)p.out + (cfg ? OUT_HF4096 : OUT_HF256));
  const float lo = -15.350567286626973f;
  const float hi = -3.0701134573253945f;
#pragma unroll
  for (int q = 0; q < 4; ++q) {
    int col = tid + 512 * q;
    int dir = col >> 10, c = col & 1023;
    float ad = fabsf(lo + (float)c * ((hi - lo) / 1023.f));
    u16* hc = HF + (size_t)c * (2 * L);
#pragma unroll
    for (int tt = 0; tt < 8; ++tt) {
      int tpos = t0 + tt;
      float tv = (float)tpos / (float)(L - 1);
      float val = acc[q][tt] * expf(-tv * ad);
      if (dir == 0) hc[L - tpos] = f2bf(val);
      else if (tpos > 0) hc[L + tpos] = f2bf(val);
      else hc[0] = 0;
    }
  }
  __syncthreads();
}

DI float wave_sum(float v) {
#pragma unroll
  for (int o = 32; o >= 1; o >>= 1) v += __shfl_xor(v, o);
  return v;
}
DI void phase_norm(const Params& p, int t, int layer, const float* xa, const float* xb, u16* dst) {
  const int lane = threadIdx.x & 63, w = threadIdx.x >> 6;
  const int row0 = t * 32 + w * 4;
  float4 v[4][4];
#pragma unroll
  for (int rr = 0; rr < 4; ++rr) {
    const int row = row0 + rr;
    const float* src = row < NPROMPT ? xa + (size_t)row * 1024 : xb + (size_t)(row - NPROMPT) * 1024;
#pragma unroll
    for (int i = 0; i < 4; ++i) v[rr][i] = *(const float4*)(src + i * 256 + lane * 4);
  }
  const float* nw = p.in[7] + layer * 1024;
#pragma unroll
  for (int rr = 0; rr < 4; ++rr) {
    const int row = row0 + rr;
    const int g = row_group(row);
    float ss = 0.f;
#pragma unroll
    for (int i = 0; i < 4; ++i) ss += v[rr][i].x * v[rr][i].x + v[rr][i].y * v[rr][i].y + v[rr][i].z * v[rr][i].z + v[rr][i].w * v[rr][i].w;
    ss = wave_sum(ss);
    const float rstd = rsqrtf(ss * (1.f / 1024.f) + 1e-6f);
    const float* shift = (const float*)(p.ws + OFF_MOD) + (layer * 3 + g) * 3072;
    const float* scale = shift + 1024;
#pragma unroll
    for (int i = 0; i < 4; ++i) {
      int col = i * 256 + lane * 4;
      float4 nwv = *(const float4*)(nw + col);
      float4 sc = *(const float4*)(scale + col);
      float4 sh = *(const float4*)(shift + col);
      float o0 = v[rr][i].x * rstd * nwv.x * (1.f + sc.x) + sh.x;
      float o1 = v[rr][i].y * rstd * nwv.y * (1.f + sc.y) + sh.y;
      float o2 = v[rr][i].z * rstd * nwv.z * (1.f + sc.z) + sh.z;
      float o3 = v[rr][i].w * rstd * nwv.w * (1.f + sc.w) + sh.w;
      u32x2 o; o[0] = pk2(o0, o1); o[1] = pk2(o2, o3);
      *(u32x2*)(dst + (size_t)row * 1024 + col) = o;
    }
  }
}
DI void phase_final_norm(const Params& p, int t) {
  const int lane = threadIdx.x & 63, w = threadIdx.x >> 6;
  const int row0 = t * 32 + w * 4;
  float4 v[4][4];
#pragma unroll
  for (int rr = 0; rr < 4; ++rr) {
    const float* src = p.out + (size_t)(row0 + rr) * 1024;
#pragma unroll
    for (int i = 0; i < 4; ++i) v[rr][i] = *(const float4*)(src + i * 256 + lane * 4);
  }
  const float* nw = p.in[30];
#pragma unroll
  for (int rr = 0; rr < 4; ++rr) {
    float* src = p.out + (size_t)(row0 + rr) * 1024;
    float ss = 0.f;
#pragma unroll
    for (int i = 0; i < 4; ++i) ss += v[rr][i].x * v[rr][i].x + v[rr][i].y * v[rr][i].y + v[rr][i].z * v[rr][i].z + v[rr][i].w * v[rr][i].w;
    ss = wave_sum(ss);
    const float rstd = rsqrtf(ss * (1.f / 1024.f) + 1e-6f);
#pragma unroll
    for (int i = 0; i < 4; ++i) {
      int col = i * 256 + lane * 4;
      float4 nwv = *(const float4*)(nw + col);
      float4 o;
      o.x = v[rr][i].x * rstd * nwv.x; o.y = v[rr][i].y * rstd * nwv.y; o.z = v[rr][i].z * rstd * nwv.z; o.w = v[rr][i].w * rstd * nwv.w;
      *(float4*)(src + col) = o;
    }
  }
}

struct GemmArgs {
  const u16* A1; int lda1;
  const u16* A2; int lda2;
  int ksplit;
  const u16* Bt; int K;
};
template <int EPI>
DI void gemm_tile(const Params& p, const GemmArgs& g, int m0, int n0, unsigned char* smem) {
  u16* As = (u16*)smem;
  u16* Bs = As + 256 * 72;
  float* rs = (float*)(Bs + 128 * 72);
  const int tid = threadIdx.x, lane = tid & 63, w = tid >> 6;
  const int wm = (w >> 1) * 64, wn = (w & 1) * 64;
  const int l15 = lane & 15, l4 = lane >> 4;
  f32x4 acc[4][4];
#pragma unroll
  for (int i = 0; i < 4; ++i)
#pragma unroll
    for (int j = 0; j < 4; ++j) acc[i][j] = (f32x4){0.f, 0.f, 0.f, 0.f};
  if (EPI == 1) {
    if (tid < 256) {
      const float* rss = (const float*)(p.ws + OFF_ROWSS) + (size_t)(m0 + tid) * 16;
      float s = 0.f;
#pragma unroll
      for (int q = 0; q < 16; ++q) s += rss[q];
      rs[tid] = rsqrtf(s * (1.f / 1024.f) + 1e-6f);
    }
  }
  u32x4 ra[4], rb[2];
  const int KT = g.K >> 6;
  auto loadg = [&](int kt) {
    const int k0 = kt << 6;
    const u16* Ab; int lda; int kk;
    if (k0 < g.ksplit) { Ab = g.A1; lda = g.lda1; kk = k0; } else { Ab = g.A2; lda = g.lda2; kk = k0 - g.ksplit; }
#pragma unroll
    for (int i = 0; i < 4; ++i) {
      int id = tid + 512 * i; int r = id >> 3, c = (id & 7) * 8;
      ra[i] = *(const u32x4*)(Ab + (size_t)(m0 + r) * lda + kk + c);
    }
#pragma unroll
    for (int i = 0; i < 2; ++i) {
      int id = tid + 512 * i; int r = id >> 3, c = (id & 7) * 8;
      rb[i] = *(const u32x4*)(g.Bt + (size_t)(n0 + r) * g.K + k0 + c);
    }
  };
  loadg(0);
  for (int kt = 0; kt < KT; ++kt) {
#pragma unroll
    for (int i = 0; i < 4; ++i) {
      int id = tid + 512 * i; int r = id >> 3, c = (id & 7) * 8;
      *(u32x4*)(As + r * 72 + c) = ra[i];
    }
#pragma unroll
    for (int i = 0; i < 2; ++i) {
      int id = tid + 512 * i; int r = id >> 3, c = (id & 7) * 8;
      *(u32x4*)(Bs + r * 72 + c) = rb[i];
    }
    __syncthreads();
    if (kt + 1 < KT) loadg(kt + 1);
    if (EPI == 1) {
      if ((kt << 6) == g.ksplit) {
#pragma unroll
        for (int i = 0; i < 4; ++i)
#pragma unroll
          for (int r = 0; r < 4; ++r) {
            float sc = rs[wm + i * 16 + l4 * 4 + r];
#pragma unroll
            for (int j = 0; j < 4; ++j) acc[i][j][r] *= sc;
          }
      }
    }
#pragma unroll
    for (int ks = 0; ks < 2; ++ks) {
      bf16x8 a[4], b[4];
#pragma unroll
      for (int i = 0; i < 4; ++i) a[i] = *(const bf16x8*)(As + (wm + i * 16 + l15) * 72 + ks * 32 + l4 * 8);
#pragma unroll
      for (int j = 0; j < 4; ++j) b[j] = *(const bf16x8*)(Bs + (wn + j * 16 + l15) * 72 + ks * 32 + l4 * 8);
#pragma unroll
      for (int i = 0; i < 4; ++i)
#pragma unroll
        for (int j = 0; j < 4; ++j) acc[i][j] = MFMA16(a[i], b[j], acc[i][j]);
    }
    __syncthreads();
  }
#pragma unroll
  for (int i = 0; i < 4; ++i) {
    const int rbase = m0 + wm + i * 16 + l4 * 4;
#pragma unroll
    for (int j = 0; j < 4; ++j) {
      const int col = n0 + wn + j * 16 + l15;
      if (EPI == 0) {
        if (col < LDC0) {
          u16* C = (u16*)(p.ws + OFF_C0A);
#pragma unroll
          for (int r = 0; r < 4; ++r) C[(size_t)(rbase + r) * LDC0 + col] = f2bf(acc[i][j][r]);
        } else if (col < 6688) {
          u16* UT = (u16*)(p.ws + OFF_UT);
          u32x2 o; o[0] = pk2(acc[i][j][0], acc[i][j][1]); o[1] = pk2(acc[i][j][2], acc[i][j][3]);
          *(u32x2*)(UT + (size_t)(col - LDC0) * UTP + rbase) = o;
        }
      } else if (EPI == 1) {
        float* X1 = (float*)(p.ws + OFF_X1);
        const float* mod = (const float*)(p.ws + OFF_MOD);
#pragma unroll
        for (int r = 0; r < 4; ++r) {
          int row = rbase + r;
          const float* xs = row < NPROMPT ? p.in[0] + (size_t)row * 1024 : p.in[1] + (size_t)(row - NPROMPT) * 1024;
          float gate = mod[(0 * 3 + row_group(row)) * 3072 + 2048 + col];
          X1[(size_t)row * 1024 + col] = xs[col] + gate * acc[i][j][r];
        }
      } else if (EPI == 2) {
        u16* C1 = (u16*)(p.ws + OFF_C1);
#pragma unroll
        for (int r = 0; r < 4; ++r) {
          int row = rbase + r;
          C1[(size_t)row * LDC1 + col] = f2bf(acc[i][j][r]);
          if (row < NPROMPT && col >= 1024 && col < 3072) {
            int cc = col - 1024; int isv = cc >> 10; cc &= 1023;
            int hh = cc >> 6, d = cc & 63; int b = row >> 8, l = row & 255;
            float* o = p.out + (isv ? O_NV : O_NK);
            o[(((size_t)b * 16 + hh) * 256 + l) * 64 + d] = acc[i][j][r];
          }
        }
      } else {
        const float* X1 = (const float*)(p.ws + OFF_X1);
        const float* mod = (const float*)(p.ws + OFF_MOD);
#pragma unroll
        for (int r = 0; r < 4; ++r) {
          int row = rbase + r;
          float gate = mod[(1 * 3 + row_group(row)) * 3072 + 2048 + col];
          p.out[(size_t)row * 1024 + col] = X1[(size_t)row * 1024 + col] + gate * acc[i][j][r];
        }
      }
    }
  }
}


DI int lds_byte(int r, int c) {
  int st = (r >> 4) * 2 + (c >> 5), rr = r & 15, cc = c & 31, ob = rr * 64 + cc * 2;
  return st * 1024 + (ob ^ (((ob >> 9) & 1) << 5));
}
DI void stage_rc(int b, int& R, int& C) {
  int st = b / 1024, sb = b % 1024, swz = sb ^ (((sb >> 9) & 1) << 5);
  R = (st >> 1) * 16 + swz / 64; C = (st & 1) * 32 + (swz % 64) / 2;
}
template <int EPI>
DI void epi_store(const Params& p, int rbase, int col, const f32x4& v) {
  if (EPI == 0) {
    if (col < LDC0) {
      u16* C = (u16*)(p.ws + OFF_C0A);
#pragma unroll
      for (int r = 0; r < 4; ++r) C[(size_t)(rbase + r) * LDC0 + col] = f2bf(v[r]);
    } else if (col < 6688) {
      u16* UT = (u16*)(p.ws + OFF_UT);
      u32x2 o; o[0] = pk2(v[0], v[1]); o[1] = pk2(v[2], v[3]);
      *(u32x2*)(UT + (size_t)(col - LDC0) * UTP + rbase) = o;
    }
  } else if (EPI == 1) {
    float* X1 = (float*)(p.ws + OFF_X1);
    const float* mod = (const float*)(p.ws + OFF_MOD);
#pragma unroll
    for (int r = 0; r < 4; ++r) {
      int row = rbase + r;
      const float* xs = row < NPROMPT ? p.in[0] + (size_t)row * 1024 : p.in[1] + (size_t)(row - NPROMPT) * 1024;
      float gate = mod[(0 * 3 + row_group(row)) * 3072 + 2048 + col];
      X1[(size_t)row * 1024 + col] = xs[col] + gate * v[r];
    }
  } else if (EPI == 2) {
    u16* C1 = (u16*)(p.ws + OFF_C1);
#pragma unroll
    for (int r = 0; r < 4; ++r) {
      int row = rbase + r;
      C1[(size_t)row * LDC1 + col] = f2bf(v[r]);
      if (row < NPROMPT && col >= 1024 && col < 3072) {
        int cc = col - 1024; int isv = cc >> 10; cc &= 1023;
        int hh = cc >> 6, d = cc & 63; int b = row >> 8, l = row & 255;
        float* o = p.out + (isv ? O_NV : O_NK);
        o[(((size_t)b * 16 + hh) * 256 + l) * 64 + d] = v[r];
      }
    }
  } else {
    const float* X1 = (const float*)(p.ws + OFF_X1);
    const float* mod = (const float*)(p.ws + OFF_MOD);
#pragma unroll
    for (int r = 0; r < 4; ++r) {
      int row = rbase + r;
      float gate = mod[(1 * 3 + row_group(row)) * 3072 + 2048 + col];
      p.out[(size_t)row * 1024 + col] = X1[(size_t)row * 1024 + col] + gate * v[r];
    }
  }
}

template <int EPI>
DI void epi_store_sw(const Params& p, int row, int col, const f32x4& v) {
  if (EPI == 0) {
    u16* C = (u16*)(p.ws + OFF_C0A);
    u32x2 o; o[0] = pk2(v[0], v[1]); o[1] = pk2(v[2], v[3]);
    *(u32x2*)(C + (size_t)row * LDC0 + col) = o;
  } else if (EPI == 1) {
    float* X1 = (float*)(p.ws + OFF_X1);
    const float* mod = (const float*)(p.ws + OFF_MOD);
    const float* xs = row < NPROMPT ? p.in[0] + (size_t)row * 1024 : p.in[1] + (size_t)(row - NPROMPT) * 1024;
    const float4 xv = *(const float4*)(xs + col);
    const float4 gt = *(const float4*)(mod + (0 * 3 + row_group(row)) * 3072 + 2048 + col);
    float4 o; o.x = xv.x + gt.x * v[0]; o.y = xv.y + gt.y * v[1]; o.z = xv.z + gt.z * v[2]; o.w = xv.w + gt.w * v[3];
    *(float4*)(X1 + (size_t)row * 1024 + col) = o;
  } else if (EPI == 2) {
    u16* C1 = (u16*)(p.ws + OFF_C1);
    u32x2 o; o[0] = pk2(v[0], v[1]); o[1] = pk2(v[2], v[3]);
    *(u32x2*)(C1 + (size_t)row * LDC1 + col) = o;
    if (row < NPROMPT && col >= 1024 && col < 3072) {
      int cc = col - 1024; int isv = cc >> 10; cc &= 1023;
      int hh = cc >> 6, d = cc & 63; int b = row >> 8, l = row & 255;
      float* op = p.out + (isv ? O_NV : O_NK);
      *(float4*)(op + (((size_t)b * 16 + hh) * 256 + l) * 64 + d) = make_float4(v[0], v[1], v[2], v[3]);
    }
  } else {
    const float* X1 = (const float*)(p.ws + OFF_X1);
    const float* mod = (const float*)(p.ws + OFF_MOD);
    const float4 xv = *(const float4*)(X1 + (size_t)row * 1024 + col);
    const float4 gt = *(const float4*)(mod + (1 * 3 + row_group(row)) * 3072 + 2048 + col);
    float4 o; o.x = xv.x + gt.x * v[0]; o.y = xv.y + gt.y * v[1]; o.z = xv.z + gt.z * v[2]; o.w = xv.w + gt.w * v[3];
    *(float4*)(p.out + (size_t)row * 1024 + col) = o;
  }
}

template <int EPI, bool SWAP>
DI void gemm256(const Params& p, const GemmArgs& g, int brow, int bcol, unsigned char* smem) {
  constexpr int HT = 128 * 64;
  u16* shm = (u16*)smem;
  float* rs = (float*)(smem + 131072);
  const int K = g.K;
#define SA(b, h) (shm + ((b) * 2 + (h)) * HT)
#define SB(b, h) (shm + (4 + (b) * 2 + (h)) * HT)
#define STAGE_A(P, br, kt) do { const u16* _ub = g.A1 + (long)(br) * g.lda1 + (long)(kt) * 64; \
    for (int _i = 0; _i < 2; ++_i) { \
      __builtin_amdgcn_global_load_lds((const unsigned*)((const char*)(_ub + (long)_i * 64 * g.lda1) + aoff1), \
        (__attribute__((address_space(3))) unsigned*)((char*)(P) + threadIdx.x * 16 + _i * 8192), 16, 0, 0); } } while (0)
#define STAGE_B(P, bc, kt) do { const u16* _ub = g.Bt + (long)(bc) * K + (long)(kt) * 64; \
    for (int _i = 0; _i < 2; ++_i) { \
      __builtin_amdgcn_global_load_lds((const unsigned*)((const char*)(_ub + (long)_i * 64 * K) + boff), \
        (__attribute__((address_space(3))) unsigned*)((char*)(P) + threadIdx.x * 16 + _i * 8192), 16, 0, 0); } } while (0)
#define LDA(dst, b, h) for (int m = 0; m < 4; ++m) for (int k = 0; k < 2; ++k) \
    dst[m][k] = *reinterpret_cast<const bf16x8*>((char*)SA(b, h) + lds_byte(wr * 64 + m * 16 + fr, k * 32 + fq * 8))
#define LDB(dst, b, h) for (int n = 0; n < 2; ++n) for (int k = 0; k < 2; ++k) \
    dst[n][k] = *reinterpret_cast<const bf16x8*>((char*)SB(b, h) + lds_byte(wc * 32 + n * 16 + fr, k * 32 + fq * 8))
#define MMA(ai, bj, At_, Bt_) do { __builtin_amdgcn_s_setprio(1); \
    for (int m = 0; m < 4; ++m) for (int n = 0; n < 2; ++n) for (int k = 0; k < 2; ++k) \
      acc[ai][bj][m][n] = SWAP ? __builtin_amdgcn_mfma_f32_16x16x32_bf16(Bt_[n][k], At_[m][k], acc[ai][bj][m][n], 0, 0, 0) \
                               : __builtin_amdgcn_mfma_f32_16x16x32_bf16(At_[m][k], Bt_[n][k], acc[ai][bj][m][n], 0, 0, 0); \
    __builtin_amdgcn_s_setprio(0); } while (0)
#define WAIT_V(n) asm volatile("s_waitcnt vmcnt(" #n ")" ::: "memory")
#define WAIT_L(n) asm volatile("s_waitcnt lgkmcnt(" #n ")" ::: "memory")
#define BAR __builtin_amdgcn_s_barrier()
#define SCHED __builtin_amdgcn_sched_barrier(0)
  const int wid = threadIdx.x >> 6, lane = threadIdx.x & 63, wr = wid >> 2, wc = wid & 3, fr = lane & 15, fq = lane >> 4;
  unsigned aoff1, boff;
  {
    int r_, c_; stage_rc(threadIdx.x * 16, r_, c_);
    aoff1 = (unsigned)(r_ * g.lda1 + c_) * 2u;
    boff = (unsigned)(r_ * K + c_) * 2u;
  }
  if (EPI == 1) {
    if (threadIdx.x < 256) {
      const float* rss = (const float*)(p.ws + OFF_ROWSS) + (size_t)(brow + threadIdx.x) * 16;
      float s = 0.f;
#pragma unroll
      for (int q = 0; q < 16; ++q) s += rss[q];
      rs[threadIdx.x] = rsqrtf(s * (1.f / 1024.f) + 1e-6f);
    }
  }
  WAIT_V(0);
  __syncthreads();
  f32x4 acc[2][2][4][2];
#pragma unroll
  for (int a = 0; a < 2; ++a)
#pragma unroll
    for (int b = 0; b < 2; ++b)
#pragma unroll
      for (int m = 0; m < 4; ++m)
#pragma unroll
        for (int n = 0; n < 2; ++n) acc[a][b][m][n] = (f32x4){0.f, 0.f, 0.f, 0.f};
  bf16x8 At[4][2], B0[2][2], B1[2][2];
  const int nt = K / 64;
  const int tscale = (EPI == 1) ? (g.ksplit >> 6) : -1;
  STAGE_B(SB(0, 0), bcol, 0); STAGE_A(SA(0, 0), brow, 0);
  STAGE_B(SB(0, 1), bcol + 128, 0); STAGE_A(SA(0, 1), brow + 128, 0);
  if (wr == 1) BAR;
  WAIT_V(4); BAR;
  STAGE_B(SB(1, 0), bcol, 1); STAGE_A(SA(1, 0), brow, 1); STAGE_B(SB(1, 1), bcol + 128, 1);
  WAIT_V(6); BAR;
  for (int t = 0; t < nt - 2; t += 2) {
    if (EPI == 1) {
      if (t == tscale) {
#pragma unroll
        for (int a = 0; a < 2; ++a)
#pragma unroll
          for (int m = 0; m < 4; ++m)
#pragma unroll
            for (int j = 0; j < 4; ++j) {
              float sc = SWAP ? rs[a * 128 + wr * 64 + m * 16 + fr] : rs[a * 128 + wr * 64 + m * 16 + fq * 4 + j];
#pragma unroll
              for (int b = 0; b < 2; ++b)
#pragma unroll
                for (int n = 0; n < 2; ++n) acc[a][b][m][n][j] *= sc;
            }
      }
    }
    LDB(B0, 0, 0); SCHED; LDA(At, 0, 0); STAGE_A(SA(1, 1), brow + 128, t + 1);
    WAIT_L(8); BAR; WAIT_L(0); MMA(0, 0, At, B0); BAR; SCHED;
    LDB(B1, 0, 1); STAGE_B(SB(0, 0), bcol, t + 2);
    BAR; WAIT_L(0); MMA(0, 1, At, B1); BAR;
    LDA(At, 0, 1); STAGE_A(SA(0, 0), brow, t + 2);
    BAR; WAIT_L(0); MMA(1, 0, At, B0); BAR; SCHED;
    STAGE_B(SB(0, 1), bcol + 128, t + 2);
    WAIT_V(6); BAR; MMA(1, 1, At, B1); BAR;
    LDB(B0, 1, 0); SCHED; LDA(At, 1, 0); STAGE_A(SA(0, 1), brow + 128, t + 2);
    WAIT_L(8); BAR; WAIT_L(0); MMA(0, 0, At, B0); BAR; SCHED;
    LDB(B1, 1, 1); STAGE_B(SB(1, 0), bcol, t + 3);
    BAR; WAIT_L(0); MMA(0, 1, At, B1); BAR;
    LDA(At, 1, 1); STAGE_A(SA(1, 0), brow, t + 3);
    BAR; WAIT_L(0); MMA(1, 0, At, B0); BAR; SCHED;
    STAGE_B(SB(1, 1), bcol + 128, t + 3);
    WAIT_V(6); BAR; MMA(1, 1, At, B1); BAR;
  }
  { LDB(B0, 0, 0); LDA(At, 0, 0); STAGE_A(SA(1, 1), brow + 128, nt - 1);
    BAR; WAIT_L(0); MMA(0, 0, At, B0); BAR;
    LDB(B1, 0, 1); BAR; WAIT_L(0); MMA(0, 1, At, B1); BAR;
    LDA(At, 0, 1); WAIT_V(4); BAR; WAIT_L(0); MMA(1, 0, At, B0); MMA(1, 1, At, B1); BAR; }
  { LDB(B0, 1, 0); LDA(At, 1, 0); WAIT_V(2); BAR; WAIT_L(0); MMA(0, 0, At, B0); BAR;
    LDB(B1, 1, 1); WAIT_V(0); BAR; WAIT_L(0); MMA(0, 1, At, B1); BAR;
    LDA(At, 1, 1); BAR; WAIT_L(0); MMA(1, 0, At, B0); MMA(1, 1, At, B1); BAR; }
  if (wr == 0) BAR;
  int e_tid = threadIdx.x, e_brow = brow, e_bcol = bcol;
  asm volatile("" : "+v"(e_tid), "+s"(e_brow), "+s"(e_bcol));
  const int e_row = SWAP ? e_brow + ((e_tid >> 8) & 1) * 64 + (e_tid & 15) : e_brow + ((e_tid >> 8) & 1) * 64 + ((e_tid >> 4) & 3) * 4;
  const int e_col = SWAP ? e_bcol + ((e_tid >> 6) & 3) * 32 + ((e_tid >> 4) & 3) * 4 : e_bcol + ((e_tid >> 6) & 3) * 32 + (e_tid & 15);
#pragma unroll
  for (int ai = 0; ai < 2; ++ai)
#pragma unroll
    for (int bj = 0; bj < 2; ++bj)
#pragma unroll
      for (int m = 0; m < 4; ++m)
#pragma unroll
        for (int n = 0; n < 2; ++n) {
          if (SWAP) epi_store_sw<EPI>(p, e_row + ai * 128 + m * 16, e_col + bj * 128 + n * 16, acc[ai][bj][m][n]);
          else epi_store<EPI>(p, e_row + ai * 128 + m * 16, e_col + bj * 128 + n * 16, acc[ai][bj][m][n]);
        }
  __syncthreads();
#undef SA
#undef SB
#undef STAGE_A
#undef STAGE_B
#undef LDA
#undef LDB
#undef MMA
#undef WAIT_V
#undef WAIT_L
#undef BAR
#undef SCHED
}
DI bool gemm_tile_coord(int round, int NN, int ntiles, int& pm, int& pn) {
  const int b = blockIdx.x;
  const int v = round * 256 + (b & 7) * 32 + (b >> 3);
  if (v >= ntiles) return false;
  pm = (v / (8 * NN)) * 8 + (v & 7);
  pn = (v >> 3) % NN;
  return true;
}
struct SsdItem { int row0; int h; int has_prev; int has_next; };
DI SsdItem ssd_item(int item) {
  SsdItem s;
  int cgi = item >> 4; s.h = item & 15;
  if (cgi < 64) { int seq = cgi >> 1, c = cgi & 1; s.row0 = seq * 256 + c * 128; s.has_prev = c > 0; s.has_next = c < 1; }
  else { int q = cgi - 64; int seq = q >> 5, c = q & 31; s.row0 = NPROMPT + seq * 4096 + c * 128; s.has_prev = c > 0; s.has_next = c < 31; }
  return s;
}
DI float ssd_load_dt(const Params& p, int row0, int h) {
  const int tid = threadIdx.x;
  const u16* C0 = (const u16*)(p.ws + OFF_C0A);
  float raw = 0.f;
  if (tid < 256) { int d = tid >> 7, l = tid & 127; raw = bf2f(C0[(size_t)(row0 + l) * LDC0 + 2560 + d * 16 + h]); }
  return raw;
}
DI void ssd_prep_dt(const Params& p, float raw, int h, float* sdt, float* scs, float* stot) {
  const int tid = threadIdx.x, lane = tid & 63, w = tid >> 6;
  if (tid < 256) {
    int d = tid >> 7, l = tid & 127;
    float x = raw + p.in[14][d * 16 + h];
    float dt = x > 20.f ? x : log1pf(expf(x));
    float a = -expf(p.in[15][d * 16 + h]);
    sdt[d * 128 + l] = dt;
    scs[d * 128 + l] = a * dt;
  }
  __syncthreads();
  if (w < 2) {
    const int d = w;
    int p0 = d == 0 ? 2 * lane : 127 - 2 * lane;
    int p1 = d == 0 ? 2 * lane + 1 : 126 - 2 * lane;
    float v0 = scs[d * 128 + p0], v1 = scs[d * 128 + p1];
    float s = v0 + v1;
#pragma unroll
    for (int off = 1; off < 64; off <<= 1) {
      float tv = __shfl_up(s, off);
      if (lane >= off) s += tv;
    }
    float excl = s - (v0 + v1);
    scs[d * 128 + p0] = excl + v0;
    scs[d * 128 + p1] = excl + v0 + v1;
    if (lane == 63) stot[d] = s;
  }
  __syncthreads();
}
DI void conv_silu8(const Params& p, int row, int ch0, bool hp, bool hn, float* out) {
  const u16* C0 = (const u16*)(p.ws + OFF_C0A);
  const u16* q = C0 + (size_t)row * LDC0 + 1024 + ch0;
  const float* cw = p.in[12]; const float* cb = p.in[13];
  float xm[8], xc[8], xp[8];
  u32x4 vc = *(const u32x4*)q;
  unpack8(vc, xc);
  if (hp) { u32x4 v = *(const u32x4*)(q - LDC0); unpack8(v, xm); } else {
#pragma unroll
    for (int e = 0; e < 8; ++e) xm[e] = 0.f;
  }
  if (hn) { u32x4 v = *(const u32x4*)(q + LDC0); unpack8(v, xp); } else {
#pragma unroll
    for (int e = 0; e < 8; ++e) xp[e] = 0.f;
  }
  float4 w0a = *(const float4*)(cw + ch0), w0b = *(const float4*)(cw + ch0 + 4);
  float4 w1a = *(const float4*)(cw + 1536 + ch0), w1b = *(const float4*)(cw + 1536 + ch0 + 4);
  float4 w2a = *(const float4*)(cw + 3072 + ch0), w2b = *(const float4*)(cw + 3072 + ch0 + 4);
  float4 ba = *(const float4*)(cb + ch0), bb = *(const float4*)(cb + ch0 + 4);
  float w0[8] = {w0a.x, w0a.y, w0a.z, w0a.w, w0b.x, w0b.y, w0b.z, w0b.w};
  float w1[8] = {w1a.x, w1a.y, w1a.z, w1a.w, w1b.x, w1b.y, w1b.z, w1b.w};
  float w2[8] = {w2a.x, w2a.y, w2a.z, w2a.w, w2b.x, w2b.y, w2b.z, w2b.w};
  float bv[8] = {ba.x, ba.y, ba.z, ba.w, bb.x, bb.y, bb.z, bb.w};
#pragma unroll
  for (int e = 0; e < 8; ++e) out[e] = silu(bv[e] + w0[e] * xm[e] + w1[e] * xc[e] + w2[e] * xp[e]);
}


template <int R>
DI void conv_load(const Params& p, int row0, int l0, int ch0, bool prev_chunk, bool next_chunk, u32x4 (&raw)[R + 2]) {
  const u16* C0 = (const u16*)(p.ws + OFF_C0A);
  const u16* q = C0 + (size_t)(row0 + l0) * LDC0 + 1024 + ch0;
  const bool hp = (l0 > 0) || prev_chunk;
  const bool hn = (l0 + R < 128) || next_chunk;
#pragma unroll
  for (int i = 0; i < R + 2; ++i) {
    const bool ok = (i == 0) ? hp : ((i == R + 1) ? hn : true);
    raw[i] = (u32x4){0u, 0u, 0u, 0u};
    if (ok) raw[i] = *(const u32x4*)(q + (long)(i - 1) * LDC0);
  }
}
template <int R>
DI void conv_compute(const Params& p, int ch0, const u32x4 (&raw)[R + 2], float (&out)[R][8]) {
  const float* cw = p.in[12]; const float* cb = p.in[13];
  float4 w0a = *(const float4*)(cw + ch0), w0b = *(const float4*)(cw + ch0 + 4);
  float4 w1a = *(const float4*)(cw + 1536 + ch0), w1b = *(const float4*)(cw + 1536 + ch0 + 4);
  float4 w2a = *(const float4*)(cw + 3072 + ch0), w2b = *(const float4*)(cw + 3072 + ch0 + 4);
  float4 ba = *(const float4*)(cb + ch0), bb = *(const float4*)(cb + ch0 + 4);
  const float w0[8] = {w0a.x, w0a.y, w0a.z, w0a.w, w0b.x, w0b.y, w0b.z, w0b.w};
  const float w1[8] = {w1a.x, w1a.y, w1a.z, w1a.w, w1b.x, w1b.y, w1b.z, w1b.w};
  const float w2[8] = {w2a.x, w2a.y, w2a.z, w2a.w, w2b.x, w2b.y, w2b.z, w2b.w};
  const float bv[8] = {ba.x, ba.y, ba.z, ba.w, bb.x, bb.y, bb.z, bb.w};
  float xm[8], xc[8], xp[8];
  unpack8(raw[0], xm); unpack8(raw[1], xc);
#pragma unroll
  for (int i = 0; i < R; ++i) {
    unpack8(raw[i + 2], xp);
#pragma unroll
    for (int e = 0; e < 8; ++e) {
      out[i][e] = silu(bv[e] + w0[e] * xm[e] + w1[e] * xc[e] + w2[e] * xp[e]);
      xm[e] = xc[e]; xc[e] = xp[e];
    }
  }
}
DI void phase_ssd_states(const Params& p, int item, unsigned char* smem) {
  u16* xT = (u16*)smem;
  u16* BTs = xT + 64 * 136;
  float* sdt = (float*)(BTs + 2 * 128 * 136);
  float* scs = sdt + 256;
  float* sw = scs + 256;
  float* stot = sw + 256;
  const int tid = threadIdx.x, lane = tid & 63, w = tid >> 6;
  const int l15 = lane & 15, l4 = lane >> 4;
  const SsdItem it = ssd_item(item);
  const int h = it.h, grp = h >> 3;
  const int xchunk = tid & 7, xrg = tid >> 3;
  const int bchunk = tid & 15, brg = tid >> 4;
  u32x4 rawx[4], rawb[6];
  const float rawdt = ssd_load_dt(p, it.row0, h);
  conv_load<2>(p, it.row0, xrg * 2, h * 64 + xchunk * 8, it.has_prev, it.has_next, rawx);
  conv_load<4>(p, it.row0, brg * 4, 1024 + grp * 128 + bchunk * 8, it.has_prev, it.has_next, rawb);
  ssd_prep_dt(p, rawdt, h, sdt, scs, stot);
  if (tid < 256) {
    int d = tid >> 7;
    sw[tid] = sdt[tid] * __expf(stot[d] - scs[tid]);
  }
  __syncthreads();
  {
    {
      float o[2][8];
      conv_compute<2>(p, h * 64 + xchunk * 8, rawx, o);
#pragma unroll
      for (int e = 0; e < 8; ++e) *(unsigned*)(xT + (xchunk * 8 + e) * 136 + xrg * 2) = pk2(o[0][e], o[1][e]);
    }
    {
      float o[4][8];
      conv_compute<4>(p, 1024 + grp * 128 + bchunk * 8, rawb, o);
#pragma unroll
      for (int dd = 0; dd < 2; ++dd) {
        const float s0 = sw[dd * 128 + brg * 4], s1 = sw[dd * 128 + brg * 4 + 1], s2 = sw[dd * 128 + brg * 4 + 2], s3 = sw[dd * 128 + brg * 4 + 3];
#pragma unroll
        for (int e = 0; e < 8; ++e) {
          u32x2 v; v[0] = pk2(o[0][e] * s0, o[1][e] * s1); v[1] = pk2(o[2][e] * s2, o[3][e] * s3);
          *(u32x2*)(BTs + dd * 128 * 136 + (bchunk * 8 + e) * 136 + brg * 4) = v;
        }
      }
    }
  }
  __syncthreads();
  const int d = w >> 2, nq = w & 3;
  f32x4 acc[4][2];
#pragma unroll
  for (int i = 0; i < 4; ++i) { acc[i][0] = (f32x4){0.f, 0.f, 0.f, 0.f}; acc[i][1] = (f32x4){0.f, 0.f, 0.f, 0.f}; }
#pragma unroll
  for (int ks = 0; ks < 4; ++ks) {
    bf16x8 a[4], b[2];
#pragma unroll
    for (int i = 0; i < 4; ++i) a[i] = *(const bf16x8*)(xT + (i * 16 + l15) * 136 + ks * 32 + l4 * 8);
#pragma unroll
    for (int j = 0; j < 2; ++j) b[j] = *(const bf16x8*)(BTs + d * 128 * 136 + (nq * 32 + j * 16 + l15) * 136 + ks * 32 + l4 * 8);
#pragma unroll
    for (int i = 0; i < 4; ++i)
#pragma unroll
      for (int j = 0; j < 2; ++j) acc[i][j] = MFMA16(a[i], b[j], acc[i][j]);
  }
  u16* S = (u16*)((unsigned char*)p.out + OUT_SBUF) + ((size_t)item * 2 + d) * 8192;
#pragma unroll
  for (int i = 0; i < 4; ++i)
#pragma unroll
    for (int j = 0; j < 2; ++j)
#pragma unroll
      for (int r = 0; r < 4; ++r) {
        int pp = i * 16 + l4 * 4 + r, n = nq * 32 + j * 16 + l15;
        S[pp * 128 + n] = f2bf(acc[i][j][r]);
      }
  if (tid < 2) {
    float* cdec = (float*)(p.ws + OFF_CDEC);
    cdec[item * 2 + tid] = __expf(stot[tid]);
  }
  __syncthreads();
}

DI void phase_scan(const Params& p, int t) {
  const int part = t & 1, d = (t >> 1) & 1, h = (t >> 2) & 15, seq = t >> 6;
  const int tid = threadIdx.x;
  const int e0 = part * 4096 + tid * 8;
  const int nc = seq < 32 ? 2 : 32;
  const int cg0 = seq < 32 ? seq * 2 : 64 + (seq - 32) * 32;
  float st[8];
  if (seq < 32) {
#pragma unroll
    for (int e = 0; e < 8; ++e) st[e] = 0.f;
  } else {
    const float* init = p.in[2] + ((((size_t)(seq - 32) * 1 + 0) * 2 + d) * 16 + h) * 8192 + e0;
    float4 a = *(const float4*)init, b = *(const float4*)(init + 4);
    st[0] = a.x; st[1] = a.y; st[2] = a.z; st[3] = a.w; st[4] = b.x; st[5] = b.y; st[6] = b.z; st[7] = b.w;
  }
  u16* Sb = (u16*)((unsigned char*)p.out + OUT_SBUF);
  const float* cdec = (const float*)(p.ws + OFF_CDEC);
  for (int cb0 = 0; cb0 < nc; cb0 += 8) {
    u32x4 vv[8]; float dec[8];
#pragma unroll
    for (int i = 0; i < 8; ++i) {
      if (cb0 + i < nc) {
        const int ci = cb0 + i;
        const int c = d == 0 ? ci : nc - 1 - ci;
        const int item = (cg0 + c) * 16 + h;
        vv[i] = *(const u32x4*)(Sb + ((size_t)item * 2 + d) * 8192 + e0);
        dec[i] = cdec[item * 2 + d];
      }
    }
#pragma unroll
    for (int i = 0; i < 8; ++i) {
      if (cb0 + i < nc) {
        const int ci = cb0 + i;
        const int c = d == 0 ? ci : nc - 1 - ci;
        const int item = (cg0 + c) * 16 + h;
        float sc[8]; unpack8(vv[i], sc);
        *(u32x4*)(Sb + ((size_t)item * 2 + d) * 8192 + e0) = pack8(st);
#pragma unroll
        for (int e = 0; e < 8; ++e) st[e] = st[e] * dec[i] + sc[e];
      }
    }
  }
  if (seq < 32) {
    float* o = p.out + O_ST + ((((size_t)seq * 1 + 0) * 2 + d) * 16 + h) * 8192 + e0;
    *(float4*)o = make_float4(st[0], st[1], st[2], st[3]);
    *(float4*)(o + 4) = make_float4(st[4], st[5], st[6], st[7]);
  }
}

DI void phase_ssd_out(const Params& p, int item, unsigned char* smem, bool dry) {
  u16* Cs = (u16*)smem;
  u16* Bs = Cs + 128 * 136;
  u16* xT = Bs + 128 * 136;
  u16* St = xT + 64 * 136;
  float* sdt = (float*)(St + 2 * 64 * 136);
  float* scs = sdt + 256;
  float* stot = scs + 256;
  const int tid = threadIdx.x, lane = tid & 63, w = tid >> 6;
  const int l15 = lane & 15, l4 = lane >> 4;
  const SsdItem it = ssd_item(item);
  const int h = it.h, grp = h >> 3;
  const int xchunk = tid & 7, xrg = tid >> 3;
  const int bchunk = tid & 15, brg = tid >> 4;
  u32x4 rawx[4], rawb[6], rawc[6], rawst[4];
  u16 zraw[4][4];
  const float rawdt = ssd_load_dt(p, it.row0, h);
  conv_load<2>(p, it.row0, xrg * 2, h * 64 + xchunk * 8, it.has_prev, it.has_next, rawx);
  conv_load<4>(p, it.row0, brg * 4, 1024 + grp * 128 + bchunk * 8, it.has_prev, it.has_next, rawb);
  conv_load<4>(p, it.row0, brg * 4, 1280 + grp * 128 + bchunk * 8, it.has_prev, it.has_next, rawc);
  {
    const u16* S = (const u16*)((const unsigned char*)p.out + OUT_SBUF) + (size_t)item * 2 * 8192;
#pragma unroll
    for (int v = 0; v < 4; ++v) {
      int id = tid + 512 * v;
      int dd = id >> 10, pp = (id >> 4) & 63, nv = (id & 15) * 8;
      rawst[v] = *(const u32x4*)(S + dd * 8192 + pp * 128 + nv);
    }
  }
  ssd_prep_dt(p, rawdt, h, sdt, scs, stot);
  {
    {
      float o[2][8];
      conv_compute<2>(p, h * 64 + xchunk * 8, rawx, o);
#pragma unroll
      for (int e = 0; e < 8; ++e) *(unsigned*)(xT + (xchunk * 8 + e) * 136 + xrg * 2) = pk2(o[0][e], o[1][e]);
    }
    {
      float o[4][8];
      conv_compute<4>(p, 1024 + grp * 128 + bchunk * 8, rawb, o);
#pragma unroll
      for (int i = 0; i < 4; ++i) *(u32x4*)(Bs + (brg * 4 + i) * 136 + bchunk * 8) = pack8(o[i]);
      conv_compute<4>(p, 1280 + grp * 128 + bchunk * 8, rawc, o);
#pragma unroll
      for (int i = 0; i < 4; ++i) *(u32x4*)(Cs + (brg * 4 + i) * 136 + bchunk * 8) = pack8(o[i]);
    }
#pragma unroll
    for (int v = 0; v < 4; ++v) {
      int id = tid + 512 * v;
      int dd = id >> 10, pp = (id >> 4) & 63, nv = (id & 15) * 8;
      *(u32x4*)(St + dd * 64 * 136 + pp * 136 + nv) = rawst[v];
    }
  }
  __syncthreads();
  {
    const u16* C0z = (const u16*)(p.ws + OFF_C0A);
#pragma unroll
    for (int i = 0; i < 4; ++i)
#pragma unroll
      for (int r = 0; r < 4; ++r)
        zraw[i][r] = C0z[(size_t)(it.row0 + 16 * w + l4 * 4 + r) * LDC0 + h * 64 + i * 16 + l15];
  }
  f32x4 cb[8], af[4], ab[4];
#pragma unroll
  for (int j = 0; j < 8; ++j) cb[j] = (f32x4){0.f, 0.f, 0.f, 0.f};
#pragma unroll
  for (int i = 0; i < 4; ++i) { af[i] = (f32x4){0.f, 0.f, 0.f, 0.f}; ab[i] = (f32x4){0.f, 0.f, 0.f, 0.f}; }
#pragma unroll
  for (int ks = 0; ks < 4; ++ks) {
    bf16x8 a = *(const bf16x8*)(Cs + (16 * w + l15) * 136 + ks * 32 + l4 * 8);
#pragma unroll
    for (int j = 0; j < 8; ++j) {
      bf16x8 b = *(const bf16x8*)(Bs + (j * 16 + l15) * 136 + ks * 32 + l4 * 8);
      cb[j] = MFMA16(a, b, cb[j]);
    }
#pragma unroll
    for (int i = 0; i < 4; ++i) {
      bf16x8 b0 = *(const bf16x8*)(St + (i * 16 + l15) * 136 + ks * 32 + l4 * 8);
      bf16x8 b1 = *(const bf16x8*)(St + 64 * 136 + (i * 16 + l15) * 136 + ks * 32 + l4 * 8);
      af[i] = MFMA16(a, b0, af[i]);
      ab[i] = MFMA16(a, b1, ab[i]);
    }
  }
  __syncthreads();
  f32x4 Y[4];
  {
    float cs0l[4], cs1l[4];
#pragma unroll
    for (int r = 0; r < 4; ++r) { int l = 16 * w + l4 * 4 + r; cs0l[r] = scs[l]; cs1l[r] = scs[128 + l]; }
#pragma unroll
    for (int j = 0; j < 8; ++j) {
      const int s = j * 16 + l15;
      const float cs0s = scs[s], cs1s = scs[128 + s], dt0s = sdt[s], dt1s = sdt[128 + s];
#pragma unroll
      for (int r = 0; r < 4; ++r) {
        const int l = 16 * w + l4 * 4 + r;
        float f;
        if (l > s) f = __expf(cs0l[r] - cs0s) * dt0s;
        else if (l < s) f = __expf(cs1l[r] - cs1s) * dt1s;
        else f = dt0s + dt1s;
        Bs[l * 136 + s] = f2bf(cb[j][r] * f);
      }
    }
#pragma unroll
    for (int r = 0; r < 4; ++r) {
      float e0 = __expf(cs0l[r]), e1 = __expf(cs1l[r]);
#pragma unroll
      for (int i = 0; i < 4; ++i) Y[i][r] = af[i][r] * e0 + ab[i][r] * e1;
    }
  }
  __syncthreads();
#pragma unroll
  for (int ks = 0; ks < 4; ++ks) {
    bf16x8 a = *(const bf16x8*)(Bs + (16 * w + l15) * 136 + ks * 32 + l4 * 8);
#pragma unroll
    for (int i = 0; i < 4; ++i) {
      bf16x8 b = *(const bf16x8*)(xT + (i * 16 + l15) * 136 + ks * 32 + l4 * 8);
      Y[i] = MFMA16(a, b, Y[i]);
    }
  }
  {
    const u16* C0 = (const u16*)(p.ws + OFF_C0A);
    u16* YAB = dry ? (u16*)(p.ws + OFF_DUMMY) + (size_t)(blockIdx.x & 15) * 400000 - (size_t)it.row0 * 2048 : (u16*)((unsigned char*)p.out + OUT_YB);
    const float dsk = p.in[16][h] + p.in[16][16 + h];
    float ss[4] = {0.f, 0.f, 0.f, 0.f};
#pragma unroll
    for (int i = 0; i < 4; ++i) {
      const int pp = i * 16 + l15;
#pragma unroll
      for (int r = 0; r < 4; ++r) {
        const int l = 16 * w + l4 * 4 + r;
        const size_t off = (size_t)(it.row0 + l) * LDC0 + h * 64 + pp;
        float xv = bf2f(xT[pp * 136 + l]);
        float y = Y[i][r] + xv * dsk;
        float z = bf2f(zraw[i][r]);
        float gv = y * silu(z);
        YAB[(size_t)(it.row0 + l) * 2048 + h * 64 + pp] = f2bf(gv);
        ss[r] += gv * gv;
      }
    }
    float* rss = (float*)(p.ws + OFF_ROWSS);
#pragma unroll
    for (int r = 0; r < 4; ++r) {
      float s = ss[r];
      s += __shfl_xor(s, 1); s += __shfl_xor(s, 2); s += __shfl_xor(s, 4); s += __shfl_xor(s, 8);
      if (l15 == 0) rss[(size_t)(it.row0 + 16 * w + l4 * 4 + r) * 16 + h] = s;
    }
  }
  __syncthreads();
}


template <int MASK>
DI void hy_seg(int dlo, int dhi, int L, int A, const u16* hr, const u16* vx, const int (&ncol)[4], const int (&acol)[4],
               int l31, int kh, f32x16 (&acc)[4]) {
  int oz = 0;
  asm volatile("" : "+v"(oz));
#pragma unroll 1
  for (int d = dlo; d <= dhi; ++d) {
    bf16x8 af[2];
#pragma unroll
    for (int khalf = 0; khalf < 2; ++khalf) {
      const int idx0 = L - 32 * d - l31 + 16 * khalf + 8 * kh;
#pragma unroll
      for (int e = 0; e < 8; ++e) af[khalf][e] = (short)hr[idx0 + e + oz * (e + 1)];
    }
    bf16x8 bfr[4][2];
#pragma unroll
    for (int j = 0; j < 4; ++j) {
      if (MASK & (1 << j)) {
        const int asrc = acol[j] - d;
        const bool valid = (asrc >= 0) && (asrc < A);
        const int nsrc = valid ? (ncol[j] - d) : ncol[j];
#pragma unroll
        for (int khalf = 0; khalf < 2; ++khalf) {
          bf16x8 t = *(const bf16x8*)(vx + nsrc * 40 + 16 * khalf + 8 * kh);
          if (!valid) t = (bf16x8){0, 0, 0, 0, 0, 0, 0, 0};
          bfr[j][khalf] = t;
        }
      }
    }
#pragma unroll
    for (int khalf = 0; khalf < 2; ++khalf)
#pragma unroll
      for (int j = 0; j < 4; ++j)
        if (MASK & (1 << j)) acc[j] = MFMA32(af[khalf], bfr[j][khalf], acc[j]);
  }
}
DI void phase_hyena(const Params& p, int it, unsigned char* smem, bool dry) {
  const int cfg = it < 256 ? 1 : 0;
  const int c0 = (it & 255) * 4;
  const int L = cfg ? 4096 : 256;
  const int A = L >> 5;
  const int lgA = cfg ? 7 : 3;
  const int rowbase = cfg ? NPROMPT : 0;
  u16* vxs = (u16*)smem;
  u16* hrs = vxs + 4 * 10240;
  const int tid = threadIdx.x, lane = tid & 63, w = tid >> 6;
  const u16* UT = (const u16*)(p.ws + OFF_UT);
  const float* cw = p.in[18]; const float* cbv = p.in[19];
  {
    const u16* HF = (const u16*)((const unsigned char*)p.out + (cfg ? OUT_HF4096 : OUT_HF256));
    const int nv = (2 * L) >> 3;
    const int lgnv = cfg ? 10 : 6;
    {
      u32x4 fv[8];
#pragma unroll
      for (int it8 = 0; it8 < 8; ++it8) {
        const int id = tid + it8 * NT;
        fv[it8] = (u32x4){0u, 0u, 0u, 0u};
        if (id < 4 * nv) { int chh = id >> lgnv, v8 = id & (nv - 1); fv[it8] = *(const u32x4*)(HF + (size_t)(c0 + chh) * 2 * L + v8 * 8); }
      }
#pragma unroll
      for (int it8 = 0; it8 < 8; ++it8) {
        const int id = tid + it8 * NT;
        if (id < 4 * nv) { int chh = id >> lgnv, v8 = id & (nv - 1); *(u32x4*)(hrs + chh * 2 * L + v8 * 8) = fv[it8]; }
      }
    }
#pragma unroll 1
    for (int hb4 = 0; hb4 < 2; ++hb4) {
    u32x4 rv[4][2]; float hm[4][2], hp[4][2];
#pragma unroll
    for (int it8 = 0; it8 < 4; ++it8) {
      const int id = tid + (hb4 * 4 + it8) * NT;
      const int chh = id >> 10, blk8 = id & 1023;
      const int pos = blk8 * 8, tl = pos & (L - 1);
#pragma unroll
      for (int which = 1; which <= 2; ++which) {
        const u16* q = UT + (size_t)(which * 1024 + c0 + chh) * UTP + rowbase + pos;
        rv[it8][which - 1] = *(const u32x4*)q;
        hm[it8][which - 1] = (tl > 0) ? bf2f(q[-1]) : 0.f;
        hp[it8][which - 1] = (tl + 8 < L) ? bf2f(q[8]) : 0.f;
      }
    }
#pragma unroll
    for (int it8 = 0; it8 < 4; ++it8) {
      const int id = tid + (hb4 * 4 + it8) * NT;
      const int chh = id >> 10, blk8 = id & 1023;
      const int pos = blk8 * 8;
      float res[8];
#pragma unroll
      for (int e = 0; e < 8; ++e) res[e] = 1.f;
#pragma unroll
      for (int which = 1; which <= 2; ++which) {
        const int uc = which * 1024 + c0 + chh;
        float xv[10];
        unpack8(rv[it8][which - 1], xv + 1);
        xv[0] = hm[it8][which - 1]; xv[9] = hp[it8][which - 1];
        const float w0 = cw[uc], w1 = cw[3072 + uc], w2 = cw[6144 + uc], bb = cbv[uc];
#pragma unroll
        for (int e = 0; e < 8; ++e) res[e] *= (bb + w0 * xv[e] + w1 * xv[e + 1] + w2 * xv[e + 2]);
      }
      const int n = pos >> 5, k = pos & 31;
      *(u32x4*)(vxs + chh * 10240 + n * 40 + k) = pack8(res);
    }
    }
  }
  __syncthreads();
  const int ch = w >> 1, wv = w & 1;
  const int l31 = lane & 31, kh = lane >> 5;
  const u16* vx = vxs + ch * 10240;
  const u16* hr = hrs + ch * 2 * L;
  f32x16 acc[4];
#pragma unroll
  for (int j = 0; j < 4; ++j)
#pragma unroll
    for (int r = 0; r < 16; ++r) acc[j][r] = 0.f;
  int ncol[4], acol[4];
#pragma unroll
  for (int j = 0; j < 4; ++j) { ncol[j] = 128 * wv + 32 * j + l31; acol[j] = ncol[j] & (A - 1); }
  if (!(dry && REP_SUB == 4)) {
  if (cfg) {
    hy_seg<1>(-127, -96, L, A, hr, vx, ncol, acol, l31, kh, acc);
    hy_seg<3>(-95, -64, L, A, hr, vx, ncol, acol, l31, kh, acc);
    hy_seg<7>(-63, -32, L, A, hr, vx, ncol, acol, l31, kh, acc);
    hy_seg<15>(-31, 31, L, A, hr, vx, ncol, acol, l31, kh, acc);
    hy_seg<14>(32, 63, L, A, hr, vx, ncol, acol, l31, kh, acc);
    hy_seg<12>(64, 95, L, A, hr, vx, ncol, acol, l31, kh, acc);
    hy_seg<8>(96, 127, L, A, hr, vx, ncol, acol, l31, kh, acc);
  } else {
    hy_seg<15>(-7, 7, L, A, hr, vx, ncol, acol, l31, kh, acc);
  }
  }
  {
    const int c = c0 + ch;
    const float hb = p.in[26][c];
    const float w0 = cw[c], w1 = cw[3072 + c], w2 = cw[6144 + c], bb = cbv[c];
    const u16* x0row = UT + (size_t)c * UTP + rowbase;
    const u16* grow = (const u16*)(p.ws + OFF_UT) + (size_t)(3072 + c) * UTP + rowbase;
    u16* groww = dry ? (u16*)(p.ws + OFF_DUMMY) + (size_t)blockIdx.x * 32768 + ch * 8192
                     : (u16*)(p.ws + OFF_UT) + (size_t)(3072 + c) * UTP + rowbase;
#pragma unroll
    for (int jh = 0; jh < 4; ++jh) {
    __builtin_amdgcn_sched_barrier(0);
    u32x2 xr[4][4], gr[4][4]; float xm[4][4], xp[4][4];
#pragma unroll
    for (int j = jh; j < jh + 1; ++j) {
      const int n = ncol[j];
#pragma unroll
      for (int q = 0; q < 4; ++q) {
        const int pos = 32 * n + 8 * q + 4 * kh;
        const int tl = pos & (L - 1);
        xr[j][q] = *(const u32x2*)(x0row + pos);
        gr[j][q] = *(const u32x2*)(grow + pos);
        xm[j][q] = tl > 0 ? bf2f(x0row[pos - 1]) : 0.f;
        xp[j][q] = (tl + 4 < L) ? bf2f(x0row[pos + 4]) : 0.f;
      }
    }
#pragma unroll
    for (int j = jh; j < jh + 1; ++j) {
      const int n = ncol[j];
#pragma unroll
      for (int q = 0; q < 4; ++q) {
        const int pos = 32 * n + 8 * q + 4 * kh;
        u32x2 vr = *(const u32x2*)(vx + n * 40 + 8 * q + 4 * kh);
        float xv[6] = {xm[j][q], bflo(xr[j][q][0]), bfhi(xr[j][q][0]), bflo(xr[j][q][1]), bfhi(xr[j][q][1]), xp[j][q]};
        float gv[4] = {bflo(gr[j][q][0]), bfhi(gr[j][q][0]), bflo(gr[j][q][1]), bfhi(gr[j][q][1])};
        float vv[4] = {bflo(vr[0]), bfhi(vr[0]), bflo(vr[1]), bfhi(vr[1])};
        float y[4];
#pragma unroll
        for (int e = 0; e < 4; ++e) {
          float x0 = bb + w0 * xv[e] + w1 * xv[e + 1] + w2 * xv[e + 2];
          y[e] = x0 * (acc[j][4 * q + e] + vv[e] * hb) * silu(gv[e]);
        }
        u32x2 o; o[0] = pk2(y[0], y[1]); o[1] = pk2(y[2], y[3]);
        *(u32x2*)(groww + pos) = o;
        __builtin_amdgcn_sched_barrier(0);
      }
    }
    }
  }
  (void)lgA;
  __syncthreads();
}

#define VSP 72
typedef __attribute__((ext_vector_type(4))) short v4i16_t;
DI float dpp_rowmax(float v) {
  v = fmaxf(v, __builtin_bit_cast(float, __builtin_amdgcn_update_dpp(0, __builtin_bit_cast(int, v), 0x128, 0xf, 0xf, false)));
  v = fmaxf(v, __builtin_bit_cast(float, __builtin_amdgcn_update_dpp(0, __builtin_bit_cast(int, v), 0x124, 0xf, 0xf, false)));
  v = fmaxf(v, __builtin_bit_cast(float, __builtin_amdgcn_update_dpp(0, __builtin_bit_cast(int, v), 0x122, 0xf, 0xf, false)));
  v = fmaxf(v, __builtin_bit_cast(float, __builtin_amdgcn_update_dpp(0, __builtin_bit_cast(int, v), 0x121, 0xf, 0xf, false)));
  return v;
}
DI float dpp_rowsum(float v) {
  v += __builtin_bit_cast(float, __builtin_amdgcn_update_dpp(0, __builtin_bit_cast(int, v), 0x128, 0xf, 0xf, false));
  v += __builtin_bit_cast(float, __builtin_amdgcn_update_dpp(0, __builtin_bit_cast(int, v), 0x124, 0xf, 0xf, false));
  v += __builtin_bit_cast(float, __builtin_amdgcn_update_dpp(0, __builtin_bit_cast(int, v), 0x122, 0xf, 0xf, false));
  v += __builtin_bit_cast(float, __builtin_amdgcn_update_dpp(0, __builtin_bit_cast(int, v), 0x121, 0xf, 0xf, false));
  return v;
}
DI void phase_attn(const Params& p, int item, unsigned char* smem, bool dry) {
  u16* VS = (u16*)smem;
  u16* Pb = VS + 768 * VSP;
  float* rp = (float*)(Pb + 8 * 16 * 72);
  float* mrg = (float*)smem;
  const int tid = threadIdx.x, lane = tid & 63, w = tid >> 6;
  const int l15 = lane & 15, l4 = lane >> 4;
  const u16* C1 = (const u16*)(p.ws + OFF_C1);
  const bool lat = item < 2048;
  int b, h, rr = 0, rows0 = 0, qrow0, keyrow0;
  if (lat) { b = item >> 10; h = (item >> 6) & 15; rr = item & 63; rows0 = min(max(rr - 4, 0), 56);
             qrow0 = NPROMPT + b * 4096 + rr * 64; keyrow0 = NPROMPT + b * 4096 + rows0 * 64; }
  else { int q = item - 2048; b = q >> 6; h = (q >> 2) & 15; int qt = q & 3; qrow0 = b * 256 + qt * 64; keyrow0 = b * 256; }
  const int jq = w & 3, gk = w >> 2;
  const int qbase = qrow0 + jq * 16;
  bf16x8 qa[2];
#pragma unroll
  for (int ks = 0; ks < 2; ++ks) qa[ks] = *(const bf16x8*)(C1 + (size_t)(qbase + l15) * LDC1 + h * 64 + ks * 32 + l4 * 8);
  const int ntile = lat ? 4 : 2;
  const int cstart = min(max(16 * jq - 8, 0), 32);
  const bool fp32k = lat && gk == 1;
  const bool local = lat && gk == 0;
  const float* ck = p.in[3] + ((size_t)b * 16 + h) * 256 * 64;
  auto loadk = [&](int tt, bf16x8 (&kb)[4][2]) {
#pragma unroll
    for (int jt = 0; jt < 4; ++jt) {
      if (fp32k) {
        const int key = tt * 64 + jt * 16 + l15;
#pragma unroll
        for (int ks = 0; ks < 2; ++ks) {
          const float* q = ck + key * 64 + ks * 32 + l4 * 8;
          float4 a = *(const float4*)q, c = *(const float4*)(q + 4);
          float f[8] = {a.x, a.y, a.z, a.w, c.x, c.y, c.z, c.w};
          u32x4 pk = pack8(f);
          kb[jt][ks] = __builtin_bit_cast(bf16x8, pk);
        }
      } else {
        int krow;
        if (lat) krow = keyrow0 + (tt * 2 + (jt >> 1)) * 64 + cstart + (jt & 1) * 16 + l15;
        else krow = keyrow0 + gk * 128 + tt * 64 + jt * 16 + l15;
#pragma unroll
        for (int ks = 0; ks < 2; ++ks)
          kb[jt][ks] = *(const bf16x8*)(C1 + (size_t)krow * LDC1 + 1024 + h * 64 + ks * 32 + l4 * 8);
      }
    }
  };
  bf16x8 kn[4][2], kn2[4][2];
  loadk(0, kn);
  if (ntile > 1) loadk(1, kn2);
  u16 graw[4][4];
  if (gk == 0) {
#pragma unroll
    for (int r = 0; r < 4; ++r)
#pragma unroll
      for (int i = 0; i < 4; ++i)
        graw[r][i] = C1[(size_t)(qbase + l4 * 4 + r) * LDC1 + 3072 + h * 64 + i * 16 + l15];
  }
  if (!(dry && REP_SUB == 7)) {
    const int nloc = lat ? 512 : 256;
    u32x4 vv[8];
#pragma unroll
    for (int i = 0; i < 8; ++i) {
      const int id = tid + i * NT;
      vv[i] = (u32x4){0u, 0u, 0u, 0u};
      if (id < nloc * 8) { int key = id >> 3, d0 = (id & 7) * 8; vv[i] = *(const u32x4*)(C1 + (size_t)(keyrow0 + key) * LDC1 + 2048 + h * 64 + d0); }
    }
    float4 cva[4], cvb[4];
    const float* cv = p.in[4] + ((size_t)b * 16 + h) * 256 * 64;
    if (lat) {
#pragma unroll
      for (int i = 0; i < 4; ++i) {
        const int id = tid + i * NT; int key = id >> 3, d0 = (id & 7) * 8;
        cva[i] = *(const float4*)(cv + key * 64 + d0); cvb[i] = *(const float4*)(cv + key * 64 + d0 + 4);
      }
    }
#pragma unroll
    for (int i = 0; i < 8; ++i) {
      const int id = tid + i * NT;
      if (id < nloc * 8) { int key = id >> 3, d0 = (id & 7) * 8; *(u32x4*)(VS + key * VSP + d0) = vv[i]; }
    }
    if (lat) {
#pragma unroll
      for (int i = 0; i < 4; ++i) {
        const int id = tid + i * NT; int key = id >> 3, d0 = (id & 7) * 8;
        float f[8] = {cva[i].x, cva[i].y, cva[i].z, cva[i].w, cvb[i].x, cvb[i].y, cvb[i].z, cvb[i].w};
        *(u32x4*)(VS + (512 + key) * VSP + d0) = pack8(f);
      }
      for (int id = tid; id < 465; id += NT) rp[id] = p.in[29][h * 465 + id] * 1.4426950408889634f;
    }
  }
  __syncthreads();
  float mrow[4], lrow[4];
  f32x4 O[4];
#pragma unroll
  for (int r = 0; r < 4; ++r) { mrow[r] = -1e30f; lrow[r] = 0.f; }
#pragma unroll
  for (int i = 0; i < 4; ++i) O[i] = (f32x4){0.f, 0.f, 0.f, 0.f};
  u16* Pw = Pb + w * 16 * 72;
  const __attribute__((address_space(3))) char* vs3 = (const __attribute__((address_space(3))) char*)VS;
  const int ntile_run = (dry && REP_SUB == 6) ? 0 : ntile;
  int dcv[2][4]; bool okv[2][4];
#pragma unroll
  for (int hf = 0; hf < 2; ++hf)
#pragma unroll
    for (int r = 0; r < 4; ++r) {
      const int kcn = cstart + hf * 16 + l15;
      const int qc = jq * 16 + l4 * 4 + r;
      const int col0 = min(max(qc - 8, 0), 48);
      dcv[hf][r] = min(max(kcn - qc + 15, 0), 30);
      okv[hf][r] = (kcn >= col0) && (kcn < col0 + 16);
    }
#pragma unroll 1
  for (int tt = 0; tt < ntile_run; ++tt) {
    bf16x8 kc[4][2];
#pragma unroll
    for (int jt = 0; jt < 4; ++jt)
#pragma unroll
      for (int ks = 0; ks < 2; ++ks) { kc[jt][ks] = kn[jt][ks]; kn[jt][ks] = kn2[jt][ks]; }
    if (tt + 2 < ntile) loadk(tt + 2, kn2);
    f32x4 S[4];
#pragma unroll
    for (int jt = 0; jt < 4; ++jt) {
      S[jt] = (f32x4){0.f, 0.f, 0.f, 0.f};
      S[jt] = MFMA16(qa[0], kc[jt][0], S[jt]);
      S[jt] = MFMA16(qa[1], kc[jt][1], S[jt]);
    }
    float sv[4][4];
#pragma unroll
    for (int jt = 0; jt < 4; ++jt)
#pragma unroll
      for (int r = 0; r < 4; ++r) {
        float s = S[jt][r] * 0.18033688011112042f;
        if (local) {
          const int dr = rows0 + tt * 2 + (jt >> 1) - rr + 7;
          s += rp[dr * 31 + dcv[jt & 1][r]];
          if (!okv[jt & 1][r]) s = -INFINITY;
        }
        sv[jt][r] = s;
      }
    float alpha[4];
#pragma unroll
    for (int r = 0; r < 4; ++r) {
      float mx = fmaxf(fmaxf(sv[0][r], sv[1][r]), fmaxf(sv[2][r], sv[3][r]));
      mx = dpp_rowmax(mx);
      float mn = fmaxf(mrow[r], mx);
      alpha[r] = __builtin_amdgcn_exp2f(mrow[r] - mn);
      mrow[r] = mn;
      float ps = 0.f;
#pragma unroll
      for (int jt = 0; jt < 4; ++jt) {
        float pv = __builtin_amdgcn_exp2f(sv[jt][r] - mn);
        ps += pv;
        Pw[(l4 * 4 + r) * 72 + jt * 16 + l15] = f2bf(pv);
      }
      lrow[r] = lrow[r] * alpha[r] + ps;
    }
#pragma unroll
    for (int i = 0; i < 4; ++i)
#pragma unroll
      for (int r = 0; r < 4; ++r) O[i][r] *= alpha[r];
    asm volatile("s_waitcnt lgkmcnt(0)" ::: "memory");
#pragma unroll
    for (int ks2 = 0; ks2 < 2; ++ks2) {
      bf16x8 pa = *(const bf16x8*)(Pw + l15 * 72 + ks2 * 32 + l4 * 8);
      int keyoff;
      if (lat) keyoff = gk == 0 ? (tt * 2 + ks2) * 64 + cstart : 512 + tt * 64 + ks2 * 32;
      else keyoff = gk * 128 + tt * 64 + ks2 * 32;
#pragma unroll
      for (int i = 0; i < 4; ++i) {
        const int rowa = keyoff + 8 * l4 + (l15 >> 2);
        const int cola = i * 16 + 4 * (l15 & 3);
        v4i16_t lo = __builtin_amdgcn_ds_read_tr16_b64_v4i16((__attribute__((address_space(3))) v4i16_t*)(vs3 + (rowa * VSP + cola) * 2));
        v4i16_t hi = __builtin_amdgcn_ds_read_tr16_b64_v4i16((__attribute__((address_space(3))) v4i16_t*)(vs3 + ((rowa + 4) * VSP + cola) * 2));
        bf16x8 vb = __builtin_shufflevector(lo, hi, 0, 1, 2, 3, 4, 5, 6, 7);
        O[i] = MFMA16(pa, vb, O[i]);
      }
    }
    asm volatile("s_waitcnt lgkmcnt(0)" ::: "memory");
  }
#pragma unroll
  for (int r = 0; r < 4; ++r) lrow[r] = dpp_rowsum(lrow[r]);
  __syncthreads();
  if (gk == 1) {
    float* m = mrg + ((w - 4) * 64 + lane) * 24;
#pragma unroll
    for (int r = 0; r < 4; ++r) { m[r] = mrow[r]; m[4 + r] = lrow[r]; }
#pragma unroll
    for (int i = 0; i < 4; ++i)
#pragma unroll
      for (int r = 0; r < 4; ++r) m[8 + i * 4 + r] = O[i][r];
  }
  __syncthreads();
  if (gk == 0) {
    const float* m = mrg + (w * 64 + lane) * 24;
    u16* C1w = dry ? (u16*)(p.ws + OFF_DUMMY) + (size_t)(blockIdx.x & 15) * 300000 - (size_t)qrow0 * LDC1 : (u16*)(p.ws + OFF_C1);
#pragma unroll
    for (int r = 0; r < 4; ++r) {
      float m1 = m[r], l1 = m[4 + r];
      float mn = fmaxf(mrow[r], m1);
      float e0 = __builtin_amdgcn_exp2f(mrow[r] - mn), e1 = __builtin_amdgcn_exp2f(m1 - mn);
      float inv = 1.f / (lrow[r] * e0 + l1 * e1);
      const int row = qbase + l4 * 4 + r;
#pragma unroll
      for (int i = 0; i < 4; ++i) {
        float o = (O[i][r] * e0 + m[8 + i * 4 + r] * e1) * inv;
        const int dcol = h * 64 + i * 16 + l15;
        float gv = bf2f(graw[r][i]);
        C1w[(size_t)row * LDC1 + dcol] = f2bf(o * silu(gv));
      }
    }
  }
  __syncthreads();
}


#define OFF_BAR 268419072ul
#define XB_TMO      128
#define XB_XCNT(j)  (256  + 64 * (j))
#define XB_XSUB(j)  (1280 + 64 * (j))
#define XB_XGEN(j)  (2304 + 64 * (j))
#define XB_TOP      3328
#define XB_TOPGEN   3392
#define XCD_BAR_WORDS 3456
#define XB_SPIN_CAP (1u << 18)
#define LAS __attribute__((address_space(3)))
DI unsigned xb_ld(unsigned* p) { return __hip_atomic_load(p, __ATOMIC_RELAXED, __HIP_MEMORY_SCOPE_AGENT); }
DI unsigned xb_add(unsigned* p, unsigned v) { return __hip_atomic_fetch_add(p, v, __ATOMIC_RELAXED, __HIP_MEMORY_SCOPE_AGENT); }
DI unsigned xb_xcc_id() { return (unsigned)__builtin_amdgcn_s_getreg((3 << 11) | 20) & 0xFu; }
#define XB_SPIN(cond, bar) do { unsigned _sp = 0; while (cond) { __builtin_amdgcn_s_sleep(1); \
    if ((++_sp & 255u) == 0u) { if (xb_ld(&(bar)[XB_TMO])) break; if (_sp > XB_SPIN_CAP) { atomicAdd(&(bar)[XB_TMO], 1u); break; } } } } while (0)
struct XcdBarrier { unsigned* bar; unsigned x; volatile LAS unsigned* st; };
DI XcdBarrier xcd_barrier_post(unsigned* bar, volatile LAS unsigned* st) {
  XcdBarrier b; b.bar = bar; b.x = xb_xcc_id(); b.st = st;
  if (threadIdx.x == 0) (void)xb_add(&bar[XB_XCNT(b.x)], 1u);
  return b;
}
DI void xcd_barrier_complete(unsigned* bar, unsigned x, unsigned& nloc, unsigned& nx) {
  const unsigned G = gridDim.x * gridDim.y * gridDim.z;
  unsigned sum, cnt, mine, sp = 0u;
  for (;;) {
    sum = 0u; cnt = 0u; mine = 0u;
#pragma unroll
    for (unsigned j = 0; j < 16; ++j) { const unsigned c = xb_ld(&bar[XB_XCNT(j)]); sum += c; cnt += (c > 0u) ? 1u : 0u; mine = (j == x) ? c : mine; }
    if (sum == G) break;
    __builtin_amdgcn_s_sleep(1);
    if ((++sp & 255u) == 0u) { if (xb_ld(&bar[XB_TMO])) break; if (sp > XB_SPIN_CAP) { atomicAdd(&bar[XB_TMO], 1u); break; } }
  }
  nloc = mine > 0u ? mine : 1u; nx = cnt > 0u ? cnt : 1u;
}
DI void xcd_barrier(const XcdBarrier& b) {
  asm volatile("s_waitcnt vmcnt(0)" ::: "memory");
  __syncthreads();
  if (threadIdx.x == 0) {
    unsigned* bar = b.bar;
    __builtin_amdgcn_s_waitcnt(0);
    unsigned nloc = b.st[0], nx = b.st[1];
    if (nloc == 0u) { xcd_barrier_complete(bar, b.x, nloc, nx); b.st[0] = nloc; b.st[1] = nx; }
    const unsigned old = xb_add(&bar[XB_XSUB(b.x)], 1u);
    const unsigned gen = old / nloc;
    if (old + 1u == (gen + 1u) * nloc) {
      __builtin_amdgcn_fence(__ATOMIC_RELEASE, "agent");
      asm volatile("s_waitcnt vmcnt(0)" ::: "memory");
      const unsigned og = xb_add(&bar[XB_TOP], 1u);
      const unsigned tg = og / nx;
      if (og + 1u == (tg + 1u) * nx) xb_add(&bar[XB_TOPGEN], 1u);
      else XB_SPIN(xb_ld(&bar[XB_TOPGEN]) == tg, bar);
      __builtin_amdgcn_fence(__ATOMIC_ACQUIRE, "agent");
      xb_add(&bar[XB_XGEN(b.x)], 1u);
      asm volatile("s_waitcnt vmcnt(0)" ::: "memory");
    } else {
      XB_SPIN(xb_ld(&bar[XB_XGEN(b.x)]) == gen, bar);
      __builtin_amdgcn_fence(__ATOMIC_ACQUIRE, "agent");
      asm volatile("s_waitcnt vmcnt(0)" ::: "memory");
    }
  }
  __syncthreads();
}
#define NPHASE 12
__global__ void __launch_bounds__(NT) mega(Params p, int ph0, int ph1) {
  __shared__ __attribute__((aligned(16))) unsigned char smem[SMEM_BYTES];
  __shared__ __attribute__((aligned(16))) unsigned xb_st[4];
  const int nb = gridDim.x, bid = blockIdx.x;
  if (threadIdx.x < 4) xb_st[threadIdx.x] = 0u;
  __syncthreads();
  const XcdBarrier xb = xcd_barrier_post((unsigned*)(p.ws + OFF_BAR), (volatile LAS unsigned*)xb_st);
  if (ph1 > 4096) cg::this_grid().sync();
#define PH_BEGIN(k) if (ph0 <= (k) && (k) < ph1) { if ((k) > ph0) xcd_barrier(xb); \
  for (int rep = (REP_MASK >> (k)) & 1; rep >= 0; --rep) { const bool dry = rep > 0; (void)dry;
#define PH_END if (rep > 0) xcd_barrier(xb); } }
  {
    {
      PH_BEGIN(0) {
        for (int t = bid; t < 544 + 192 + 880; t += nb) {
          if (t < 544) phase_filter(p, t, smem);
          else if (t < 736) phase_ada(p, t - 544, smem);
          else {
            int q = t - 736;
            if (q < 432) transpose_tile<float>(p.in[10], 6688, 6688, (u16*)(p.ws + OFF_WINE), 1024, q & 15, q >> 4, nullptr, 0, smem);
            else if (q < 560) { q -= 432; transpose_tile<float>(p.in[11], 1024, 1024, (u16*)(p.ws + OFF_WOUTE), 2048, q & 31, q >> 5, p.in[17], 1024, smem); }
            else if (q < 816) { q -= 560; transpose_tile<float>(p.in[27], 4096, 4096, (u16*)(p.ws + OFF_WINO), 1024, q & 15, q >> 4, nullptr, 0, smem); }
            else { q -= 816; transpose_tile<float>(p.in[28], 1024, 1024, (u16*)(p.ws + OFF_WOUTO), 1024, q & 15, q >> 4, nullptr, 0, smem); }
          }
        }
      } PH_END
      PH_BEGIN(1) {
        for (int t = bid; t < 512; t += nb) phase_norm(p, t, 0, p.in[0], p.in[1], (u16*)((unsigned char*)p.out + OUT_H0));
      } PH_END
      PH_BEGIN(2) {
        GemmArgs g; g.A1 = (const u16*)((const unsigned char*)p.out + OUT_H0); g.lda1 = 1024; g.A2 = g.A1; g.lda2 = 1024; g.ksplit = 1 << 30;
        g.Bt = (const u16*)(p.ws + OFF_WINE); g.K = 1024;
        for (int rd = 0; rd * 256 < 64 * 27; ++rd) { int pm, pn; if (gemm_tile_coord(rd, 27, 64 * 27, pm, pn)) { if (pn <= 9) gemm256<0, true>(p, g, pm * 256, pn * 256, smem); else gemm256<0, false>(p, g, pm * 256, pn * 256, smem); } }
      } PH_END
      PH_BEGIN(3) {
        for (int t = bid; t < 512 + 2048; t += nb) {
          if (dry && (REP_SUB == 1 || REP_SUB == 4) && t >= 256) continue;
          if (dry && REP_SUB == 2 && (t < 256 || t >= 512)) continue;
          if (dry && REP_SUB == 3 && t < 512) continue;
          if (t < 512) phase_hyena(p, t, smem, dry);
          else phase_ssd_states(p, t - 512, smem);
        }
      } PH_END
      PH_BEGIN(4) {
        for (int t = bid; t < 34 * 64; t += nb) phase_scan(p, t);
      } PH_END
      PH_BEGIN(5) {
        for (int t = bid; t < 2048 + 1024; t += nb) {
          if (t < 2048) phase_ssd_out(p, t, smem, dry);
          else {
            int q = t - 2048;
            transpose_tile<u16>((const u16*)(p.ws + OFF_UT) + (size_t)3072 * UTP, MROWS, UTP,
                                (u16*)((unsigned char*)p.out + OUT_YB) + 1024, 2048, q & 15, q >> 4, nullptr, 0, smem);
          }
        }
      } PH_END
      PH_BEGIN(6) {
        GemmArgs g; g.A1 = (const u16*)((const unsigned char*)p.out + OUT_YB); g.lda1 = 2048;
        g.A2 = g.A1; g.lda2 = 2048; g.ksplit = 1024;
        g.Bt = (const u16*)(p.ws + OFF_WOUTE); g.K = 2048;
        for (int rd = 0; rd * 256 < 64 * 4; ++rd) { int pm, pn; if (gemm_tile_coord(rd, 4, 64 * 4, pm, pn)) gemm256<1, true>(p, g, pm * 256, pn * 256, smem); }
      } PH_END
      PH_BEGIN(7) {
        const float* x1 = (const float*)(p.ws + OFF_X1);
        for (int t = bid; t < 512; t += nb) phase_norm(p, t, 1, x1, x1 + (size_t)NPROMPT * 1024, (u16*)(p.ws + OFF_H1));
      } PH_END
      PH_BEGIN(8) {
        GemmArgs g; g.A1 = (const u16*)(p.ws + OFF_H1); g.lda1 = 1024; g.A2 = g.A1; g.lda2 = 1024; g.ksplit = 1 << 30;
        g.Bt = (const u16*)(p.ws + OFF_WINO); g.K = 1024;
        for (int rd = 0; rd * 256 < 64 * 16; ++rd) { int pm, pn; if (gemm_tile_coord(rd, 16, 64 * 16, pm, pn)) gemm256<2, true>(p, g, pm * 256, pn * 256, smem); }
      } PH_END
      PH_BEGIN(9) {
        for (int t = bid; t < 4096; t += nb) phase_attn(p, t, smem, dry);
      } PH_END
      PH_BEGIN(10) {
        GemmArgs g; g.A1 = (const u16*)(p.ws + OFF_C1); g.lda1 = LDC1; g.A2 = g.A1; g.lda2 = LDC1; g.ksplit = 1 << 30;
        g.Bt = (const u16*)(p.ws + OFF_WOUTO); g.K = 1024;
        for (int rd = 0; rd * 256 < 64 * 4; ++rd) { int pm, pn; if (gemm_tile_coord(rd, 4, 64 * 4, pm, pn)) gemm256<3, true>(p, g, pm * 256, pn * 256, smem); }
      } PH_END
      PH_BEGIN(11) {
        for (int t = bid; t < 512; t += nb) phase_final_norm(p, t);
      } PH_END
    }
  }
}

extern "C" void kernel_launch(void* const* d_in, const int* in_sizes, int n_in, void* d_out, int out_size,
                              void* d_ws, size_t ws_size, hipStream_t stream) {
  static int grid_blocks = 0;
  if (!grid_blocks) {
    int dev = 0, cus = 0, per_cu = 0;
    hipGetDevice(&dev);
    hipDeviceGetAttribute(&cus, hipDeviceAttributeMultiprocessorCount, dev);
    hipOccupancyMaxActiveBlocksPerMultiprocessor(&per_cu, mega, NT, 0);
    if (per_cu < 1) per_cu = 1;
    grid_blocks = cus * per_cu;
  }
  Params p{};
  for (int i = 0; i < 31; ++i) p.in[i] = (const float*)d_in[i];
  p.out = (float*)d_out;
  p.ws = (unsigned char*)d_ws;
#if MULTI
  for (int ph = 0; ph < NPHASE; ++ph) {
    hipLaunchKernelGGL(mega, dim3(grid_blocks), dim3(NT), 0, stream, p, ph, ph + 1);
  }
#else
  hipMemsetAsync((unsigned char*)d_ws + OFF_BAR, 0, XCD_BAR_WORDS * sizeof(unsigned), stream);
  int ph0 = 0, ph1 = NPHASE;
  void* args[] = {&p, &ph0, &ph1};
  hipError_t e = hipLaunchCooperativeKernel((void*)mega, dim3(grid_blocks), dim3(NT), args, 0, stream);
  if (e != hipSuccess) fprintf(stderr, "cooperative launch failed: %s (grid %d)\n", hipGetErrorString(e), grid_blocks);
#endif
}
```

```cpp
#include <hip/hip_runtime.h>
#include <hip/hip_cooperative_groups.h>
#include <cstdio>
namespace cg = cooperative_groups;

#ifndef REP_MASK
#define REP_MASK 0
#endif
#ifndef REP_SUB
#define REP_SUB 0
#endif
#define OFF_DUMMY 249651200ul
#ifndef MULTI
#define MULTI 0
#endif

#define NT 512
#define DI __device__ __forceinline__
typedef unsigned short u16;
typedef __attribute__((ext_vector_type(8))) short bf16x8;
typedef __attribute__((ext_vector_type(4))) float f32x4;
typedef __attribute__((ext_vector_type(16))) float f32x16;
typedef __attribute__((ext_vector_type(4))) unsigned u32x4;
typedef __attribute__((ext_vector_type(2))) unsigned u32x2;

#define MFMA16(a, b, c) __builtin_amdgcn_mfma_f32_16x16x32_bf16((a), (b), (c), 0, 0, 0)
#define MFMA32(a, b, c) __builtin_amdgcn_mfma_f32_32x32x16_bf16((a), (b), (c), 0, 0, 0)

#define MROWS 16384
#define NPROMPT 8192
#define UTP 16448
#define LDC1 4160
#define LDC0 2592
#define NPAD0 6784
#define SMEM_BYTES 151552

#define OFF_WINE   0ul
#define OFF_WOUTE  14155776ul
#define OFF_WINO   18350080ul
#define OFF_WOUTO  26738688ul
#define OFF_MOD    28835840ul
#define OFF_ROWSS  28909568ul
#define OFF_CDEC   29958144ul
#define OFF_UT     29974528ul
#define OFF_C0A    164716544ul
#define OFF_X1     OFF_UT
#define OFF_C1     97083392ul
#define OFF_H1     233398272ul
#define OUT_H0     0ul
#define OUT_YB     0ul
#define OUT_HF4096 33554432ul
#define OUT_HF256  (33554432ul + 16777216ul)
#define OUT_SBUF   100663296ul
#define O_YP 0ul
#define O_YS 8388608ul
#define O_ST 16777216ul
#define O_NK 25165824ul
#define O_NV 33554432ul

struct Params {
  const float* in[31];
  float* out;
  unsigned char* ws;
};

typedef float f32x2_t __attribute__((ext_vector_type(2)));
typedef __bf16 bf16x2_t __attribute__((ext_vector_type(2)));
DI unsigned pk2(float a, float b) {
  f32x2_t v = {a, b};
  bf16x2_t r = __builtin_convertvector(v, bf16x2_t);
  return __builtin_bit_cast(unsigned, r);
}
DI u16 f2bf(float x) { return (u16)(pk2(x, x) & 0xffffu); }
DI float bf2f(u16 h) { return __uint_as_float(((unsigned)h) << 16); }
DI float silu(float x) { return x * __builtin_amdgcn_rcpf(1.f + __expf(-x)); }
DI float bflo(unsigned u) { return __uint_as_float(u << 16); }
DI float bfhi(unsigned u) { return __uint_as_float(u & 0xffff0000u); }
DI void unpack8(const u32x4& v, float* f) {
  f[0] = bflo(v[0]); f[1] = bfhi(v[0]); f[2] = bflo(v[1]); f[3] = bfhi(v[1]);
  f[4] = bflo(v[2]); f[5] = bfhi(v[2]); f[6] = bflo(v[3]); f[7] = bfhi(v[3]);
}
DI u32x4 pack8(const float* f) {
  u32x4 o; o[0] = pk2(f[0], f[1]); o[1] = pk2(f[2], f[3]); o[2] = pk2(f[4], f[5]); o[3] = pk2(f[6], f[7]); return o;
}
DI int row_group(int row) { return row < NPROMPT ? 0 : 1 + ((row - NPROMPT) >> 12); }

DI void phase_ada(const Params& p, int t, unsigned char* smem) {
  float* sc = (float*)smem;
  float* red = sc + 3072;
  const int layer = t / 96, cc = t % 96;
  const int tid = threadIdx.x;
  for (int i = tid; i < 3072; i += NT) {
    int g = i >> 10, k = i & 1023;
    float v = (g == 0) ? p.in[6][k] : p.in[5][(g - 1) * 1024 + k];
    sc[i] = silu(v);
  }
  __syncthreads();
  const int col = tid & 31, kg = tid >> 5;
  const float* w = p.in[8] + (size_t)layer * 1024 * 3072 + cc * 32 + col;
  float a0 = 0.f, a1 = 0.f, a2 = 0.f;
#pragma unroll 8
  for (int k = kg * 64; k < kg * 64 + 64; ++k) {
    float wv = w[(size_t)k * 3072];
    a0 += sc[k] * wv; a1 += sc[1024 + k] * wv; a2 += sc[2048 + k] * wv;
  }
  red[(kg * 3 + 0) * 32 + col] = a0;
  red[(kg * 3 + 1) * 32 + col] = a1;
  red[(kg * 3 + 2) * 32 + col] = a2;
  __syncthreads();
  if (tid < 96) {
    int g = tid >> 5, c = tid & 31;
    float s = 0.f;
    for (int q = 0; q < 16; ++q) s += red[(q * 3 + g) * 32 + c];
    int colg = cc * 32 + c;
    float* mod = (float*)(p.ws + OFF_MOD);
    mod[(layer * 3 + g) * 3072 + colg] = s + p.in[9][layer * 3072 + colg];
  }
  __syncthreads();
}

DI float ld_src(const float* q) { return *q; }
DI float ld_src(const u16* q) { return bf2f(*q); }
template <typename ST>
DI void transpose_tile(const ST* src, int N, int ldsrc, u16* dst, int lddst, int kt, int nt4,
                       const float* kscale, int kscale_n, unsigned char* smem) {
  float* tile = (float*)smem;
  const int tid = threadIdx.x;
  const int c = tid & 63, r0 = tid >> 6;
  float v[4][8];
#pragma unroll
  for (int q = 0; q < 4; ++q)
#pragma unroll
    for (int i = 0; i < 8; ++i) {
      int r = r0 + 8 * i;
      int k = kt * 64 + r, n = (nt4 * 4 + q) * 64 + c;
      v[q][i] = 0.f;
      if (n < N) v[q][i] = ld_src(src + (size_t)k * ldsrc + n);
    }
#pragma unroll
  for (int q = 0; q < 4; ++q)
#pragma unroll
    for (int i = 0; i < 8; ++i) {
      int r = r0 + 8 * i;
      int k = kt * 64 + r;
      float x = v[q][i];
      if (kscale != nullptr && k < kscale_n) x *= kscale[k];
      tile[q * 4160 + r * 65 + c] = x;
    }
  __syncthreads();
  const int rr = tid >> 3, c8 = (tid & 7) * 8;
#pragma unroll
  for (int q = 0; q < 4; ++q) {
    float f[8];
#pragma unroll
    for (int e = 0; e < 8; ++e) f[e] = tile[q * 4160 + (c8 + e) * 65 + rr];
    *(u32x4*)(dst + (size_t)((nt4 * 4 + q) * 64 + rr) * lddst + kt * 64 + c8) = pack8(f);
  }
  __syncthreads();
}

DI void phase_filter(const Params& p, int t, unsigned char* smem) {
  const int cfg = t < 256 ? 1 : 0;
  const int L = cfg ? 4096 : 256;
  const int t0 = (cfg ? t : t - 256) * 16;
  float* feats = (float*)smem;
  float* h1 = feats + 16 * 36;
  float* h2 = h1 + 1024;
  const float* w1 = p.in[20]; const float* b1 = p.in[21]; const float* w2 = p.in[22];
  const float* b2 = p.in[23]; const float* w3 = p.in[24]; const float* fr = p.in[25];
  const int tid = threadIdx.x;
  for (int id = tid; id < 16 * 33; id += NT) {
    int tt = id / 33, i = id % 33;
    int tpos = t0 + tt;
    float tv = (float)tpos / (float)(L - 1);
    float wv = 6.283185307179586f * (float)tpos / (float)L;
    float f;
    if (i == 0) f = tv;
    else if (i <= 16) { float fi = 1e-4f + (float)(i - 1) * ((15.f - 1e-4f) / 15.f); f = cosf(fi * wv); }
    else { float fi = 1e-4f + (float)(i - 17) * ((15.f - 1e-4f) / 15.f); f = -sinf(fi * wv); }
    feats[tt * 36 + i] = f;
  }
  __syncthreads();
#pragma unroll
  for (int hh = 0; hh < 2; ++hh) {
    int tt = (tid >> 6) + hh * 8, j = tid & 63;
    float s = b1[j];
#pragma unroll 4
    for (int i = 0; i < 33; ++i) s += feats[tt * 36 + i] * w1[i * 64 + j];
    h1[tt * 64 + j] = sinf(fr[j] * s);
  }
  __syncthreads();
#pragma unroll
  for (int hh = 0; hh < 2; ++hh) {
    int tt = (tid >> 6) + hh * 8, j = tid & 63;
    float s = b2[j];
#pragma unroll 8
    for (int i = 0; i < 64; ++i) s += h1[tt * 64 + i] * w2[i * 64 + j];
    h2[tt * 64 + j] = sinf(fr[j] * s);
  }
  __syncthreads();
  float acc[4][16];
#pragma unroll
  for (int q = 0; q < 4; ++q)
#pragma unroll
    for (int tt = 0; tt < 16; ++tt) acc[q][tt] = 0.f;
#pragma unroll 8
  for (int k = 0; k < 64; ++k) {
    float wv[4];
#pragma unroll
    for (int q = 0; q < 4; ++q) wv[q] = w3[k * 2048 + tid + 512 * q];
#pragma unroll
    for (int tt = 0; tt < 16; ++tt) {
      float hv = h2[tt * 64 + k];
#pragma unroll
      for (int q = 0; q < 4; ++q) acc[q][tt] += hv * wv[q];
    }
  }
  u16* HF = (u16*)((unsigned char*)p.out + (cfg ? OUT_HF4096 : OUT_HF256));
  const float lo = -15.350567286626973f;
  const float hi = -3.0701134573253945f;
#pragma unroll
  for (int q = 0; q < 4; ++q) {
    int col = tid + 512 * q;
    int dir = col >> 10, c = col & 1023;
    float ad = fabsf(lo + (float)c * ((hi - lo) / 1023.f));
    u16* hc = HF + (size_t)c * (2 * L);
#pragma unroll
    for (int tt = 0; tt < 16; ++tt) {
      int tpos = t0 + tt;
      float tv = (float)tpos / (float)(L - 1);
      float val = acc[q][tt] * __expf(-tv * ad);
      if (dir == 0) hc[L - tpos] = f2bf(val);
      else if (tpos > 0) hc[L + tpos] = f2bf(val);
      else hc[0] = 0;
    }
  }
  __syncthreads();
}

DI float wave_sum(float v) {
#pragma unroll
  for (int o = 32; o >= 1; o >>= 1) v += __shfl_xor(v, o);
  return v;
}
DI void phase_norm(const Params& p, int t, int layer, const float* xa, const float* xb, u16* dst) {
  const int lane = threadIdx.x & 63, w = threadIdx.x >> 6;
  const int row0 = t * 32 + w * 4;
  float4 v[4][4];
#pragma unroll
  for (int rr = 0; rr < 4; ++rr) {
    const int row = row0 + rr;
    const float* src = row < NPROMPT ? xa + (size_t)row * 1024 : xb + (size_t)(row - NPROMPT) * 1024;
#pragma unroll
    for (int i = 0; i < 4; ++i) v[rr][i] = *(const float4*)(src + i * 256 + lane * 4);
  }
  const float* nw = p.in[7] + layer * 1024;
#pragma unroll
  for (int rr = 0; rr < 4; ++rr) {
    const int row = row0 + rr;
    const int g = row_group(row);
    float ss = 0.f;
#pragma unroll
    for (int i = 0; i < 4; ++i) ss += v[rr][i].x * v[rr][i].x + v[rr][i].y * v[rr][i].y + v[rr][i].z * v[rr][i].z + v[rr][i].w * v[rr][i].w;
    ss = wave_sum(ss);
    const float rstd = rsqrtf(ss * (1.f / 1024.f) + 1e-6f);
    const float* shift = (const float*)(p.ws + OFF_MOD) + (layer * 3 + g) * 3072;
    const float* scale = shift + 1024;
#pragma unroll
    for (int i = 0; i < 4; ++i) {
      int col = i * 256 + lane * 4;
      float4 nwv = *(const float4*)(nw + col);
      float4 sc = *(const float4*)(scale + col);
      float4 sh = *(const float4*)(shift + col);
      float o0 = v[rr][i].x * rstd * nwv.x * (1.f + sc.x) + sh.x;
      float o1 = v[rr][i].y * rstd * nwv.y * (1.f + sc.y) + sh.y;
      float o2 = v[rr][i].z * rstd * nwv.z * (1.f + sc.z) + sh.z;
      float o3 = v[rr][i].w * rstd * nwv.w * (1.f + sc.w) + sh.w;
      u32x2 o; o[0] = pk2(o0, o1); o[1] = pk2(o2, o3);
      *(u32x2*)(dst + (size_t)row * 1024 + col) = o;
    }
  }
}
DI void phase_final_norm(const Params& p, int t) {
  const int lane = threadIdx.x & 63, w = threadIdx.x >> 6;
  const int row0 = t * 32 + w * 4;
  float4 v[4][4];
#pragma unroll
  for (int rr = 0; rr < 4; ++rr) {
    const float* src = p.out + (size_t)(row0 + rr) * 1024;
#pragma unroll
    for (int i = 0; i < 4; ++i) v[rr][i] = *(const float4*)(src + i * 256 + lane * 4);
  }
  const float* nw = p.in[30];
#pragma unroll
  for (int rr = 0; rr < 4; ++rr) {
    float* src = p.out + (size_t)(row0 + rr) * 1024;
    float ss = 0.f;
#pragma unroll
    for (int i = 0; i < 4; ++i) ss += v[rr][i].x * v[rr][i].x + v[rr][i].y * v[rr][i].y + v[rr][i].z * v[rr][i].z + v[rr][i].w * v[rr][i].w;
    ss = wave_sum(ss);
    const float rstd = rsqrtf(ss * (1.f / 1024.f) + 1e-6f);
#pragma unroll
    for (int i = 0; i < 4; ++i) {
      int col = i * 256 + lane * 4;
      float4 nwv = *(const float4*)(nw + col);
      float4 o;
      o.x = v[rr][i].x * rstd * nwv.x; o.y = v[rr][i].y * rstd * nwv.y; o.z = v[rr][i].z * rstd * nwv.z; o.w = v[rr][i].w * rstd * nwv.w;
      *(float4*)(src + col) = o;
    }
  }
}

struct GemmArgs {
  const u16* A1; int lda1;
  const u16* A2; int lda2;
  int ksplit;
  const u16* Bt; int K;
};
template <int EPI>
DI void gemm_tile(const Params& p, const GemmArgs& g, int m0, int n0, unsigned char* smem) {
  u16* As = (u16*)smem;
  u16* Bs = As + 256 * 72;
  float* rs = (float*)(Bs + 128 * 72);
  const int tid = threadIdx.x, lane = tid & 63, w = tid >> 6;
  const int wm = (w >> 1) * 64, wn = (w & 1) * 64;
  const int l15 = lane & 15, l4 = lane >> 4;
  f32x4 acc[4][4];
#pragma unroll
  for (int i = 0; i < 4; ++i)
#pragma unroll
    for (int j = 0; j < 4; ++j) acc[i][j] = (f32x4){0.f, 0.f, 0.f, 0.f};
  if (EPI == 1) {
    if (tid < 256) {
      const float* rss = (const float*)(p.ws + OFF_ROWSS) + (size_t)(m0 + tid) * 16;
      float s = 0.f;
#pragma unroll
      for (int q = 0; q < 16; ++q) s += rss[q];
      rs[tid] = rsqrtf(s * (1.f / 1024.f) + 1e-6f);
    }
  }
  u32x4 ra[4], rb[2];
  const int KT = g.K >> 6;
  auto loadg = [&](int kt) {
    const int k0 = kt << 6;
    const u16* Ab; int lda; int kk;
    if (k0 < g.ksplit) { Ab = g.A1; lda = g.lda1; kk = k0; } else { Ab = g.A2; lda = g.lda2; kk = k0 - g.ksplit; }
#pragma unroll
    for (int i = 0; i < 4; ++i) {
      int id = tid + 512 * i; int r = id >> 3, c = (id & 7) * 8;
      ra[i] = *(const u32x4*)(Ab + (size_t)(m0 + r) * lda + kk + c);
    }
#pragma unroll
    for (int i = 0; i < 2; ++i) {
      int id = tid + 512 * i; int r = id >> 3, c = (id & 7) * 8;
      rb[i] = *(const u32x4*)(g.Bt + (size_t)(n0 + r) * g.K + k0 + c);
    }
  };
  loadg(0);
  for (int kt = 0; kt < KT; ++kt) {
#pragma unroll
    for (int i = 0; i < 4; ++i) {
      int id = tid + 512 * i; int r = id >> 3, c = (id & 7) * 8;
      *(u32x4*)(As + r * 72 + c) = ra[i];
    }
#pragma unroll
    for (int i = 0; i < 2; ++i) {
      int id = tid + 512 * i; int r = id >> 3, c = (id & 7) * 8;
      *(u32x4*)(Bs + r * 72 + c) = rb[i];
    }
    __syncthreads();
    if (kt + 1 < KT) loadg(kt + 1);
    if (EPI == 1) {
      if ((kt << 6) == g.ksplit) {
#pragma unroll
        for (int i = 0; i < 4; ++i)
#pragma unroll
          for (int r = 0; r < 4; ++r) {
            float sc = rs[wm + i * 16 + l4 * 4 + r];
#pragma unroll
            for (int j = 0; j < 4; ++j) acc[i][j][r] *= sc;
          }
      }
    }
#pragma unroll
    for (int ks = 0; ks < 2; ++ks) {
      bf16x8 a[4], b[4];
#pragma unroll
      for (int i = 0; i < 4; ++i) a[i] = *(const bf16x8*)(As + (wm + i * 16 + l15) * 72 + ks * 32 + l4 * 8);
#pragma unroll
      for (int j = 0; j < 4; ++j) b[j] = *(const bf16x8*)(Bs + (wn + j * 16 + l15) * 72 + ks * 32 + l4 * 8);
#pragma unroll
      for (int i = 0; i < 4; ++i)
#pragma unroll
        for (int j = 0; j < 4; ++j) acc[i][j] = MFMA16(a[i], b[j], acc[i][j]);
    }
    __syncthreads();
  }
#pragma unroll
  for (int i = 0; i < 4; ++i) {
    const int rbase = m0 + wm + i * 16 + l4 * 4;
#pragma unroll
    for (int j = 0; j < 4; ++j) {
      const int col = n0 + wn + j * 16 + l15;
      if (EPI == 0) {
        if (col < LDC0) {
          u16* C = (u16*)(p.ws + OFF_C0A);
#pragma unroll
          for (int r = 0; r < 4; ++r) C[(size_t)(rbase + r) * LDC0 + col] = f2bf(acc[i][j][r]);
        } else if (col < 6688) {
          u16* UT = (u16*)(p.ws + OFF_UT);
          u32x2 o; o[0] = pk2(acc[i][j][0], acc[i][j][1]); o[1] = pk2(acc[i][j][2], acc[i][j][3]);
          *(u32x2*)(UT + (size_t)(col - LDC0) * UTP + rbase) = o;
        }
      } else if (EPI == 1) {
        float* X1 = (float*)(p.ws + OFF_X1);
        const float* mod = (const float*)(p.ws + OFF_MOD);
#pragma unroll
        for (int r = 0; r < 4; ++r) {
          int row = rbase + r;
          const float* xs = row < NPROMPT ? p.in[0] + (size_t)row * 1024 : p.in[1] + (size_t)(row - NPROMPT) * 1024;
          float gate = mod[(0 * 3 + row_group(row)) * 3072 + 2048 + col];
          X1[(size_t)row * 1024 + col] = xs[col] + gate * acc[i][j][r];
        }
      } else if (EPI == 2) {
        u16* C1 = (u16*)(p.ws + OFF_C1);
#pragma unroll
        for (int r = 0; r < 4; ++r) {
          int row = rbase + r;
          C1[(size_t)row * LDC1 + col] = f2bf(acc[i][j][r]);
          if (row < NPROMPT && col >= 1024 && col < 3072) {
            int cc = col - 1024; int isv = cc >> 10; cc &= 1023;
            int hh = cc >> 6, d = cc & 63; int b = row >> 8, l = row & 255;
            float* o = p.out + (isv ? O_NV : O_NK);
            o[(((size_t)b * 16 + hh) * 256 + l) * 64 + d] = acc[i][j][r];
          }
        }
      } else {
        const float* X1 = (const float*)(p.ws + OFF_X1);
        const float* mod = (const float*)(p.ws + OFF_MOD);
#pragma unroll
        for (int r = 0; r < 4; ++r) {
          int row = rbase + r;
          float gate = mod[(1 * 3 + row_group(row)) * 3072 + 2048 + col];
          p.out[(size_t)row * 1024 + col] = X1[(size_t)row * 1024 + col] + gate * acc[i][j][r];
        }
      }
    }
  }
}


DI int lds_byte(int r, int c) {
  int st = (r >> 4) * 2 + (c >> 5), rr = r & 15, cc = c & 31, ob = rr * 64 + cc * 2;
  return st * 1024 + (ob ^ (((ob >> 9) & 1) << 5));
}
DI void stage_rc(int b, int& R, int& C) {
  int st = b / 1024, sb = b % 1024, swz = sb ^ (((sb >> 9) & 1) << 5);
  R = (st >> 1) * 16 + swz / 64; C = (st & 1) * 32 + (swz % 64) / 2;
}
template <int EPI>
DI void epi_store(const Params& p, int rbase, int col, const f32x4& v) {
  if (EPI == 0) {
    if (col < LDC0) {
      u16* C = (u16*)(p.ws + OFF_C0A);
#pragma unroll
      for (int r = 0; r < 4; ++r) C[(size_t)(rbase + r) * LDC0 + col] = f2bf(v[r]);
    } else if (col < 6688) {
      u16* UT = (u16*)(p.ws + OFF_UT);
      u32x2 o; o[0] = pk2(v[0], v[1]); o[1] = pk2(v[2], v[3]);
      *(u32x2*)(UT + (size_t)(col - LDC0) * UTP + rbase) = o;
    }
  } else if (EPI == 1) {
    float* X1 = (float*)(p.ws + OFF_X1);
    const float* mod = (const float*)(p.ws + OFF_MOD);
#pragma unroll
    for (int r = 0; r < 4; ++r) {
      int row = rbase + r;
      const float* xs = row < NPROMPT ? p.in[0] + (size_t)row * 1024 : p.in[1] + (size_t)(row - NPROMPT) * 1024;
      float gate = mod[(0 * 3 + row_group(row)) * 3072 + 2048 + col];
      X1[(size_t)row * 1024 + col] = xs[col] + gate * v[r];
    }
  } else if (EPI == 2) {
    u16* C1 = (u16*)(p.ws + OFF_C1);
#pragma unroll
    for (int r = 0; r < 4; ++r) {
      int row = rbase + r;
      C1[(size_t)row * LDC1 + col] = f2bf(v[r]);
      if (row < NPROMPT && col >= 1024 && col < 3072) {
        int cc = col - 1024; int isv = cc >> 10; cc &= 1023;
        int hh = cc >> 6, d = cc & 63; int b = row >> 8, l = row & 255;
        float* o = p.out + (isv ? O_NV : O_NK);
        o[(((size_t)b * 16 + hh) * 256 + l) * 64 + d] = v[r];
      }
    }
  } else {
    const float* X1 = (const float*)(p.ws + OFF_X1);
    const float* mod = (const float*)(p.ws + OFF_MOD);
#pragma unroll
    for (int r = 0; r < 4; ++r) {
      int row = rbase + r;
      float gate = mod[(1 * 3 + row_group(row)) * 3072 + 2048 + col];
      p.out[(size_t)row * 1024 + col] = X1[(size_t)row * 1024 + col] + gate * v[r];
    }
  }
}

template <int EPI>
DI void epi_store_sw(const Params& p, int row, int col, const f32x4& v) {
  if (EPI == 0) {
    u16* C = (u16*)(p.ws + OFF_C0A);
    u32x2 o; o[0] = pk2(v[0], v[1]); o[1] = pk2(v[2], v[3]);
    *(u32x2*)(C + (size_t)row * LDC0 + col) = o;
  } else if (EPI == 1) {
    float* X1 = (float*)(p.ws + OFF_X1);
    const float* mod = (const float*)(p.ws + OFF_MOD);
    const float* xs = row < NPROMPT ? p.in[0] + (size_t)row * 1024 : p.in[1] + (size_t)(row - NPROMPT) * 1024;
    const float4 xv = *(const float4*)(xs + col);
    const float4 gt = *(const float4*)(mod + (0 * 3 + row_group(row)) * 3072 + 2048 + col);
    float4 o; o.x = xv.x + gt.x * v[0]; o.y = xv.y + gt.y * v[1]; o.z = xv.z + gt.z * v[2]; o.w = xv.w + gt.w * v[3];
    *(float4*)(X1 + (size_t)row * 1024 + col) = o;
  } else if (EPI == 2) {
    u16* C1 = (u16*)(p.ws + OFF_C1);
    u32x2 o; o[0] = pk2(v[0], v[1]); o[1] = pk2(v[2], v[3]);
    *(u32x2*)(C1 + (size_t)row * LDC1 + col) = o;
    if (row < NPROMPT && col >= 1024 && col < 3072) {
      int cc = col - 1024; int isv = cc >> 10; cc &= 1023;
      int hh = cc >> 6, d = cc & 63; int b = row >> 8, l = row & 255;
      float* op = p.out + (isv ? O_NV : O_NK);
      *(float4*)(op + (((size_t)b * 16 + hh) * 256 + l) * 64 + d) = make_float4(v[0], v[1], v[2], v[3]);
    }
  } else {
    const float* X1 = (const float*)(p.ws + OFF_X1);
    const float* mod = (const float*)(p.ws + OFF_MOD);
    const float4 xv = *(const float4*)(X1 + (size_t)row * 1024 + col);
    const float4 gt = *(const float4*)(mod + (1 * 3 + row_group(row)) * 3072 + 2048 + col);
    float4 o; o.x = xv.x + gt.x * v[0]; o.y = xv.y + gt.y * v[1]; o.z = xv.z + gt.z * v[2]; o.w = xv.w + gt.w * v[3];
    *(float4*)(p.out + (size_t)row * 1024 + col) = o;
  }
}

template <int EPI, bool SWAP>
DI void gemm256(const Params& p, const GemmArgs& g, int brow, int bcol, unsigned char* smem) {
  constexpr int HT = 128 * 64;
  u16* shm = (u16*)smem;
  float* rs = (float*)(smem + 131072);
  const int K = g.K;
#define SA(b, h) (shm + ((b) * 2 + (h)) * HT)
#define SB(b, h) (shm + (4 + (b) * 2 + (h)) * HT)
#define STAGE_A(P, br, kt) do { const u16* _ub = g.A1 + (long)(br) * g.lda1 + (long)(kt) * 64; \
    for (int _i = 0; _i < 2; ++_i) { \
      __builtin_amdgcn_global_load_lds((const unsigned*)((const char*)(_ub + (long)_i * 64 * g.lda1) + aoff1), \
        (__attribute__((address_space(3))) unsigned*)((char*)(P) + threadIdx.x * 16 + _i * 8192), 16, 0, 0); } } while (0)
#define STAGE_B(P, bc, kt) do { const u16* _ub = g.Bt + (long)(bc) * K + (long)(kt) * 64; \
    for (int _i = 0; _i < 2; ++_i) { \
      __builtin_amdgcn_global_load_lds((const unsigned*)((const char*)(_ub + (long)_i * 64 * K) + boff), \
        (__attribute__((address_space(3))) unsigned*)((char*)(P) + threadIdx.x * 16 + _i * 8192), 16, 0, 0); } } while (0)
#define LDA(dst, b, h) for (int m = 0; m < 4; ++m) for (int k = 0; k < 2; ++k) \
    dst[m][k] = *reinterpret_cast<const bf16x8*>((char*)SA(b, h) + lds_byte(wr * 64 + m * 16 + fr, k * 32 + fq * 8))
#define LDB(dst, b, h) for (int n = 0; n < 2; ++n) for (int k = 0; k < 2; ++k) \
    dst[n][k] = *reinterpret_cast<const bf16x8*>((char*)SB(b, h) + lds_byte(wc * 32 + n * 16 + fr, k * 32 + fq * 8))
#define MMA(ai, bj, At_, Bt_) do { __builtin_amdgcn_s_setprio(1); \
    for (int m = 0; m < 4; ++m) for (int n = 0; n < 2; ++n) for (int k = 0; k < 2; ++k) \
      acc[ai][bj][m][n] = SWAP ? __builtin_amdgcn_mfma_f32_16x16x32_bf16(Bt_[n][k], At_[m][k], acc[ai][bj][m][n], 0, 0, 0) \
                               : __builtin_amdgcn_mfma_f32_16x16x32_bf16(At_[m][k], Bt_[n][k], acc[ai][bj][m][n], 0, 0, 0); \
    __builtin_amdgcn_s_setprio(0); } while (0)
#define WAIT_V(n) asm volatile("s_waitcnt vmcnt(" #n ")" ::: "memory")
#define WAIT_L(n) asm volatile("s_waitcnt lgkmcnt(" #n ")" ::: "memory")
#define BAR __builtin_amdgcn_s_barrier()
#define SCHED __builtin_amdgcn_sched_barrier(0)
  const int wid = threadIdx.x >> 6, lane = threadIdx.x & 63, wr = wid >> 2, wc = wid & 3, fr = lane & 15, fq = lane >> 4;
  unsigned aoff1, boff;
  {
    int r_, c_; stage_rc(threadIdx.x * 16, r_, c_);
    aoff1 = (unsigned)(r_ * g.lda1 + c_) * 2u;
    boff = (unsigned)(r_ * K + c_) * 2u;
  }
  if (EPI == 1) {
    if (threadIdx.x < 256) {
      const float* rss = (const float*)(p.ws + OFF_ROWSS) + (size_t)(brow + threadIdx.x) * 16;
      float s = 0.f;
#pragma unroll
      for (int q = 0; q < 16; ++q) s += rss[q];
      rs[threadIdx.x] = rsqrtf(s * (1.f / 1024.f) + 1e-6f);
    }
  }
  WAIT_V(0);
  __syncthreads();
  f32x4 acc[2][2][4][2];
#pragma unroll
  for (int a = 0; a < 2; ++a)
#pragma unroll
    for (int b = 0; b < 2; ++b)
#pragma unroll
      for (int m = 0; m < 4; ++m)
#pragma unroll
        for (int n = 0; n < 2; ++n) acc[a][b][m][n] = (f32x4){0.f, 0.f, 0.f, 0.f};
  bf16x8 At[4][2], B0[2][2], B1[2][2];
  const int nt = K / 64;
  const int tscale = (EPI == 1) ? (g.ksplit >> 6) : -1;
  STAGE_B(SB(0, 0), bcol, 0); STAGE_A(SA(0, 0), brow, 0);
  STAGE_B(SB(0, 1), bcol + 128, 0); STAGE_A(SA(0, 1), brow + 128, 0);
  if (wr == 1) BAR;
  WAIT_V(4); BAR;
  STAGE_B(SB(1, 0), bcol, 1); STAGE_A(SA(1, 0), brow, 1); STAGE_B(SB(1, 1), bcol + 128, 1);
  WAIT_V(6); BAR;
  for (int t = 0; t < nt - 2; t += 2) {
    if (EPI == 1) {
      if (t == tscale) {
#pragma unroll
        for (int a = 0; a < 2; ++a)
#pragma unroll
          for (int m = 0; m < 4; ++m)
#pragma unroll
            for (int j = 0; j < 4; ++j) {
              float sc = SWAP ? rs[a * 128 + wr * 64 + m * 16 + fr] : rs[a * 128 + wr * 64 + m * 16 + fq * 4 + j];
#pragma unroll
              for (int b = 0; b < 2; ++b)
#pragma unroll
                for (int n = 0; n < 2; ++n) acc[a][b][m][n][j] *= sc;
            }
      }
    }
    LDB(B0, 0, 0); SCHED; LDA(At, 0, 0); STAGE_A(SA(1, 1), brow + 128, t + 1);
    WAIT_L(8); BAR; WAIT_L(0); MMA(0, 0, At, B0); BAR; SCHED;
    LDB(B1, 0, 1); STAGE_B(SB(0, 0), bcol, t + 2);
    BAR; WAIT_L(0); MMA(0, 1, At, B1); BAR;
    LDA(At, 0, 1); STAGE_A(SA(0, 0), brow, t + 2);
    BAR; WAIT_L(0); MMA(1, 0, At, B0); BAR; SCHED;
    STAGE_B(SB(0, 1), bcol + 128, t + 2);
    WAIT_V(6); BAR; MMA(1, 1, At, B1); BAR;
    LDB(B0, 1, 0); SCHED; LDA(At, 1, 0); STAGE_A(SA(0, 1), brow + 128, t + 2);
    WAIT_L(8); BAR; WAIT_L(0); MMA(0, 0, At, B0); BAR; SCHED;
    LDB(B1, 1, 1); STAGE_B(SB(1, 0), bcol, t + 3);
    BAR; WAIT_L(0); MMA(0, 1, At, B1); BAR;
    LDA(At, 1, 1); STAGE_A(SA(1, 0), brow, t + 3);
    BAR; WAIT_L(0); MMA(1, 0, At, B0); BAR; SCHED;
    STAGE_B(SB(1, 1), bcol + 128, t + 3);
    WAIT_V(6); BAR; MMA(1, 1, At, B1); BAR;
  }
  { LDB(B0, 0, 0); LDA(At, 0, 0); STAGE_A(SA(1, 1), brow + 128, nt - 1);
    BAR; WAIT_L(0); MMA(0, 0, At, B0); BAR;
    LDB(B1, 0, 1); BAR; WAIT_L(0); MMA(0, 1, At, B1); BAR;
    LDA(At, 0, 1); WAIT_V(4); BAR; WAIT_L(0); MMA(1, 0, At, B0); MMA(1, 1, At, B1); BAR; }
  { LDB(B0, 1, 0); LDA(At, 1, 0); WAIT_V(2); BAR; WAIT_L(0); MMA(0, 0, At, B0); BAR;
    LDB(B1, 1, 1); WAIT_V(0); BAR; WAIT_L(0); MMA(0, 1, At, B1); BAR;
    LDA(At, 1, 1); BAR; WAIT_L(0); MMA(1, 0, At, B0); MMA(1, 1, At, B1); BAR; }
  if (wr == 0) BAR;
  int e_tid = threadIdx.x, e_brow = brow, e_bcol = bcol;
  asm volatile("" : "+v"(e_tid), "+s"(e_brow), "+s"(e_bcol));
  const int e_row = SWAP ? e_brow + ((e_tid >> 8) & 1) * 64 + (e_tid & 15) : e_brow + ((e_tid >> 8) & 1) * 64 + ((e_tid >> 4) & 3) * 4;
  const int e_col = SWAP ? e_bcol + ((e_tid >> 6) & 3) * 32 + ((e_tid >> 4) & 3) * 4 : e_bcol + ((e_tid >> 6) & 3) * 32 + (e_tid & 15);
#pragma unroll
  for (int ai = 0; ai < 2; ++ai)
#pragma unroll
    for (int bj = 0; bj < 2; ++bj)
#pragma unroll
      for (int m = 0; m < 4; ++m)
#pragma unroll
        for (int n = 0; n < 2; ++n) {
          if (SWAP) epi_store_sw<EPI>(p, e_row + ai * 128 + m * 16, e_col + bj * 128 + n * 16, acc[ai][bj][m][n]);
          else epi_store<EPI>(p, e_row + ai * 128 + m * 16, e_col + bj * 128 + n * 16, acc[ai][bj][m][n]);
        }
  __syncthreads();
#undef SA
#undef SB
#undef STAGE_A
#undef STAGE_B
#undef LDA
#undef LDB
#undef MMA
#undef WAIT_V
#undef WAIT_L
#undef BAR
#undef SCHED
}
DI bool gemm_tile_coord(int round, int NN, int ntiles, int& pm, int& pn) {
  const int b = blockIdx.x;
  const int v = round * 256 + (b & 7) * 32 + (b >> 3);
  if (v >= ntiles) return false;
  pm = (v / (8 * NN)) * 8 + (v & 7);
  pn = (v >> 3) % NN;
  return true;
}
struct SsdItem { int row0; int h; int has_prev; int has_next; };
DI SsdItem ssd_item(int item) {
  SsdItem s;
  int cgi = item >> 4; s.h = item & 15;
  if (cgi < 64) { int seq = cgi >> 1, c = cgi & 1; s.row0 = seq * 256 + c * 128; s.has_prev = c > 0; s.has_next = c < 1; }
  else { int q = cgi - 64; int seq = q >> 5, c = q & 31; s.row0 = NPROMPT + seq * 4096 + c * 128; s.has_prev = c > 0; s.has_next = c < 31; }
  return s;
}
DI float ssd_load_dt(const Params& p, int row0, int h) {
  const int tid = threadIdx.x;
  const u16* C0 = (const u16*)(p.ws + OFF_C0A);
  float raw = 0.f;
  if (tid < 256) { int d = tid >> 7, l = tid & 127; raw = bf2f(C0[(size_t)(row0 + l) * LDC0 + 2560 + d * 16 + h]); }
  return raw;
}
DI void ssd_prep_dt(const Params& p, float raw, int h, float* sdt, float* scs, float* stot) {
  const int tid = threadIdx.x, lane = tid & 63, w = tid >> 6;
  if (tid < 256) {
    int d = tid >> 7, l = tid & 127;
    float x = raw + p.in[14][d * 16 + h];
    float dt = x > 20.f ? x : log1pf(expf(x));
    float a = -expf(p.in[15][d * 16 + h]);
    sdt[d * 128 + l] = dt;
    scs[d * 128 + l] = a * dt;
  }
  __syncthreads();
  if (w < 2) {
    const int d = w;
    int p0 = d == 0 ? 2 * lane : 127 - 2 * lane;
    int p1 = d == 0 ? 2 * lane + 1 : 126 - 2 * lane;
    float v0 = scs[d * 128 + p0], v1 = scs[d * 128 + p1];
    float s = v0 + v1;
#pragma unroll
    for (int off = 1; off < 64; off <<= 1) {
      float tv = __shfl_up(s, off);
      if (lane >= off) s += tv;
    }
    float excl = s - (v0 + v1);
    scs[d * 128 + p0] = excl + v0;
    scs[d * 128 + p1] = excl + v0 + v1;
    if (lane == 63) stot[d] = s;
  }
  __syncthreads();
}
DI void conv_silu8(const Params& p, int row, int ch0, bool hp, bool hn, float* out) {
  const u16* C0 = (const u16*)(p.ws + OFF_C0A);
  const u16* q = C0 + (size_t)row * LDC0 + 1024 + ch0;
  const float* cw = p.in[12]; const float* cb = p.in[13];
  float xm[8], xc[8], xp[8];
  u32x4 vc = *(const u32x4*)q;
  unpack8(vc, xc);
  if (hp) { u32x4 v = *(const u32x4*)(q - LDC0); unpack8(v, xm); } else {
#pragma unroll
    for (int e = 0; e < 8; ++e) xm[e] = 0.f;
  }
  if (hn) { u32x4 v = *(const u32x4*)(q + LDC0); unpack8(v, xp); } else {
#pragma unroll
    for (int e = 0; e < 8; ++e) xp[e] = 0.f;
  }
  float4 w0a = *(const float4*)(cw + ch0), w0b = *(const float4*)(cw + ch0 + 4);
  float4 w1a = *(const float4*)(cw + 1536 + ch0), w1b = *(const float4*)(cw + 1536 + ch0 + 4);
  float4 w2a = *(const float4*)(cw + 3072 + ch0), w2b = *(const float4*)(cw + 3072 + ch0 + 4);
  float4 ba = *(const float4*)(cb + ch0), bb = *(const float4*)(cb + ch0 + 4);
  float w0[8] = {w0a.x, w0a.y, w0a.z, w0a.w, w0b.x, w0b.y, w0b.z, w0b.w};
  float w1[8] = {w1a.x, w1a.y, w1a.z, w1a.w, w1b.x, w1b.y, w1b.z, w1b.w};
  float w2[8] = {w2a.x, w2a.y, w2a.z, w2a.w, w2b.x, w2b.y, w2b.z, w2b.w};
  float bv[8] = {ba.x, ba.y, ba.z, ba.w, bb.x, bb.y, bb.z, bb.w};
#pragma unroll
  for (int e = 0; e < 8; ++e) out[e] = silu(bv[e] + w0[e] * xm[e] + w1[e] * xc[e] + w2[e] * xp[e]);
}


template <int R>
DI void conv_load(const Params& p, int row0, int l0, int ch0, bool prev_chunk, bool next_chunk, u32x4 (&raw)[R + 2]) {
  const u16* C0 = (const u16*)(p.ws + OFF_C0A);
  const u16* q = C0 + (size_t)(row0 + l0) * LDC0 + 1024 + ch0;
  const bool hp = (l0 > 0) || prev_chunk;
  const bool hn = (l0 + R < 128) || next_chunk;
#pragma unroll
  for (int i = 0; i < R + 2; ++i) {
    const bool ok = (i == 0) ? hp : ((i == R + 1) ? hn : true);
    raw[i] = (u32x4){0u, 0u, 0u, 0u};
    if (ok) raw[i] = *(const u32x4*)(q + (long)(i - 1) * LDC0);
  }
}
template <int R>
DI void conv_compute(const Params& p, int ch0, const u32x4 (&raw)[R + 2], float (&out)[R][8]) {
  const float* cw = p.in[12]; const float* cb = p.in[13];
  float4 w0a = *(const float4*)(cw + ch0), w0b = *(const float4*)(cw + ch0 + 4);
  float4 w1a = *(const float4*)(cw + 1536 + ch0), w1b = *(const float4*)(cw + 1536 + ch0 + 4);
  float4 w2a = *(const float4*)(cw + 3072 + ch0), w2b = *(const float4*)(cw + 3072 + ch0 + 4);
  float4 ba = *(const float4*)(cb + ch0), bb = *(const float4*)(cb + ch0 + 4);
  const float w0[8] = {w0a.x, w0a.y, w0a.z, w0a.w, w0b.x, w0b.y, w0b.z, w0b.w};
  const float w1[8] = {w1a.x, w1a.y, w1a.z, w1a.w, w1b.x, w1b.y, w1b.z, w1b.w};
  const float w2[8] = {w2a.x, w2a.y, w2a.z, w2a.w, w2b.x, w2b.y, w2b.z, w2b.w};
  const float bv[8] = {ba.x, ba.y, ba.z, ba.w, bb.x, bb.y, bb.z, bb.w};
  float xm[8], xc[8], xp[8];
  unpack8(raw[0], xm); unpack8(raw[1], xc);
#pragma unroll
  for (int i = 0; i < R; ++i) {
    unpack8(raw[i + 2], xp);
#pragma unroll
    for (int e = 0; e < 8; ++e) {
      out[i][e] = silu(bv[e] + w0[e] * xm[e] + w1[e] * xc[e] + w2[e] * xp[e]);
      xm[e] = xc[e]; xc[e] = xp[e];
    }
  }
}
DI void phase_ssd_states(const Params& p, int item, unsigned char* smem) {
  u16* xT = (u16*)smem;
  u16* BTs = xT + 64 * 136;
  float* sdt = (float*)(BTs + 2 * 128 * 136);
  float* scs = sdt + 256;
  float* sw = scs + 256;
  float* stot = sw + 256;
  const int tid = threadIdx.x, lane = tid & 63, w = tid >> 6;
  const int l15 = lane & 15, l4 = lane >> 4;
  const SsdItem it = ssd_item(item);
  const int h = it.h, grp = h >> 3;
  const int xchunk = tid & 7, xrg = tid >> 3;
  const int bchunk = tid & 15, brg = tid >> 4;
  u32x4 rawx[4], rawb[6];
  const float rawdt = ssd_load_dt(p, it.row0, h);
  conv_load<2>(p, it.row0, xrg * 2, h * 64 + xchunk * 8, it.has_prev, it.has_next, rawx);
  conv_load<4>(p, it.row0, brg * 4, 1024 + grp * 128 + bchunk * 8, it.has_prev, it.has_next, rawb);
  ssd_prep_dt(p, rawdt, h, sdt, scs, stot);
  if (tid < 256) {
    int d = tid >> 7;
    sw[tid] = sdt[tid] * __expf(stot[d] - scs[tid]);
  }
  __syncthreads();
  {
    {
      float o[2][8];
      conv_compute<2>(p, h * 64 + xchunk * 8, rawx, o);
#pragma unroll
      for (int e = 0; e < 8; ++e) *(unsigned*)(xT + (xchunk * 8 + e) * 136 + xrg * 2) = pk2(o[0][e], o[1][e]);
    }
    {
      float o[4][8];
      conv_compute<4>(p, 1024 + grp * 128 + bchunk * 8, rawb, o);
#pragma unroll
      for (int dd = 0; dd < 2; ++dd) {
        const float s0 = sw[dd * 128 + brg * 4], s1 = sw[dd * 128 + brg * 4 + 1], s2 = sw[dd * 128 + brg * 4 + 2], s3 = sw[dd * 128 + brg * 4 + 3];
#pragma unroll
        for (int e = 0; e < 8; ++e) {
          u32x2 v; v[0] = pk2(o[0][e] * s0, o[1][e] * s1); v[1] = pk2(o[2][e] * s2, o[3][e] * s3);
          *(u32x2*)(BTs + dd * 128 * 136 + (bchunk * 8 + e) * 136 + brg * 4) = v;
        }
      }
    }
  }
  __syncthreads();
  const int d = w >> 2, nq = w & 3;
  f32x4 acc[4][2];
#pragma unroll
  for (int i = 0; i < 4; ++i) { acc[i][0] = (f32x4){0.f, 0.f, 0.f, 0.f}; acc[i][1] = (f32x4){0.f, 0.f, 0.f, 0.f}; }
#pragma unroll
  for (int ks = 0; ks < 4; ++ks) {
    bf16x8 a[4], b[2];
#pragma unroll
    for (int i = 0; i < 4; ++i) a[i] = *(const bf16x8*)(xT + (i * 16 + l15) * 136 + ks * 32 + l4 * 8);
#pragma unroll
    for (int j = 0; j < 2; ++j) b[j] = *(const bf16x8*)(BTs + d * 128 * 136 + (nq * 32 + j * 16 + l15) * 136 + ks * 32 + l4 * 8);
#pragma unroll
    for (int i = 0; i < 4; ++i)
#pragma unroll
      for (int j = 0; j < 2; ++j) acc[i][j] = MFMA16(a[i], b[j], acc[i][j]);
  }
  u16* S = (u16*)((unsigned char*)p.out + OUT_SBUF) + ((size_t)item * 2 + d) * 8192;
#pragma unroll
  for (int i = 0; i < 4; ++i)
#pragma unroll
    for (int j = 0; j < 2; ++j)
#pragma unroll
      for (int r = 0; r < 4; ++r) {
        int pp = i * 16 + l4 * 4 + r, n = nq * 32 + j * 16 + l15;
        S[pp * 128 + n] = f2bf(acc[i][j][r]);
      }
  if (tid < 2) {
    float* cdec = (float*)(p.ws + OFF_CDEC);
    cdec[item * 2 + tid] = __expf(stot[tid]);
  }
  __syncthreads();
}

DI void phase_scan(const Params& p, int t) {
  const int part = t & 1, d = (t >> 1) & 1, h = (t >> 2) & 15, seq = t >> 6;
  const int tid = threadIdx.x;
  const int e0 = part * 4096 + tid * 8;
  const int nc = seq < 32 ? 2 : 32;
  const int cg0 = seq < 32 ? seq * 2 : 64 + (seq - 32) * 32;
  float st[8];
  if (seq < 32) {
#pragma unroll
    for (int e = 0; e < 8; ++e) st[e] = 0.f;
  } else {
    const float* init = p.in[2] + ((((size_t)(seq - 32) * 1 + 0) * 2 + d) * 16 + h) * 8192 + e0;
    float4 a = *(const float4*)init, b = *(const float4*)(init + 4);
    st[0] = a.x; st[1] = a.y; st[2] = a.z; st[3] = a.w; st[4] = b.x; st[5] = b.y; st[6] = b.z; st[7] = b.w;
  }
  u16* Sb = (u16*)((unsigned char*)p.out + OUT_SBUF);
  const float* cdec = (const float*)(p.ws + OFF_CDEC);
  for (int cb0 = 0; cb0 < nc; cb0 += 8) {
    u32x4 vv[8]; float dec[8];
#pragma unroll
    for (int i = 0; i < 8; ++i) {
      if (cb0 + i < nc) {
        const int ci = cb0 + i;
        const int c = d == 0 ? ci : nc - 1 - ci;
        const int item = (cg0 + c) * 16 + h;
        vv[i] = *(const u32x4*)(Sb + ((size_t)item * 2 + d) * 8192 + e0);
        dec[i] = cdec[item * 2 + d];
      }
    }
#pragma unroll
    for (int i = 0; i < 8; ++i) {
      if (cb0 + i < nc) {
        const int ci = cb0 + i;
        const int c = d == 0 ? ci : nc - 1 - ci;
        const int item = (cg0 + c) * 16 + h;
        float sc[8]; unpack8(vv[i], sc);
        *(u32x4*)(Sb + ((size_t)item * 2 + d) * 8192 + e0) = pack8(st);
#pragma unroll
        for (int e = 0; e < 8; ++e) st[e] = st[e] * dec[i] + sc[e];
      }
    }
  }
  if (seq < 32) {
    float* o = p.out + O_ST + ((((size_t)seq * 1 + 0) * 2 + d) * 16 + h) * 8192 + e0;
    *(float4*)o = make_float4(st[0], st[1], st[2], st[3]);
    *(float4*)(o + 4) = make_float4(st[4], st[5], st[6], st[7]);
  }
}

DI void phase_ssd_out(const Params& p, int item, unsigned char* smem, bool dry) {
  u16* Cs = (u16*)smem;
  u16* Bs = Cs + 128 * 136;
  u16* xT = Bs + 128 * 136;
  u16* St = xT + 64 * 136;
  float* sdt = (float*)(St + 2 * 64 * 136);
  float* scs = sdt + 256;
  float* stot = scs + 256;
  const int tid = threadIdx.x, lane = tid & 63, w = tid >> 6;
  const int l15 = lane & 15, l4 = lane >> 4;
  const SsdItem it = ssd_item(item);
  const int h = it.h, grp = h >> 3;
  const int xchunk = tid & 7, xrg = tid >> 3;
  const int bchunk = tid & 15, brg = tid >> 4;
  u32x4 rawx[4], rawb[6], rawc[6], rawst[4];
  u16 zraw[4][4];
  const float rawdt = ssd_load_dt(p, it.row0, h);
  conv_load<2>(p, it.row0, xrg * 2, h * 64 + xchunk * 8, it.has_prev, it.has_next, rawx);
  conv_load<4>(p, it.row0, brg * 4, 1024 + grp * 128 + bchunk * 8, it.has_prev, it.has_next, rawb);
  conv_load<4>(p, it.row0, brg * 4, 1280 + grp * 128 + bchunk * 8, it.has_prev, it.has_next, rawc);
  {
    const u16* S = (const u16*)((const unsigned char*)p.out + OUT_SBUF) + (size_t)item * 2 * 8192;
#pragma unroll
    for (int v = 0; v < 4; ++v) {
      int id = tid + 512 * v;
      int dd = id >> 10, pp = (id >> 4) & 63, nv = (id & 15) * 8;
      rawst[v] = *(const u32x4*)(S + dd * 8192 + pp * 128 + nv);
    }
  }
  ssd_prep_dt(p, rawdt, h, sdt, scs, stot);
  {
    {
      float o[2][8];
      conv_compute<2>(p, h * 64 + xchunk * 8, rawx, o);
#pragma unroll
      for (int e = 0; e < 8; ++e) *(unsigned*)(xT + (xchunk * 8 + e) * 136 + xrg * 2) = pk2(o[0][e], o[1][e]);
    }
    {
      float o[4][8];
      conv_compute<4>(p, 1024 + grp * 128 + bchunk * 8, rawb, o);
#pragma unroll
      for (int i = 0; i < 4; ++i) *(u32x4*)(Bs + (brg * 4 + i) * 136 + bchunk * 8) = pack8(o[i]);
      conv_compute<4>(p, 1280 + grp * 128 + bchunk * 8, rawc, o);
#pragma unroll
      for (int i = 0; i < 4; ++i) *(u32x4*)(Cs + (brg * 4 + i) * 136 + bchunk * 8) = pack8(o[i]);
    }
#pragma unroll
    for (int v = 0; v < 4; ++v) {
      int id = tid + 512 * v;
      int dd = id >> 10, pp = (id >> 4) & 63, nv = (id & 15) * 8;
      *(u32x4*)(St + dd * 64 * 136 + pp * 136 + nv) = rawst[v];
    }
  }
  __syncthreads();
  {
    const u16* C0z = (const u16*)(p.ws + OFF_C0A);
#pragma unroll
    for (int i = 0; i < 4; ++i)
#pragma unroll
      for (int r = 0; r < 4; ++r)
        zraw[i][r] = C0z[(size_t)(it.row0 + 16 * w + l4 * 4 + r) * LDC0 + h * 64 + i * 16 + l15];
  }
  f32x4 cb[8], af[4], ab[4];
#pragma unroll
  for (int j = 0; j < 8; ++j) cb[j] = (f32x4){0.f, 0.f, 0.f, 0.f};
#pragma unroll
  for (int i = 0; i < 4; ++i) { af[i] = (f32x4){0.f, 0.f, 0.f, 0.f}; ab[i] = (f32x4){0.f, 0.f, 0.f, 0.f}; }
#pragma unroll
  for (int ks = 0; ks < 4; ++ks) {
    bf16x8 a = *(const bf16x8*)(Cs + (16 * w + l15) * 136 + ks * 32 + l4 * 8);
#pragma unroll
    for (int j = 0; j < 8; ++j) {
      bf16x8 b = *(const bf16x8*)(Bs + (j * 16 + l15) * 136 + ks * 32 + l4 * 8);
      cb[j] = MFMA16(b, a, cb[j]);
    }
#pragma unroll
    for (int i = 0; i < 4; ++i) {
      bf16x8 b0 = *(const bf16x8*)(St + (i * 16 + l15) * 136 + ks * 32 + l4 * 8);
      bf16x8 b1 = *(const bf16x8*)(St + 64 * 136 + (i * 16 + l15) * 136 + ks * 32 + l4 * 8);
      af[i] = MFMA16(a, b0, af[i]);
      ab[i] = MFMA16(a, b1, ab[i]);
    }
  }
  __syncthreads();
  f32x4 Y[4];
  {
    const int lrow = 16 * w + l15;
    const float cs0l = scs[lrow], cs1l = scs[128 + lrow];
#pragma unroll
    for (int j = 0; j < 8; ++j) {
      const int s0 = j * 16 + l4 * 4;
      float f[4];
      if (j < w) {
        const float4 c4 = *(const float4*)(scs + s0), d4 = *(const float4*)(sdt + s0);
        f[0] = __expf(cs0l - c4.x) * d4.x; f[1] = __expf(cs0l - c4.y) * d4.y; f[2] = __expf(cs0l - c4.z) * d4.z; f[3] = __expf(cs0l - c4.w) * d4.w;
      } else if (j > w) {
        const float4 c4 = *(const float4*)(scs + 128 + s0), d4 = *(const float4*)(sdt + 128 + s0);
        f[0] = __expf(cs1l - c4.x) * d4.x; f[1] = __expf(cs1l - c4.y) * d4.y; f[2] = __expf(cs1l - c4.z) * d4.z; f[3] = __expf(cs1l - c4.w) * d4.w;
      } else {
        const float4 c4 = *(const float4*)(scs + s0), d4 = *(const float4*)(sdt + s0);
        const float4 e4 = *(const float4*)(scs + 128 + s0), g4 = *(const float4*)(sdt + 128 + s0);
        const float c0[4] = {c4.x, c4.y, c4.z, c4.w}, d0[4] = {d4.x, d4.y, d4.z, d4.w};
        const float c1[4] = {e4.x, e4.y, e4.z, e4.w}, d1[4] = {g4.x, g4.y, g4.z, g4.w};
#pragma unroll
        for (int jj = 0; jj < 4; ++jj) {
          const int sidx = s0 + jj;
          float v;
          if (lrow > sidx) v = __expf(cs0l - c0[jj]) * d0[jj];
          else if (lrow < sidx) v = __expf(cs1l - c1[jj]) * d1[jj];
          else v = d0[jj] + d1[jj];
          f[jj] = v;
        }
      }
      u32x2 o; o[0] = pk2(cb[j][0] * f[0], cb[j][1] * f[1]); o[1] = pk2(cb[j][2] * f[2], cb[j][3] * f[3]);
      *(u32x2*)(Bs + lrow * 136 + s0) = o;
    }
#pragma unroll
    for (int r = 0; r < 4; ++r) {
      const int l = 16 * w + l4 * 4 + r;
      float e0 = __expf(scs[l]), e1 = __expf(scs[128 + l]);
#pragma unroll
      for (int i = 0; i < 4; ++i) Y[i][r] = af[i][r] * e0 + ab[i][r] * e1;
    }
  }
  __syncthreads();
#pragma unroll
  for (int ks = 0; ks < 4; ++ks) {
    bf16x8 a = *(const bf16x8*)(Bs + (16 * w + l15) * 136 + ks * 32 + l4 * 8);
#pragma unroll
    for (int i = 0; i < 4; ++i) {
      bf16x8 b = *(const bf16x8*)(xT + (i * 16 + l15) * 136 + ks * 32 + l4 * 8);
      Y[i] = MFMA16(a, b, Y[i]);
    }
  }
  {
    const u16* C0 = (const u16*)(p.ws + OFF_C0A);
    u16* YAB = dry ? (u16*)(p.ws + OFF_DUMMY) + (size_t)(blockIdx.x & 15) * 400000 - (size_t)it.row0 * 2048 : (u16*)((unsigned char*)p.out + OUT_YB);
    const float dsk = p.in[16][h] + p.in[16][16 + h];
    float ss[4] = {0.f, 0.f, 0.f, 0.f};
#pragma unroll
    for (int i = 0; i < 4; ++i) {
      const int pp = i * 16 + l15;
#pragma unroll
      for (int r = 0; r < 4; ++r) {
        const int l = 16 * w + l4 * 4 + r;
        const size_t off = (size_t)(it.row0 + l) * LDC0 + h * 64 + pp;
        float xv = bf2f(xT[pp * 136 + l]);
        float y = Y[i][r] + xv * dsk;
        float z = bf2f(zraw[i][r]);
        float gv = y * silu(z);
        YAB[(size_t)(it.row0 + l) * 2048 + h * 64 + pp] = f2bf(gv);
        ss[r] += gv * gv;
      }
    }
    float* rss = (float*)(p.ws + OFF_ROWSS);
#pragma unroll
    for (int r = 0; r < 4; ++r) {
      float s = ss[r];
      s += __shfl_xor(s, 1); s += __shfl_xor(s, 2); s += __shfl_xor(s, 4); s += __shfl_xor(s, 8);
      if (l15 == 0) rss[(size_t)(it.row0 + 16 * w + l4 * 4 + r) * 16 + h] = s;
    }
  }
  __syncthreads();
}


template <int MASK, int PART>
DI void hy_seg(int dlo, int dhi, int L, int A, const u16* hr, const u16* vx, const int (&ncol)[4], const int (&acol)[4],
               int l31, int kh, f32x16 (&acc)[4]) {
  int oz = 0;
  asm volatile("" : "+v"(oz));
#pragma unroll 1
  for (int d = dlo; d <= dhi; ++d) {
    bf16x8 af[2];
#pragma unroll
    for (int khalf = 0; khalf < 2; ++khalf) {
      const int idx0 = L - 32 * d - l31 + 16 * khalf + 8 * kh;
#pragma unroll
      for (int e = 0; e < 8; ++e) af[khalf][e] = (short)hr[idx0 + e + oz * (e + 1)];
    }
    bf16x8 bfr[4][2];
#pragma unroll
    for (int j = 0; j < 4; ++j) {
      if (MASK & (1 << j)) {
        const int asrc = acol[j] - d;
        const bool valid = (asrc >= 0) && (asrc < A);
        const int nsrc = valid ? (ncol[j] - d) : ncol[j];
#pragma unroll
        for (int khalf = 0; khalf < 2; ++khalf) {
          bf16x8 t = *(const bf16x8*)(vx + nsrc * 40 + 16 * khalf + 8 * kh);
          if ((PART & (1 << j)) && !valid) t = (bf16x8){0, 0, 0, 0, 0, 0, 0, 0};
          bfr[j][khalf] = t;
        }
      }
    }
#pragma unroll
    for (int khalf = 0; khalf < 2; ++khalf)
#pragma unroll
      for (int j = 0; j < 4; ++j)
        if (MASK & (1 << j)) acc[j] = MFMA32(af[khalf], bfr[j][khalf], acc[j]);
  }
}
DI void phase_hyena(const Params& p, int it, unsigned char* smem, bool dry) {
  const int cfg = it < 256 ? 1 : 0;
  const int c0 = (it & 255) * 4;
  const int L = cfg ? 4096 : 256;
  const int A = L >> 5;
  const int lgA = cfg ? 7 : 3;
  const int rowbase = cfg ? NPROMPT : 0;
  u16* vxs = (u16*)smem;
  u16* hrs = vxs + 4 * 10240;
  const int tid = threadIdx.x, lane = tid & 63, w = tid >> 6;
  const u16* UT = (const u16*)(p.ws + OFF_UT);
  const float* cw = p.in[18]; const float* cbv = p.in[19];
  {
    const u16* HF = (const u16*)((const unsigned char*)p.out + (cfg ? OUT_HF4096 : OUT_HF256));
    const int nv = (2 * L) >> 3;
    const int lgnv = cfg ? 10 : 6;
    {
      u32x4 fv[8];
#pragma unroll
      for (int it8 = 0; it8 < 8; ++it8) {
        const int id = tid + it8 * NT;
        fv[it8] = (u32x4){0u, 0u, 0u, 0u};
        if (id < 4 * nv) { int chh = id >> lgnv, v8 = id & (nv - 1); fv[it8] = *(const u32x4*)(HF + (size_t)(c0 + chh) * 2 * L + v8 * 8); }
      }
#pragma unroll
      for (int it8 = 0; it8 < 8; ++it8) {
        const int id = tid + it8 * NT;
        if (id < 4 * nv) { int chh = id >> lgnv, v8 = id & (nv - 1); *(u32x4*)(hrs + chh * 2 * L + v8 * 8) = fv[it8]; }
      }
    }
#pragma unroll 1
    for (int hb4 = 0; hb4 < 2; ++hb4) {
    u32x4 rv[4][2]; float hm[4][2], hp[4][2];
#pragma unroll
    for (int it8 = 0; it8 < 4; ++it8) {
      const int id = tid + (hb4 * 4 + it8) * NT;
      const int chh = id >> 10, blk8 = id & 1023;
      const int pos = blk8 * 8, tl = pos & (L - 1);
#pragma unroll
      for (int which = 1; which <= 2; ++which) {
        const u16* q = UT + (size_t)(which * 1024 + c0 + chh) * UTP + rowbase + pos;
        rv[it8][which - 1] = *(const u32x4*)q;
        hm[it8][which - 1] = (tl > 0) ? bf2f(q[-1]) : 0.f;
        hp[it8][which - 1] = (tl + 8 < L) ? bf2f(q[8]) : 0.f;
      }
    }
#pragma unroll
    for (int it8 = 0; it8 < 4; ++it8) {
      const int id = tid + (hb4 * 4 + it8) * NT;
      const int chh = id >> 10, blk8 = id & 1023;
      const int pos = blk8 * 8;
      float res[8];
#pragma unroll
      for (int e = 0; e < 8; ++e) res[e] = 1.f;
#pragma unroll
      for (int which = 1; which <= 2; ++which) {
        const int uc = which * 1024 + c0 + chh;
        float xv[10];
        unpack8(rv[it8][which - 1], xv + 1);
        xv[0] = hm[it8][which - 1]; xv[9] = hp[it8][which - 1];
        const float w0 = cw[uc], w1 = cw[3072 + uc], w2 = cw[6144 + uc], bb = cbv[uc];
#pragma unroll
        for (int e = 0; e < 8; ++e) res[e] *= (bb + w0 * xv[e] + w1 * xv[e + 1] + w2 * xv[e + 2]);
      }
      const int n = pos >> 5, k = pos & 31;
      *(u32x4*)(vxs + chh * 10240 + n * 40 + k) = pack8(res);
    }
    }
  }
  __syncthreads();
  const int ch = w >> 1, wv = w & 1;
  const int l31 = lane & 31, kh = lane >> 5;
  const u16* vx = vxs + ch * 10240;
  const u16* hr = hrs + ch * 2 * L;
  f32x16 acc[4];
#pragma unroll
  for (int j = 0; j < 4; ++j)
#pragma unroll
    for (int r = 0; r < 16; ++r) acc[j][r] = 0.f;
  int ncol[4], acol[4];
#pragma unroll
  for (int j = 0; j < 4; ++j) { ncol[j] = 128 * wv + 32 * j + l31; acol[j] = ncol[j] & (A - 1); }
  if (!(dry && REP_SUB == 4)) {
  if (cfg) {
    hy_seg<1, 1>(-127, -96, L, A, hr, vx, ncol, acol, l31, kh, acc);
    hy_seg<3, 2>(-95, -64, L, A, hr, vx, ncol, acol, l31, kh, acc);
    hy_seg<7, 4>(-63, -32, L, A, hr, vx, ncol, acol, l31, kh, acc);
    hy_seg<15, 9>(-31, 31, L, A, hr, vx, ncol, acol, l31, kh, acc);
    hy_seg<14, 2>(32, 63, L, A, hr, vx, ncol, acol, l31, kh, acc);
    hy_seg<12, 4>(64, 95, L, A, hr, vx, ncol, acol, l31, kh, acc);
    hy_seg<8, 8>(96, 127, L, A, hr, vx, ncol, acol, l31, kh, acc);
  } else {
    hy_seg<15, 15>(-7, 7, L, A, hr, vx, ncol, acol, l31, kh, acc);
  }
  }
  {
    const float hb = p.in[26][c0 + ch];
#pragma unroll
    for (int j = 0; j < 4; ++j) {
      const int n = ncol[j];
#pragma unroll
      for (int q = 0; q < 4; ++q) {
        u32x2 vr = *(const u32x2*)(vx + n * 40 + 8 * q + 4 * kh);
        acc[j][4 * q + 0] += bflo(vr[0]) * hb; acc[j][4 * q + 1] += bfhi(vr[0]) * hb;
        acc[j][4 * q + 2] += bflo(vr[1]) * hb; acc[j][4 * q + 3] += bfhi(vr[1]) * hb;
      }
    }
  }
  __syncthreads();
  float* FL = (float*)smem;
  {
#pragma unroll
    for (int j = 0; j < 4; ++j) {
      const int n = ncol[j];
#pragma unroll
      for (int q = 0; q < 4; ++q) {
        const int pos = 32 * n + 8 * q + 4 * kh;
        *(float4*)(FL + ch * 9216 + pos + (pos >> 5) * 4) = make_float4(acc[j][4 * q], acc[j][4 * q + 1], acc[j][4 * q + 2], acc[j][4 * q + 3]);
      }
    }
  }
  __syncthreads();
#pragma unroll 2
  for (int it8 = 0; it8 < 8; ++it8) {
    const int chh = it8 >> 1;
    const int c = c0 + chh;
    const int pos = ((tid + it8 * NT) & 1023) * 8;
    const int tl = pos & (L - 1);
    const u16* x0row = UT + (size_t)c * UTP + rowbase;
    const u16* grow = UT + (size_t)(3072 + c) * UTP + rowbase;
    u16* groww = dry ? (u16*)(p.ws + OFF_DUMMY) + (size_t)blockIdx.x * 32768 + chh * 8192
                     : (u16*)(p.ws + OFF_UT) + (size_t)(3072 + c) * UTP + rowbase;
    const u32x4 xr = *(const u32x4*)(x0row + pos);
    const u32x4 gr = *(const u32x4*)(grow + pos);
    float xv[10], gv[8];
    unpack8(xr, xv + 1); unpack8(gr, gv);
    xv[0] = tl > 0 ? bf2f(x0row[pos - 1]) : 0.f;
    xv[9] = (tl + 8 < L) ? bf2f(x0row[pos + 8]) : 0.f;
    const float w0 = cw[c], w1 = cw[3072 + c], w2 = cw[6144 + c], bb = cbv[c];
    const float* fl = FL + chh * 9216 + pos + (pos >> 5) * 4;
    const float4 a0 = *(const float4*)fl, a1 = *(const float4*)(fl + 4);
    const float av[8] = {a0.x, a0.y, a0.z, a0.w, a1.x, a1.y, a1.z, a1.w};
    float y[8];
#pragma unroll
    for (int e = 0; e < 8; ++e) {
      float x0 = bb + w0 * xv[e] + w1 * xv[e + 1] + w2 * xv[e + 2];
      y[e] = x0 * av[e] * silu(gv[e]);
    }
    *(u32x4*)(groww + pos) = pack8(y);
  }
  (void)lgA;
  __syncthreads();
}

#define VSP 72
typedef __attribute__((ext_vector_type(4))) short v4i16_t;
DI float dpp_rowmax(float v) {
  v = fmaxf(v, __builtin_bit_cast(float, __builtin_amdgcn_update_dpp(0, __builtin_bit_cast(int, v), 0x128, 0xf, 0xf, false)));
  v = fmaxf(v, __builtin_bit_cast(float, __builtin_amdgcn_update_dpp(0, __builtin_bit_cast(int, v), 0x124, 0xf, 0xf, false)));
  v = fmaxf(v, __builtin_bit_cast(float, __builtin_amdgcn_update_dpp(0, __builtin_bit_cast(int, v), 0x122, 0xf, 0xf, false)));
  v = fmaxf(v, __builtin_bit_cast(float, __builtin_amdgcn_update_dpp(0, __builtin_bit_cast(int, v), 0x121, 0xf, 0xf, false)));
  return v;
}
DI float dpp_rowsum(float v) {
  v += __builtin_bit_cast(float, __builtin_amdgcn_update_dpp(0, __builtin_bit_cast(int, v), 0x128, 0xf, 0xf, false));
  v += __builtin_bit_cast(float, __builtin_amdgcn_update_dpp(0, __builtin_bit_cast(int, v), 0x124, 0xf, 0xf, false));
  v += __builtin_bit_cast(float, __builtin_amdgcn_update_dpp(0, __builtin_bit_cast(int, v), 0x122, 0xf, 0xf, false));
  v += __builtin_bit_cast(float, __builtin_amdgcn_update_dpp(0, __builtin_bit_cast(int, v), 0x121, 0xf, 0xf, false));
  return v;
}
#define OUT_CKV 0ul
DI void phase_attn(const Params& p, int item, unsigned char* smem, bool dry) {
  u16* VS = (u16*)smem;
  u16* Pb = VS + 832 * VSP;
  float* rp = (float*)(Pb + 8 * 16 * 72);
  const int tid = threadIdx.x, lane = tid & 63, w = tid >> 6;
  const int l15 = lane & 15, l4 = lane >> 4;
  const u16* C1 = (const u16*)(p.ws + OFF_C1);
  const u16* CK = (const u16*)((const unsigned char*)p.out + OUT_CKV);
  const u16* CV = CK + 524288;
  const bool lat = item < 1024;
  int b, h, myr = 0, rows0w = 0, vrow0 = 0, nvrows = 0, qbase, jq = w & 3;
  if (lat) {
    b = item >> 9; h = (item >> 5) & 15; const int r0 = (item & 31) * 2;
    myr = r0 + (w >> 2);
    rows0w = min(max(myr - 4, 0), 56);
    vrow0 = min(max(r0 - 4, 0), 56);
    nvrows = min(9, 64 - vrow0);
    qbase = NPROMPT + b * 4096 + myr * 64 + jq * 16;
  } else {
    const int q = item - 1024; b = q >> 5; h = (q >> 1) & 15;
    qbase = b * 256 + (q & 1) * 128 + w * 16;
  }
  const int cstart = min(max(16 * jq - 8, 0), 32);
  const int ntile = lat ? 8 : 4;
  bf16x8 qa[2];
#pragma unroll
  for (int ks = 0; ks < 2; ++ks) qa[ks] = *(const bf16x8*)(C1 + (size_t)(qbase + l15) * LDC1 + h * 64 + ks * 32 + l4 * 8);
  auto loadk = [&](int tt, bf16x8 (&kb)[4][2]) {
#pragma unroll
    for (int jt = 0; jt < 4; ++jt) {
      const u16* src;
      if (lat) {
        if (tt < 4) src = C1 + (size_t)(NPROMPT + b * 4096 + (rows0w + tt * 2 + (jt >> 1)) * 64 + cstart + (jt & 1) * 16 + l15) * LDC1 + 1024 + h * 64;
        else src = CK + ((size_t)(b * 16 + h) * 256 + (tt - 4) * 64 + jt * 16 + l15) * 64;
      } else {
        src = C1 + (size_t)(b * 256 + tt * 64 + jt * 16 + l15) * LDC1 + 1024 + h * 64;
      }
#pragma unroll
      for (int ks = 0; ks < 2; ++ks) kb[jt][ks] = *(const bf16x8*)(src + ks * 32 + l4 * 8);
    }
  };
  bf16x8 kn[4][2], kn2[4][2];
  loadk(0, kn);
  loadk(1, kn2);
  u16 graw[4][4];
#pragma unroll
  for (int r = 0; r < 4; ++r)
#pragma unroll
    for (int i = 0; i < 4; ++i)
      graw[r][i] = C1[(size_t)(qbase + l4 * 4 + r) * LDC1 + 3072 + h * 64 + i * 16 + l15];
  {
    const int nloc = lat ? nvrows * 64 : 256;
    const int keyrow0 = lat ? NPROMPT + b * 4096 + vrow0 * 64 : b * 256;
    u32x4 vv[9], cvv[4];
#pragma unroll
    for (int i = 0; i < 9; ++i) {
      const int id = tid + i * NT;
      vv[i] = (u32x4){0u, 0u, 0u, 0u};
      if (id < nloc * 8) { int key = id >> 3, d0 = (id & 7) * 8; vv[i] = *(const u32x4*)(C1 + (size_t)(keyrow0 + key) * LDC1 + 2048 + h * 64 + d0); }
    }
    if (lat) {
#pragma unroll
      for (int i = 0; i < 4; ++i) {
        const int id = tid + i * NT; int key = id >> 3, d0 = (id & 7) * 8;
        cvv[i] = *(const u32x4*)(CV + ((size_t)(b * 16 + h) * 256 + key) * 64 + d0);
      }
    }
#pragma unroll
    for (int i = 0; i < 9; ++i) {
      const int id = tid + i * NT;
      if (id < nloc * 8) { int key = id >> 3, d0 = (id & 7) * 8; *(u32x4*)(VS + key * VSP + d0) = vv[i]; }
    }
    if (lat) {
#pragma unroll
      for (int i = 0; i < 4; ++i) {
        const int id = tid + i * NT; int key = id >> 3, d0 = (id & 7) * 8;
        *(u32x4*)(VS + (576 + key) * VSP + d0) = cvv[i];
      }
      for (int id = tid; id < 465; id += NT) rp[id] = p.in[29][h * 465 + id] * 1.4426950408889634f;
    }
  }
  __syncthreads();
  float mrow[4], lrow[4];
  f32x4 O[4];
#pragma unroll
  for (int r = 0; r < 4; ++r) { mrow[r] = -1e30f; lrow[r] = 0.f; }
#pragma unroll
  for (int i = 0; i < 4; ++i) O[i] = (f32x4){0.f, 0.f, 0.f, 0.f};
  u16* Pw = Pb + w * 16 * 72;
  const __attribute__((address_space(3))) char* vs3 = (const __attribute__((address_space(3))) char*)VS;
  int dcv[2][4]; bool okv[2][4];
#pragma unroll
  for (int hf = 0; hf < 2; ++hf)
#pragma unroll
    for (int r = 0; r < 4; ++r) {
      const int kcn = cstart + hf * 16 + l15;
      const int qc = jq * 16 + l4 * 4 + r;
      const int col0 = min(max(qc - 8, 0), 48);
      dcv[hf][r] = min(max(kcn - qc + 15, 0), 30);
      okv[hf][r] = (kcn >= col0) && (kcn < col0 + 16);
    }
#pragma unroll 1
  for (int tt = 0; tt < ntile; ++tt) {
    bf16x8 kc[4][2];
#pragma unroll
    for (int jt = 0; jt < 4; ++jt)
#pragma unroll
      for (int ks = 0; ks < 2; ++ks) { kc[jt][ks] = kn[jt][ks]; kn[jt][ks] = kn2[jt][ks]; }
    if (tt + 2 < ntile) loadk(tt + 2, kn2);
    const bool local = lat && tt < 4;
    f32x4 S[4];
#pragma unroll
    for (int jt = 0; jt < 4; ++jt) {
      S[jt] = (f32x4){0.f, 0.f, 0.f, 0.f};
      S[jt] = MFMA16(qa[0], kc[jt][0], S[jt]);
      S[jt] = MFMA16(qa[1], kc[jt][1], S[jt]);
    }
    float sv[4][4];
#pragma unroll
    for (int jt = 0; jt < 4; ++jt)
#pragma unroll
      for (int r = 0; r < 4; ++r) {
        float s = S[jt][r] * 0.18033688011112042f;
        if (local) {
          const int dr = rows0w + tt * 2 + (jt >> 1) - myr + 7;
          s += rp[dr * 31 + dcv[jt & 1][r]];
          if (!okv[jt & 1][r]) s = -INFINITY;
        }
        sv[jt][r] = s;
      }
    float alpha[4];
#pragma unroll
    for (int r = 0; r < 4; ++r) {
      float mx = fmaxf(fmaxf(sv[0][r], sv[1][r]), fmaxf(sv[2][r], sv[3][r]));
      mx = dpp_rowmax(mx);
      float mn = fmaxf(mrow[r], mx);
      alpha[r] = __builtin_amdgcn_exp2f(mrow[r] - mn);
      mrow[r] = mn;
      float ps = 0.f;
#pragma unroll
      for (int jt = 0; jt < 4; ++jt) {
        float pv = __builtin_amdgcn_exp2f(sv[jt][r] - mn);
        ps += pv;
        Pw[(l4 * 4 + r) * 72 + jt * 16 + l15] = f2bf(pv);
      }
      lrow[r] = lrow[r] * alpha[r] + ps;
    }
#pragma unroll
    for (int i = 0; i < 4; ++i)
#pragma unroll
      for (int r = 0; r < 4; ++r) O[i][r] *= alpha[r];
    asm volatile("s_waitcnt lgkmcnt(0)" ::: "memory");
#pragma unroll
    for (int ks2 = 0; ks2 < 2; ++ks2) {
      bf16x8 pa = *(const bf16x8*)(Pw + l15 * 72 + ks2 * 32 + l4 * 8);
      int keyoff;
      if (lat) keyoff = tt < 4 ? (rows0w - vrow0 + tt * 2 + ks2) * 64 + cstart : 576 + (tt - 4) * 64 + ks2 * 32;
      else keyoff = tt * 64 + ks2 * 32;
#pragma unroll
      for (int i = 0; i < 4; ++i) {
        const int rowa = keyoff + 8 * l4 + (l15 >> 2);
        const int cola = i * 16 + 4 * (l15 & 3);
        v4i16_t lo = __builtin_amdgcn_ds_read_tr16_b64_v4i16((__attribute__((address_space(3))) v4i16_t*)(vs3 + (rowa * VSP + cola) * 2));
        v4i16_t hi = __builtin_amdgcn_ds_read_tr16_b64_v4i16((__attribute__((address_space(3))) v4i16_t*)(vs3 + ((rowa + 4) * VSP + cola) * 2));
        bf16x8 vb = __builtin_shufflevector(lo, hi, 0, 1, 2, 3, 4, 5, 6, 7);
        O[i] = MFMA16(pa, vb, O[i]);
      }
    }
    asm volatile("s_waitcnt lgkmcnt(0)" ::: "memory");
  }
  {
    u16* C1w = dry ? (u16*)(p.ws + OFF_DUMMY) + (size_t)(blockIdx.x & 15) * 300000 + (size_t)w * 16 * LDC1 - (size_t)qbase * LDC1 : (u16*)(p.ws + OFF_C1);
#pragma unroll
    for (int r = 0; r < 4; ++r) {
      const float inv = 1.f / dpp_rowsum(lrow[r]);
      const int row = qbase + l4 * 4 + r;
#pragma unroll
      for (int i = 0; i < 4; ++i) {
        const int dcol = h * 64 + i * 16 + l15;
        C1w[(size_t)row * LDC1 + dcol] = f2bf(O[i][r] * inv * silu(bf2f(graw[r][i])));
      }
    }
  }
  __syncthreads();
}

DI void phase_ckv(const Params& p, int t) {
  const int id = t * NT + threadIdx.x;
  const int arr = id >> 16, v = id & 65535;
  const float* src = p.in[3 + arr] + (size_t)v * 8;
  float4 a = *(const float4*)src, c = *(const float4*)(src + 4);
  float f[8] = {a.x, a.y, a.z, a.w, c.x, c.y, c.z, c.w};
  u16* dst = (u16*)((unsigned char*)p.out + OUT_CKV) + (size_t)arr * 524288 + (size_t)v * 8;
  *(u32x4*)dst = pack8(f);
}

#define OFF_BAR 268419072ul
#define XB_TMO      128
#define XB_XCNT(j)  (256  + 64 * (j))
#define XB_XSUB(j)  (1280 + 64 * (j))
#define XB_XGEN(j)  (2304 + 64 * (j))
#define XB_TOP      3328
#define XB_TOPGEN   3392
#define XCD_BAR_WORDS 3456
#define XB_SPIN_CAP (1u << 18)
#define LAS __attribute__((address_space(3)))
DI unsigned xb_ld(unsigned* p) { return __hip_atomic_load(p, __ATOMIC_RELAXED, __HIP_MEMORY_SCOPE_AGENT); }
DI unsigned xb_add(unsigned* p, unsigned v) { return __hip_atomic_fetch_add(p, v, __ATOMIC_RELAXED, __HIP_MEMORY_SCOPE_AGENT); }
DI unsigned xb_xcc_id() { return (unsigned)__builtin_amdgcn_s_getreg((3 << 11) | 20) & 0xFu; }
#define XB_SPIN(cond, bar) do { unsigned _sp = 0; while (cond) { __builtin_amdgcn_s_sleep(1); \
    if ((++_sp & 255u) == 0u) { if (xb_ld(&(bar)[XB_TMO])) break; if (_sp > XB_SPIN_CAP) { atomicAdd(&(bar)[XB_TMO], 1u); break; } } } } while (0)
struct XcdBarrier { unsigned* bar; unsigned x; volatile LAS unsigned* st; };
DI XcdBarrier xcd_barrier_post(unsigned* bar, volatile LAS unsigned* st) {
  XcdBarrier b; b.bar = bar; b.x = xb_xcc_id(); b.st = st;
  if (threadIdx.x == 0) (void)xb_add(&bar[XB_XCNT(b.x)], 1u);
  return b;
}
DI void xcd_barrier_complete(unsigned* bar, unsigned x, unsigned& nloc, unsigned& nx) {
  const unsigned G = gridDim.x * gridDim.y * gridDim.z;
  unsigned sum, cnt, mine, sp = 0u;
  for (;;) {
    sum = 0u; cnt = 0u; mine = 0u;
#pragma unroll
    for (unsigned j = 0; j < 16; ++j) { const unsigned c = xb_ld(&bar[XB_XCNT(j)]); sum += c; cnt += (c > 0u) ? 1u : 0u; mine = (j == x) ? c : mine; }
    if (sum == G) break;
    __builtin_amdgcn_s_sleep(1);
    if ((++sp & 255u) == 0u) { if (xb_ld(&bar[XB_TMO])) break; if (sp > XB_SPIN_CAP) { atomicAdd(&bar[XB_TMO], 1u); break; } }
  }
  nloc = mine > 0u ? mine : 1u; nx = cnt > 0u ? cnt : 1u;
}
DI void xcd_barrier(const XcdBarrier& b) {
  asm volatile("s_waitcnt vmcnt(0)" ::: "memory");
  __syncthreads();
  if (threadIdx.x == 0) {
    unsigned* bar = b.bar;
    __builtin_amdgcn_s_waitcnt(0);
    unsigned nloc = b.st[0], nx = b.st[1];
    if (nloc == 0u) { xcd_barrier_complete(bar, b.x, nloc, nx); b.st[0] = nloc; b.st[1] = nx; }
    const unsigned old = xb_add(&bar[XB_XSUB(b.x)], 1u);
    const unsigned gen = old / nloc;
    if (old + 1u == (gen + 1u) * nloc) {
      __builtin_amdgcn_fence(__ATOMIC_RELEASE, "agent");
      asm volatile("s_waitcnt vmcnt(0)" ::: "memory");
      const unsigned og = xb_add(&bar[XB_TOP], 1u);
      const unsigned tg = og / nx;
      if (og + 1u == (tg + 1u) * nx) xb_add(&bar[XB_TOPGEN], 1u);
      else XB_SPIN(xb_ld(&bar[XB_TOPGEN]) == tg, bar);
      __builtin_amdgcn_fence(__ATOMIC_ACQUIRE, "agent");
      xb_add(&bar[XB_XGEN(b.x)], 1u);
      asm volatile("s_waitcnt vmcnt(0)" ::: "memory");
    } else {
      XB_SPIN(xb_ld(&bar[XB_XGEN(b.x)]) == gen, bar);
      __builtin_amdgcn_fence(__ATOMIC_ACQUIRE, "agent");
      asm volatile("s_waitcnt vmcnt(0)" ::: "memory");
    }
  }
  __syncthreads();
}
#define NPHASE 12
__global__ void __launch_bounds__(NT) mega(Params p, int ph0, int ph1) {
  __shared__ __attribute__((aligned(16))) unsigned char smem[SMEM_BYTES];
  __shared__ __attribute__((aligned(16))) unsigned xb_st[4];
  const int nb = gridDim.x, bid = blockIdx.x;
  if (threadIdx.x < 4) xb_st[threadIdx.x] = 0u;
  __syncthreads();
  const XcdBarrier xb = xcd_barrier_post((unsigned*)(p.ws + OFF_BAR), (volatile LAS unsigned*)xb_st);
  if (ph1 > 4096) cg::this_grid().sync();
#define PH_BEGIN(k) if (ph0 <= (k) && (k) < ph1) { if ((k) > ph0) xcd_barrier(xb); \
  for (int rep = (REP_MASK >> (k)) & 1; rep >= 0; --rep) { const bool dry = rep > 0; (void)dry;
#define PH_END if (rep > 0) xcd_barrier(xb); } }
  {
    {
      PH_BEGIN(0) {
        for (int t = bid; t < 272 + 192 + 880; t += nb) {
          if (t < 272) phase_filter(p, t, smem);
          else if (t < 464) phase_ada(p, t - 272, smem);
          else {
            int q = t - 464;
            if (q < 432) transpose_tile<float>(p.in[10], 6688, 6688, (u16*)(p.ws + OFF_WINE), 1024, q & 15, q >> 4, nullptr, 0, smem);
            else if (q < 560) { q -= 432; transpose_tile<float>(p.in[11], 1024, 1024, (u16*)(p.ws + OFF_WOUTE), 2048, q & 31, q >> 5, p.in[17], 1024, smem); }
            else if (q < 816) { q -= 560; transpose_tile<float>(p.in[27], 4096, 4096, (u16*)(p.ws + OFF_WINO), 1024, q & 15, q >> 4, nullptr, 0, smem); }
            else { q -= 816; transpose_tile<float>(p.in[28], 1024, 1024, (u16*)(p.ws + OFF_WOUTO), 1024, q & 15, q >> 4, nullptr, 0, smem); }
          }
        }
      } PH_END
      PH_BEGIN(1) {
        for (int t = bid; t < 512; t += nb) phase_norm(p, t, 0, p.in[0], p.in[1], (u16*)((unsigned char*)p.out + OUT_H0));
      } PH_END
      PH_BEGIN(2) {
        GemmArgs g; g.A1 = (const u16*)((const unsigned char*)p.out + OUT_H0); g.lda1 = 1024; g.A2 = g.A1; g.lda2 = 1024; g.ksplit = 1 << 30;
        g.Bt = (const u16*)(p.ws + OFF_WINE); g.K = 1024;
        for (int rd = 0; rd * 256 < 64 * 27; ++rd) { int pm, pn; if (gemm_tile_coord(rd, 27, 64 * 27, pm, pn)) { if (pn <= 9) gemm256<0, true>(p, g, pm * 256, pn * 256, smem); else gemm256<0, false>(p, g, pm * 256, pn * 256, smem); } }
      } PH_END
      PH_BEGIN(3) {
        for (int t = bid; t < 512 + 2048; t += nb) {
          if (dry && (REP_SUB == 1 || REP_SUB == 4) && t >= 256) continue;
          if (dry && REP_SUB == 2 && (t < 256 || t >= 512)) continue;
          if (dry && REP_SUB == 3 && t < 512) continue;
          if (t < 512) phase_hyena(p, t, smem, dry);
          else phase_ssd_states(p, t - 512, smem);
        }
      } PH_END
      PH_BEGIN(4) {
        for (int t = bid; t < 34 * 64; t += nb) phase_scan(p, t);
      } PH_END
      PH_BEGIN(5) {
        for (int t = bid; t < 2048 + 1024; t += nb) {
          if (t < 2048) phase_ssd_out(p, t, smem, dry);
          else {
            int q = t - 2048;
            transpose_tile<u16>((const u16*)(p.ws + OFF_UT) + (size_t)3072 * UTP, MROWS, UTP,
                                (u16*)((unsigned char*)p.out + OUT_YB) + 1024, 2048, q & 15, q >> 4, nullptr, 0, smem);
          }
        }
      } PH_END
      PH_BEGIN(6) {
        GemmArgs g; g.A1 = (const u16*)((const unsigned char*)p.out + OUT_YB); g.lda1 = 2048;
        g.A2 = g.A1; g.lda2 = 2048; g.ksplit = 1024;
        g.Bt = (const u16*)(p.ws + OFF_WOUTE); g.K = 2048;
        for (int rd = 0; rd * 256 < 64 * 4; ++rd) { int pm, pn; if (gemm_tile_coord(rd, 4, 64 * 4, pm, pn)) gemm256<1, true>(p, g, pm * 256, pn * 256, smem); }
      } PH_END
      PH_BEGIN(7) {
        const float* x1 = (const float*)(p.ws + OFF_X1);
        for (int t = bid; t < 512 + 256; t += nb) { if (t < 512) phase_norm(p, t, 1, x1, x1 + (size_t)NPROMPT * 1024, (u16*)(p.ws + OFF_H1)); else phase_ckv(p, t - 512); }
      } PH_END
      PH_BEGIN(8) {
        GemmArgs g; g.A1 = (const u16*)(p.ws + OFF_H1); g.lda1 = 1024; g.A2 = g.A1; g.lda2 = 1024; g.ksplit = 1 << 30;
        g.Bt = (const u16*)(p.ws + OFF_WINO); g.K = 1024;
        for (int rd = 0; rd * 256 < 64 * 16; ++rd) { int pm, pn; if (gemm_tile_coord(rd, 16, 64 * 16, pm, pn)) gemm256<2, true>(p, g, pm * 256, pn * 256, smem); }
      } PH_END
      PH_BEGIN(9) {
        for (int t = bid; t < 2048; t += nb) phase_attn(p, t, smem, dry);
      } PH_END
      PH_BEGIN(10) {
        GemmArgs g; g.A1 = (const u16*)(p.ws + OFF_C1); g.lda1 = LDC1; g.A2 = g.A1; g.lda2 = LDC1; g.ksplit = 1 << 30;
        g.Bt = (const u16*)(p.ws + OFF_WOUTO); g.K = 1024;
        for (int rd = 0; rd * 256 < 64 * 4; ++rd) { int pm, pn; if (gemm_tile_coord(rd, 4, 64 * 4, pm, pn)) gemm256<3, true>(p, g, pm * 256, pn * 256, smem); }
      } PH_END
      PH_BEGIN(11) {
        for (int t = bid; t < 512; t += nb) phase_final_norm(p, t);
      } PH_END
    }
  }
}

extern "C" void kernel_launch(void* const* d_in, const int* in_sizes, int n_in, void* d_out, int out_size,
                              void* d_ws, size_t ws_size, hipStream_t stream) {
  static int grid_blocks = 0;
  if (!grid_blocks) {
    int dev = 0, cus = 0, per_cu = 0;
    hipGetDevice(&dev);
    hipDeviceGetAttribute(&cus, hipDeviceAttributeMultiprocessorCount, dev);
    hipOccupancyMaxActiveBlocksPerMultiprocessor(&per_cu, mega, NT, 0);
    if (per_cu < 1) per_cu = 1;
    grid_blocks = cus * per_cu;
  }
  Params p{};
  for (int i = 0; i < 31; ++i) p.in[i] = (const float*)d_in[i];
  p.out = (float*)d_out;
  p.ws = (unsigned char*)d_ws;
#if MULTI
  for (int ph = 0; ph < NPHASE; ++ph) {
    hipLaunchKernelGGL(mega, dim3(grid_blocks), dim3(NT), 0, stream, p, ph, ph + 1);
  }
#else
  hipMemsetAsync((unsigned char*)d_ws + OFF_BAR, 0, XCD_BAR_WORDS * sizeof(unsigned), stream);
  int ph0 = 0, ph1 = NPHASE;
  void* args[] = {&p, &ph0, &ph1};
  hipError_t e = hipLaunchCooperativeKernel((void*)mega, dim3(grid_blocks), dim3(NT), args, 0, stream);
  if (e != hipSuccess) fprintf(stderr, "cooperative launch failed: %s (grid %d)\n", hipGetErrorString(e), grid_blocks);
#endif
}
```

```cpp
#include <hip/hip_runtime.h>
#include <hip/hip_cooperative_groups.h>
#include <cstdio>
namespace cg = cooperative_groups;

#ifndef REP_MASK
#define REP_MASK 0
#endif
#ifndef REP_SUB
#define REP_SUB 0
#endif
#define OFF_DUMMY 249651200ul
#ifndef MULTI
#define MULTI 0
#endif

#define NT 512
#define DI __device__ __forceinline__
typedef unsigned short u16;
typedef __attribute__((ext_vector_type(8))) short bf16x8;
typedef __attribute__((ext_vector_type(4))) float f32x4;
typedef __attribute__((ext_vector_type(16))) float f32x16;
typedef __attribute__((ext_vector_type(4))) unsigned u32x4;
typedef __attribute__((ext_vector_type(2))) unsigned u32x2;

#define MFMA16(a, b, c) __builtin_amdgcn_mfma_f32_16x16x32_bf16((a), (b), (c), 0, 0, 0)
#define MFMA32(a, b, c) __builtin_amdgcn_mfma_f32_32x32x16_bf16((a), (b), (c), 0, 0, 0)

#define MROWS 16384
#define NPROMPT 8192
#define UTP 16448
#define LDC1 4160
#define LDC0 2592
#define NPAD0 6784
#define SMEM_BYTES 151552

#define OFF_WINE   0ul
#define OFF_WOUTE  14155776ul
#define OFF_WINO   18350080ul
#define OFF_WOUTO  26738688ul
#define OFF_MOD    28835840ul
#define OFF_ROWSS  28909568ul
#define OFF_CDEC   29958144ul
#define OFF_UT     29974528ul
#define OFF_C0A    164716544ul
#define OFF_X1     OFF_UT
#define OFF_C1     97083392ul
#define OFF_H1     233398272ul
#define OUT_H0     0ul
#define OUT_YB     0ul
#define OUT_HF4096 33554432ul
#define OUT_HF256  (33554432ul + 16777216ul)
#define OUT_SBUF   100663296ul
#define O_YP 0ul
#define O_YS 8388608ul
#define O_ST 16777216ul
#define O_NK 25165824ul
#define O_NV 33554432ul

struct Params {
  const float* in[31];
  float* out;
  unsigned char* ws;
};

typedef float f32x2_t __attribute__((ext_vector_type(2)));
typedef __bf16 bf16x2_t __attribute__((ext_vector_type(2)));
DI unsigned pk2(float a, float b) {
  f32x2_t v = {a, b};
  bf16x2_t r = __builtin_convertvector(v, bf16x2_t);
  return __builtin_bit_cast(unsigned, r);
}
DI u16 f2bf(float x) { return (u16)(pk2(x, x) & 0xffffu); }
DI float bf2f(u16 h) { return __uint_as_float(((unsigned)h) << 16); }
DI float silu(float x) { return x * __builtin_amdgcn_rcpf(1.f + __expf(-x)); }
DI float bflo(unsigned u) { return __uint_as_float(u << 16); }
DI float bfhi(unsigned u) { return __uint_as_float(u & 0xffff0000u); }
DI void unpack8(const u32x4& v, float* f) {
  f[0] = bflo(v[0]); f[1] = bfhi(v[0]); f[2] = bflo(v[1]); f[3] = bfhi(v[1]);
  f[4] = bflo(v[2]); f[5] = bfhi(v[2]); f[6] = bflo(v[3]); f[7] = bfhi(v[3]);
}
DI u32x4 pack8(const float* f) {
  u32x4 o; o[0] = pk2(f[0], f[1]); o[1] = pk2(f[2], f[3]); o[2] = pk2(f[4], f[5]); o[3] = pk2(f[6], f[7]); return o;
}
DI int row_group(int row) { return row < NPROMPT ? 0 : 1 + ((row - NPROMPT) >> 12); }

DI void phase_ada(const Params& p, int t, unsigned char* smem) {
  float* sc = (float*)smem;
  float* red = sc + 3072;
  const int layer = t / 96, cc = t % 96;
  const int tid = threadIdx.x;
  for (int i = tid; i < 3072; i += NT) {
    int g = i >> 10, k = i & 1023;
    float v = (g == 0) ? p.in[6][k] : p.in[5][(g - 1) * 1024 + k];
    sc[i] = silu(v);
  }
  __syncthreads();
  const int col = tid & 31, kg = tid >> 5;
  const float* w = p.in[8] + (size_t)layer * 1024 * 3072 + cc * 32 + col;
  float a0 = 0.f, a1 = 0.f, a2 = 0.f;
#pragma unroll 8
  for (int k = kg * 64; k < kg * 64 + 64; ++k) {
    float wv = w[(size_t)k * 3072];
    a0 += sc[k] * wv; a1 += sc[1024 + k] * wv; a2 += sc[2048 + k] * wv;
  }
  red[(kg * 3 + 0) * 32 + col] = a0;
  red[(kg * 3 + 1) * 32 + col] = a1;
  red[(kg * 3 + 2) * 32 + col] = a2;
  __syncthreads();
  if (tid < 96) {
    int g = tid >> 5, c = tid & 31;
    float s = 0.f;
    for (int q = 0; q < 16; ++q) s += red[(q * 3 + g) * 32 + c];
    int colg = cc * 32 + c;
    float* mod = (float*)(p.ws + OFF_MOD);
    mod[(layer * 3 + g) * 3072 + colg] = s + p.in[9][layer * 3072 + colg];
  }
  __syncthreads();
}

DI float ld_src(const float* q) { return *q; }
DI float ld_src(const u16* q) { return bf2f(*q); }
template <typename ST>
DI void transpose_tile(const ST* src, int N, int ldsrc, u16* dst, int lddst, int kt, int nt4,
                       const float* kscale, int kscale_n, unsigned char* smem) {
  float* tile = (float*)smem;
  const int tid = threadIdx.x;
  const int c = tid & 63, r0 = tid >> 6;
  float v[4][8];
#pragma unroll
  for (int q = 0; q < 4; ++q)
#pragma unroll
    for (int i = 0; i < 8; ++i) {
      int r = r0 + 8 * i;
      int k = kt * 64 + r, n = (nt4 * 4 + q) * 64 + c;
      v[q][i] = 0.f;
      if (n < N) v[q][i] = ld_src(src + (size_t)k * ldsrc + n);
    }
#pragma unroll
  for (int q = 0; q < 4; ++q)
#pragma unroll
    for (int i = 0; i < 8; ++i) {
      int r = r0 + 8 * i;
      int k = kt * 64 + r;
      float x = v[q][i];
      if (kscale != nullptr && k < kscale_n) x *= kscale[k];
      tile[q * 4160 + r * 65 + c] = x;
    }
  __syncthreads();
  const int rr = tid >> 3, c8 = (tid & 7) * 8;
#pragma unroll
  for (int q = 0; q < 4; ++q) {
    float f[8];
#pragma unroll
    for (int e = 0; e < 8; ++e) f[e] = tile[q * 4160 + (c8 + e) * 65 + rr];
    *(u32x4*)(dst + (size_t)((nt4 * 4 + q) * 64 + rr) * lddst + kt * 64 + c8) = pack8(f);
  }
  __syncthreads();
}

DI void phase_filter(const Params& p, int t, unsigned char* smem) {
  const int cfg = t < 256 ? 1 : 0;
  const int L = cfg ? 4096 : 256;
  const int t0 = (cfg ? t : t - 256) * 16;
  float* feats = (float*)smem;
  float* h1 = feats + 16 * 36;
  float* h2 = h1 + 1024;
  const float* w1 = p.in[20]; const float* b1 = p.in[21]; const float* w2 = p.in[22];
  const float* b2 = p.in[23]; const float* w3 = p.in[24]; const float* fr = p.in[25];
  const int tid = threadIdx.x;
  for (int id = tid; id < 16 * 33; id += NT) {
    int tt = id / 33, i = id % 33;
    int tpos = t0 + tt;
    float tv = (float)tpos / (float)(L - 1);
    float wv = 6.283185307179586f * (float)tpos / (float)L;
    float f;
    if (i == 0) f = tv;
    else if (i <= 16) { float fi = 1e-4f + (float)(i - 1) * ((15.f - 1e-4f) / 15.f); f = cosf(fi * wv); }
    else { float fi = 1e-4f + (float)(i - 17) * ((15.f - 1e-4f) / 15.f); f = -sinf(fi * wv); }
    feats[tt * 36 + i] = f;
  }
  __syncthreads();
#pragma unroll
  for (int hh = 0; hh < 2; ++hh) {
    int tt = (tid >> 6) + hh * 8, j = tid & 63;
    float s = b1[j];
#pragma unroll 4
    for (int i = 0; i < 33; ++i) s += feats[tt * 36 + i] * w1[i * 64 + j];
    h1[tt * 64 + j] = sinf(fr[j] * s);
  }
  __syncthreads();
#pragma unroll
  for (int hh = 0; hh < 2; ++hh) {
    int tt = (tid >> 6) + hh * 8, j = tid & 63;
    float s = b2[j];
#pragma unroll 8
    for (int i = 0; i < 64; ++i) s += h1[tt * 64 + i] * w2[i * 64 + j];
    h2[tt * 64 + j] = sinf(fr[j] * s);
  }
  __syncthreads();
  float acc[4][16];
#pragma unroll
  for (int q = 0; q < 4; ++q)
#pragma unroll
    for (int tt = 0; tt < 16; ++tt) acc[q][tt] = 0.f;
#pragma unroll 8
  for (int k = 0; k < 64; ++k) {
    float wv[4];
#pragma unroll
    for (int q = 0; q < 4; ++q) wv[q] = w3[k * 2048 + tid + 512 * q];
#pragma unroll
    for (int tt = 0; tt < 16; ++tt) {
      float hv = h2[tt * 64 + k];
#pragma unroll
      for (int q = 0; q < 4; ++q) acc[q][tt] += hv * wv[q];
    }
  }
  u16* HF = (u16*)((unsigned char*)p.out + (cfg ? OUT_HF4096 : OUT_HF256));
  const float lo = -15.350567286626973f;
  const float hi = -3.0701134573253945f;
#pragma unroll
  for (int q = 0; q < 4; ++q) {
    int col = tid + 512 * q;
    int dir = col >> 10, c = col & 1023;
    float ad = fabsf(lo + (float)c * ((hi - lo) / 1023.f));
    u16* hc = HF + (size_t)c * (2 * L);
#pragma unroll
    for (int tt = 0; tt < 16; ++tt) {
      int tpos = t0 + tt;
      float tv = (float)tpos / (float)(L - 1);
      float val = acc[q][tt] * __expf(-tv * ad);
      if (dir == 0) hc[L - tpos] = f2bf(val);
      else if (tpos > 0) hc[L + tpos] = f2bf(val);
      else hc[0] = 0;
    }
  }
  __syncthreads();
}

DI float wave_sum(float v) {
#pragma unroll
  for (int o = 32; o >= 1; o >>= 1) v += __shfl_xor(v, o);
  return v;
}
DI void phase_norm(const Params& p, int t, int layer, const float* xa, const float* xb, u16* dst) {
  const int lane = threadIdx.x & 63, w = threadIdx.x >> 6;
  const int row0 = t * 32 + w * 4;
  float4 v[4][4];
#pragma unroll
  for (int rr = 0; rr < 4; ++rr) {
    const int row = row0 + rr;
    const float* src = row < NPROMPT ? xa + (size_t)row * 1024 : xb + (size_t)(row - NPROMPT) * 1024;
#pragma unroll
    for (int i = 0; i < 4; ++i) v[rr][i] = *(const float4*)(src + i * 256 + lane * 4);
  }
  const float* nw = p.in[7] + layer * 1024;
#pragma unroll
  for (int rr = 0; rr < 4; ++rr) {
    const int row = row0 + rr;
    const int g = row_group(row);
    float ss = 0.f;
#pragma unroll
    for (int i = 0; i < 4; ++i) ss += v[rr][i].x * v[rr][i].x + v[rr][i].y * v[rr][i].y + v[rr][i].z * v[rr][i].z + v[rr][i].w * v[rr][i].w;
    ss = wave_sum(ss);
    const float rstd = rsqrtf(ss * (1.f / 1024.f) + 1e-6f);
    const float* shift = (const float*)(p.ws + OFF_MOD) + (layer * 3 + g) * 3072;
    const float* scale = shift + 1024;
#pragma unroll
    for (int i = 0; i < 4; ++i) {
      int col = i * 256 + lane * 4;
      float4 nwv = *(const float4*)(nw + col);
      float4 sc = *(const float4*)(scale + col);
      float4 sh = *(const float4*)(shift + col);
      float o0 = v[rr][i].x * rstd * nwv.x * (1.f + sc.x) + sh.x;
      float o1 = v[rr][i].y * rstd * nwv.y * (1.f + sc.y) + sh.y;
      float o2 = v[rr][i].z * rstd * nwv.z * (1.f + sc.z) + sh.z;
      float o3 = v[rr][i].w * rstd * nwv.w * (1.f + sc.w) + sh.w;
      u32x2 o; o[0] = pk2(o0, o1); o[1] = pk2(o2, o3);
      *(u32x2*)(dst + (size_t)row * 1024 + col) = o;
    }
  }
}
DI void phase_final_norm(const Params& p, int t) {
  const int lane = threadIdx.x & 63, w = threadIdx.x >> 6;
  const int row0 = t * 32 + w * 4;
  float4 v[4][4];
#pragma unroll
  for (int rr = 0; rr < 4; ++rr) {
    const float* src = p.out + (size_t)(row0 + rr) * 1024;
#pragma unroll
    for (int i = 0; i < 4; ++i) v[rr][i] = *(const float4*)(src + i * 256 + lane * 4);
  }
  const float* nw = p.in[30];
#pragma unroll
  for (int rr = 0; rr < 4; ++rr) {
    float* src = p.out + (size_t)(row0 + rr) * 1024;
    float ss = 0.f;
#pragma unroll
    for (int i = 0; i < 4; ++i) ss += v[rr][i].x * v[rr][i].x + v[rr][i].y * v[rr][i].y + v[rr][i].z * v[rr][i].z + v[rr][i].w * v[rr][i].w;
    ss = wave_sum(ss);
    const float rstd = rsqrtf(ss * (1.f / 1024.f) + 1e-6f);
#pragma unroll
    for (int i = 0; i < 4; ++i) {
      int col = i * 256 + lane * 4;
      float4 nwv = *(const float4*)(nw + col);
      float4 o;
      o.x = v[rr][i].x * rstd * nwv.x; o.y = v[rr][i].y * rstd * nwv.y; o.z = v[rr][i].z * rstd * nwv.z; o.w = v[rr][i].w * rstd * nwv.w;
      *(float4*)(src + col) = o;
    }
  }
}

struct GemmArgs {
  const u16* A1; int lda1;
  const u16* A2; int lda2;
  int ksplit;
  const u16* Bt; int K;
};
template <int EPI>
DI void gemm_tile(const Params& p, const GemmArgs& g, int m0, int n0, unsigned char* smem) {
  u16* As = (u16*)smem;
  u16* Bs = As + 256 * 72;
  float* rs = (float*)(Bs + 128 * 72);
  const int tid = threadIdx.x, lane = tid & 63, w = tid >> 6;
  const int wm = (w >> 1) * 64, wn = (w & 1) * 64;
  const int l15 = lane & 15, l4 = lane >> 4;
  f32x4 acc[4][4];
#pragma unroll
  for (int i = 0; i < 4; ++i)
#pragma unroll
    for (int j = 0; j < 4; ++j) acc[i][j] = (f32x4){0.f, 0.f, 0.f, 0.f};
  if (EPI == 1) {
    if (tid < 256) {
      const float* rss = (const float*)(p.ws + OFF_ROWSS) + (size_t)(m0 + tid) * 16;
      float s = 0.f;
#pragma unroll
      for (int q = 0; q < 16; ++q) s += rss[q];
      rs[tid] = rsqrtf(s * (1.f / 1024.f) + 1e-6f);
    }
  }
  u32x4 ra[4], rb[2];
  const int KT = g.K >> 6;
  auto loadg = [&](int kt) {
    const int k0 = kt << 6;
    const u16* Ab; int lda; int kk;
    if (k0 < g.ksplit) { Ab = g.A1; lda = g.lda1; kk = k0; } else { Ab = g.A2; lda = g.lda2; kk = k0 - g.ksplit; }
#pragma unroll
    for (int i = 0; i < 4; ++i) {
      int id = tid + 512 * i; int r = id >> 3, c = (id & 7) * 8;
      ra[i] = *(const u32x4*)(Ab + (size_t)(m0 + r) * lda + kk + c);
    }
#pragma unroll
    for (int i = 0; i < 2; ++i) {
      int id = tid + 512 * i; int r = id >> 3, c = (id & 7) * 8;
      rb[i] = *(const u32x4*)(g.Bt + (size_t)(n0 + r) * g.K + k0 + c);
    }
  };
  loadg(0);
  for (int kt = 0; kt < KT; ++kt) {
#pragma unroll
    for (int i = 0; i < 4; ++i) {
      int id = tid + 512 * i; int r = id >> 3, c = (id & 7) * 8;
      *(u32x4*)(As + r * 72 + c) = ra[i];
    }
#pragma unroll
    for (int i = 0; i < 2; ++i) {
      int id = tid + 512 * i; int r = id >> 3, c = (id & 7) * 8;
      *(u32x4*)(Bs + r * 72 + c) = rb[i];
    }
    __syncthreads();
    if (kt + 1 < KT) loadg(kt + 1);
    if (EPI == 1) {
      if ((kt << 6) == g.ksplit) {
#pragma unroll
        for (int i = 0; i < 4; ++i)
#pragma unroll
          for (int r = 0; r < 4; ++r) {
            float sc = rs[wm + i * 16 + l4 * 4 + r];
#pragma unroll
            for (int j = 0; j < 4; ++j) acc[i][j][r] *= sc;
          }
      }
    }
#pragma unroll
    for (int ks = 0; ks < 2; ++ks) {
      bf16x8 a[4], b[4];
#pragma unroll
      for (int i = 0; i < 4; ++i) a[i] = *(const bf16x8*)(As + (wm + i * 16 + l15) * 72 + ks * 32 + l4 * 8);
#pragma unroll
      for (int j = 0; j < 4; ++j) b[j] = *(const bf16x8*)(Bs + (wn + j * 16 + l15) * 72 + ks * 32 + l4 * 8);
#pragma unroll
      for (int i = 0; i < 4; ++i)
#pragma unroll
        for (int j = 0; j < 4; ++j) acc[i][j] = MFMA16(a[i], b[j], acc[i][j]);
    }
    __syncthreads();
  }
#pragma unroll
  for (int i = 0; i < 4; ++i) {
    const int rbase = m0 + wm + i * 16 + l4 * 4;
#pragma unroll
    for (int j = 0; j < 4; ++j) {
      const int col = n0 + wn + j * 16 + l15;
      if (EPI == 0) {
        if (col < LDC0) {
          u16* C = (u16*)(p.ws + OFF_C0A);
#pragma unroll
          for (int r = 0; r < 4; ++r) C[(size_t)(rbase + r) * LDC0 + col] = f2bf(acc[i][j][r]);
        } else if (col < 6688) {
          u16* UT = (u16*)(p.ws + OFF_UT);
          u32x2 o; o[0] = pk2(acc[i][j][0], acc[i][j][1]); o[1] = pk2(acc[i][j][2], acc[i][j][3]);
          *(u32x2*)(UT + (size_t)(col - LDC0) * UTP + rbase) = o;
        }
      } else if (EPI == 1) {
        float* X1 = (float*)(p.ws + OFF_X1);
        const float* mod = (const float*)(p.ws + OFF_MOD);
#pragma unroll
        for (int r = 0; r < 4; ++r) {
          int row = rbase + r;
          const float* xs = row < NPROMPT ? p.in[0] + (size_t)row * 1024 : p.in[1] + (size_t)(row - NPROMPT) * 1024;
          float gate = mod[(0 * 3 + row_group(row)) * 3072 + 2048 + col];
          X1[(size_t)row * 1024 + col] = xs[col] + gate * acc[i][j][r];
        }
      } else if (EPI == 2) {
        u16* C1 = (u16*)(p.ws + OFF_C1);
#pragma unroll
        for (int r = 0; r < 4; ++r) {
          int row = rbase + r;
          C1[(size_t)row * LDC1 + col] = f2bf(acc[i][j][r]);
          if (row < NPROMPT && col >= 1024 && col < 3072) {
            int cc = col - 1024; int isv = cc >> 10; cc &= 1023;
            int hh = cc >> 6, d = cc & 63; int b = row >> 8, l = row & 255;
            float* o = p.out + (isv ? O_NV : O_NK);
            o[(((size_t)b * 16 + hh) * 256 + l) * 64 + d] = acc[i][j][r];
          }
        }
      } else {
        const float* X1 = (const float*)(p.ws + OFF_X1);
        const float* mod = (const float*)(p.ws + OFF_MOD);
#pragma unroll
        for (int r = 0; r < 4; ++r) {
          int row = rbase + r;
          float gate = mod[(1 * 3 + row_group(row)) * 3072 + 2048 + col];
          p.out[(size_t)row * 1024 + col] = X1[(size_t)row * 1024 + col] + gate * acc[i][j][r];
        }
      }
    }
  }
}


DI int lds_byte(int r, int c) {
  int st = (r >> 4) * 2 + (c >> 5), rr = r & 15, cc = c & 31, ob = rr * 64 + cc * 2;
  return st * 1024 + (ob ^ (((ob >> 9) & 1) << 5));
}
DI void stage_rc(int b, int& R, int& C) {
  int st = b / 1024, sb = b % 1024, swz = sb ^ (((sb >> 9) & 1) << 5);
  R = (st >> 1) * 16 + swz / 64; C = (st & 1) * 32 + (swz % 64) / 2;
}
template <int EPI>
DI void epi_store(const Params& p, int rbase, int col, const f32x4& v) {
  if (EPI == 0) {
    if (col < LDC0) {
      u16* C = (u16*)(p.ws + OFF_C0A);
#pragma unroll
      for (int r = 0; r < 4; ++r) C[(size_t)(rbase + r) * LDC0 + col] = f2bf(v[r]);
    } else if (col < 6688) {
      u16* UT = (u16*)(p.ws + OFF_UT);
      u32x2 o; o[0] = pk2(v[0], v[1]); o[1] = pk2(v[2], v[3]);
      *(u32x2*)(UT + (size_t)(col - LDC0) * UTP + rbase) = o;
    }
  } else if (EPI == 1) {
    float* X1 = (float*)(p.ws + OFF_X1);
    const float* mod = (const float*)(p.ws + OFF_MOD);
#pragma unroll
    for (int r = 0; r < 4; ++r) {
      int row = rbase + r;
      const float* xs = row < NPROMPT ? p.in[0] + (size_t)row * 1024 : p.in[1] + (size_t)(row - NPROMPT) * 1024;
      float gate = mod[(0 * 3 + row_group(row)) * 3072 + 2048 + col];
      X1[(size_t)row * 1024 + col] = xs[col] + gate * v[r];
    }
  } else if (EPI == 2) {
    u16* C1 = (u16*)(p.ws + OFF_C1);
#pragma unroll
    for (int r = 0; r < 4; ++r) {
      int row = rbase + r;
      C1[(size_t)row * LDC1 + col] = f2bf(v[r]);
      if (row < NPROMPT && col >= 1024 && col < 3072) {
        int cc = col - 1024; int isv = cc >> 10; cc &= 1023;
        int hh = cc >> 6, d = cc & 63; int b = row >> 8, l = row & 255;
        float* o = p.out + (isv ? O_NV : O_NK);
        o[(((size_t)b * 16 + hh) * 256 + l) * 64 + d] = v[r];
      }
    }
  } else {
    const float* X1 = (const float*)(p.ws + OFF_X1);
    const float* mod = (const float*)(p.ws + OFF_MOD);
#pragma unroll
    for (int r = 0; r < 4; ++r) {
      int row = rbase + r;
      float gate = mod[(1 * 3 + row_group(row)) * 3072 + 2048 + col];
      p.out[(size_t)row * 1024 + col] = X1[(size_t)row * 1024 + col] + gate * v[r];
    }
  }
}

template <int EPI>
DI void epi_store_sw(const Params& p, int row, int col, const f32x4& v) {
  if (EPI == 0) {
    u16* C = (u16*)(p.ws + OFF_C0A);
    u32x2 o; o[0] = pk2(v[0], v[1]); o[1] = pk2(v[2], v[3]);
    *(u32x2*)(C + (size_t)row * LDC0 + col) = o;
  } else if (EPI == 1) {
    float* X1 = (float*)(p.ws + OFF_X1);
    const float* mod = (const float*)(p.ws + OFF_MOD);
    const float* xs = row < NPROMPT ? p.in[0] + (size_t)row * 1024 : p.in[1] + (size_t)(row - NPROMPT) * 1024;
    const float4 xv = *(const float4*)(xs + col);
    const float4 gt = *(const float4*)(mod + (0 * 3 + row_group(row)) * 3072 + 2048 + col);
    float4 o; o.x = xv.x + gt.x * v[0]; o.y = xv.y + gt.y * v[1]; o.z = xv.z + gt.z * v[2]; o.w = xv.w + gt.w * v[3];
    *(float4*)(X1 + (size_t)row * 1024 + col) = o;
  } else if (EPI == 2) {
    u16* C1 = (u16*)(p.ws + OFF_C1);
    u32x2 o; o[0] = pk2(v[0], v[1]); o[1] = pk2(v[2], v[3]);
    *(u32x2*)(C1 + (size_t)row * LDC1 + col) = o;
    if (row < NPROMPT && col >= 1024 && col < 3072) {
      int cc = col - 1024; int isv = cc >> 10; cc &= 1023;
      int hh = cc >> 6, d = cc & 63; int b = row >> 8, l = row & 255;
      float* op = p.out + (isv ? O_NV : O_NK);
      *(float4*)(op + (((size_t)b * 16 + hh) * 256 + l) * 64 + d) = make_float4(v[0], v[1], v[2], v[3]);
    }
  } else {
    const float* X1 = (const float*)(p.ws + OFF_X1);
    const float* mod = (const float*)(p.ws + OFF_MOD);
    const float4 xv = *(const float4*)(X1 + (size_t)row * 1024 + col);
    const float4 gt = *(const float4*)(mod + (1 * 3 + row_group(row)) * 3072 + 2048 + col);
    float4 o; o.x = xv.x + gt.x * v[0]; o.y = xv.y + gt.y * v[1]; o.z = xv.z + gt.z * v[2]; o.w = xv.w + gt.w * v[3];
    *(float4*)(p.out + (size_t)row * 1024 + col) = o;
  }
}

template <int EPI, bool SWAP>
DI void gemm256(const Params& p, const GemmArgs& g, int brow, int bcol, unsigned char* smem) {
  constexpr int HT = 128 * 64;
  u16* shm = (u16*)smem;
  float* rs = (float*)(smem + 131072);
  const int K = g.K;
#define SA(b, h) (shm + ((b) * 2 + (h)) * HT)
#define SB(b, h) (shm + (4 + (b) * 2 + (h)) * HT)
#define STAGE_A(P, br, kt) do { const u16* _ub = g.A1 + (long)(br) * g.lda1 + (long)(kt) * 64; \
    for (int _i = 0; _i < 2; ++_i) { \
      __builtin_amdgcn_global_load_lds((const unsigned*)((const char*)(_ub + (long)_i * 64 * g.lda1) + aoff1), \
        (__attribute__((address_space(3))) unsigned*)((char*)(P) + threadIdx.x * 16 + _i * 8192), 16, 0, 0); } } while (0)
#define STAGE_B(P, bc, kt) do { const u16* _ub = g.Bt + (long)(bc) * K + (long)(kt) * 64; \
    for (int _i = 0; _i < 2; ++_i) { \
      __builtin_amdgcn_global_load_lds((const unsigned*)((const char*)(_ub + (long)_i * 64 * K) + boff), \
        (__attribute__((address_space(3))) unsigned*)((char*)(P) + threadIdx.x * 16 + _i * 8192), 16, 0, 0); } } while (0)
#define LDA(dst, b, h) for (int m = 0; m < 4; ++m) for (int k = 0; k < 2; ++k) \
    dst[m][k] = *reinterpret_cast<const bf16x8*>((char*)SA(b, h) + lds_byte(wr * 64 + m * 16 + fr, k * 32 + fq * 8))
#define LDB(dst, b, h) for (int n = 0; n < 2; ++n) for (int k = 0; k < 2; ++k) \
    dst[n][k] = *reinterpret_cast<const bf16x8*>((char*)SB(b, h) + lds_byte(wc * 32 + n * 16 + fr, k * 32 + fq * 8))
#define MMA(ai, bj, At_, Bt_) do { __builtin_amdgcn_s_setprio(1); \
    for (int m = 0; m < 4; ++m) for (int n = 0; n < 2; ++n) for (int k = 0; k < 2; ++k) \
      acc[ai][bj][m][n] = SWAP ? __builtin_amdgcn_mfma_f32_16x16x32_bf16(Bt_[n][k], At_[m][k], acc[ai][bj][m][n], 0, 0, 0) \
                               : __builtin_amdgcn_mfma_f32_16x16x32_bf16(At_[m][k], Bt_[n][k], acc[ai][bj][m][n], 0, 0, 0); \
    __builtin_amdgcn_s_setprio(0); } while (0)
#define WAIT_V(n) asm volatile("s_waitcnt vmcnt(" #n ")" ::: "memory")
#define WAIT_L(n) asm volatile("s_waitcnt lgkmcnt(" #n ")" ::: "memory")
#define BAR __builtin_amdgcn_s_barrier()
#define SCHED __builtin_amdgcn_sched_barrier(0)
  const int wid = threadIdx.x >> 6, lane = threadIdx.x & 63, wr = wid >> 2, wc = wid & 3, fr = lane & 15, fq = lane >> 4;
  unsigned aoff1, boff;
  {
    int r_, c_; stage_rc(threadIdx.x * 16, r_, c_);
    aoff1 = (unsigned)(r_ * g.lda1 + c_) * 2u;
    boff = (unsigned)(r_ * K + c_) * 2u;
  }
  if (EPI == 1) {
    if (threadIdx.x < 256) {
      const float* rss = (const float*)(p.ws + OFF_ROWSS) + (size_t)(brow + threadIdx.x) * 16;
      float s = 0.f;
#pragma unroll
      for (int q = 0; q < 16; ++q) s += rss[q];
      rs[threadIdx.x] = rsqrtf(s * (1.f / 1024.f) + 1e-6f);
    }
  }
  WAIT_V(0);
  __syncthreads();
  f32x4 acc[2][2][4][2];
#pragma unroll
  for (int a = 0; a < 2; ++a)
#pragma unroll
    for (int b = 0; b < 2; ++b)
#pragma unroll
      for (int m = 0; m < 4; ++m)
#pragma unroll
        for (int n = 0; n < 2; ++n) acc[a][b][m][n] = (f32x4){0.f, 0.f, 0.f, 0.f};
  bf16x8 At[4][2], B0[2][2], B1[2][2];
  const int nt = K / 64;
  const int tscale = (EPI == 1) ? (g.ksplit >> 6) : -1;
  STAGE_B(SB(0, 0), bcol, 0); STAGE_A(SA(0, 0), brow, 0);
  STAGE_B(SB(0, 1), bcol + 128, 0); STAGE_A(SA(0, 1), brow + 128, 0);
  if (wr == 1) BAR;
  WAIT_V(4); BAR;
  STAGE_B(SB(1, 0), bcol, 1); STAGE_A(SA(1, 0), brow, 1); STAGE_B(SB(1, 1), bcol + 128, 1);
  WAIT_V(6); BAR;
  for (int t = 0; t < nt - 2; t += 2) {
    if (EPI == 1) {
      if (t == tscale) {
#pragma unroll
        for (int a = 0; a < 2; ++a)
#pragma unroll
          for (int m = 0; m < 4; ++m)
#pragma unroll
            for (int j = 0; j < 4; ++j) {
              float sc = SWAP ? rs[a * 128 + wr * 64 + m * 16 + fr] : rs[a * 128 + wr * 64 + m * 16 + fq * 4 + j];
#pragma unroll
              for (int b = 0; b < 2; ++b)
#pragma unroll
                for (int n = 0; n < 2; ++n) acc[a][b][m][n][j] *= sc;
            }
      }
    }
    LDB(B0, 0, 0); SCHED; LDA(At, 0, 0); STAGE_A(SA(1, 1), brow + 128, t + 1);
    WAIT_L(8); BAR; WAIT_L(0); MMA(0, 0, At, B0); BAR; SCHED;
    LDB(B1, 0, 1); STAGE_B(SB(0, 0), bcol, t + 2);
    BAR; WAIT_L(0); MMA(0, 1, At, B1); BAR;
    LDA(At, 0, 1); STAGE_A(SA(0, 0), brow, t + 2);
    BAR; WAIT_L(0); MMA(1, 0, At, B0); BAR; SCHED;
    STAGE_B(SB(0, 1), bcol + 128, t + 2);
    WAIT_V(6); BAR; MMA(1, 1, At, B1); BAR;
    LDB(B0, 1, 0); SCHED; LDA(At, 1, 0); STAGE_A(SA(0, 1), brow + 128, t + 2);
    WAIT_L(8); BAR; WAIT_L(0); MMA(0, 0, At, B0); BAR; SCHED;
    LDB(B1, 1, 1); STAGE_B(SB(1, 0), bcol, t + 3);
    BAR; WAIT_L(0); MMA(0, 1, At, B1); BAR;
    LDA(At, 1, 1); STAGE_A(SA(1, 0), brow, t + 3);
    BAR; WAIT_L(0); MMA(1, 0, At, B0); BAR; SCHED;
    STAGE_B(SB(1, 1), bcol + 128, t + 3);
    WAIT_V(6); BAR; MMA(1, 1, At, B1); BAR;
  }
  { LDB(B0, 0, 0); LDA(At, 0, 0); STAGE_A(SA(1, 1), brow + 128, nt - 1);
    BAR; WAIT_L(0); MMA(0, 0, At, B0); BAR;
    LDB(B1, 0, 1); BAR; WAIT_L(0); MMA(0, 1, At, B1); BAR;
    LDA(At, 0, 1); WAIT_V(4); BAR; WAIT_L(0); MMA(1, 0, At, B0); MMA(1, 1, At, B1); BAR; }
  { LDB(B0, 1, 0); LDA(At, 1, 0); WAIT_V(2); BAR; WAIT_L(0); MMA(0, 0, At, B0); BAR;
    LDB(B1, 1, 1); WAIT_V(0); BAR; WAIT_L(0); MMA(0, 1, At, B1); BAR;
    LDA(At, 1, 1); BAR; WAIT_L(0); MMA(1, 0, At, B0); MMA(1, 1, At, B1); BAR; }
  if (wr == 0) BAR;
  int e_tid = threadIdx.x, e_brow = brow, e_bcol = bcol;
  asm volatile("" : "+v"(e_tid), "+s"(e_brow), "+s"(e_bcol));
  const int e_row = SWAP ? e_brow + ((e_tid >> 8) & 1) * 64 + (e_tid & 15) : e_brow + ((e_tid >> 8) & 1) * 64 + ((e_tid >> 4) & 3) * 4;
  const int e_col = SWAP ? e_bcol + ((e_tid >> 6) & 3) * 32 + ((e_tid >> 4) & 3) * 4 : e_bcol + ((e_tid >> 6) & 3) * 32 + (e_tid & 15);
#pragma unroll
  for (int ai = 0; ai < 2; ++ai)
#pragma unroll
    for (int bj = 0; bj < 2; ++bj)
#pragma unroll
      for (int m = 0; m < 4; ++m)
#pragma unroll
        for (int n = 0; n < 2; ++n) {
          if (SWAP) epi_store_sw<EPI>(p, e_row + ai * 128 + m * 16, e_col + bj * 128 + n * 16, acc[ai][bj][m][n]);
          else epi_store<EPI>(p, e_row + ai * 128 + m * 16, e_col + bj * 128 + n * 16, acc[ai][bj][m][n]);
        }
  __syncthreads();
#undef SA
#undef SB
#undef STAGE_A
#undef STAGE_B
#undef LDA
#undef LDB
#undef MMA
#undef WAIT_V
#undef WAIT_L
#undef BAR
#undef SCHED
}
DI bool gemm_tile_coord(int round, int NN, int ntiles, int& pm, int& pn) {
  const int b = blockIdx.x;
  const int v = round * 256 + (b & 7) * 32 + (b >> 3);
  if (v >= ntiles) return false;
  pm = (v / (8 * NN)) * 8 + (v & 7);
  pn = (v >> 3) % NN;
  return true;
}
struct SsdItem { int row0; int h; int has_prev; int has_next; };
DI SsdItem ssd_item(int item) {
  SsdItem s;
  int cgi = item >> 4; s.h = item & 15;
  if (cgi < 64) { int seq = cgi >> 1, c = cgi & 1; s.row0 = seq * 256 + c * 128; s.has_prev = c > 0; s.has_next = c < 1; }
  else { int q = cgi - 64; int seq = q >> 5, c = q & 31; s.row0 = NPROMPT + seq * 4096 + c * 128; s.has_prev = c > 0; s.has_next = c < 31; }
  return s;
}
DI float ssd_load_dt(const Params& p, int row0, int h) {
  const int tid = threadIdx.x;
  const u16* C0 = (const u16*)(p.ws + OFF_C0A);
  float raw = 0.f;
  if (tid < 256) { int d = tid >> 7, l = tid & 127; raw = bf2f(C0[(size_t)(row0 + l) * LDC0 + 2560 + d * 16 + h]); }
  return raw;
}
DI void ssd_prep_dt(const Params& p, float raw, int h, float* sdt, float* scs, float* stot) {
  const int tid = threadIdx.x, lane = tid & 63, w = tid >> 6;
  if (tid < 256) {
    int d = tid >> 7, l = tid & 127;
    float x = raw + p.in[14][d * 16 + h];
    float dt = x > 20.f ? x : log1pf(expf(x));
    float a = -expf(p.in[15][d * 16 + h]);
    sdt[d * 128 + l] = dt;
    scs[d * 128 + l] = a * dt;
  }
  __syncthreads();
  if (w < 2) {
    const int d = w;
    int p0 = d == 0 ? 2 * lane : 127 - 2 * lane;
    int p1 = d == 0 ? 2 * lane + 1 : 126 - 2 * lane;
    float v0 = scs[d * 128 + p0], v1 = scs[d * 128 + p1];
    float s = v0 + v1;
#pragma unroll
    for (int off = 1; off < 64; off <<= 1) {
      float tv = __shfl_up(s, off);
      if (lane >= off) s += tv;
    }
    float excl = s - (v0 + v1);
    scs[d * 128 + p0] = excl + v0;
    scs[d * 128 + p1] = excl + v0 + v1;
    if (lane == 63) stot[d] = s;
  }
  __syncthreads();
}
DI void conv_silu8(const Params& p, int row, int ch0, bool hp, bool hn, float* out) {
  const u16* C0 = (const u16*)(p.ws + OFF_C0A);
  const u16* q = C0 + (size_t)row * LDC0 + 1024 + ch0;
  const float* cw = p.in[12]; const float* cb = p.in[13];
  float xm[8], xc[8], xp[8];
  u32x4 vc = *(const u32x4*)q;
  unpack8(vc, xc);
  if (hp) { u32x4 v = *(const u32x4*)(q - LDC0); unpack8(v, xm); } else {
#pragma unroll
    for (int e = 0; e < 8; ++e) xm[e] = 0.f;
  }
  if (hn) { u32x4 v = *(const u32x4*)(q + LDC0); unpack8(v, xp); } else {
#pragma unroll
    for (int e = 0; e < 8; ++e) xp[e] = 0.f;
  }
  float4 w0a = *(const float4*)(cw + ch0), w0b = *(const float4*)(cw + ch0 + 4);
  float4 w1a = *(const float4*)(cw + 1536 + ch0), w1b = *(const float4*)(cw + 1536 + ch0 + 4);
  float4 w2a = *(const float4*)(cw + 3072 + ch0), w2b = *(const float4*)(cw + 3072 + ch0 + 4);
  float4 ba = *(const float4*)(cb + ch0), bb = *(const float4*)(cb + ch0 + 4);
  float w0[8] = {w0a.x, w0a.y, w0a.z, w0a.w, w0b.x, w0b.y, w0b.z, w0b.w};
  float w1[8] = {w1a.x, w1a.y, w1a.z, w1a.w, w1b.x, w1b.y, w1b.z, w1b.w};
  float w2[8] = {w2a.x, w2a.y, w2a.z, w2a.w, w2b.x, w2b.y, w2b.z, w2b.w};
  float bv[8] = {ba.x, ba.y, ba.z, ba.w, bb.x, bb.y, bb.z, bb.w};
#pragma unroll
  for (int e = 0; e < 8; ++e) out[e] = silu(bv[e] + w0[e] * xm[e] + w1[e] * xc[e] + w2[e] * xp[e]);
}


template <int R>
DI void conv_load(const Params& p, int row0, int l0, int ch0, bool prev_chunk, bool next_chunk, u32x4 (&raw)[R + 2]) {
  const u16* C0 = (const u16*)(p.ws + OFF_C0A);
  const u16* q = C0 + (size_t)(row0 + l0) * LDC0 + 1024 + ch0;
  const bool hp = (l0 > 0) || prev_chunk;
  const bool hn = (l0 + R < 128) || next_chunk;
#pragma unroll
  for (int i = 0; i < R + 2; ++i) {
    const bool ok = (i == 0) ? hp : ((i == R + 1) ? hn : true);
    raw[i] = (u32x4){0u, 0u, 0u, 0u};
    if (ok) raw[i] = *(const u32x4*)(q + (long)(i - 1) * LDC0);
  }
}
template <int R>
DI void conv_compute(const Params& p, int ch0, const u32x4 (&raw)[R + 2], float (&out)[R][8]) {
  const float* cw = p.in[12]; const float* cb = p.in[13];
  float4 w0a = *(const float4*)(cw + ch0), w0b = *(const float4*)(cw + ch0 + 4);
  float4 w1a = *(const float4*)(cw + 1536 + ch0), w1b = *(const float4*)(cw + 1536 + ch0 + 4);
  float4 w2a = *(const float4*)(cw + 3072 + ch0), w2b = *(const float4*)(cw + 3072 + ch0 + 4);
  float4 ba = *(const float4*)(cb + ch0), bb = *(const float4*)(cb + ch0 + 4);
  const float w0[8] = {w0a.x, w0a.y, w0a.z, w0a.w, w0b.x, w0b.y, w0b.z, w0b.w};
  const float w1[8] = {w1a.x, w1a.y, w1a.z, w1a.w, w1b.x, w1b.y, w1b.z, w1b.w};
  const float w2[8] = {w2a.x, w2a.y, w2a.z, w2a.w, w2b.x, w2b.y, w2b.z, w2b.w};
  const float bv[8] = {ba.x, ba.y, ba.z, ba.w, bb.x, bb.y, bb.z, bb.w};
  float xm[8], xc[8], xp[8];
  unpack8(raw[0], xm); unpack8(raw[1], xc);
#pragma unroll
  for (int i = 0; i < R; ++i) {
    unpack8(raw[i + 2], xp);
#pragma unroll
    for (int e = 0; e < 8; ++e) {
      out[i][e] = silu(bv[e] + w0[e] * xm[e] + w1[e] * xc[e] + w2[e] * xp[e]);
      xm[e] = xc[e]; xc[e] = xp[e];
    }
  }
}
DI void phase_ssd_states(const Params& p, int item, unsigned char* smem) {
  u16* xT = (u16*)smem;
  u16* BTs = xT + 64 * 136;
  float* sdt = (float*)(BTs + 2 * 128 * 136);
  float* scs = sdt + 256;
  float* sw = scs + 256;
  float* stot = sw + 256;
  const int tid = threadIdx.x, lane = tid & 63, w = tid >> 6;
  const int l15 = lane & 15, l4 = lane >> 4;
  const SsdItem it = ssd_item(item);
  const int h = it.h, grp = h >> 3;
  const int xchunk = tid & 7, xrg = tid >> 3;
  const int bchunk = tid & 15, brg = tid >> 4;
  u32x4 rawx[4], rawb[6];
  const float rawdt = ssd_load_dt(p, it.row0, h);
  conv_load<2>(p, it.row0, xrg * 2, h * 64 + xchunk * 8, it.has_prev, it.has_next, rawx);
  conv_load<4>(p, it.row0, brg * 4, 1024 + grp * 128 + bchunk * 8, it.has_prev, it.has_next, rawb);
  ssd_prep_dt(p, rawdt, h, sdt, scs, stot);
  if (tid < 256) {
    int d = tid >> 7;
    sw[tid] = sdt[tid] * __expf(stot[d] - scs[tid]);
  }
  __syncthreads();
  {
    {
      float o[2][8];
      conv_compute<2>(p, h * 64 + xchunk * 8, rawx, o);
#pragma unroll
      for (int e = 0; e < 8; ++e) *(unsigned*)(xT + (xchunk * 8 + e) * 136 + xrg * 2) = pk2(o[0][e], o[1][e]);
    }
    {
      float o[4][8];
      conv_compute<4>(p, 1024 + grp * 128 + bchunk * 8, rawb, o);
#pragma unroll
      for (int dd = 0; dd < 2; ++dd) {
        const float s0 = sw[dd * 128 + brg * 4], s1 = sw[dd * 128 + brg * 4 + 1], s2 = sw[dd * 128 + brg * 4 + 2], s3 = sw[dd * 128 + brg * 4 + 3];
#pragma unroll
        for (int e = 0; e < 8; ++e) {
          u32x2 v; v[0] = pk2(o[0][e] * s0, o[1][e] * s1); v[1] = pk2(o[2][e] * s2, o[3][e] * s3);
          *(u32x2*)(BTs + dd * 128 * 136 + (bchunk * 8 + e) * 136 + brg * 4) = v;
        }
      }
    }
  }
  __syncthreads();
  const int d = w >> 2, nq = w & 3;
  f32x4 acc[4][2];
#pragma unroll
  for (int i = 0; i < 4; ++i) { acc[i][0] = (f32x4){0.f, 0.f, 0.f, 0.f}; acc[i][1] = (f32x4){0.f, 0.f, 0.f, 0.f}; }
#pragma unroll
  for (int ks = 0; ks < 4; ++ks) {
    bf16x8 a[4], b[2];
#pragma unroll
    for (int i = 0; i < 4; ++i) a[i] = *(const bf16x8*)(xT + (i * 16 + l15) * 136 + ks * 32 + l4 * 8);
#pragma unroll
    for (int j = 0; j < 2; ++j) b[j] = *(const bf16x8*)(BTs + d * 128 * 136 + (nq * 32 + j * 16 + l15) * 136 + ks * 32 + l4 * 8);
#pragma unroll
    for (int i = 0; i < 4; ++i)
#pragma unroll
      for (int j = 0; j < 2; ++j) acc[i][j] = MFMA16(a[i], b[j], acc[i][j]);
  }
  u16* S = (u16*)((unsigned char*)p.out + OUT_SBUF) + ((size_t)item * 2 + d) * 8192;
#pragma unroll
  for (int i = 0; i < 4; ++i)
#pragma unroll
    for (int j = 0; j < 2; ++j)
#pragma unroll
      for (int r = 0; r < 4; ++r) {
        int pp = i * 16 + l4 * 4 + r, n = nq * 32 + j * 16 + l15;
        S[pp * 128 + n] = f2bf(acc[i][j][r]);
      }
  if (tid < 2) {
    float* cdec = (float*)(p.ws + OFF_CDEC);
    cdec[item * 2 + tid] = __expf(stot[tid]);
  }
  __syncthreads();
}

DI void phase_scan(const Params& p, int t) {
  const int part = t & 1, d = (t >> 1) & 1, h = (t >> 2) & 15, seq = t >> 6;
  const int tid = threadIdx.x;
  const int e0 = part * 4096 + tid * 8;
  const int nc = seq < 32 ? 2 : 32;
  const int cg0 = seq < 32 ? seq * 2 : 64 + (seq - 32) * 32;
  float st[8];
  if (seq < 32) {
#pragma unroll
    for (int e = 0; e < 8; ++e) st[e] = 0.f;
  } else {
    const float* init = p.in[2] + ((((size_t)(seq - 32) * 1 + 0) * 2 + d) * 16 + h) * 8192 + e0;
    float4 a = *(const float4*)init, b = *(const float4*)(init + 4);
    st[0] = a.x; st[1] = a.y; st[2] = a.z; st[3] = a.w; st[4] = b.x; st[5] = b.y; st[6] = b.z; st[7] = b.w;
  }
  u16* Sb = (u16*)((unsigned char*)p.out + OUT_SBUF);
  const float* cdec = (const float*)(p.ws + OFF_CDEC);
  for (int cb0 = 0; cb0 < nc; cb0 += 8) {
    u32x4 vv[8]; float dec[8];
#pragma unroll
    for (int i = 0; i < 8; ++i) {
      if (cb0 + i < nc) {
        const int ci = cb0 + i;
        const int c = d == 0 ? ci : nc - 1 - ci;
        const int item = (cg0 + c) * 16 + h;
        vv[i] = *(const u32x4*)(Sb + ((size_t)item * 2 + d) * 8192 + e0);
        dec[i] = cdec[item * 2 + d];
      }
    }
#pragma unroll
    for (int i = 0; i < 8; ++i) {
      if (cb0 + i < nc) {
        const int ci = cb0 + i;
        const int c = d == 0 ? ci : nc - 1 - ci;
        const int item = (cg0 + c) * 16 + h;
        float sc[8]; unpack8(vv[i], sc);
        *(u32x4*)(Sb + ((size_t)item * 2 + d) * 8192 + e0) = pack8(st);
#pragma unroll
        for (int e = 0; e < 8; ++e) st[e] = st[e] * dec[i] + sc[e];
      }
    }
  }
  if (seq < 32) {
    float* o = p.out + O_ST + ((((size_t)seq * 1 + 0) * 2 + d) * 16 + h) * 8192 + e0;
    *(float4*)o = make_float4(st[0], st[1], st[2], st[3]);
    *(float4*)(o + 4) = make_float4(st[4], st[5], st[6], st[7]);
  }
}

DI void phase_ssd_out(const Params& p, int item, unsigned char* smem, bool dry) {
  u16* Cs = (u16*)smem;
  u16* Bs = Cs + 128 * 136;
  u16* xT = Bs + 128 * 136;
  u16* St = xT + 64 * 136;
  float* sdt = (float*)(St + 2 * 64 * 136);
  float* scs = sdt + 256;
  float* stot = scs + 256;
  const int tid = threadIdx.x, lane = tid & 63, w = tid >> 6;
  const int l15 = lane & 15, l4 = lane >> 4;
  const SsdItem it = ssd_item(item);
  const int h = it.h, grp = h >> 3;
  const int xchunk = tid & 7, xrg = tid >> 3;
  const int bchunk = tid & 15, brg = tid >> 4;
  u32x4 rawx[4], rawb[6], rawc[6], rawst[4];
  u16 zraw[4][4];
  const float rawdt = ssd_load_dt(p, it.row0, h);
  conv_load<2>(p, it.row0, xrg * 2, h * 64 + xchunk * 8, it.has_prev, it.has_next, rawx);
  conv_load<4>(p, it.row0, brg * 4, 1024 + grp * 128 + bchunk * 8, it.has_prev, it.has_next, rawb);
  conv_load<4>(p, it.row0, brg * 4, 1280 + grp * 128 + bchunk * 8, it.has_prev, it.has_next, rawc);
  {
    const u16* S = (const u16*)((const unsigned char*)p.out + OUT_SBUF) + (size_t)item * 2 * 8192;
#pragma unroll
    for (int v = 0; v < 4; ++v) {
      int id = tid + 512 * v;
      int dd = id >> 10, pp = (id >> 4) & 63, nv = (id & 15) * 8;
      rawst[v] = *(const u32x4*)(S + dd * 8192 + pp * 128 + nv);
    }
  }
  ssd_prep_dt(p, rawdt, h, sdt, scs, stot);
  {
    {
      float o[2][8];
      conv_compute<2>(p, h * 64 + xchunk * 8, rawx, o);
#pragma unroll
      for (int e = 0; e < 8; ++e) *(unsigned*)(xT + (xchunk * 8 + e) * 136 + xrg * 2) = pk2(o[0][e], o[1][e]);
    }
    {
      float o[4][8];
      conv_compute<4>(p, 1024 + grp * 128 + bchunk * 8, rawb, o);
#pragma unroll
      for (int i = 0; i < 4; ++i) *(u32x4*)(Bs + (brg * 4 + i) * 136 + bchunk * 8) = pack8(o[i]);
      conv_compute<4>(p, 1280 + grp * 128 + bchunk * 8, rawc, o);
#pragma unroll
      for (int i = 0; i < 4; ++i) *(u32x4*)(Cs + (brg * 4 + i) * 136 + bchunk * 8) = pack8(o[i]);
    }
#pragma unroll
    for (int v = 0; v < 4; ++v) {
      int id = tid + 512 * v;
      int dd = id >> 10, pp = (id >> 4) & 63, nv = (id & 15) * 8;
      *(u32x4*)(St + dd * 64 * 136 + pp * 136 + nv) = rawst[v];
    }
  }
  __syncthreads();
  {
    const u16* C0z = (const u16*)(p.ws + OFF_C0A);
#pragma unroll
    for (int i = 0; i < 4; ++i)
#pragma unroll
      for (int r = 0; r < 4; ++r)
        zraw[i][r] = C0z[(size_t)(it.row0 + 16 * w + l4 * 4 + r) * LDC0 + h * 64 + i * 16 + l15];
  }
  f32x4 cb[8], af[4], ab[4];
#pragma unroll
  for (int j = 0; j < 8; ++j) cb[j] = (f32x4){0.f, 0.f, 0.f, 0.f};
#pragma unroll
  for (int i = 0; i < 4; ++i) { af[i] = (f32x4){0.f, 0.f, 0.f, 0.f}; ab[i] = (f32x4){0.f, 0.f, 0.f, 0.f}; }
#pragma unroll
  for (int ks = 0; ks < 4; ++ks) {
    bf16x8 a = *(const bf16x8*)(Cs + (16 * w + l15) * 136 + ks * 32 + l4 * 8);
#pragma unroll
    for (int j = 0; j < 8; ++j) {
      bf16x8 b = *(const bf16x8*)(Bs + (j * 16 + l15) * 136 + ks * 32 + l4 * 8);
      cb[j] = MFMA16(b, a, cb[j]);
    }
#pragma unroll
    for (int i = 0; i < 4; ++i) {
      bf16x8 b0 = *(const bf16x8*)(St + (i * 16 + l15) * 136 + ks * 32 + l4 * 8);
      bf16x8 b1 = *(const bf16x8*)(St + 64 * 136 + (i * 16 + l15) * 136 + ks * 32 + l4 * 8);
      af[i] = MFMA16(a, b0, af[i]);
      ab[i] = MFMA16(a, b1, ab[i]);
    }
  }
  __syncthreads();
  f32x4 Y[4];
  {
    const int lrow = 16 * w + l15;
    const float cs0l = scs[lrow], cs1l = scs[128 + lrow];
#pragma unroll
    for (int j = 0; j < 8; ++j) {
      const int s0 = j * 16 + l4 * 4;
      float f[4];
      if (j < w) {
        const float4 c4 = *(const float4*)(scs + s0), d4 = *(const float4*)(sdt + s0);
        f[0] = __expf(cs0l - c4.x) * d4.x; f[1] = __expf(cs0l - c4.y) * d4.y; f[2] = __expf(cs0l - c4.z) * d4.z; f[3] = __expf(cs0l - c4.w) * d4.w;
      } else if (j > w) {
        const float4 c4 = *(const float4*)(scs + 128 + s0), d4 = *(const float4*)(sdt + 128 + s0);
        f[0] = __expf(cs1l - c4.x) * d4.x; f[1] = __expf(cs1l - c4.y) * d4.y; f[2] = __expf(cs1l - c4.z) * d4.z; f[3] = __expf(cs1l - c4.w) * d4.w;
      } else {
        const float4 c4 = *(const float4*)(scs + s0), d4 = *(const float4*)(sdt + s0);
        const float4 e4 = *(const float4*)(scs + 128 + s0), g4 = *(const float4*)(sdt + 128 + s0);
        const float c0[4] = {c4.x, c4.y, c4.z, c4.w}, d0[4] = {d4.x, d4.y, d4.z, d4.w};
        const float c1[4] = {e4.x, e4.y, e4.z, e4.w}, d1[4] = {g4.x, g4.y, g4.z, g4.w};
#pragma unroll
        for (int jj = 0; jj < 4; ++jj) {
          const int sidx = s0 + jj;
          float v;
          if (lrow > sidx) v = __expf(cs0l - c0[jj]) * d0[jj];
          else if (lrow < sidx) v = __expf(cs1l - c1[jj]) * d1[jj];
          else v = d0[jj] + d1[jj];
          f[jj] = v;
        }
      }
      u32x2 o; o[0] = pk2(cb[j][0] * f[0], cb[j][1] * f[1]); o[1] = pk2(cb[j][2] * f[2], cb[j][3] * f[3]);
      *(u32x2*)(Bs + lrow * 136 + s0) = o;
    }
#pragma unroll
    for (int r = 0; r < 4; ++r) {
      const int l = 16 * w + l4 * 4 + r;
      float e0 = __expf(scs[l]), e1 = __expf(scs[128 + l]);
#pragma unroll
      for (int i = 0; i < 4; ++i) Y[i][r] = af[i][r] * e0 + ab[i][r] * e1;
    }
  }
  __syncthreads();
#pragma unroll
  for (int ks = 0; ks < 4; ++ks) {
    bf16x8 a = *(const bf16x8*)(Bs + (16 * w + l15) * 136 + ks * 32 + l4 * 8);
#pragma unroll
    for (int i = 0; i < 4; ++i) {
      bf16x8 b = *(const bf16x8*)(xT + (i * 16 + l15) * 136 + ks * 32 + l4 * 8);
      Y[i] = MFMA16(a, b, Y[i]);
    }
  }
  {
    const u16* C0 = (const u16*)(p.ws + OFF_C0A);
    u16* YAB = dry ? (u16*)(p.ws + OFF_DUMMY) + (size_t)(blockIdx.x & 15) * 400000 - (size_t)it.row0 * 2048 : (u16*)((unsigned char*)p.out + OUT_YB);
    const float dsk = p.in[16][h] + p.in[16][16 + h];
    float ss[4] = {0.f, 0.f, 0.f, 0.f};
#pragma unroll
    for (int i = 0; i < 4; ++i) {
      const int pp = i * 16 + l15;
#pragma unroll
      for (int r = 0; r < 4; ++r) {
        const int l = 16 * w + l4 * 4 + r;
        const size_t off = (size_t)(it.row0 + l) * LDC0 + h * 64 + pp;
        float xv = bf2f(xT[pp * 136 + l]);
        float y = Y[i][r] + xv * dsk;
        float z = bf2f(zraw[i][r]);
        float gv = y * silu(z);
        YAB[(size_t)(it.row0 + l) * 2048 + h * 64 + pp] = f2bf(gv);
        ss[r] += gv * gv;
      }
    }
    float* rss = (float*)(p.ws + OFF_ROWSS);
#pragma unroll
    for (int r = 0; r < 4; ++r) {
      float s = ss[r];
      s += __shfl_xor(s, 1); s += __shfl_xor(s, 2); s += __shfl_xor(s, 4); s += __shfl_xor(s, 8);
      if (l15 == 0) rss[(size_t)(it.row0 + 16 * w + l4 * 4 + r) * 16 + h] = s;
    }
  }
  __syncthreads();
}


template <int MASK, int PART>
DI void hy_seg(int dlo, int dhi, int L, int A, const u16* hr, const u16* vx, const int (&ncol)[4], const int (&acol)[4],
               int l31, int kh, f32x16 (&acc)[4]) {
  int oz = 0;
  asm volatile("" : "+v"(oz));
#pragma unroll 1
  for (int d = dlo; d <= dhi; ++d) {
    bf16x8 af[2];
#pragma unroll
    for (int khalf = 0; khalf < 2; ++khalf) {
      const int idx0 = L - 32 * d - l31 + 16 * khalf + 8 * kh;
#pragma unroll
      for (int e = 0; e < 8; ++e) af[khalf][e] = (short)hr[idx0 + e + oz * (e + 1)];
    }
    bf16x8 bfr[4][2];
#pragma unroll
    for (int j = 0; j < 4; ++j) {
      if (MASK & (1 << j)) {
        const int asrc = acol[j] - d;
        const bool valid = (asrc >= 0) && (asrc < A);
        const int nsrc = valid ? (ncol[j] - d) : ncol[j];
#pragma unroll
        for (int khalf = 0; khalf < 2; ++khalf) {
          bf16x8 t = *(const bf16x8*)(vx + nsrc * 40 + 16 * khalf + 8 * kh);
          if ((PART & (1 << j)) && !valid) t = (bf16x8){0, 0, 0, 0, 0, 0, 0, 0};
          bfr[j][khalf] = t;
        }
      }
    }
#pragma unroll
    for (int khalf = 0; khalf < 2; ++khalf)
#pragma unroll
      for (int j = 0; j < 4; ++j)
        if (MASK & (1 << j)) acc[j] = MFMA32(af[khalf], bfr[j][khalf], acc[j]);
  }
}
DI void phase_hyena(const Params& p, int it, unsigned char* smem, bool dry) {
  const int cfg = it < 256 ? 1 : 0;
  const int c0 = (it & 255) * 4;
  const int L = cfg ? 4096 : 256;
  const int A = L >> 5;
  const int lgA = cfg ? 7 : 3;
  const int rowbase = cfg ? NPROMPT : 0;
  u16* vxs = (u16*)smem;
  u16* hrs = vxs + 4 * 10240;
  const int tid = threadIdx.x, lane = tid & 63, w = tid >> 6;
  const u16* UT = (const u16*)(p.ws + OFF_UT);
  const float* cw = p.in[18]; const float* cbv = p.in[19];
  {
    const u16* HF = (const u16*)((const unsigned char*)p.out + (cfg ? OUT_HF4096 : OUT_HF256));
    const int nv = (2 * L) >> 3;
    const int lgnv = cfg ? 10 : 6;
    {
      u32x4 fv[8];
#pragma unroll
      for (int it8 = 0; it8 < 8; ++it8) {
        const int id = tid + it8 * NT;
        fv[it8] = (u32x4){0u, 0u, 0u, 0u};
        if (id < 4 * nv) { int chh = id >> lgnv, v8 = id & (nv - 1); fv[it8] = *(const u32x4*)(HF + (size_t)(c0 + chh) * 2 * L + v8 * 8); }
      }
#pragma unroll
      for (int it8 = 0; it8 < 8; ++it8) {
        const int id = tid + it8 * NT;
        if (id < 4 * nv) { int chh = id >> lgnv, v8 = id & (nv - 1); *(u32x4*)(hrs + chh * 2 * L + v8 * 8) = fv[it8]; }
      }
    }
#pragma unroll 1
    for (int hb4 = 0; hb4 < 2; ++hb4) {
    u32x4 rv[4][2]; float hm[4][2], hp[4][2];
#pragma unroll
    for (int it8 = 0; it8 < 4; ++it8) {
      const int id = tid + (hb4 * 4 + it8) * NT;
      const int chh = id >> 10, blk8 = id & 1023;
      const int pos = blk8 * 8, tl = pos & (L - 1);
#pragma unroll
      for (int which = 1; which <= 2; ++which) {
        const u16* q = UT + (size_t)(which * 1024 + c0 + chh) * UTP + rowbase + pos;
        rv[it8][which - 1] = *(const u32x4*)q;
        hm[it8][which - 1] = (tl > 0) ? bf2f(q[-1]) : 0.f;
        hp[it8][which - 1] = (tl + 8 < L) ? bf2f(q[8]) : 0.f;
      }
    }
#pragma unroll
    for (int it8 = 0; it8 < 4; ++it8) {
      const int id = tid + (hb4 * 4 + it8) * NT;
      const int chh = id >> 10, blk8 = id & 1023;
      const int pos = blk8 * 8;
      float res[8];
#pragma unroll
      for (int e = 0; e < 8; ++e) res[e] = 1.f;
#pragma unroll
      for (int which = 1; which <= 2; ++which) {
        const int uc = which * 1024 + c0 + chh;
        float xv[10];
        unpack8(rv[it8][which - 1], xv + 1);
        xv[0] = hm[it8][which - 1]; xv[9] = hp[it8][which - 1];
        const float w0 = cw[uc], w1 = cw[3072 + uc], w2 = cw[6144 + uc], bb = cbv[uc];
#pragma unroll
        for (int e = 0; e < 8; ++e) res[e] *= (bb + w0 * xv[e] + w1 * xv[e + 1] + w2 * xv[e + 2]);
      }
      const int n = pos >> 5, k = pos & 31;
      *(u32x4*)(vxs + chh * 10240 + n * 40 + k) = pack8(res);
    }
    }
  }
  __syncthreads();
  const int ch = w >> 1, wv = w & 1;
  const int l31 = lane & 31, kh = lane >> 5;
  const u16* vx = vxs + ch * 10240;
  const u16* hr = hrs + ch * 2 * L;
  f32x16 acc[4];
#pragma unroll
  for (int j = 0; j < 4; ++j)
#pragma unroll
    for (int r = 0; r < 16; ++r) acc[j][r] = 0.f;
  int ncol[4], acol[4];
#pragma unroll
  for (int j = 0; j < 4; ++j) { ncol[j] = 128 * wv + 32 * j + l31; acol[j] = ncol[j] & (A - 1); }
  if (!(dry && REP_SUB == 4)) {
  if (cfg) {
    hy_seg<1, 1>(-127, -96, L, A, hr, vx, ncol, acol, l31, kh, acc);
    hy_seg<3, 2>(-95, -64, L, A, hr, vx, ncol, acol, l31, kh, acc);
    hy_seg<7, 4>(-63, -32, L, A, hr, vx, ncol, acol, l31, kh, acc);
    hy_seg<15, 9>(-31, 31, L, A, hr, vx, ncol, acol, l31, kh, acc);
    hy_seg<14, 2>(32, 63, L, A, hr, vx, ncol, acol, l31, kh, acc);
    hy_seg<12, 4>(64, 95, L, A, hr, vx, ncol, acol, l31, kh, acc);
    hy_seg<8, 8>(96, 127, L, A, hr, vx, ncol, acol, l31, kh, acc);
  } else {
    hy_seg<15, 15>(-7, 7, L, A, hr, vx, ncol, acol, l31, kh, acc);
  }
  }
  {
    const float hb = p.in[26][c0 + ch];
#pragma unroll
    for (int j = 0; j < 4; ++j) {
      const int n = ncol[j];
#pragma unroll
      for (int q = 0; q < 4; ++q) {
        u32x2 vr = *(const u32x2*)(vx + n * 40 + 8 * q + 4 * kh);
        acc[j][4 * q + 0] += bflo(vr[0]) * hb; acc[j][4 * q + 1] += bfhi(vr[0]) * hb;
        acc[j][4 * q + 2] += bflo(vr[1]) * hb; acc[j][4 * q + 3] += bfhi(vr[1]) * hb;
      }
    }
  }
  __syncthreads();
  float* FL = (float*)smem;
  {
#pragma unroll
    for (int j = 0; j < 4; ++j) {
      const int n = ncol[j];
#pragma unroll
      for (int q = 0; q < 4; ++q) {
        const int pos = 32 * n + 8 * q + 4 * kh;
        *(float4*)(FL + ch * 9216 + pos + (pos >> 5) * 4) = make_float4(acc[j][4 * q], acc[j][4 * q + 1], acc[j][4 * q + 2], acc[j][4 * q + 3]);
      }
    }
  }
  __syncthreads();
#pragma unroll 2
  for (int it8 = 0; it8 < 8; ++it8) {
    const int chh = it8 >> 1;
    const int c = c0 + chh;
    const int pos = ((tid + it8 * NT) & 1023) * 8;
    const int tl = pos & (L - 1);
    const u16* x0row = UT + (size_t)c * UTP + rowbase;
    const u16* grow = UT + (size_t)(3072 + c) * UTP + rowbase;
    u16* groww = dry ? (u16*)(p.ws + OFF_DUMMY) + (size_t)blockIdx.x * 32768 + chh * 8192
                     : (u16*)(p.ws + OFF_UT) + (size_t)(3072 + c) * UTP + rowbase;
    const u32x4 xr = *(const u32x4*)(x0row + pos);
    const u32x4 gr = *(const u32x4*)(grow + pos);
    float xv[10], gv[8];
    unpack8(xr, xv + 1); unpack8(gr, gv);
    xv[0] = tl > 0 ? bf2f(x0row[pos - 1]) : 0.f;
    xv[9] = (tl + 8 < L) ? bf2f(x0row[pos + 8]) : 0.f;
    const float w0 = cw[c], w1 = cw[3072 + c], w2 = cw[6144 + c], bb = cbv[c];
    const float* fl = FL + chh * 9216 + pos + (pos >> 5) * 4;
    const float4 a0 = *(const float4*)fl, a1 = *(const float4*)(fl + 4);
    const float av[8] = {a0.x, a0.y, a0.z, a0.w, a1.x, a1.y, a1.z, a1.w};
    float y[8];
#pragma unroll
    for (int e = 0; e < 8; ++e) {
      float x0 = bb + w0 * xv[e] + w1 * xv[e + 1] + w2 * xv[e + 2];
      y[e] = x0 * av[e] * silu(gv[e]);
    }
    *(u32x4*)(groww + pos) = pack8(y);
  }
  (void)lgA;
  __syncthreads();
}

#define VSP 72
typedef __attribute__((ext_vector_type(4))) short v4i16_t;
DI float dpp_rowmax(float v) {
  v = fmaxf(v, __builtin_bit_cast(float, __builtin_amdgcn_update_dpp(0, __builtin_bit_cast(int, v), 0x128, 0xf, 0xf, false)));
  v = fmaxf(v, __builtin_bit_cast(float, __builtin_amdgcn_update_dpp(0, __builtin_bit_cast(int, v), 0x124, 0xf, 0xf, false)));
  v = fmaxf(v, __builtin_bit_cast(float, __builtin_amdgcn_update_dpp(0, __builtin_bit_cast(int, v), 0x122, 0xf, 0xf, false)));
  v = fmaxf(v, __builtin_bit_cast(float, __builtin_amdgcn_update_dpp(0, __builtin_bit_cast(int, v), 0x121, 0xf, 0xf, false)));
  return v;
}
DI float dpp_rowsum(float v) {
  v += __builtin_bit_cast(float, __builtin_amdgcn_update_dpp(0, __builtin_bit_cast(int, v), 0x128, 0xf, 0xf, false));
  v += __builtin_bit_cast(float, __builtin_amdgcn_update_dpp(0, __builtin_bit_cast(int, v), 0x124, 0xf, 0xf, false));
  v += __builtin_bit_cast(float, __builtin_amdgcn_update_dpp(0, __builtin_bit_cast(int, v), 0x122, 0xf, 0xf, false));
  v += __builtin_bit_cast(float, __builtin_amdgcn_update_dpp(0, __builtin_bit_cast(int, v), 0x121, 0xf, 0xf, false));
  return v;
}
#define OUT_CKV 0ul
DI void phase_attn(const Params& p, int item, unsigned char* smem, bool dry) {
  u16* VS = (u16*)smem;
  u16* Pb = VS + 832 * VSP;
  float* rp = (float*)(Pb + 8 * 16 * 72);
  const int tid = threadIdx.x, lane = tid & 63, w = tid >> 6;
  const int l15 = lane & 15, l4 = lane >> 4;
  const u16* C1 = (const u16*)(p.ws + OFF_C1);
  const u16* CK = (const u16*)((const unsigned char*)p.out + OUT_CKV);
  const u16* CV = CK + 524288;
  const bool lat = item < 1024;
  int b, h, myr = 0, rows0w = 0, vrow0 = 0, nvrows = 0, qbase, jq = w & 3;
  if (lat) {
    b = item >> 9; h = (item >> 5) & 15; const int r0 = (item & 31) * 2;
    myr = r0 + (w >> 2);
    rows0w = min(max(myr - 4, 0), 56);
    vrow0 = min(max(r0 - 4, 0), 56);
    nvrows = min(9, 64 - vrow0);
    qbase = NPROMPT + b * 4096 + myr * 64 + jq * 16;
  } else {
    const int q = item - 1024; b = q >> 5; h = (q >> 1) & 15;
    qbase = b * 256 + (q & 1) * 128 + w * 16;
  }
  const int cstart = min(max(16 * jq - 8, 0), 32);
  const int ntile = lat ? 8 : 4;
  bf16x8 qa[2];
#pragma unroll
  for (int ks = 0; ks < 2; ++ks) qa[ks] = *(const bf16x8*)(C1 + (size_t)(qbase + l15) * LDC1 + h * 64 + ks * 32 + l4 * 8);
  auto loadk = [&](int tt, bf16x8 (&kb)[4][2]) {
#pragma unroll
    for (int jt = 0; jt < 4; ++jt) {
      const u16* src;
      if (lat) {
        if (tt < 4) src = C1 + (size_t)(NPROMPT + b * 4096 + (rows0w + tt * 2 + (jt >> 1)) * 64 + cstart + (jt & 1) * 16 + l15) * LDC1 + 1024 + h * 64;
        else src = CK + ((size_t)(b * 16 + h) * 256 + (tt - 4) * 64 + jt * 16 + l15) * 64;
      } else {
        src = C1 + (size_t)(b * 256 + tt * 64 + jt * 16 + l15) * LDC1 + 1024 + h * 64;
      }
#pragma unroll
      for (int ks = 0; ks < 2; ++ks) kb[jt][ks] = *(const bf16x8*)(src + ks * 32 + l4 * 8);
    }
  };
  bf16x8 kn[4][2], kn2[4][2];
  loadk(0, kn);
  loadk(1, kn2);
  u16 graw[4][4];
#pragma unroll
  for (int r = 0; r < 4; ++r)
#pragma unroll
    for (int i = 0; i < 4; ++i)
      graw[r][i] = C1[(size_t)(qbase + l4 * 4 + r) * LDC1 + 3072 + h * 64 + i * 16 + l15];
  {
    const int nloc = lat ? nvrows * 64 : 256;
    const int keyrow0 = lat ? NPROMPT + b * 4096 + vrow0 * 64 : b * 256;
    u32x4 vv[9], cvv[4];
#pragma unroll
    for (int i = 0; i < 9; ++i) {
      const int id = tid + i * NT;
      vv[i] = (u32x4){0u, 0u, 0u, 0u};
      if (id < nloc * 8) { int key = id >> 3, d0 = (id & 7) * 8; vv[i] = *(const u32x4*)(C1 + (size_t)(keyrow0 + key) * LDC1 + 2048 + h * 64 + d0); }
    }
    if (lat) {
#pragma unroll
      for (int i = 0; i < 4; ++i) {
        const int id = tid + i * NT; int key = id >> 3, d0 = (id & 7) * 8;
        cvv[i] = *(const u32x4*)(CV + ((size_t)(b * 16 + h) * 256 + key) * 64 + d0);
      }
    }
#pragma unroll
    for (int i = 0; i < 9; ++i) {
      const int id = tid + i * NT;
      if (id < nloc * 8) { int key = id >> 3, d0 = (id & 7) * 8; *(u32x4*)(VS + key * VSP + d0) = vv[i]; }
    }
    if (lat) {
#pragma unroll
      for (int i = 0; i < 4; ++i) {
        const int id = tid + i * NT; int key = id >> 3, d0 = (id & 7) * 8;
        *(u32x4*)(VS + (576 + key) * VSP + d0) = cvv[i];
      }
      for (int id = tid; id < 465; id += NT) rp[id] = p.in[29][h * 465 + id] * 1.4426950408889634f;
    }
  }
  __syncthreads();
  float mrow[4], lrow[4];
  f32x4 O[4];
#pragma unroll
  for (int r = 0; r < 4; ++r) { mrow[r] = -1e30f; lrow[r] = 0.f; }
#pragma unroll
  for (int i = 0; i < 4; ++i) O[i] = (f32x4){0.f, 0.f, 0.f, 0.f};
  u16* Pw = Pb + w * 16 * 72;
  const __attribute__((address_space(3))) char* vs3 = (const __attribute__((address_space(3))) char*)VS;
  int dcv[2][4]; bool okv[2][4];
#pragma unroll
  for (int hf = 0; hf < 2; ++hf)
#pragma unroll
    for (int r = 0; r < 4; ++r) {
      const int kcn = cstart + hf * 16 + l15;
      const int qc = jq * 16 + l4 * 4 + r;
      const int col0 = min(max(qc - 8, 0), 48);
      dcv[hf][r] = min(max(kcn - qc + 15, 0), 30);
      okv[hf][r] = (kcn >= col0) && (kcn < col0 + 16);
    }
#pragma unroll 1
  for (int tt = 0; tt < ntile; ++tt) {
    bf16x8 kc[4][2];
#pragma unroll
    for (int jt = 0; jt < 4; ++jt)
#pragma unroll
      for (int ks = 0; ks < 2; ++ks) { kc[jt][ks] = kn[jt][ks]; kn[jt][ks] = kn2[jt][ks]; }
    if (tt + 2 < ntile) loadk(tt + 2, kn2);
    const bool local = lat && tt < 4;
    f32x4 S[4];
#pragma unroll
    for (int jt = 0; jt < 4; ++jt) {
      S[jt] = (f32x4){0.f, 0.f, 0.f, 0.f};
      S[jt] = MFMA16(qa[0], kc[jt][0], S[jt]);
      S[jt] = MFMA16(qa[1], kc[jt][1], S[jt]);
    }
    float sv[4][4];
#pragma unroll
    for (int jt = 0; jt < 4; ++jt)
#pragma unroll
      for (int r = 0; r < 4; ++r) {
        float s = S[jt][r] * 0.18033688011112042f;
        if (local) {
          const int dr = rows0w + tt * 2 + (jt >> 1) - myr + 7;
          s += rp[dr * 31 + dcv[jt & 1][r]];
          if (!okv[jt & 1][r]) s = -INFINITY;
        }
        sv[jt][r] = s;
      }
    float alpha[4];
#pragma unroll
    for (int r = 0; r < 4; ++r) {
      float mx = fmaxf(fmaxf(sv[0][r], sv[1][r]), fmaxf(sv[2][r], sv[3][r]));
      mx = dpp_rowmax(mx);
      float mn = fmaxf(mrow[r], mx);
      alpha[r] = __builtin_amdgcn_exp2f(mrow[r] - mn);
      mrow[r] = mn;
      float ps = 0.f;
#pragma unroll
      for (int jt = 0; jt < 4; ++jt) {
        float pv = __builtin_amdgcn_exp2f(sv[jt][r] - mn);
        ps += pv;
        Pw[(l4 * 4 + r) * 72 + jt * 16 + l15] = f2bf(pv);
      }
      lrow[r] = lrow[r] * alpha[r] + ps;
    }
#pragma unroll
    for (int i = 0; i < 4; ++i)
#pragma unroll
      for (int r = 0; r < 4; ++r) O[i][r] *= alpha[r];
    asm volatile("s_waitcnt lgkmcnt(0)" ::: "memory");
#pragma unroll
    for (int ks2 = 0; ks2 < 2; ++ks2) {
      bf16x8 pa = *(const bf16x8*)(Pw + l15 * 72 + ks2 * 32 + l4 * 8);
      int keyoff;
      if (lat) keyoff = tt < 4 ? (rows0w - vrow0 + tt * 2 + ks2) * 64 + cstart : 576 + (tt - 4) * 64 + ks2 * 32;
      else keyoff = tt * 64 + ks2 * 32;
#pragma unroll
      for (int i = 0; i < 4; ++i) {
        const int rowa = keyoff + 8 * l4 + (l15 >> 2);
        const int cola = i * 16 + 4 * (l15 & 3);
        v4i16_t lo = __builtin_amdgcn_ds_read_tr16_b64_v4i16((__attribute__((address_space(3))) v4i16_t*)(vs3 + (rowa * VSP + cola) * 2));
        v4i16_t hi = __builtin_amdgcn_ds_read_tr16_b64_v4i16((__attribute__((address_space(3))) v4i16_t*)(vs3 + ((rowa + 4) * VSP + cola) * 2));
        bf16x8 vb = __builtin_shufflevector(lo, hi, 0, 1, 2, 3, 4, 5, 6, 7);
        O[i] = MFMA16(pa, vb, O[i]);
      }
    }
    asm volatile("s_waitcnt lgkmcnt(0)" ::: "memory");
  }
  {
    u16* C1w = dry ? (u16*)(p.ws + OFF_DUMMY) + (size_t)(blockIdx.x & 15) * 300000 + (size_t)w * 16 * LDC1 - (size_t)qbase * LDC1 : (u16*)(p.ws + OFF_C1);
#pragma unroll
    for (int r = 0; r < 4; ++r) {
      const float inv = 1.f / dpp_rowsum(lrow[r]);
      const int row = qbase + l4 * 4 + r;
#pragma unroll
      for (int i = 0; i < 4; ++i) {
        const int dcol = h * 64 + i * 16 + l15;
        C1w[(size_t)row * LDC1 + dcol] = f2bf(O[i][r] * inv * silu(bf2f(graw[r][i])));
      }
    }
  }
  __syncthreads();
}

DI void phase_ckv(const Params& p, int t) {
  const int id = t * NT + threadIdx.x;
  const int arr = id >> 16, v = id & 65535;
  const float* src = p.in[3 + arr] + (size_t)v * 8;
  float4 a = *(const float4*)src, c = *(const float4*)(src + 4);
  float f[8] = {a.x, a.y, a.z, a.w, c.x, c.y, c.z, c.w};
  u16* dst = (u16*)((unsigned char*)p.out + OUT_CKV) + (size_t)arr * 524288 + (size_t)v * 8;
  *(u32x4*)dst = pack8(f);
}


DI void phase_ssd_out_grp(const Params& p, int item, unsigned char* smem, bool dry) {
  u16* Cs = (u16*)smem;
  u16* Bs = Cs + 128 * 136;
  u16* xT = Bs + 128 * 136;
  u16* St = xT + 64 * 136;
  float* sdt = (float*)(St + 2 * 64 * 136);
  float* scs = sdt + 2048;
  const int tid = threadIdx.x, lane = tid & 63, w = tid >> 6;
  const int l15 = lane & 15, l4 = lane >> 4;
  const int cgi = item >> 1, grp = item & 1;
  int row0, has_prev, has_next;
  if (cgi < 64) { int seq = cgi >> 1, c = cgi & 1; row0 = seq * 256 + c * 128; has_prev = c > 0; has_next = c < 1; }
  else { int q = cgi - 64; int seq = q >> 5, c = q & 31; row0 = NPROMPT + seq * 4096 + c * 128; has_prev = c > 0; has_next = c < 31; }
  const u16* C0 = (const u16*)(p.ws + OFF_C0A);
  const int xchunk = tid & 7, xrg = tid >> 3;
  const int bchunk = tid & 15, brg = tid >> 4;
  u32x4 rawb[6], rawc[6];
  conv_load<4>(p, row0, brg * 4, 1024 + grp * 128 + bchunk * 8, has_prev, has_next, rawb);
  conv_load<4>(p, row0, brg * 4, 1280 + grp * 128 + bchunk * 8, has_prev, has_next, rawc);
  float rdt[4];
#pragma unroll
  for (int i = 0; i < 4; ++i) {
    const int id = tid + i * NT; const int h8 = id >> 8, d = (id >> 7) & 1, l = id & 127;
    rdt[i] = bf2f(C0[(size_t)(row0 + l) * LDC0 + 2560 + d * 16 + grp * 8 + h8]);
  }
#pragma unroll
  for (int i = 0; i < 4; ++i) {
    const int id = tid + i * NT; const int h8 = id >> 8, d = (id >> 7) & 1;
    const int hh = grp * 8 + h8;
    float x = rdt[i] + p.in[14][d * 16 + hh];
    float dt = x > 20.f ? x : log1pf(expf(x));
    float a = -expf(p.in[15][d * 16 + hh]);
    sdt[id] = dt; scs[id] = a * dt;
  }
  __syncthreads();
#pragma unroll
  for (int k = 0; k < 2; ++k) {
    const int sq = 2 * w + k; const int d = sq & 1;
    float* base = scs + sq * 128;
    int p0 = d == 0 ? 2 * lane : 127 - 2 * lane;
    int p1 = d == 0 ? 2 * lane + 1 : 126 - 2 * lane;
    float v0 = base[p0], v1 = base[p1];
    float sacc = v0 + v1;
#pragma unroll
    for (int off = 1; off < 64; off <<= 1) {
      float tv = __shfl_up(sacc, off);
      if (lane >= off) sacc += tv;
    }
    float excl = sacc - (v0 + v1);
    base[p0] = excl + v0;
    base[p1] = excl + v0 + v1;
  }
  {
    float o[4][8];
    conv_compute<4>(p, 1024 + grp * 128 + bchunk * 8, rawb, o);
#pragma unroll
    for (int i = 0; i < 4; ++i) *(u32x4*)(Bs + (brg * 4 + i) * 136 + bchunk * 8) = pack8(o[i]);
    conv_compute<4>(p, 1280 + grp * 128 + bchunk * 8, rawc, o);
#pragma unroll
    for (int i = 0; i < 4; ++i) *(u32x4*)(Cs + (brg * 4 + i) * 136 + bchunk * 8) = pack8(o[i]);
  }
  __syncthreads();
  f32x4 cb[8];
#pragma unroll
  for (int j = 0; j < 8; ++j) cb[j] = (f32x4){0.f, 0.f, 0.f, 0.f};
#pragma unroll
  for (int ks = 0; ks < 4; ++ks) {
    bf16x8 a = *(const bf16x8*)(Cs + (16 * w + l15) * 136 + ks * 32 + l4 * 8);
#pragma unroll
    for (int j = 0; j < 8; ++j) {
      bf16x8 b = *(const bf16x8*)(Bs + (j * 16 + l15) * 136 + ks * 32 + l4 * 8);
      cb[j] = MFMA16(b, a, cb[j]);
    }
  }
  __syncthreads();
  const int lrow = 16 * w + l15;
#pragma unroll 1
  for (int h8 = 0; h8 < 8; ++h8) {
    const int h = grp * 8 + h8;
    const float* sdh = sdt + h8 * 256;
    const float* sch = scs + h8 * 256;
    u32x4 rawx[4], rawst[4];
    u16 zraw[4][4];
    conv_load<2>(p, row0, xrg * 2, h * 64 + xchunk * 8, has_prev, has_next, rawx);
    {
      const u16* S = (const u16*)((const unsigned char*)p.out + OUT_SBUF) + (size_t)(cgi * 16 + h) * 2 * 8192;
#pragma unroll
      for (int v = 0; v < 4; ++v) {
        int id = tid + 512 * v;
        int dd = id >> 10, pp = (id >> 4) & 63, nv = (id & 15) * 8;
        rawst[v] = *(const u32x4*)(S + dd * 8192 + pp * 128 + nv);
      }
#pragma unroll
      for (int i = 0; i < 4; ++i)
#pragma unroll
        for (int r = 0; r < 4; ++r)
          zraw[i][r] = C0[(size_t)(row0 + 16 * w + l4 * 4 + r) * LDC0 + h * 64 + i * 16 + l15];
    }
    {
      const float cs0l = sch[lrow], cs1l = sch[128 + lrow];
#pragma unroll
      for (int j = 0; j < 8; ++j) {
        const int s0 = j * 16 + l4 * 4;
        float f[4];
        if (j < w) {
          const float4 c4 = *(const float4*)(sch + s0), d4 = *(const float4*)(sdh + s0);
          f[0] = __expf(cs0l - c4.x) * d4.x; f[1] = __expf(cs0l - c4.y) * d4.y; f[2] = __expf(cs0l - c4.z) * d4.z; f[3] = __expf(cs0l - c4.w) * d4.w;
        } else if (j > w) {
          const float4 c4 = *(const float4*)(sch + 128 + s0), d4 = *(const float4*)(sdh + 128 + s0);
          f[0] = __expf(cs1l - c4.x) * d4.x; f[1] = __expf(cs1l - c4.y) * d4.y; f[2] = __expf(cs1l - c4.z) * d4.z; f[3] = __expf(cs1l - c4.w) * d4.w;
        } else {
          const float4 c4 = *(const float4*)(sch + s0), d4 = *(const float4*)(sdh + s0);
          const float4 e4 = *(const float4*)(sch + 128 + s0), g4 = *(const float4*)(sdh + 128 + s0);
          const float c0[4] = {c4.x, c4.y, c4.z, c4.w}, d0[4] = {d4.x, d4.y, d4.z, d4.w};
          const float c1[4] = {e4.x, e4.y, e4.z, e4.w}, d1[4] = {g4.x, g4.y, g4.z, g4.w};
#pragma unroll
          for (int jj = 0; jj < 4; ++jj) {
            const int sidx = s0 + jj;
            float v;
            if (lrow > sidx) v = __expf(cs0l - c0[jj]) * d0[jj];
            else if (lrow < sidx) v = __expf(cs1l - c1[jj]) * d1[jj];
            else v = d0[jj] + d1[jj];
            f[jj] = v;
          }
        }
        u32x2 o; o[0] = pk2(cb[j][0] * f[0], cb[j][1] * f[1]); o[1] = pk2(cb[j][2] * f[2], cb[j][3] * f[3]);
        *(u32x2*)(Bs + lrow * 136 + s0) = o;
      }
    }
    {
      float o[2][8];
      conv_compute<2>(p, h * 64 + xchunk * 8, rawx, o);
#pragma unroll
      for (int e = 0; e < 8; ++e) *(unsigned*)(xT + (xchunk * 8 + e) * 136 + xrg * 2) = pk2(o[0][e], o[1][e]);
#pragma unroll
      for (int v = 0; v < 4; ++v) {
        int id = tid + 512 * v;
        int dd = id >> 10, pp = (id >> 4) & 63, nv = (id & 15) * 8;
        *(u32x4*)(St + dd * 64 * 136 + pp * 136 + nv) = rawst[v];
      }
    }
    __syncthreads();
    f32x4 af[4], ab[4], Y[4];
#pragma unroll
    for (int i = 0; i < 4; ++i) { af[i] = (f32x4){0.f, 0.f, 0.f, 0.f}; ab[i] = (f32x4){0.f, 0.f, 0.f, 0.f}; }
#pragma unroll
    for (int ks = 0; ks < 4; ++ks) {
      bf16x8 a = *(const bf16x8*)(Cs + (16 * w + l15) * 136 + ks * 32 + l4 * 8);
#pragma unroll
      for (int i = 0; i < 4; ++i) {
        bf16x8 b0 = *(const bf16x8*)(St + (i * 16 + l15) * 136 + ks * 32 + l4 * 8);
        bf16x8 b1 = *(const bf16x8*)(St + 64 * 136 + (i * 16 + l15) * 136 + ks * 32 + l4 * 8);
        af[i] = MFMA16(a, b0, af[i]);
        ab[i] = MFMA16(a, b1, ab[i]);
      }
    }
#pragma unroll
    for (int r = 0; r < 4; ++r) {
      const int l = 16 * w + l4 * 4 + r;
      float e0 = __expf(sch[l]), e1 = __expf(sch[128 + l]);
#pragma unroll
      for (int i = 0; i < 4; ++i) Y[i][r] = af[i][r] * e0 + ab[i][r] * e1;
    }
#pragma unroll
    for (int ks = 0; ks < 4; ++ks) {
      bf16x8 a = *(const bf16x8*)(Bs + (16 * w + l15) * 136 + ks * 32 + l4 * 8);
#pragma unroll
      for (int i = 0; i < 4; ++i) {
        bf16x8 b = *(const bf16x8*)(xT + (i * 16 + l15) * 136 + ks * 32 + l4 * 8);
        Y[i] = MFMA16(a, b, Y[i]);
      }
    }
    {
      u16* YAB = dry ? (u16*)(p.ws + OFF_DUMMY) + (size_t)(blockIdx.x & 15) * 400000 - (size_t)row0 * 2048 : (u16*)((unsigned char*)p.out + OUT_YB);
      const float dsk = p.in[16][h] + p.in[16][16 + h];
      float ss[4] = {0.f, 0.f, 0.f, 0.f};
#pragma unroll
      for (int i = 0; i < 4; ++i) {
        const int pp = i * 16 + l15;
#pragma unroll
        for (int r = 0; r < 4; ++r) {
          const int l = 16 * w + l4 * 4 + r;
          float xv = bf2f(xT[pp * 136 + l]);
          float y = Y[i][r] + xv * dsk;
          float gv = y * silu(bf2f(zraw[i][r]));
          YAB[(size_t)(row0 + l) * 2048 + h * 64 + pp] = f2bf(gv);
          ss[r] += gv * gv;
        }
      }
      float* rss = (float*)(p.ws + OFF_ROWSS);
#pragma unroll
      for (int r = 0; r < 4; ++r) {
        float sv = dpp_rowsum(ss[r]);
        if (l15 == 0) rss[(size_t)(row0 + 16 * w + l4 * 4 + r) * 16 + h] = sv;
      }
    }
    __syncthreads();
  }
}

DI void phase_ssd_states_grp(const Params& p, int item, unsigned char* smem) {
  u16* BT = (u16*)smem;
  u16* xTs = BT + 128 * 136;
  float* sdt = (float*)(xTs + 2 * 64 * 136);
  float* scs = sdt + 2048;
  float* sw = scs + 2048;
  float* stot = sw + 2048;
  const int tid = threadIdx.x, lane = tid & 63, w = tid >> 6;
  const int l15 = lane & 15, l4 = lane >> 4;
  const int cgi = item >> 1, grp = item & 1;
  int row0, has_prev, has_next;
  if (cgi < 64) { int seq = cgi >> 1, c = cgi & 1; row0 = seq * 256 + c * 128; has_prev = c > 0; has_next = c < 1; }
  else { int q = cgi - 64; int seq = q >> 5, c = q & 31; row0 = NPROMPT + seq * 4096 + c * 128; has_prev = c > 0; has_next = c < 31; }
  const u16* C0 = (const u16*)(p.ws + OFF_C0A);
  const int xchunk = tid & 7, xrg = tid >> 3;
  const int bchunk = tid & 15, brg = tid >> 4;
  u32x4 rawb[6];
  conv_load<4>(p, row0, brg * 4, 1024 + grp * 128 + bchunk * 8, has_prev, has_next, rawb);
  float rdt[4];
#pragma unroll
  for (int i = 0; i < 4; ++i) {
    const int id = tid + i * NT; const int h8 = id >> 8, d = (id >> 7) & 1, l = id & 127;
    rdt[i] = bf2f(C0[(size_t)(row0 + l) * LDC0 + 2560 + d * 16 + grp * 8 + h8]);
  }
#pragma unroll
  for (int i = 0; i < 4; ++i) {
    const int id = tid + i * NT; const int h8 = id >> 8, d = (id >> 7) & 1;
    const int hh = grp * 8 + h8;
    float x = rdt[i] + p.in[14][d * 16 + hh];
    float dt = x > 20.f ? x : log1pf(expf(x));
    float a = -expf(p.in[15][d * 16 + hh]);
    sdt[id] = dt; scs[id] = a * dt;
  }
  __syncthreads();
#pragma unroll
  for (int k = 0; k < 2; ++k) {
    const int sq = 2 * w + k; const int d = sq & 1;
    float* base = scs + sq * 128;
    int p0 = d == 0 ? 2 * lane : 127 - 2 * lane;
    int p1 = d == 0 ? 2 * lane + 1 : 126 - 2 * lane;
    float v0 = base[p0], v1 = base[p1];
    float sacc = v0 + v1;
#pragma unroll
    for (int off = 1; off < 64; off <<= 1) {
      float tv = __shfl_up(sacc, off);
      if (lane >= off) sacc += tv;
    }
    float excl = sacc - (v0 + v1);
    base[p0] = excl + v0;
    base[p1] = excl + v0 + v1;
    if (lane == 63) stot[sq] = sacc;
  }
  {
    float o[4][8];
    conv_compute<4>(p, 1024 + grp * 128 + bchunk * 8, rawb, o);
#pragma unroll
    for (int e = 0; e < 8; ++e) {
      u32x2 v; v[0] = pk2(o[0][e], o[1][e]); v[1] = pk2(o[2][e], o[3][e]);
      *(u32x2*)(BT + (bchunk * 8 + e) * 136 + brg * 4) = v;
    }
  }
  __syncthreads();
#pragma unroll
  for (int i = 0; i < 4; ++i) {
    const int id = tid + i * NT; const int sq = id >> 7;
    sw[id] = sdt[id] * __expf(stot[sq] - scs[id]);
  }
  if (tid < 16) {
    float* cdec = (float*)(p.ws + OFF_CDEC);
    const int h8 = tid >> 1, d = tid & 1;
    cdec[(cgi * 16 + grp * 8 + h8) * 2 + d] = __expf(stot[tid]);
  }
  __syncthreads();
  const int d = w >> 2, nq = w & 3;
#pragma unroll 1
  for (int h8 = 0; h8 < 8; ++h8) {
    const int h = grp * 8 + h8;
    u32x4 rawx[4];
    conv_load<2>(p, row0, xrg * 2, h * 64 + xchunk * 8, has_prev, has_next, rawx);
    {
      float o[2][8];
      conv_compute<2>(p, h * 64 + xchunk * 8, rawx, o);
#pragma unroll
      for (int dd = 0; dd < 2; ++dd) {
        const float s0 = sw[h8 * 256 + dd * 128 + xrg * 2], s1 = sw[h8 * 256 + dd * 128 + xrg * 2 + 1];
#pragma unroll
        for (int e = 0; e < 8; ++e) *(unsigned*)(xTs + dd * 64 * 136 + (xchunk * 8 + e) * 136 + xrg * 2) = pk2(o[0][e] * s0, o[1][e] * s1);
      }
    }
    __syncthreads();
    f32x4 acc[4][2];
#pragma unroll
    for (int i = 0; i < 4; ++i) { acc[i][0] = (f32x4){0.f, 0.f, 0.f, 0.f}; acc[i][1] = (f32x4){0.f, 0.f, 0.f, 0.f}; }
#pragma unroll
    for (int ks = 0; ks < 4; ++ks) {
      bf16x8 a[4], b[2];
#pragma unroll
      for (int i = 0; i < 4; ++i) a[i] = *(const bf16x8*)(xTs + d * 64 * 136 + (i * 16 + l15) * 136 + ks * 32 + l4 * 8);
#pragma unroll
      for (int j = 0; j < 2; ++j) b[j] = *(const bf16x8*)(BT + (nq * 32 + j * 16 + l15) * 136 + ks * 32 + l4 * 8);
#pragma unroll
      for (int i = 0; i < 4; ++i)
#pragma unroll
        for (int j = 0; j < 2; ++j) acc[i][j] = MFMA16(b[j], a[i], acc[i][j]);
    }
    u16* S = (u16*)((unsigned char*)p.out + OUT_SBUF) + ((size_t)(cgi * 16 + h) * 2 + d) * 8192;
#pragma unroll
    for (int i = 0; i < 4; ++i)
#pragma unroll
      for (int j = 0; j < 2; ++j) {
        const int pp = i * 16 + l15, n = nq * 32 + j * 16 + l4 * 4;
        u32x2 o; o[0] = pk2(acc[i][j][0], acc[i][j][1]); o[1] = pk2(acc[i][j][2], acc[i][j][3]);
        *(u32x2*)(S + pp * 128 + n) = o;
      }
    __syncthreads();
  }
}
#define OFF_BAR 268419072ul
#define XB_TMO      128
#define XB_XCNT(j)  (256  + 64 * (j))
#define XB_XSUB(j)  (1280 + 64 * (j))
#define XB_XGEN(j)  (2304 + 64 * (j))
#define XB_TOP      3328
#define XB_TOPGEN   3392
#define XCD_BAR_WORDS 3456
#define XB_SPIN_CAP (1u << 18)
#define LAS __attribute__((address_space(3)))
DI unsigned xb_ld(unsigned* p) { return __hip_atomic_load(p, __ATOMIC_RELAXED, __HIP_MEMORY_SCOPE_AGENT); }
DI unsigned xb_add(unsigned* p, unsigned v) { return __hip_atomic_fetch_add(p, v, __ATOMIC_RELAXED, __HIP_MEMORY_SCOPE_AGENT); }
DI unsigned xb_xcc_id() { return (unsigned)__builtin_amdgcn_s_getreg((3 << 11) | 20) & 0xFu; }
#define XB_SPIN(cond, bar) do { unsigned _sp = 0; while (cond) { __builtin_amdgcn_s_sleep(1); \
    if ((++_sp & 255u) == 0u) { if (xb_ld(&(bar)[XB_TMO])) break; if (_sp > XB_SPIN_CAP) { atomicAdd(&(bar)[XB_TMO], 1u); break; } } } } while (0)
struct XcdBarrier { unsigned* bar; unsigned x; volatile LAS unsigned* st; };
DI XcdBarrier xcd_barrier_post(unsigned* bar, volatile LAS unsigned* st) {
  XcdBarrier b; b.bar = bar; b.x = xb_xcc_id(); b.st = st;
  if (threadIdx.x == 0) (void)xb_add(&bar[XB_XCNT(b.x)], 1u);
  return b;
}
DI void xcd_barrier_complete(unsigned* bar, unsigned x, unsigned& nloc, unsigned& nx) {
  const unsigned G = gridDim.x * gridDim.y * gridDim.z;
  unsigned sum, cnt, mine, sp = 0u;
  for (;;) {
    sum = 0u; cnt = 0u; mine = 0u;
#pragma unroll
    for (unsigned j = 0; j < 16; ++j) { const unsigned c = xb_ld(&bar[XB_XCNT(j)]); sum += c; cnt += (c > 0u) ? 1u : 0u; mine = (j == x) ? c : mine; }
    if (sum == G) break;
    __builtin_amdgcn_s_sleep(1);
    if ((++sp & 255u) == 0u) { if (xb_ld(&bar[XB_TMO])) break; if (sp > XB_SPIN_CAP) { atomicAdd(&bar[XB_TMO], 1u); break; } }
  }
  nloc = mine > 0u ? mine : 1u; nx = cnt > 0u ? cnt : 1u;
}
DI void xcd_barrier(const XcdBarrier& b) {
  asm volatile("s_waitcnt vmcnt(0)" ::: "memory");
  __syncthreads();
  if (threadIdx.x == 0) {
    unsigned* bar = b.bar;
    __builtin_amdgcn_s_waitcnt(0);
    unsigned nloc = b.st[0], nx = b.st[1];
    if (nloc == 0u) { xcd_barrier_complete(bar, b.x, nloc, nx); b.st[0] = nloc; b.st[1] = nx; }
    const unsigned old = xb_add(&bar[XB_XSUB(b.x)], 1u);
    const unsigned gen = old / nloc;
    if (old + 1u == (gen + 1u) * nloc) {
      __builtin_amdgcn_fence(__ATOMIC_RELEASE, "agent");
      asm volatile("s_waitcnt vmcnt(0)" ::: "memory");
      const unsigned og = xb_add(&bar[XB_TOP], 1u);
      const unsigned tg = og / nx;
      if (og + 1u == (tg + 1u) * nx) xb_add(&bar[XB_TOPGEN], 1u);
      else XB_SPIN(xb_ld(&bar[XB_TOPGEN]) == tg, bar);
      __builtin_amdgcn_fence(__ATOMIC_ACQUIRE, "agent");
      xb_add(&bar[XB_XGEN(b.x)], 1u);
      asm volatile("s_waitcnt vmcnt(0)" ::: "memory");
    } else {
      XB_SPIN(xb_ld(&bar[XB_XGEN(b.x)]) == gen, bar);
      __builtin_amdgcn_fence(__ATOMIC_ACQUIRE, "agent");
      asm volatile("s_waitcnt vmcnt(0)" ::: "memory");
    }
  }
  __syncthreads();
}
#define NPHASE 12
__global__ void __launch_bounds__(NT) mega(Params p, int ph0, int ph1) {
  __shared__ __attribute__((aligned(16))) unsigned char smem[SMEM_BYTES];
  __shared__ __attribute__((aligned(16))) unsigned xb_st[4];
  const int nb = gridDim.x, bid = blockIdx.x;
  if (threadIdx.x < 4) xb_st[threadIdx.x] = 0u;
  __syncthreads();
  const XcdBarrier xb = xcd_barrier_post((unsigned*)(p.ws + OFF_BAR), (volatile LAS unsigned*)xb_st);
  if (ph1 > 4096) cg::this_grid().sync();
#define PH_BEGIN(k) if (ph0 <= (k) && (k) < ph1) { if ((k) > ph0) xcd_barrier(xb); \
  for (int rep = (REP_MASK >> (k)) & 1; rep >= 0; --rep) { const bool dry = rep > 0; (void)dry;
#define PH_END if (rep > 0) xcd_barrier(xb); } }
  {
    {
      PH_BEGIN(0) {
#pragma unroll 1
        for (int ft = bid; ft < 272; ft += 256) phase_filter(p, ft, smem);
        if (bid >= 16) {
          const int nl = nb - 16;
          for (int q0 = bid - 16; q0 < 192 + 880; q0 += nl) {
            if (q0 < 192) phase_ada(p, q0, smem);
            else {
              int q = q0 - 192;
              if (q < 432) transpose_tile<float>(p.in[10], 6688, 6688, (u16*)(p.ws + OFF_WINE), 1024, q & 15, q >> 4, nullptr, 0, smem);
              else if (q < 560) { q -= 432; transpose_tile<float>(p.in[11], 1024, 1024, (u16*)(p.ws + OFF_WOUTE), 2048, q & 31, q >> 5, p.in[17], 1024, smem); }
              else if (q < 816) { q -= 560; transpose_tile<float>(p.in[27], 4096, 4096, (u16*)(p.ws + OFF_WINO), 1024, q & 15, q >> 4, nullptr, 0, smem); }
              else { q -= 816; transpose_tile<float>(p.in[28], 1024, 1024, (u16*)(p.ws + OFF_WOUTO), 1024, q & 15, q >> 4, nullptr, 0, smem); }
            }
          }
        }
      } PH_END
      PH_BEGIN(1) {
        for (int t = bid; t < 512; t += nb) phase_norm(p, t, 0, p.in[0], p.in[1], (u16*)((unsigned char*)p.out + OUT_H0));
      } PH_END
      PH_BEGIN(2) {
        GemmArgs g; g.A1 = (const u16*)((const unsigned char*)p.out + OUT_H0); g.lda1 = 1024; g.A2 = g.A1; g.lda2 = 1024; g.ksplit = 1 << 30;
        g.Bt = (const u16*)(p.ws + OFF_WINE); g.K = 1024;
        for (int rd = 0; rd * 256 < 64 * 27; ++rd) { int pm, pn; if (gemm_tile_coord(rd, 27, 64 * 27, pm, pn)) { if (pn <= 9) gemm256<0, true>(p, g, pm * 256, pn * 256, smem); else gemm256<0, false>(p, g, pm * 256, pn * 256, smem); } }
      } PH_END
      PH_BEGIN(3) {
        for (int t = bid; t < 512 + 256; t += nb) {
          if (dry && (REP_SUB == 1 || REP_SUB == 4) && t >= 256) continue;
          if (dry && REP_SUB == 2 && (t < 256 || t >= 512)) continue;
          if (dry && REP_SUB == 3 && t < 512) continue;
          if (t < 512) phase_hyena(p, t, smem, dry);
          else phase_ssd_states_grp(p, t - 512, smem);
        }
      } PH_END
      PH_BEGIN(4) {
        for (int t = bid; t < 34 * 64; t += nb) phase_scan(p, t);
      } PH_END
      PH_BEGIN(5) {
        for (int t = bid; t < 256 + 1024; t += nb) {
          if (t < 256) phase_ssd_out_grp(p, t, smem, dry);
          else {
            int q = t - 256;
            transpose_tile<u16>((const u16*)(p.ws + OFF_UT) + (size_t)3072 * UTP, MROWS, UTP,
                                (u16*)((unsigned char*)p.out + OUT_YB) + 1024, 2048, q & 15, q >> 4, nullptr, 0, smem);
          }
        }
      } PH_END
      PH_BEGIN(6) {
        GemmArgs g; g.A1 = (const u16*)((const unsigned char*)p.out + OUT_YB); g.lda1 = 2048;
        g.A2 = g.A1; g.lda2 = 2048; g.ksplit = 1024;
        g.Bt = (const u16*)(p.ws + OFF_WOUTE); g.K = 2048;
        for (int rd = 0; rd * 256 < 64 * 4; ++rd) { int pm, pn; if (gemm_tile_coord(rd, 4, 64 * 4, pm, pn)) gemm256<1, true>(p, g, pm * 256, pn * 256, smem); }
      } PH_END
      PH_BEGIN(7) {
        const float* x1 = (const float*)(p.ws + OFF_X1);
        for (int t = bid; t < 512 + 256; t += nb) { if (t < 512) phase_norm(p, t, 1, x1, x1 + (size_t)NPROMPT * 1024, (u16*)(p.ws + OFF_H1)); else phase_ckv(p, t - 512); }
      } PH_END
      PH_BEGIN(8) {
        GemmArgs g; g.A1 = (const u16*)(p.ws + OFF_H1); g.lda1 = 1024; g.A2 = g.A1; g.lda2 = 1024; g.ksplit = 1 << 30;
        g.Bt = (const u16*)(p.ws + OFF_WINO); g.K = 1024;
        for (int rd = 0; rd * 256 < 64 * 16; ++rd) { int pm, pn; if (gemm_tile_coord(rd, 16, 64 * 16, pm, pn)) gemm256<2, true>(p, g, pm * 256, pn * 256, smem); }
      } PH_END
      PH_BEGIN(9) {
        for (int t = bid; t < 2048; t += nb) phase_attn(p, t, smem, dry);
      } PH_END
      PH_BEGIN(10) {
        GemmArgs g; g.A1 = (const u16*)(p.ws + OFF_C1); g.lda1 = LDC1; g.A2 = g.A1; g.lda2 = LDC1; g.ksplit = 1 << 30;
        g.Bt = (const u16*)(p.ws + OFF_WOUTO); g.K = 1024;
        for (int rd = 0; rd * 256 < 64 * 4; ++rd) { int pm, pn; if (gemm_tile_coord(rd, 4, 64 * 4, pm, pn)) gemm256<3, true>(p, g, pm * 256, pn * 256, smem); }
      } PH_END
      PH_BEGIN(11) {
        for (int t = bid; t < 512; t += nb) phase_final_norm(p, t);
      } PH_END
    }
  }
}

extern "C" void kernel_launch(void* const* d_in, const int* in_sizes, int n_in, void* d_out, int out_size,
                              void* d_ws, size_t ws_size, hipStream_t stream) {
  static int grid_blocks = 0;
  if (!grid_blocks) {
    int dev = 0, cus = 0, per_cu = 0;
    hipGetDevice(&dev);
    hipDeviceGetAttribute(&cus, hipDeviceAttributeMultiprocessorCount, dev);
    hipOccupancyMaxActiveBlocksPerMultiprocessor(&per_cu, mega, NT, 0);
    if (per_cu < 1) per_cu = 1;
    grid_blocks = cus * per_cu;
  }
  Params p{};
  for (int i = 0; i < 31; ++i) p.in[i] = (const float*)d_in[i];
  p.out = (float*)d_out;
  p.ws = (unsigned char*)d_ws;
#if MULTI
  for (int ph = 0; ph < NPHASE; ++ph) {
    hipLaunchKernelGGL(mega, dim3(grid_blocks), dim3(NT), 0, stream, p, ph, ph + 1);
  }
#else
  hipMemsetAsync((unsigned char*)d_ws + OFF_BAR, 0, XCD_BAR_WORDS * sizeof(unsigned), stream);
  int ph0 = 0, ph1 = NPHASE;
  void* args[] = {&p, &ph0, &ph1};
  hipError_t e = hipLaunchCooperativeKernel((void*)mega, dim3(grid_blocks), dim3(NT), args, 0, stream);
  if (e != hipSuccess) fprintf(stderr, "cooperative launch failed: %s (grid %d)\n", hipGetErrorString(e), grid_blocks);
#endif
}
```

```cpp
#include <hip/hip_runtime.h>
#include <hip/hip_cooperative_groups.h>
#include <cstdio>
namespace cg = cooperative_groups;

#ifndef REP_MASK
#define REP_MASK 0
#endif
#ifndef REP_SUB
#define REP_SUB 0
#endif
#define OFF_DUMMY 249651200ul
#ifndef MULTI
#define MULTI 0
#endif

#define NT 512
#define DI __device__ __forceinline__
typedef unsigned short u16;
typedef __attribute__((ext_vector_type(8))) short bf16x8;
typedef __attribute__((ext_vector_type(4))) float f32x4;
typedef __attribute__((ext_vector_type(16))) float f32x16;
typedef __attribute__((ext_vector_type(4))) unsigned u32x4;
typedef __attribute__((ext_vector_type(2))) unsigned u32x2;

#define MFMA16(a, b, c) __builtin_amdgcn_mfma_f32_16x16x32_bf16((a), (b), (c), 0, 0, 0)
#define MFMA32(a, b, c) __builtin_amdgcn_mfma_f32_32x32x16_bf16((a), (b), (c), 0, 0, 0)

#define MROWS 16384
#define NPROMPT 8192
#define UTP 16448
#define LDC1 4160
#define LDC0 2592
#define NPAD0 6784
#define SMEM_BYTES 151552

#define OFF_WINE   0ul
#define OFF_WOUTE  14155776ul
#define OFF_WINO   18350080ul
#define OFF_WOUTO  26738688ul
#define OFF_MOD    28835840ul
#define OFF_ROWSS  28909568ul
#define OFF_CDEC   29958144ul
#define OFF_UT     29974528ul
#define OFF_C0A    164716544ul
#define OFF_X1     OFF_UT
#define OFF_C1     97083392ul
#define OFF_H1     233398272ul
#define OUT_H0     0ul
#define OUT_YB     0ul
#define OUT_HF4096 33554432ul
#define OUT_HF256  (33554432ul + 16777216ul)
#define OUT_SBUF   100663296ul
#define O_YP 0ul
#define O_YS 8388608ul
#define O_ST 16777216ul
#define O_NK 25165824ul
#define O_NV 33554432ul

struct Params {
  const float* in[31];
  float* out;
  unsigned char* ws;
};

typedef float f32x2_t __attribute__((ext_vector_type(2)));
typedef __bf16 bf16x2_t __attribute__((ext_vector_type(2)));
DI unsigned pk2(float a, float b) {
  f32x2_t v = {a, b};
  bf16x2_t r = __builtin_convertvector(v, bf16x2_t);
  return __builtin_bit_cast(unsigned, r);
}
DI u16 f2bf(float x) { return (u16)(pk2(x, x) & 0xffffu); }
DI float bf2f(u16 h) { return __uint_as_float(((unsigned)h) << 16); }
DI float silu(float x) { return x * __builtin_amdgcn_rcpf(1.f + __expf(-x)); }
DI float bflo(unsigned u) { return __uint_as_float(u << 16); }
DI float bfhi(unsigned u) { return __uint_as_float(u & 0xffff0000u); }
DI void unpack8(const u32x4& v, float* f) {
  f[0] = bflo(v[0]); f[1] = bfhi(v[0]); f[2] = bflo(v[1]); f[3] = bfhi(v[1]);
  f[4] = bflo(v[2]); f[5] = bfhi(v[2]); f[6] = bflo(v[3]); f[7] = bfhi(v[3]);
}
DI u32x4 pack8(const float* f) {
  u32x4 o; o[0] = pk2(f[0], f[1]); o[1] = pk2(f[2], f[3]); o[2] = pk2(f[4], f[5]); o[3] = pk2(f[6], f[7]); return o;
}
DI int row_group(int row) { return row < NPROMPT ? 0 : 1 + ((row - NPROMPT) >> 12); }

DI void phase_ada(const Params& p, int t, unsigned char* smem) {
  float* sc = (float*)smem;
  float* red = sc + 3072;
  const int layer = t / 96, cc = t % 96;
  const int tid = threadIdx.x;
  for (int i = tid; i < 3072; i += NT) {
    int g = i >> 10, k = i & 1023;
    float v = (g == 0) ? p.in[6][k] : p.in[5][(g - 1) * 1024 + k];
    sc[i] = silu(v);
  }
  __syncthreads();
  const int col = tid & 31, kg = tid >> 5;
  const float* w = p.in[8] + (size_t)layer * 1024 * 3072 + cc * 32 + col;
  float a0 = 0.f, a1 = 0.f, a2 = 0.f;
#pragma unroll 8
  for (int k = kg * 64; k < kg * 64 + 64; ++k) {
    float wv = w[(size_t)k * 3072];
    a0 += sc[k] * wv; a1 += sc[1024 + k] * wv; a2 += sc[2048 + k] * wv;
  }
  red[(kg * 3 + 0) * 32 + col] = a0;
  red[(kg * 3 + 1) * 32 + col] = a1;
  red[(kg * 3 + 2) * 32 + col] = a2;
  __syncthreads();
  if (tid < 96) {
    int g = tid >> 5, c = tid & 31;
    float s = 0.f;
    for (int q = 0; q < 16; ++q) s += red[(q * 3 + g) * 32 + c];
    int colg = cc * 32 + c;
    float* mod = (float*)(p.ws + OFF_MOD);
    mod[(layer * 3 + g) * 3072 + colg] = s + p.in[9][layer * 3072 + colg];
  }
  __syncthreads();
}

DI float ld_src(const float* q) { return *q; }
DI float ld_src(const u16* q) { return bf2f(*q); }
template <typename ST>
DI void transpose_tile(const ST* src, int N, int ldsrc, u16* dst, int lddst, int kt, int nt4,
                       const float* kscale, int kscale_n, unsigned char* smem) {
  float* tile = (float*)smem;
  const int tid = threadIdx.x;
  const int c = tid & 63, r0 = tid >> 6;
  float v[4][8];
#pragma unroll
  for (int q = 0; q < 4; ++q)
#pragma unroll
    for (int i = 0; i < 8; ++i) {
      int r = r0 + 8 * i;
      int k = kt * 64 + r, n = (nt4 * 4 + q) * 64 + c;
      v[q][i] = 0.f;
      if (n < N) v[q][i] = ld_src(src + (size_t)k * ldsrc + n);
    }
#pragma unroll
  for (int q = 0; q < 4; ++q)
#pragma unroll
    for (int i = 0; i < 8; ++i) {
      int r = r0 + 8 * i;
      int k = kt * 64 + r;
      float x = v[q][i];
      if (kscale != nullptr && k < kscale_n) x *= kscale[k];
      tile[q * 4160 + r * 65 + c] = x;
    }
  __syncthreads();
  const int rr = tid >> 3, c8 = (tid & 7) * 8;
#pragma unroll
  for (int q = 0; q < 4; ++q) {
    float f[8];
#pragma unroll
    for (int e = 0; e < 8; ++e) f[e] = tile[q * 4160 + (c8 + e) * 65 + rr];
    *(u32x4*)(dst + (size_t)((nt4 * 4 + q) * 64 + rr) * lddst + kt * 64 + c8) = pack8(f);
  }
  __syncthreads();
}

DI void phase_filter(const Params& p, int t, unsigned char* smem) {
  const int L = 4096;
  const int t0 = t * 16;
  float* feats = (float*)smem;
  float* h1 = feats + 18 * 36;
  float* h2 = h1 + 18 * 64;
  const float* w1 = p.in[20]; const float* b1 = p.in[21]; const float* w2 = p.in[22];
  const float* b2 = p.in[23]; const float* w3 = p.in[24]; const float* fr = p.in[25];
  const int tid = threadIdx.x;
  float* w1s = h2 + 64 * 20;
  float* w2s = w1s + 33 * 64;
  {
    float r1[5], r2[8];
#pragma unroll
    for (int i = 0; i < 5; ++i) { const int id = tid + i * NT; r1[i] = id < 33 * 64 ? w1[id] : 0.f; }
#pragma unroll
    for (int i = 0; i < 8; ++i) r2[i] = w2[tid + i * NT];
#pragma unroll
    for (int i = 0; i < 5; ++i) { const int id = tid + i * NT; if (id < 33 * 64) w1s[id] = r1[i]; }
#pragma unroll
    for (int i = 0; i < 8; ++i) w2s[tid + i * NT] = r2[i];
  }
  for (int id = tid; id < 18 * 33; id += NT) {
    int tt = id / 33, i = id % 33;
    const int Lr = tt < 17 ? 4096 : 256;
    const int tpos = tt < 17 ? t0 + tt : t;
    float tv = (float)tpos / (float)(Lr - 1);
    float wv = 6.283185307179586f * (float)tpos / (float)Lr;
    float f;
    if (i == 0) f = tv;
    else if (i <= 16) { float fi = 1e-4f + (float)(i - 1) * ((15.f - 1e-4f) / 15.f); f = cosf(fi * wv); }
    else { float fi = 1e-4f + (float)(i - 17) * ((15.f - 1e-4f) / 15.f); f = -sinf(fi * wv); }
    feats[tt * 36 + i] = f;
  }
  __syncthreads();
  for (int id = tid; id < 18 * 64; id += NT) {
    int tt = id >> 6, j = id & 63;
    float s = b1[j];
#pragma unroll 11
    for (int i = 0; i < 33; ++i) s += feats[tt * 36 + i] * w1s[i * 64 + j];
    h1[tt * 64 + j] = sinf(fr[j] * s);
  }
  __syncthreads();
  for (int id = tid; id < 18 * 64; id += NT) {
    int tt = id >> 6, j = id & 63;
    float s = b2[j];
#pragma unroll 16
    for (int i = 0; i < 64; ++i) s += h1[tt * 64 + i] * w2s[i * 64 + j];
    h2[j * 20 + tt] = sinf(fr[j] * s);
  }
  __syncthreads();
  float acc[4][18];
#pragma unroll
  for (int q = 0; q < 4; ++q)
#pragma unroll
    for (int tt = 0; tt < 18; ++tt) acc[q][tt] = 0.f;
#pragma unroll 1
  for (int k0 = 0; k0 < 64; k0 += 4) {
    float wv[4][4];
    float4 hq[4][5];
#pragma unroll
    for (int kk = 0; kk < 4; ++kk) {
#pragma unroll
      for (int q = 0; q < 4; ++q) wv[kk][q] = w3[(k0 + kk) * 2048 + tid + 512 * q];
#pragma unroll
      for (int v = 0; v < 5; ++v) hq[kk][v] = *(const float4*)(h2 + (k0 + kk) * 20 + v * 4);
    }
#pragma unroll
    for (int kk = 0; kk < 4; ++kk) {
      const float hv[20] = {hq[kk][0].x, hq[kk][0].y, hq[kk][0].z, hq[kk][0].w, hq[kk][1].x, hq[kk][1].y, hq[kk][1].z, hq[kk][1].w,
                            hq[kk][2].x, hq[kk][2].y, hq[kk][2].z, hq[kk][2].w, hq[kk][3].x, hq[kk][3].y, hq[kk][3].z, hq[kk][3].w,
                            hq[kk][4].x, hq[kk][4].y, hq[kk][4].z, hq[kk][4].w};
#pragma unroll
      for (int tt = 0; tt < 18; ++tt)
#pragma unroll
        for (int q = 0; q < 4; ++q) acc[q][tt] += hv[tt] * wv[kk][q];
    }
  }
  u16* HF = (u16*)((unsigned char*)p.out + OUT_HF4096);
  u16* HFp = (u16*)((unsigned char*)p.out + OUT_HF256);
  const float lo = -15.350567286626973f;
  const float hi = -3.0701134573253945f;
#pragma unroll
  for (int q = 0; q < 4; ++q) {
    int col = tid + 512 * q;
    int dir = col >> 10, c = col & 1023;
    float ad = fabsf(lo + (float)c * ((hi - lo) / 1023.f));
    u16* hc = HF + (size_t)c * (2 * L);
    float v[16];
    if (dir == 0) {
#pragma unroll
      for (int e = 0; e < 16; ++e) {
        const int j = 15 - e; const int tpos = t0 + j;
        v[e] = acc[q][j] * __expf(-((float)tpos / (float)(L - 1)) * ad);
      }
      *(u32x4*)(hc + (L - 16 - t0)) = pack8(v);
      *(u32x4*)(hc + (L - 8 - t0)) = pack8(v + 8);
    } else {
#pragma unroll
      for (int e = 0; e < 16; ++e) {
        const int tpos = t0 + 1 + e;
        v[e] = (tpos < L) ? acc[q][e + 1] * __expf(-((float)tpos / (float)(L - 1)) * ad) : 0.f;
      }
      *(u32x4*)(hc + (L + t0)) = pack8(v);
      *(u32x4*)(hc + (L + t0 + 8)) = pack8(v + 8);
    }
    {
      u16* hp = HFp + (size_t)c * 512;
      const float val = acc[q][17] * __expf(-((float)t / 255.f) * ad);
      if (dir == 0) hp[255 - t] = f2bf(val);
      else { if (t > 0) hp[255 + t] = f2bf(val); else hp[511] = 0; }
    }
  }
  __syncthreads();
}

DI float wave_sum(float v) {
#pragma unroll
  for (int o = 32; o >= 1; o >>= 1) v += __shfl_xor(v, o);
  return v;
}
DI void phase_norm(const Params& p, int t, int layer, const float* xa, const float* xb, u16* dst) {
  const int lane = threadIdx.x & 63, w = threadIdx.x >> 6;
  const int row0 = t * 32 + w * 4;
  float4 v[4][4];
#pragma unroll
  for (int rr = 0; rr < 4; ++rr) {
    const int row = row0 + rr;
    const float* src = row < NPROMPT ? xa + (size_t)row * 1024 : xb + (size_t)(row - NPROMPT) * 1024;
#pragma unroll
    for (int i = 0; i < 4; ++i) v[rr][i] = *(const float4*)(src + i * 256 + lane * 4);
  }
  const float* nw = p.in[7] + layer * 1024;
#pragma unroll
  for (int rr = 0; rr < 4; ++rr) {
    const int row = row0 + rr;
    const int g = row_group(row);
    float ss = 0.f;
#pragma unroll
    for (int i = 0; i < 4; ++i) ss += v[rr][i].x * v[rr][i].x + v[rr][i].y * v[rr][i].y + v[rr][i].z * v[rr][i].z + v[rr][i].w * v[rr][i].w;
    ss = wave_sum(ss);
    const float rstd = rsqrtf(ss * (1.f / 1024.f) + 1e-6f);
    const float* shift = (const float*)(p.ws + OFF_MOD) + (layer * 3 + g) * 3072;
    const float* scale = shift + 1024;
#pragma unroll
    for (int i = 0; i < 4; ++i) {
      int col = i * 256 + lane * 4;
      float4 nwv = *(const float4*)(nw + col);
      float4 sc = *(const float4*)(scale + col);
      float4 sh = *(const float4*)(shift + col);
      float o0 = v[rr][i].x * rstd * nwv.x * (1.f + sc.x) + sh.x;
      float o1 = v[rr][i].y * rstd * nwv.y * (1.f + sc.y) + sh.y;
      float o2 = v[rr][i].z * rstd * nwv.z * (1.f + sc.z) + sh.z;
      float o3 = v[rr][i].w * rstd * nwv.w * (1.f + sc.w) + sh.w;
      u32x2 o; o[0] = pk2(o0, o1); o[1] = pk2(o2, o3);
      *(u32x2*)(dst + (size_t)row * 1024 + col) = o;
    }
  }
}
DI void phase_final_norm(const Params& p, int t) {
  const int lane = threadIdx.x & 63, w = threadIdx.x >> 6;
  const int row0 = t * 32 + w * 4;
  float4 v[4][4];
#pragma unroll
  for (int rr = 0; rr < 4; ++rr) {
    const float* src = p.out + (size_t)(row0 + rr) * 1024;
#pragma unroll
    for (int i = 0; i < 4; ++i) v[rr][i] = *(const float4*)(src + i * 256 + lane * 4);
  }
  const float* nw = p.in[30];
#pragma unroll
  for (int rr = 0; rr < 4; ++rr) {
    float* src = p.out + (size_t)(row0 + rr) * 1024;
    float ss = 0.f;
#pragma unroll
    for (int i = 0; i < 4; ++i) ss += v[rr][i].x * v[rr][i].x + v[rr][i].y * v[rr][i].y + v[rr][i].z * v[rr][i].z + v[rr][i].w * v[rr][i].w;
    ss = wave_sum(ss);
    const float rstd = rsqrtf(ss * (1.f / 1024.f) + 1e-6f);
#pragma unroll
    for (int i = 0; i < 4; ++i) {
      int col = i * 256 + lane * 4;
      float4 nwv = *(const float4*)(nw + col);
      float4 o;
      o.x = v[rr][i].x * rstd * nwv.x; o.y = v[rr][i].y * rstd * nwv.y; o.z = v[rr][i].z * rstd * nwv.z; o.w = v[rr][i].w * rstd * nwv.w;
      *(float4*)(src + col) = o;
    }
  }
}

struct GemmArgs {
  const u16* A1; int lda1;
  const u16* A2; int lda2;
  int ksplit;
  const u16* Bt; int K;
};
template <int EPI>
DI void gemm_tile(const Params& p, const GemmArgs& g, int m0, int n0, unsigned char* smem) {
  u16* As = (u16*)smem;
  u16* Bs = As + 256 * 72;
  float* rs = (float*)(Bs + 128 * 72);
  const int tid = threadIdx.x, lane = tid & 63, w = tid >> 6;
  const int wm = (w >> 1) * 64, wn = (w & 1) * 64;
  const int l15 = lane & 15, l4 = lane >> 4;
  f32x4 acc[4][4];
#pragma unroll
  for (int i = 0; i < 4; ++i)
#pragma unroll
    for (int j = 0; j < 4; ++j) acc[i][j] = (f32x4){0.f, 0.f, 0.f, 0.f};
  if (EPI == 1) {
    if (tid < 256) {
      const float* rss = (const float*)(p.ws + OFF_ROWSS) + (size_t)(m0 + tid) * 16;
      float s = 0.f;
#pragma unroll
      for (int q = 0; q < 16; ++q) s += rss[q];
      rs[tid] = rsqrtf(s * (1.f / 1024.f) + 1e-6f);
    }
  }
  u32x4 ra[4], rb[2];
  const int KT = g.K >> 6;
  auto loadg = [&](int kt) {
    const int k0 = kt << 6;
    const u16* Ab; int lda; int kk;
    if (k0 < g.ksplit) { Ab = g.A1; lda = g.lda1; kk = k0; } else { Ab = g.A2; lda = g.lda2; kk = k0 - g.ksplit; }
#pragma unroll
    for (int i = 0; i < 4; ++i) {
      int id = tid + 512 * i; int r = id >> 3, c = (id & 7) * 8;
      ra[i] = *(const u32x4*)(Ab + (size_t)(m0 + r) * lda + kk + c);
    }
#pragma unroll
    for (int i = 0; i < 2; ++i) {
      int id = tid + 512 * i; int r = id >> 3, c = (id & 7) * 8;
      rb[i] = *(const u32x4*)(g.Bt + (size_t)(n0 + r) * g.K + k0 + c);
    }
  };
  loadg(0);
  for (int kt = 0; kt < KT; ++kt) {
#pragma unroll
    for (int i = 0; i < 4; ++i) {
      int id = tid + 512 * i; int r = id >> 3, c = (id & 7) * 8;
      *(u32x4*)(As + r * 72 + c) = ra[i];
    }
#pragma unroll
    for (int i = 0; i < 2; ++i) {
      int id = tid + 512 * i; int r = id >> 3, c = (id & 7) * 8;
      *(u32x4*)(Bs + r * 72 + c) = rb[i];
    }
    __syncthreads();
    if (kt + 1 < KT) loadg(kt + 1);
    if (EPI == 1) {
      if ((kt << 6) == g.ksplit) {
#pragma unroll
        for (int i = 0; i < 4; ++i)
#pragma unroll
          for (int r = 0; r < 4; ++r) {
            float sc = rs[wm + i * 16 + l4 * 4 + r];
#pragma unroll
            for (int j = 0; j < 4; ++j) acc[i][j][r] *= sc;
          }
      }
    }
#pragma unroll
    for (int ks = 0; ks < 2; ++ks) {
      bf16x8 a[4], b[4];
#pragma unroll
      for (int i = 0; i < 4; ++i) a[i] = *(const bf16x8*)(As + (wm + i * 16 + l15) * 72 + ks * 32 + l4 * 8);
#pragma unroll
      for (int j = 0; j < 4; ++j) b[j] = *(const bf16x8*)(Bs + (wn + j * 16 + l15) * 72 + ks * 32 + l4 * 8);
#pragma unroll
      for (int i = 0; i < 4; ++i)
#pragma unroll
        for (int j = 0; j < 4; ++j) acc[i][j] = MFMA16(a[i], b[j], acc[i][j]);
    }
    __syncthreads();
  }
#pragma unroll
  for (int i = 0; i < 4; ++i) {
    const int rbase = m0 + wm + i * 16 + l4 * 4;
#pragma unroll
    for (int j = 0; j < 4; ++j) {
      const int col = n0 + wn + j * 16 + l15;
      if (EPI == 0) {
        if (col < LDC0) {
          u16* C = (u16*)(p.ws + OFF_C0A);
#pragma unroll
          for (int r = 0; r < 4; ++r) C[(size_t)(rbase + r) * LDC0 + col] = f2bf(acc[i][j][r]);
        } else if (col < 6688) {
          u16* UT = (u16*)(p.ws + OFF_UT);
          u32x2 o; o[0] = pk2(acc[i][j][0], acc[i][j][1]); o[1] = pk2(acc[i][j][2], acc[i][j][3]);
          *(u32x2*)(UT + (size_t)(col - LDC0) * UTP + rbase) = o;
        }
      } else if (EPI == 1) {
        float* X1 = (float*)(p.ws + OFF_X1);
        const float* mod = (const float*)(p.ws + OFF_MOD);
#pragma unroll
        for (int r = 0; r < 4; ++r) {
          int row = rbase + r;
          const float* xs = row < NPROMPT ? p.in[0] + (size_t)row * 1024 : p.in[1] + (size_t)(row - NPROMPT) * 1024;
          float gate = mod[(0 * 3 + row_group(row)) * 3072 + 2048 + col];
          X1[(size_t)row * 1024 + col] = xs[col] + gate * acc[i][j][r];
        }
      } else if (EPI == 2) {
        u16* C1 = (u16*)(p.ws + OFF_C1);
#pragma unroll
        for (int r = 0; r < 4; ++r) {
          int row = rbase + r;
          C1[(size_t)row * LDC1 + col] = f2bf(acc[i][j][r]);
          if (row < NPROMPT && col >= 1024 && col < 3072) {
            int cc = col - 1024; int isv = cc >> 10; cc &= 1023;
            int hh = cc >> 6, d = cc & 63; int b = row >> 8, l = row & 255;
            float* o = p.out + (isv ? O_NV : O_NK);
            o[(((size_t)b * 16 + hh) * 256 + l) * 64 + d] = acc[i][j][r];
          }
        }
      } else {
        const float* X1 = (const float*)(p.ws + OFF_X1);
        const float* mod = (const float*)(p.ws + OFF_MOD);
#pragma unroll
        for (int r = 0; r < 4; ++r) {
          int row = rbase + r;
          float gate = mod[(1 * 3 + row_group(row)) * 3072 + 2048 + col];
          p.out[(size_t)row * 1024 + col] = X1[(size_t)row * 1024 + col] + gate * acc[i][j][r];
        }
      }
    }
  }
}


DI int lds_byte(int r, int c) {
  int st = (r >> 4) * 2 + (c >> 5), rr = r & 15, cc = c & 31, ob = rr * 64 + cc * 2;
  return st * 1024 + (ob ^ (((ob >> 9) & 1) << 5));
}
DI void stage_rc(int b, int& R, int& C) {
  int st = b / 1024, sb = b % 1024, swz = sb ^ (((sb >> 9) & 1) << 5);
  R = (st >> 1) * 16 + swz / 64; C = (st & 1) * 32 + (swz % 64) / 2;
}
template <int EPI>
DI void epi_store(const Params& p, int rbase, int col, const f32x4& v) {
  if (EPI == 0) {
    if (col < LDC0) {
      u16* C = (u16*)(p.ws + OFF_C0A);
#pragma unroll
      for (int r = 0; r < 4; ++r) C[(size_t)(rbase + r) * LDC0 + col] = f2bf(v[r]);
    } else if (col < 6688) {
      u16* UT = (u16*)(p.ws + OFF_UT);
      u32x2 o; o[0] = pk2(v[0], v[1]); o[1] = pk2(v[2], v[3]);
      *(u32x2*)(UT + (size_t)(col - LDC0) * UTP + rbase) = o;
    }
  } else if (EPI == 1) {
    float* X1 = (float*)(p.ws + OFF_X1);
    const float* mod = (const float*)(p.ws + OFF_MOD);
#pragma unroll
    for (int r = 0; r < 4; ++r) {
      int row = rbase + r;
      const float* xs = row < NPROMPT ? p.in[0] + (size_t)row * 1024 : p.in[1] + (size_t)(row - NPROMPT) * 1024;
      float gate = mod[(0 * 3 + row_group(row)) * 3072 + 2048 + col];
      X1[(size_t)row * 1024 + col] = xs[col] + gate * v[r];
    }
  } else if (EPI == 2) {
    u16* C1 = (u16*)(p.ws + OFF_C1);
#pragma unroll
    for (int r = 0; r < 4; ++r) {
      int row = rbase + r;
      C1[(size_t)row * LDC1 + col] = f2bf(v[r]);
      if (row < NPROMPT && col >= 1024 && col < 3072) {
        int cc = col - 1024; int isv = cc >> 10; cc &= 1023;
        int hh = cc >> 6, d = cc & 63; int b = row >> 8, l = row & 255;
        float* o = p.out + (isv ? O_NV : O_NK);
        o[(((size_t)b * 16 + hh) * 256 + l) * 64 + d] = v[r];
      }
    }
  } else {
    const float* X1 = (const float*)(p.ws + OFF_X1);
    const float* mod = (const float*)(p.ws + OFF_MOD);
#pragma unroll
    for (int r = 0; r < 4; ++r) {
      int row = rbase + r;
      float gate = mod[(1 * 3 + row_group(row)) * 3072 + 2048 + col];
      p.out[(size_t)row * 1024 + col] = X1[(size_t)row * 1024 + col] + gate * v[r];
    }
  }
}

template <int EPI>
DI void epi_store_sw(const Params& p, int row, int col, const f32x4& v) {
  if (EPI == 0) {
    u16* C = (u16*)(p.ws + OFF_C0A);
    u32x2 o; o[0] = pk2(v[0], v[1]); o[1] = pk2(v[2], v[3]);
    *(u32x2*)(C + (size_t)row * LDC0 + col) = o;
  } else if (EPI == 1) {
    float* X1 = (float*)(p.ws + OFF_X1);
    const float* mod = (const float*)(p.ws + OFF_MOD);
    const float* xs = row < NPROMPT ? p.in[0] + (size_t)row * 1024 : p.in[1] + (size_t)(row - NPROMPT) * 1024;
    const float4 xv = *(const float4*)(xs + col);
    const float4 gt = *(const float4*)(mod + (0 * 3 + row_group(row)) * 3072 + 2048 + col);
    float4 o; o.x = xv.x + gt.x * v[0]; o.y = xv.y + gt.y * v[1]; o.z = xv.z + gt.z * v[2]; o.w = xv.w + gt.w * v[3];
    *(float4*)(X1 + (size_t)row * 1024 + col) = o;
  } else if (EPI == 2) {
    u16* C1 = (u16*)(p.ws + OFF_C1);
    u32x2 o; o[0] = pk2(v[0], v[1]); o[1] = pk2(v[2], v[3]);
    *(u32x2*)(C1 + (size_t)row * LDC1 + col) = o;
    if (row < NPROMPT && col >= 1024 && col < 3072) {
      int cc = col - 1024; int isv = cc >> 10; cc &= 1023;
      int hh = cc >> 6, d = cc & 63; int b = row >> 8, l = row & 255;
      float* op = p.out + (isv ? O_NV : O_NK);
      *(float4*)(op + (((size_t)b * 16 + hh) * 256 + l) * 64 + d) = make_float4(v[0], v[1], v[2], v[3]);
    }
  } else {
    const float* X1 = (const float*)(p.ws + OFF_X1);
    const float* mod = (const float*)(p.ws + OFF_MOD);
    const float4 xv = *(const float4*)(X1 + (size_t)row * 1024 + col);
    const float4 gt = *(const float4*)(mod + (1 * 3 + row_group(row)) * 3072 + 2048 + col);
    float4 o; o.x = xv.x + gt.x * v[0]; o.y = xv.y + gt.y * v[1]; o.z = xv.z + gt.z * v[2]; o.w = xv.w + gt.w * v[3];
    *(float4*)(p.out + (size_t)row * 1024 + col) = o;
  }
}

template <int EPI, bool SWAP>
DI void gemm256(const Params& p, const GemmArgs& g, int brow, int bcol, unsigned char* smem) {
  constexpr int HT = 128 * 64;
  u16* shm = (u16*)smem;
  float* rs = (float*)(smem + 131072);
  const int K = g.K;
#define SA(b, h) (shm + ((b) * 2 + (h)) * HT)
#define SB(b, h) (shm + (4 + (b) * 2 + (h)) * HT)
#define STAGE_A(P, br, kt) do { const u16* _ub = g.A1 + (long)(br) * g.lda1 + (long)(kt) * 64; \
    for (int _i = 0; _i < 2; ++_i) { \
      __builtin_amdgcn_global_load_lds((const unsigned*)((const char*)(_ub + (long)_i * 64 * g.lda1) + aoff1), \
        (__attribute__((address_space(3))) unsigned*)((char*)(P) + threadIdx.x * 16 + _i * 8192), 16, 0, 0); } } while (0)
#define STAGE_B(P, bc, kt) do { const u16* _ub = g.Bt + (long)(bc) * K + (long)(kt) * 64; \
    for (int _i = 0; _i < 2; ++_i) { \
      __builtin_amdgcn_global_load_lds((const unsigned*)((const char*)(_ub + (long)_i * 64 * K) + boff), \
        (__attribute__((address_space(3))) unsigned*)((char*)(P) + threadIdx.x * 16 + _i * 8192), 16, 0, 0); } } while (0)
#define LDA(dst, b, h) for (int m = 0; m < 4; ++m) for (int k = 0; k < 2; ++k) \
    dst[m][k] = *reinterpret_cast<const bf16x8*>((char*)SA(b, h) + lds_byte(wr * 64 + m * 16 + fr, k * 32 + fq * 8))
#define LDB(dst, b, h) for (int n = 0; n < 2; ++n) for (int k = 0; k < 2; ++k) \
    dst[n][k] = *reinterpret_cast<const bf16x8*>((char*)SB(b, h) + lds_byte(wc * 32 + n * 16 + fr, k * 32 + fq * 8))
#define MMA(ai, bj, At_, Bt_) do { __builtin_amdgcn_s_setprio(1); \
    for (int m = 0; m < 4; ++m) for (int n = 0; n < 2; ++n) for (int k = 0; k < 2; ++k) \
      acc[ai][bj][m][n] = SWAP ? __builtin_amdgcn_mfma_f32_16x16x32_bf16(Bt_[n][k], At_[m][k], acc[ai][bj][m][n], 0, 0, 0) \
                               : __builtin_amdgcn_mfma_f32_16x16x32_bf16(At_[m][k], Bt_[n][k], acc[ai][bj][m][n], 0, 0, 0); \
    __builtin_amdgcn_s_setprio(0); } while (0)
#define WAIT_V(n) asm volatile("s_waitcnt vmcnt(" #n ")" ::: "memory")
#define WAIT_L(n) asm volatile("s_waitcnt lgkmcnt(" #n ")" ::: "memory")
#define BAR __builtin_amdgcn_s_barrier()
#define SCHED __builtin_amdgcn_sched_barrier(0)
  const int wid = threadIdx.x >> 6, lane = threadIdx.x & 63, wr = wid >> 2, wc = wid & 3, fr = lane & 15, fq = lane >> 4;
  unsigned aoff1, boff;
  {
    int r_, c_; stage_rc(threadIdx.x * 16, r_, c_);
    aoff1 = (unsigned)(r_ * g.lda1 + c_) * 2u;
    boff = (unsigned)(r_ * K + c_) * 2u;
  }
  if (EPI == 1) {
    if (threadIdx.x < 256) {
      const float* rss = (const float*)(p.ws + OFF_ROWSS) + (size_t)(brow + threadIdx.x) * 16;
      float s = 0.f;
#pragma unroll
      for (int q = 0; q < 16; ++q) s += rss[q];
      rs[threadIdx.x] = rsqrtf(s * (1.f / 1024.f) + 1e-6f);
    }
  }
  WAIT_V(0);
  __syncthreads();
  f32x4 acc[2][2][4][2];
#pragma unroll
  for (int a = 0; a < 2; ++a)
#pragma unroll
    for (int b = 0; b < 2; ++b)
#pragma unroll
      for (int m = 0; m < 4; ++m)
#pragma unroll
        for (int n = 0; n < 2; ++n) acc[a][b][m][n] = (f32x4){0.f, 0.f, 0.f, 0.f};
  bf16x8 At[4][2], B0[2][2], B1[2][2];
  const int nt = K / 64;
  const int tscale = (EPI == 1) ? (g.ksplit >> 6) : -1;
  STAGE_B(SB(0, 0), bcol, 0); STAGE_A(SA(0, 0), brow, 0);
  STAGE_B(SB(0, 1), bcol + 128, 0); STAGE_A(SA(0, 1), brow + 128, 0);
  if (wr == 1) BAR;
  WAIT_V(4); BAR;
  STAGE_B(SB(1, 0), bcol, 1); STAGE_A(SA(1, 0), brow, 1); STAGE_B(SB(1, 1), bcol + 128, 1);
  WAIT_V(6); BAR;
  for (int t = 0; t < nt - 2; t += 2) {
    if (EPI == 1) {
      if (t == tscale) {
#pragma unroll
        for (int a = 0; a < 2; ++a)
#pragma unroll
          for (int m = 0; m < 4; ++m)
#pragma unroll
            for (int j = 0; j < 4; ++j) {
              float sc = SWAP ? rs[a * 128 + wr * 64 + m * 16 + fr] : rs[a * 128 + wr * 64 + m * 16 + fq * 4 + j];
#pragma unroll
              for (int b = 0; b < 2; ++b)
#pragma unroll
                for (int n = 0; n < 2; ++n) acc[a][b][m][n][j] *= sc;
            }
      }
    }
    LDB(B0, 0, 0); SCHED; LDA(At, 0, 0); STAGE_A(SA(1, 1), brow + 128, t + 1);
    WAIT_L(8); BAR; WAIT_L(0); MMA(0, 0, At, B0); BAR; SCHED;
    LDB(B1, 0, 1); STAGE_B(SB(0, 0), bcol, t + 2);
    BAR; WAIT_L(0); MMA(0, 1, At, B1); BAR;
    LDA(At, 0, 1); STAGE_A(SA(0, 0), brow, t + 2);
    BAR; WAIT_L(0); MMA(1, 0, At, B0); BAR; SCHED;
    STAGE_B(SB(0, 1), bcol + 128, t + 2);
    WAIT_V(6); BAR; MMA(1, 1, At, B1); BAR;
    LDB(B0, 1, 0); SCHED; LDA(At, 1, 0); STAGE_A(SA(0, 1), brow + 128, t + 2);
    WAIT_L(8); BAR; WAIT_L(0); MMA(0, 0, At, B0); BAR; SCHED;
    LDB(B1, 1, 1); STAGE_B(SB(1, 0), bcol, t + 3);
    BAR; WAIT_L(0); MMA(0, 1, At, B1); BAR;
    LDA(At, 1, 1); STAGE_A(SA(1, 0), brow, t + 3);
    BAR; WAIT_L(0); MMA(1, 0, At, B0); BAR; SCHED;
    STAGE_B(SB(1, 1), bcol + 128, t + 3);
    WAIT_V(6); BAR; MMA(1, 1, At, B1); BAR;
  }
  { LDB(B0, 0, 0); LDA(At, 0, 0); STAGE_A(SA(1, 1), brow + 128, nt - 1);
    BAR; WAIT_L(0); MMA(0, 0, At, B0); BAR;
    LDB(B1, 0, 1); BAR; WAIT_L(0); MMA(0, 1, At, B1); BAR;
    LDA(At, 0, 1); WAIT_V(4); BAR; WAIT_L(0); MMA(1, 0, At, B0); MMA(1, 1, At, B1); BAR; }
  { LDB(B0, 1, 0); LDA(At, 1, 0); WAIT_V(2); BAR; WAIT_L(0); MMA(0, 0, At, B0); BAR;
    LDB(B1, 1, 1); WAIT_V(0); BAR; WAIT_L(0); MMA(0, 1, At, B1); BAR;
    LDA(At, 1, 1); BAR; WAIT_L(0); MMA(1, 0, At, B0); MMA(1, 1, At, B1); BAR; }
  if (wr == 0) BAR;
  int e_tid = threadIdx.x, e_brow = brow, e_bcol = bcol;
  asm volatile("" : "+v"(e_tid), "+s"(e_brow), "+s"(e_bcol));
  const int e_row = SWAP ? e_brow + ((e_tid >> 8) & 1) * 64 + (e_tid & 15) : e_brow + ((e_tid >> 8) & 1) * 64 + ((e_tid >> 4) & 3) * 4;
  const int e_col = SWAP ? e_bcol + ((e_tid >> 6) & 3) * 32 + ((e_tid >> 4) & 3) * 4 : e_bcol + ((e_tid >> 6) & 3) * 32 + (e_tid & 15);
#pragma unroll
  for (int ai = 0; ai < 2; ++ai)
#pragma unroll
    for (int bj = 0; bj < 2; ++bj)
#pragma unroll
      for (int m = 0; m < 4; ++m)
#pragma unroll
        for (int n = 0; n < 2; ++n) {
          if (SWAP) epi_store_sw<EPI>(p, e_row + ai * 128 + m * 16, e_col + bj * 128 + n * 16, acc[ai][bj][m][n]);
          else epi_store<EPI>(p, e_row + ai * 128 + m * 16, e_col + bj * 128 + n * 16, acc[ai][bj][m][n]);
        }
  __syncthreads();
#undef SA
#undef SB
#undef STAGE_A
#undef STAGE_B
#undef LDA
#undef LDB
#undef MMA
#undef WAIT_V
#undef WAIT_L
#undef BAR
#undef SCHED
}
DI bool gemm_tile_coord(int round, int NN, int ntiles, int& pm, int& pn) {
  const int b = blockIdx.x;
  const int v = round * 256 + (b & 7) * 32 + (b >> 3);
  if (v >= ntiles) return false;
  pm = (v / (8 * NN)) * 8 + (v & 7);
  pn = (v >> 3) % NN;
  return true;
}
struct SsdItem { int row0; int h; int has_prev; int has_next; };
DI SsdItem ssd_item(int item) {
  SsdItem s;
  int cgi = item >> 4; s.h = item & 15;
  if (cgi < 64) { int seq = cgi >> 1, c = cgi & 1; s.row0 = seq * 256 + c * 128; s.has_prev = c > 0; s.has_next = c < 1; }
  else { int q = cgi - 64; int seq = q >> 5, c = q & 31; s.row0 = NPROMPT + seq * 4096 + c * 128; s.has_prev = c > 0; s.has_next = c < 31; }
  return s;
}
DI float ssd_load_dt(const Params& p, int row0, int h) {
  const int tid = threadIdx.x;
  const u16* C0 = (const u16*)(p.ws + OFF_C0A);
  float raw = 0.f;
  if (tid < 256) { int d = tid >> 7, l = tid & 127; raw = bf2f(C0[(size_t)(row0 + l) * LDC0 + 2560 + d * 16 + h]); }
  return raw;
}
DI void ssd_prep_dt(const Params& p, float raw, int h, float* sdt, float* scs, float* stot) {
  const int tid = threadIdx.x, lane = tid & 63, w = tid >> 6;
  if (tid < 256) {
    int d = tid >> 7, l = tid & 127;
    float x = raw + p.in[14][d * 16 + h];
    float dt = x > 20.f ? x : log1pf(expf(x));
    float a = -expf(p.in[15][d * 16 + h]);
    sdt[d * 128 + l] = dt;
    scs[d * 128 + l] = a * dt;
  }
  __syncthreads();
  if (w < 2) {
    const int d = w;
    int p0 = d == 0 ? 2 * lane : 127 - 2 * lane;
    int p1 = d == 0 ? 2 * lane + 1 : 126 - 2 * lane;
    float v0 = scs[d * 128 + p0], v1 = scs[d * 128 + p1];
    float s = v0 + v1;
#pragma unroll
    for (int off = 1; off < 64; off <<= 1) {
      float tv = __shfl_up(s, off);
      if (lane >= off) s += tv;
    }
    float excl = s - (v0 + v1);
    scs[d * 128 + p0] = excl + v0;
    scs[d * 128 + p1] = excl + v0 + v1;
    if (lane == 63) stot[d] = s;
  }
  __syncthreads();
}
DI void conv_silu8(const Params& p, int row, int ch0, bool hp, bool hn, float* out) {
  const u16* C0 = (const u16*)(p.ws + OFF_C0A);
  const u16* q = C0 + (size_t)row * LDC0 + 1024 + ch0;
  const float* cw = p.in[12]; const float* cb = p.in[13];
  float xm[8], xc[8], xp[8];
  u32x4 vc = *(const u32x4*)q;
  unpack8(vc, xc);
  if (hp) { u32x4 v = *(const u32x4*)(q - LDC0); unpack8(v, xm); } else {
#pragma unroll
    for (int e = 0; e < 8; ++e) xm[e] = 0.f;
  }
  if (hn) { u32x4 v = *(const u32x4*)(q + LDC0); unpack8(v, xp); } else {
#pragma unroll
    for (int e = 0; e < 8; ++e) xp[e] = 0.f;
  }
  float4 w0a = *(const float4*)(cw + ch0), w0b = *(const float4*)(cw + ch0 + 4);
  float4 w1a = *(const float4*)(cw + 1536 + ch0), w1b = *(const float4*)(cw + 1536 + ch0 + 4);
  float4 w2a = *(const float4*)(cw + 3072 + ch0), w2b = *(const float4*)(cw + 3072 + ch0 + 4);
  float4 ba = *(const float4*)(cb + ch0), bb = *(const float4*)(cb + ch0 + 4);
  float w0[8] = {w0a.x, w0a.y, w0a.z, w0a.w, w0b.x, w0b.y, w0b.z, w0b.w};
  float w1[8] = {w1a.x, w1a.y, w1a.z, w1a.w, w1b.x, w1b.y, w1b.z, w1b.w};
  float w2[8] = {w2a.x, w2a.y, w2a.z, w2a.w, w2b.x, w2b.y, w2b.z, w2b.w};
  float bv[8] = {ba.x, ba.y, ba.z, ba.w, bb.x, bb.y, bb.z, bb.w};
#pragma unroll
  for (int e = 0; e < 8; ++e) out[e] = silu(bv[e] + w0[e] * xm[e] + w1[e] * xc[e] + w2[e] * xp[e]);
}


template <int R>
DI void conv_load(const Params& p, int row0, int l0, int ch0, bool prev_chunk, bool next_chunk, u32x4 (&raw)[R + 2]) {
  const u16* C0 = (const u16*)(p.ws + OFF_C0A);
  const u16* q = C0 + (size_t)(row0 + l0) * LDC0 + 1024 + ch0;
  const bool hp = (l0 > 0) || prev_chunk;
  const bool hn = (l0 + R < 128) || next_chunk;
#pragma unroll
  for (int i = 0; i < R + 2; ++i) {
    const bool ok = (i == 0) ? hp : ((i == R + 1) ? hn : true);
    raw[i] = (u32x4){0u, 0u, 0u, 0u};
    if (ok) raw[i] = *(const u32x4*)(q + (long)(i - 1) * LDC0);
  }
}
template <int R>
DI void conv_compute(const Params& p, int ch0, const u32x4 (&raw)[R + 2], float (&out)[R][8]) {
  const float* cw = p.in[12]; const float* cb = p.in[13];
  float4 w0a = *(const float4*)(cw + ch0), w0b = *(const float4*)(cw + ch0 + 4);
  float4 w1a = *(const float4*)(cw + 1536 + ch0), w1b = *(const float4*)(cw + 1536 + ch0 + 4);
  float4 w2a = *(const float4*)(cw + 3072 + ch0), w2b = *(const float4*)(cw + 3072 + ch0 + 4);
  float4 ba = *(const float4*)(cb + ch0), bb = *(const float4*)(cb + ch0 + 4);
  const float w0[8] = {w0a.x, w0a.y, w0a.z, w0a.w, w0b.x, w0b.y, w0b.z, w0b.w};
  const float w1[8] = {w1a.x, w1a.y, w1a.z, w1a.w, w1b.x, w1b.y, w1b.z, w1b.w};
  const float w2[8] = {w2a.x, w2a.y, w2a.z, w2a.w, w2b.x, w2b.y, w2b.z, w2b.w};
  const float bv[8] = {ba.x, ba.y, ba.z, ba.w, bb.x, bb.y, bb.z, bb.w};
  float xm[8], xc[8], xp[8];
  unpack8(raw[0], xm); unpack8(raw[1], xc);
#pragma unroll
  for (int i = 0; i < R; ++i) {
    unpack8(raw[i + 2], xp);
#pragma unroll
    for (int e = 0; e < 8; ++e) {
      out[i][e] = silu(bv[e] + w0[e] * xm[e] + w1[e] * xc[e] + w2[e] * xp[e]);
      xm[e] = xc[e]; xc[e] = xp[e];
    }
  }
}
DI void phase_ssd_states(const Params& p, int item, unsigned char* smem) {
  u16* xT = (u16*)smem;
  u16* BTs = xT + 64 * 136;
  float* sdt = (float*)(BTs + 2 * 128 * 136);
  float* scs = sdt + 256;
  float* sw = scs + 256;
  float* stot = sw + 256;
  const int tid = threadIdx.x, lane = tid & 63, w = tid >> 6;
  const int l15 = lane & 15, l4 = lane >> 4;
  const SsdItem it = ssd_item(item);
  const int h = it.h, grp = h >> 3;
  const int xchunk = tid & 7, xrg = tid >> 3;
  const int bchunk = tid & 15, brg = tid >> 4;
  u32x4 rawx[4], rawb[6];
  const float rawdt = ssd_load_dt(p, it.row0, h);
  conv_load<2>(p, it.row0, xrg * 2, h * 64 + xchunk * 8, it.has_prev, it.has_next, rawx);
  conv_load<4>(p, it.row0, brg * 4, 1024 + grp * 128 + bchunk * 8, it.has_prev, it.has_next, rawb);
  ssd_prep_dt(p, rawdt, h, sdt, scs, stot);
  if (tid < 256) {
    int d = tid >> 7;
    sw[tid] = sdt[tid] * __expf(stot[d] - scs[tid]);
  }
  __syncthreads();
  {
    {
      float o[2][8];
      conv_compute<2>(p, h * 64 + xchunk * 8, rawx, o);
#pragma unroll
      for (int e = 0; e < 8; ++e) *(unsigned*)(xT + (xchunk * 8 + e) * 136 + xrg * 2) = pk2(o[0][e], o[1][e]);
    }
    {
      float o[4][8];
      conv_compute<4>(p, 1024 + grp * 128 + bchunk * 8, rawb, o);
#pragma unroll
      for (int dd = 0; dd < 2; ++dd) {
        const float s0 = sw[dd * 128 + brg * 4], s1 = sw[dd * 128 + brg * 4 + 1], s2 = sw[dd * 128 + brg * 4 + 2], s3 = sw[dd * 128 + brg * 4 + 3];
#pragma unroll
        for (int e = 0; e < 8; ++e) {
          u32x2 v; v[0] = pk2(o[0][e] * s0, o[1][e] * s1); v[1] = pk2(o[2][e] * s2, o[3][e] * s3);
          *(u32x2*)(BTs + dd * 128 * 136 + (bchunk * 8 + e) * 136 + brg * 4) = v;
        }
      }
    }
  }
  __syncthreads();
  const int d = w >> 2, nq = w & 3;
  f32x4 acc[4][2];
#pragma unroll
  for (int i = 0; i < 4; ++i) { acc[i][0] = (f32x4){0.f, 0.f, 0.f, 0.f}; acc[i][1] = (f32x4){0.f, 0.f, 0.f, 0.f}; }
#pragma unroll
  for (int ks = 0; ks < 4; ++ks) {
    bf16x8 a[4], b[2];
#pragma unroll
    for (int i = 0; i < 4; ++i) a[i] = *(const bf16x8*)(xT + (i * 16 + l15) * 136 + ks * 32 + l4 * 8);
#pragma unroll
    for (int j = 0; j < 2; ++j) b[j] = *(const bf16x8*)(BTs + d * 128 * 136 + (nq * 32 + j * 16 + l15) * 136 + ks * 32 + l4 * 8);
#pragma unroll
    for (int i = 0; i < 4; ++i)
#pragma unroll
      for (int j = 0; j < 2; ++j) acc[i][j] = MFMA16(a[i], b[j], acc[i][j]);
  }
  u16* S = (u16*)((unsigned char*)p.out + OUT_SBUF) + ((size_t)item * 2 + d) * 8192;
#pragma unroll
  for (int i = 0; i < 4; ++i)
#pragma unroll
    for (int j = 0; j < 2; ++j)
#pragma unroll
      for (int r = 0; r < 4; ++r) {
        int pp = i * 16 + l4 * 4 + r, n = nq * 32 + j * 16 + l15;
        S[pp * 128 + n] = f2bf(acc[i][j][r]);
      }
  if (tid < 2) {
    float* cdec = (float*)(p.ws + OFF_CDEC);
    cdec[item * 2 + tid] = __expf(stot[tid]);
  }
  __syncthreads();
}

DI void phase_scan(const Params& p, int t) {
  const int part = t & 1, d = (t >> 1) & 1, h = (t >> 2) & 15, seq = t >> 6;
  const int tid = threadIdx.x;
  const int e0 = part * 4096 + tid * 8;
  const int nc = seq < 32 ? 2 : 32;
  const int cg0 = seq < 32 ? seq * 2 : 64 + (seq - 32) * 32;
  float st[8];
  if (seq < 32) {
#pragma unroll
    for (int e = 0; e < 8; ++e) st[e] = 0.f;
  } else {
    const float* init = p.in[2] + ((((size_t)(seq - 32) * 1 + 0) * 2 + d) * 16 + h) * 8192 + e0;
    float4 a = *(const float4*)init, b = *(const float4*)(init + 4);
    st[0] = a.x; st[1] = a.y; st[2] = a.z; st[3] = a.w; st[4] = b.x; st[5] = b.y; st[6] = b.z; st[7] = b.w;
  }
  u16* Sb = (u16*)((unsigned char*)p.out + OUT_SBUF);
  const float* cdec = (const float*)(p.ws + OFF_CDEC);
  for (int cb0 = 0; cb0 < nc; cb0 += 8) {
    u32x4 vv[8]; float dec[8];
#pragma unroll
    for (int i = 0; i < 8; ++i) {
      if (cb0 + i < nc) {
        const int ci = cb0 + i;
        const int c = d == 0 ? ci : nc - 1 - ci;
        const int item = (cg0 + c) * 16 + h;
        vv[i] = *(const u32x4*)(Sb + ((size_t)item * 2 + d) * 8192 + e0);
        dec[i] = cdec[item * 2 + d];
      }
    }
#pragma unroll
    for (int i = 0; i < 8; ++i) {
      if (cb0 + i < nc) {
        const int ci = cb0 + i;
        const int c = d == 0 ? ci : nc - 1 - ci;
        const int item = (cg0 + c) * 16 + h;
        float sc[8]; unpack8(vv[i], sc);
        *(u32x4*)(Sb + ((size_t)item * 2 + d) * 8192 + e0) = pack8(st);
#pragma unroll
        for (int e = 0; e < 8; ++e) st[e] = st[e] * dec[i] + sc[e];
      }
    }
  }
  if (seq < 32) {
    float* o = p.out + O_ST + ((((size_t)seq * 1 + 0) * 2 + d) * 16 + h) * 8192 + e0;
    *(float4*)o = make_float4(st[0], st[1], st[2], st[3]);
    *(float4*)(o + 4) = make_float4(st[4], st[5], st[6], st[7]);
  }
}

DI void phase_ssd_out(const Params& p, int item, unsigned char* smem, bool dry) {
  u16* Cs = (u16*)smem;
  u16* Bs = Cs + 128 * 136;
  u16* xT = Bs + 128 * 136;
  u16* St = xT + 64 * 136;
  float* sdt = (float*)(St + 2 * 64 * 136);
  float* scs = sdt + 256;
  float* stot = scs + 256;
  const int tid = threadIdx.x, lane = tid & 63, w = tid >> 6;
  const int l15 = lane & 15, l4 = lane >> 4;
  const SsdItem it = ssd_item(item);
  const int h = it.h, grp = h >> 3;
  const int xchunk = tid & 7, xrg = tid >> 3;
  const int bchunk = tid & 15, brg = tid >> 4;
  u32x4 rawx[4], rawb[6], rawc[6], rawst[4];
  u16 zraw[4][4];
  const float rawdt = ssd_load_dt(p, it.row0, h);
  conv_load<2>(p, it.row0, xrg * 2, h * 64 + xchunk * 8, it.has_prev, it.has_next, rawx);
  conv_load<4>(p, it.row0, brg * 4, 1024 + grp * 128 + bchunk * 8, it.has_prev, it.has_next, rawb);
  conv_load<4>(p, it.row0, brg * 4, 1280 + grp * 128 + bchunk * 8, it.has_prev, it.has_next, rawc);
  {
    const u16* S = (const u16*)((const unsigned char*)p.out + OUT_SBUF) + (size_t)item * 2 * 8192;
#pragma unroll
    for (int v = 0; v < 4; ++v) {
      int id = tid + 512 * v;
      int dd = id >> 10, pp = (id >> 4) & 63, nv = (id & 15) * 8;
      rawst[v] = *(const u32x4*)(S + dd * 8192 + pp * 128 + nv);
    }
  }
  ssd_prep_dt(p, rawdt, h, sdt, scs, stot);
  {
    {
      float o[2][8];
      conv_compute<2>(p, h * 64 + xchunk * 8, rawx, o);
#pragma unroll
      for (int e = 0; e < 8; ++e) *(unsigned*)(xT + (xchunk * 8 + e) * 136 + xrg * 2) = pk2(o[0][e], o[1][e]);
    }
    {
      float o[4][8];
      conv_compute<4>(p, 1024 + grp * 128 + bchunk * 8, rawb, o);
#pragma unroll
      for (int i = 0; i < 4; ++i) *(u32x4*)(Bs + (brg * 4 + i) * 136 + bchunk * 8) = pack8(o[i]);
      conv_compute<4>(p, 1280 + grp * 128 + bchunk * 8, rawc, o);
#pragma unroll
      for (int i = 0; i < 4; ++i) *(u32x4*)(Cs + (brg * 4 + i) * 136 + bchunk * 8) = pack8(o[i]);
    }
#pragma unroll
    for (int v = 0; v < 4; ++v) {
      int id = tid + 512 * v;
      int dd = id >> 10, pp = (id >> 4) & 63, nv = (id & 15) * 8;
      *(u32x4*)(St + dd * 64 * 136 + pp * 136 + nv) = rawst[v];
    }
  }
  __syncthreads();
  {
    const u16* C0z = (const u16*)(p.ws + OFF_C0A);
#pragma unroll
    for (int i = 0; i < 4; ++i)
#pragma unroll
      for (int r = 0; r < 4; ++r)
        zraw[i][r] = C0z[(size_t)(it.row0 + 16 * w + l4 * 4 + r) * LDC0 + h * 64 + i * 16 + l15];
  }
  f32x4 cb[8], af[4], ab[4];
#pragma unroll
  for (int j = 0; j < 8; ++j) cb[j] = (f32x4){0.f, 0.f, 0.f, 0.f};
#pragma unroll
  for (int i = 0; i < 4; ++i) { af[i] = (f32x4){0.f, 0.f, 0.f, 0.f}; ab[i] = (f32x4){0.f, 0.f, 0.f, 0.f}; }
#pragma unroll
  for (int ks = 0; ks < 4; ++ks) {
    bf16x8 a = *(const bf16x8*)(Cs + (16 * w + l15) * 136 + ks * 32 + l4 * 8);
#pragma unroll
    for (int j = 0; j < 8; ++j) {
      bf16x8 b = *(const bf16x8*)(Bs + (j * 16 + l15) * 136 + ks * 32 + l4 * 8);
      cb[j] = MFMA16(b, a, cb[j]);
    }
#pragma unroll
    for (int i = 0; i < 4; ++i) {
      bf16x8 b0 = *(const bf16x8*)(St + (i * 16 + l15) * 136 + ks * 32 + l4 * 8);
      bf16x8 b1 = *(const bf16x8*)(St + 64 * 136 + (i * 16 + l15) * 136 + ks * 32 + l4 * 8);
      af[i] = MFMA16(a, b0, af[i]);
      ab[i] = MFMA16(a, b1, ab[i]);
    }
  }
  __syncthreads();
  f32x4 Y[4];
  {
    const int lrow = 16 * w + l15;
    const float cs0l = scs[lrow], cs1l = scs[128 + lrow];
#pragma unroll
    for (int j = 0; j < 8; ++j) {
      const int s0 = j * 16 + l4 * 4;
      float f[4];
      if (j < w) {
        const float4 c4 = *(const float4*)(scs + s0), d4 = *(const float4*)(sdt + s0);
        f[0] = __expf(cs0l - c4.x) * d4.x; f[1] = __expf(cs0l - c4.y) * d4.y; f[2] = __expf(cs0l - c4.z) * d4.z; f[3] = __expf(cs0l - c4.w) * d4.w;
      } else if (j > w) {
        const float4 c4 = *(const float4*)(scs + 128 + s0), d4 = *(const float4*)(sdt + 128 + s0);
        f[0] = __expf(cs1l - c4.x) * d4.x; f[1] = __expf(cs1l - c4.y) * d4.y; f[2] = __expf(cs1l - c4.z) * d4.z; f[3] = __expf(cs1l - c4.w) * d4.w;
      } else {
        const float4 c4 = *(const float4*)(scs + s0), d4 = *(const float4*)(sdt + s0);
        const float4 e4 = *(const float4*)(scs + 128 + s0), g4 = *(const float4*)(sdt + 128 + s0);
        const float c0[4] = {c4.x, c4.y, c4.z, c4.w}, d0[4] = {d4.x, d4.y, d4.z, d4.w};
        const float c1[4] = {e4.x, e4.y, e4.z, e4.w}, d1[4] = {g4.x, g4.y, g4.z, g4.w};
#pragma unroll
        for (int jj = 0; jj < 4; ++jj) {
          const int sidx = s0 + jj;
          float v;
          if (lrow > sidx) v = __expf(cs0l - c0[jj]) * d0[jj];
          else if (lrow < sidx) v = __expf(cs1l - c1[jj]) * d1[jj];
          else v = d0[jj] + d1[jj];
          f[jj] = v;
        }
      }
      u32x2 o; o[0] = pk2(cb[j][0] * f[0], cb[j][1] * f[1]); o[1] = pk2(cb[j][2] * f[2], cb[j][3] * f[3]);
      *(u32x2*)(Bs + lrow * 136 + s0) = o;
    }
#pragma unroll
    for (int r = 0; r < 4; ++r) {
      const int l = 16 * w + l4 * 4 + r;
      float e0 = __expf(scs[l]), e1 = __expf(scs[128 + l]);
#pragma unroll
      for (int i = 0; i < 4; ++i) Y[i][r] = af[i][r] * e0 + ab[i][r] * e1;
    }
  }
  __syncthreads();
#pragma unroll
  for (int ks = 0; ks < 4; ++ks) {
    bf16x8 a = *(const bf16x8*)(Bs + (16 * w + l15) * 136 + ks * 32 + l4 * 8);
#pragma unroll
    for (int i = 0; i < 4; ++i) {
      bf16x8 b = *(const bf16x8*)(xT + (i * 16 + l15) * 136 + ks * 32 + l4 * 8);
      Y[i] = MFMA16(a, b, Y[i]);
    }
  }
  {
    const u16* C0 = (const u16*)(p.ws + OFF_C0A);
    u16* YAB = dry ? (u16*)(p.ws + OFF_DUMMY) + (size_t)(blockIdx.x & 15) * 400000 - (size_t)it.row0 * 2048 : (u16*)((unsigned char*)p.out + OUT_YB);
    const float dsk = p.in[16][h] + p.in[16][16 + h];
    float ss[4] = {0.f, 0.f, 0.f, 0.f};
#pragma unroll
    for (int i = 0; i < 4; ++i) {
      const int pp = i * 16 + l15;
#pragma unroll
      for (int r = 0; r < 4; ++r) {
        const int l = 16 * w + l4 * 4 + r;
        const size_t off = (size_t)(it.row0 + l) * LDC0 + h * 64 + pp;
        float xv = bf2f(xT[pp * 136 + l]);
        float y = Y[i][r] + xv * dsk;
        float z = bf2f(zraw[i][r]);
        float gv = y * silu(z);
        YAB[(size_t)(it.row0 + l) * 2048 + h * 64 + pp] = f2bf(gv);
        ss[r] += gv * gv;
      }
    }
    float* rss = (float*)(p.ws + OFF_ROWSS);
#pragma unroll
    for (int r = 0; r < 4; ++r) {
      float s = ss[r];
      s += __shfl_xor(s, 1); s += __shfl_xor(s, 2); s += __shfl_xor(s, 4); s += __shfl_xor(s, 8);
      if (l15 == 0) rss[(size_t)(it.row0 + 16 * w + l4 * 4 + r) * 16 + h] = s;
    }
  }
  __syncthreads();
}


template <int MASK, int PART>
DI void hy_seg(int dlo, int dhi, int L, int A, const u16* hr, const u16* vx, const int (&ncol)[4], const int (&acol)[4],
               int l31, int kh, f32x16 (&acc)[4]) {
  int oz = 0;
  asm volatile("" : "+v"(oz));
#pragma unroll 1
  for (int d = dlo; d <= dhi; ++d) {
    bf16x8 af[2];
#pragma unroll
    for (int khalf = 0; khalf < 2; ++khalf) {
      const int idx0 = L - 1 - 32 * d - l31 + 16 * khalf + 8 * kh;
#pragma unroll
      for (int e = 0; e < 8; ++e) af[khalf][e] = (short)hr[idx0 + e + oz * (e + 1)];
    }
    bf16x8 bfr[4][2];
#pragma unroll
    for (int j = 0; j < 4; ++j) {
      if (MASK & (1 << j)) {
        const int asrc = acol[j] - d;
        const bool valid = (asrc >= 0) && (asrc < A);
        const int nsrc = valid ? (ncol[j] - d) : ncol[j];
#pragma unroll
        for (int khalf = 0; khalf < 2; ++khalf) {
          bf16x8 t = *(const bf16x8*)(vx + nsrc * 40 + 16 * khalf + 8 * kh);
          if ((PART & (1 << j)) && !valid) t = (bf16x8){0, 0, 0, 0, 0, 0, 0, 0};
          bfr[j][khalf] = t;
        }
      }
    }
#pragma unroll
    for (int khalf = 0; khalf < 2; ++khalf)
#pragma unroll
      for (int j = 0; j < 4; ++j)
        if (MASK & (1 << j)) acc[j] = MFMA32(af[khalf], bfr[j][khalf], acc[j]);
  }
}
DI void phase_hyena(const Params& p, int it, unsigned char* smem, bool dry) {
  const int cfg = it < 256 ? 1 : 0;
  const int c0 = (it & 255) * 4;
  const int L = cfg ? 4096 : 256;
  const int A = L >> 5;
  const int lgA = cfg ? 7 : 3;
  const int rowbase = cfg ? NPROMPT : 0;
  u16* vxs = (u16*)smem;
  u16* hrs = vxs + 4 * 10240;
  const int tid = threadIdx.x, lane = tid & 63, w = tid >> 6;
  const u16* UT = (const u16*)(p.ws + OFF_UT);
  const float* cw = p.in[18]; const float* cbv = p.in[19];
  {
    const u16* HF = (const u16*)((const unsigned char*)p.out + (cfg ? OUT_HF4096 : OUT_HF256));
    const int nv = (2 * L) >> 3;
    const int lgnv = cfg ? 10 : 6;
    {
      u32x4 fv[8];
#pragma unroll
      for (int it8 = 0; it8 < 8; ++it8) {
        const int id = tid + it8 * NT;
        fv[it8] = (u32x4){0u, 0u, 0u, 0u};
        if (id < 4 * nv) { int chh = id >> lgnv, v8 = id & (nv - 1); fv[it8] = *(const u32x4*)(HF + (size_t)(c0 + chh) * 2 * L + v8 * 8); }
      }
#pragma unroll
      for (int it8 = 0; it8 < 8; ++it8) {
        const int id = tid + it8 * NT;
        if (id < 4 * nv) { int chh = id >> lgnv, v8 = id & (nv - 1); *(u32x4*)(hrs + chh * 2 * L + v8 * 8) = fv[it8]; }
      }
    }
#pragma unroll 1
    for (int hb4 = 0; hb4 < 2; ++hb4) {
    u32x4 rv[4][2]; float hm[4][2], hp[4][2];
#pragma unroll
    for (int it8 = 0; it8 < 4; ++it8) {
      const int id = tid + (hb4 * 4 + it8) * NT;
      const int chh = id >> 10, blk8 = id & 1023;
      const int pos = blk8 * 8, tl = pos & (L - 1);
#pragma unroll
      for (int which = 1; which <= 2; ++which) {
        const u16* q = UT + (size_t)(which * 1024 + c0 + chh) * UTP + rowbase + pos;
        rv[it8][which - 1] = *(const u32x4*)q;
        hm[it8][which - 1] = (tl > 0) ? bf2f(q[-1]) : 0.f;
        hp[it8][which - 1] = (tl + 8 < L) ? bf2f(q[8]) : 0.f;
      }
    }
#pragma unroll
    for (int it8 = 0; it8 < 4; ++it8) {
      const int id = tid + (hb4 * 4 + it8) * NT;
      const int chh = id >> 10, blk8 = id & 1023;
      const int pos = blk8 * 8;
      float res[8];
#pragma unroll
      for (int e = 0; e < 8; ++e) res[e] = 1.f;
#pragma unroll
      for (int which = 1; which <= 2; ++which) {
        const int uc = which * 1024 + c0 + chh;
        float xv[10];
        unpack8(rv[it8][which - 1], xv + 1);
        xv[0] = hm[it8][which - 1]; xv[9] = hp[it8][which - 1];
        const float w0 = cw[uc], w1 = cw[3072 + uc], w2 = cw[6144 + uc], bb = cbv[uc];
#pragma unroll
        for (int e = 0; e < 8; ++e) res[e] *= (bb + w0 * xv[e] + w1 * xv[e + 1] + w2 * xv[e + 2]);
      }
      const int n = pos >> 5, k = pos & 31;
      *(u32x4*)(vxs + chh * 10240 + n * 40 + k) = pack8(res);
    }
    }
  }
  __syncthreads();
  const int ch = w >> 1, wv = w & 1;
  const int l31 = lane & 31, kh = lane >> 5;
  const u16* vx = vxs + ch * 10240;
  const u16* hr = hrs + ch * 2 * L;
  f32x16 acc[4];
#pragma unroll
  for (int j = 0; j < 4; ++j)
#pragma unroll
    for (int r = 0; r < 16; ++r) acc[j][r] = 0.f;
  int ncol[4], acol[4];
#pragma unroll
  for (int j = 0; j < 4; ++j) { ncol[j] = 128 * wv + 32 * j + l31; acol[j] = ncol[j] & (A - 1); }
  if (!(dry && REP_SUB == 4)) {
  if (cfg) {
    hy_seg<1, 1>(-127, -96, L, A, hr, vx, ncol, acol, l31, kh, acc);
    hy_seg<3, 2>(-95, -64, L, A, hr, vx, ncol, acol, l31, kh, acc);
    hy_seg<7, 4>(-63, -32, L, A, hr, vx, ncol, acol, l31, kh, acc);
    hy_seg<15, 9>(-31, 31, L, A, hr, vx, ncol, acol, l31, kh, acc);
    hy_seg<14, 2>(32, 63, L, A, hr, vx, ncol, acol, l31, kh, acc);
    hy_seg<12, 4>(64, 95, L, A, hr, vx, ncol, acol, l31, kh, acc);
    hy_seg<8, 8>(96, 127, L, A, hr, vx, ncol, acol, l31, kh, acc);
  } else {
    hy_seg<15, 15>(-7, 7, L, A, hr, vx, ncol, acol, l31, kh, acc);
  }
  }
  {
    const float hb = p.in[26][c0 + ch];
#pragma unroll
    for (int j = 0; j < 4; ++j) {
      const int n = ncol[j];
#pragma unroll
      for (int q = 0; q < 4; ++q) {
        u32x2 vr = *(const u32x2*)(vx + n * 40 + 8 * q + 4 * kh);
        acc[j][4 * q + 0] += bflo(vr[0]) * hb; acc[j][4 * q + 1] += bfhi(vr[0]) * hb;
        acc[j][4 * q + 2] += bflo(vr[1]) * hb; acc[j][4 * q + 3] += bfhi(vr[1]) * hb;
      }
    }
  }
  __syncthreads();
  float* FL = (float*)smem;
  {
#pragma unroll
    for (int j = 0; j < 4; ++j) {
      const int n = ncol[j];
#pragma unroll
      for (int q = 0; q < 4; ++q) {
        const int pos = 32 * n + 8 * q + 4 * kh;
        *(float4*)(FL + ch * 9216 + pos + (pos >> 5) * 4) = make_float4(acc[j][4 * q], acc[j][4 * q + 1], acc[j][4 * q + 2], acc[j][4 * q + 3]);
      }
    }
  }
  __syncthreads();
#pragma unroll 2
  for (int it8 = 0; it8 < 8; ++it8) {
    const int chh = it8 >> 1;
    const int c = c0 + chh;
    const int pos = ((tid + it8 * NT) & 1023) * 8;
    const int tl = pos & (L - 1);
    const u16* x0row = UT + (size_t)c * UTP + rowbase;
    const u16* grow = UT + (size_t)(3072 + c) * UTP + rowbase;
    u16* groww = dry ? (u16*)(p.ws + OFF_DUMMY) + (size_t)blockIdx.x * 32768 + chh * 8192
                     : (u16*)(p.ws + OFF_UT) + (size_t)(3072 + c) * UTP + rowbase;
    const u32x4 xr = *(const u32x4*)(x0row + pos);
    const u32x4 gr = *(const u32x4*)(grow + pos);
    float xv[10], gv[8];
    unpack8(xr, xv + 1); unpack8(gr, gv);
    xv[0] = tl > 0 ? bf2f(x0row[pos - 1]) : 0.f;
    xv[9] = (tl + 8 < L) ? bf2f(x0row[pos + 8]) : 0.f;
    const float w0 = cw[c], w1 = cw[3072 + c], w2 = cw[6144 + c], bb = cbv[c];
    const float* fl = FL + chh * 9216 + pos + (pos >> 5) * 4;
    const float4 a0 = *(const float4*)fl, a1 = *(const float4*)(fl + 4);
    const float av[8] = {a0.x, a0.y, a0.z, a0.w, a1.x, a1.y, a1.z, a1.w};
    float y[8];
#pragma unroll
    for (int e = 0; e < 8; ++e) {
      float x0 = bb + w0 * xv[e] + w1 * xv[e + 1] + w2 * xv[e + 2];
      y[e] = x0 * av[e] * silu(gv[e]);
    }
    *(u32x4*)(groww + pos) = pack8(y);
  }
  (void)lgA;
  __syncthreads();
}

#define VSP 72
typedef __attribute__((ext_vector_type(4))) short v4i16_t;
DI float dpp_rowmax(float v) {
  v = fmaxf(v, __builtin_bit_cast(float, __builtin_amdgcn_update_dpp(0, __builtin_bit_cast(int, v), 0x128, 0xf, 0xf, false)));
  v = fmaxf(v, __builtin_bit_cast(float, __builtin_amdgcn_update_dpp(0, __builtin_bit_cast(int, v), 0x124, 0xf, 0xf, false)));
  v = fmaxf(v, __builtin_bit_cast(float, __builtin_amdgcn_update_dpp(0, __builtin_bit_cast(int, v), 0x122, 0xf, 0xf, false)));
  v = fmaxf(v, __builtin_bit_cast(float, __builtin_amdgcn_update_dpp(0, __builtin_bit_cast(int, v), 0x121, 0xf, 0xf, false)));
  return v;
}
DI float dpp_rowsum(float v) {
  v += __builtin_bit_cast(float, __builtin_amdgcn_update_dpp(0, __builtin_bit_cast(int, v), 0x128, 0xf, 0xf, false));
  v += __builtin_bit_cast(float, __builtin_amdgcn_update_dpp(0, __builtin_bit_cast(int, v), 0x124, 0xf, 0xf, false));
  v += __builtin_bit_cast(float, __builtin_amdgcn_update_dpp(0, __builtin_bit_cast(int, v), 0x122, 0xf, 0xf, false));
  v += __builtin_bit_cast(float, __builtin_amdgcn_update_dpp(0, __builtin_bit_cast(int, v), 0x121, 0xf, 0xf, false));
  return v;
}
#define OUT_CKV 0ul
DI void phase_attn(const Params& p, int item, unsigned char* smem, bool dry) {
  u16* VS = (u16*)smem;
  u16* Pb = VS + 832 * VSP;
  float* rp = (float*)(Pb + 8 * 16 * 72);
  const int tid = threadIdx.x, lane = tid & 63, w = tid >> 6;
  const int l15 = lane & 15, l4 = lane >> 4;
  const u16* C1 = (const u16*)(p.ws + OFF_C1);
  const u16* CK = (const u16*)((const unsigned char*)p.out + OUT_CKV);
  const u16* CV = CK + 524288;
  const bool lat = item < 1024;
  int b, h, myr = 0, rows0w = 0, vrow0 = 0, nvrows = 0, qbase, jq = w & 3;
  if (lat) {
    b = item >> 9; h = (item >> 5) & 15; const int r0 = (item & 31) * 2;
    myr = r0 + (w >> 2);
    rows0w = min(max(myr - 4, 0), 56);
    vrow0 = min(max(r0 - 4, 0), 56);
    nvrows = min(9, 64 - vrow0);
    qbase = NPROMPT + b * 4096 + myr * 64 + jq * 16;
  } else {
    const int q = item - 1024; b = q >> 5; h = (q >> 1) & 15;
    qbase = b * 256 + (q & 1) * 128 + w * 16;
  }
  const int cstart = min(max(16 * jq - 8, 0), 32);
  const int ntile = lat ? 8 : 4;
  bf16x8 qa[2];
#pragma unroll
  for (int ks = 0; ks < 2; ++ks) qa[ks] = *(const bf16x8*)(C1 + (size_t)(qbase + l15) * LDC1 + h * 64 + ks * 32 + l4 * 8);
  auto loadk = [&](int tt, bf16x8 (&kb)[4][2]) {
#pragma unroll
    for (int jt = 0; jt < 4; ++jt) {
      const u16* src;
      if (lat) {
        if (tt < 4) src = C1 + (size_t)(NPROMPT + b * 4096 + (rows0w + tt * 2 + (jt >> 1)) * 64 + cstart + (jt & 1) * 16 + l15) * LDC1 + 1024 + h * 64;
        else src = CK + ((size_t)(b * 16 + h) * 256 + (tt - 4) * 64 + jt * 16 + l15) * 64;
      } else {
        src = C1 + (size_t)(b * 256 + tt * 64 + jt * 16 + l15) * LDC1 + 1024 + h * 64;
      }
#pragma unroll
      for (int ks = 0; ks < 2; ++ks) kb[jt][ks] = *(const bf16x8*)(src + ks * 32 + l4 * 8);
    }
  };
  bf16x8 kn[4][2], kn2[4][2];
  loadk(0, kn);
  loadk(1, kn2);
  u16 graw[4][4];
#pragma unroll
  for (int r = 0; r < 4; ++r)
#pragma unroll
    for (int i = 0; i < 4; ++i)
      graw[r][i] = C1[(size_t)(qbase + l4 * 4 + r) * LDC1 + 3072 + h * 64 + i * 16 + l15];
  {
    const int nloc = lat ? nvrows * 64 : 256;
    const int keyrow0 = lat ? NPROMPT + b * 4096 + vrow0 * 64 : b * 256;
    u32x4 vv[9], cvv[4];
#pragma unroll
    for (int i = 0; i < 9; ++i) {
      const int id = tid + i * NT;
      vv[i] = (u32x4){0u, 0u, 0u, 0u};
      if (id < nloc * 8) { int key = id >> 3, d0 = (id & 7) * 8; vv[i] = *(const u32x4*)(C1 + (size_t)(keyrow0 + key) * LDC1 + 2048 + h * 64 + d0); }
    }
    if (lat) {
#pragma unroll
      for (int i = 0; i < 4; ++i) {
        const int id = tid + i * NT; int key = id >> 3, d0 = (id & 7) * 8;
        cvv[i] = *(const u32x4*)(CV + ((size_t)(b * 16 + h) * 256 + key) * 64 + d0);
      }
    }
#pragma unroll
    for (int i = 0; i < 9; ++i) {
      const int id = tid + i * NT;
      if (id < nloc * 8) { int key = id >> 3, d0 = (id & 7) * 8; *(u32x4*)(VS + key * VSP + d0) = vv[i]; }
    }
    if (lat) {
#pragma unroll
      for (int i = 0; i < 4; ++i) {
        const int id = tid + i * NT; int key = id >> 3, d0 = (id & 7) * 8;
        *(u32x4*)(VS + (576 + key) * VSP + d0) = cvv[i];
      }
      for (int id = tid; id < 465; id += NT) rp[id] = p.in[29][h * 465 + id] * 1.4426950408889634f;
    }
  }
  __syncthreads();
  float mrow[4], lrow[4];
  f32x4 O[4];
#pragma unroll
  for (int r = 0; r < 4; ++r) { mrow[r] = -1e30f; lrow[r] = 0.f; }
#pragma unroll
  for (int i = 0; i < 4; ++i) O[i] = (f32x4){0.f, 0.f, 0.f, 0.f};
  u16* Pw = Pb + w * 16 * 72;
  const __attribute__((address_space(3))) char* vs3 = (const __attribute__((address_space(3))) char*)VS;
  int dcv[2][4]; bool okv[2][4];
#pragma unroll
  for (int hf = 0; hf < 2; ++hf)
#pragma unroll
    for (int r = 0; r < 4; ++r) {
      const int kcn = cstart + hf * 16 + l15;
      const int qc = jq * 16 + l4 * 4 + r;
      const int col0 = min(max(qc - 8, 0), 48);
      dcv[hf][r] = min(max(kcn - qc + 15, 0), 30);
      okv[hf][r] = (kcn >= col0) && (kcn < col0 + 16);
    }
#pragma unroll 1
  for (int tt = 0; tt < ntile; ++tt) {
    bf16x8 kc[4][2];
#pragma unroll
    for (int jt = 0; jt < 4; ++jt)
#pragma unroll
      for (int ks = 0; ks < 2; ++ks) { kc[jt][ks] = kn[jt][ks]; kn[jt][ks] = kn2[jt][ks]; }
    if (tt + 2 < ntile) loadk(tt + 2, kn2);
    const bool local = lat && tt < 4;
    f32x4 S[4];
#pragma unroll
    for (int jt = 0; jt < 4; ++jt) {
      S[jt] = (f32x4){0.f, 0.f, 0.f, 0.f};
      S[jt] = MFMA16(qa[0], kc[jt][0], S[jt]);
      S[jt] = MFMA16(qa[1], kc[jt][1], S[jt]);
    }
    float sv[4][4];
#pragma unroll
    for (int jt = 0; jt < 4; ++jt)
#pragma unroll
      for (int r = 0; r < 4; ++r) {
        float s = S[jt][r] * 0.18033688011112042f;
        if (local) {
          const int dr = rows0w + tt * 2 + (jt >> 1) - myr + 7;
          s += rp[dr * 31 + dcv[jt & 1][r]];
          if (!okv[jt & 1][r]) s = -INFINITY;
        }
        sv[jt][r] = s;
      }
    float alpha[4];
#pragma unroll
    for (int r = 0; r < 4; ++r) {
      float mx = fmaxf(fmaxf(sv[0][r], sv[1][r]), fmaxf(sv[2][r], sv[3][r]));
      mx = dpp_rowmax(mx);
      float mn = fmaxf(mrow[r], mx);
      alpha[r] = __builtin_amdgcn_exp2f(mrow[r] - mn);
      mrow[r] = mn;
      float ps = 0.f;
#pragma unroll
      for (int jt = 0; jt < 4; ++jt) {
        float pv = __builtin_amdgcn_exp2f(sv[jt][r] - mn);
        ps += pv;
        Pw[(l4 * 4 + r) * 72 + jt * 16 + l15] = f2bf(pv);
      }
      lrow[r] = lrow[r] * alpha[r] + ps;
    }
#pragma unroll
    for (int i = 0; i < 4; ++i)
#pragma unroll
      for (int r = 0; r < 4; ++r) O[i][r] *= alpha[r];
    asm volatile("s_waitcnt lgkmcnt(0)" ::: "memory");
#pragma unroll
    for (int ks2 = 0; ks2 < 2; ++ks2) {
      bf16x8 pa = *(const bf16x8*)(Pw + l15 * 72 + ks2 * 32 + l4 * 8);
      int keyoff;
      if (lat) keyoff = tt < 4 ? (rows0w - vrow0 + tt * 2 + ks2) * 64 + cstart : 576 + (tt - 4) * 64 + ks2 * 32;
      else keyoff = tt * 64 + ks2 * 32;
#pragma unroll
      for (int i = 0; i < 4; ++i) {
        const int rowa = keyoff + 8 * l4 + (l15 >> 2);
        const int cola = i * 16 + 4 * (l15 & 3);
        v4i16_t lo = __builtin_amdgcn_ds_read_tr16_b64_v4i16((__attribute__((address_space(3))) v4i16_t*)(vs3 + (rowa * VSP + cola) * 2));
        v4i16_t hi = __builtin_amdgcn_ds_read_tr16_b64_v4i16((__attribute__((address_space(3))) v4i16_t*)(vs3 + ((rowa + 4) * VSP + cola) * 2));
        bf16x8 vb = __builtin_shufflevector(lo, hi, 0, 1, 2, 3, 4, 5, 6, 7);
        O[i] = MFMA16(pa, vb, O[i]);
      }
    }
    asm volatile("s_waitcnt lgkmcnt(0)" ::: "memory");
  }
  {
    u16* C1w = dry ? (u16*)(p.ws + OFF_DUMMY) + (size_t)(blockIdx.x & 15) * 300000 + (size_t)w * 16 * LDC1 - (size_t)qbase * LDC1 : (u16*)(p.ws + OFF_C1);
#pragma unroll
    for (int r = 0; r < 4; ++r) {
      const float inv = 1.f / dpp_rowsum(lrow[r]);
      const int row = qbase + l4 * 4 + r;
#pragma unroll
      for (int i = 0; i < 4; ++i) {
        const int dcol = h * 64 + i * 16 + l15;
        C1w[(size_t)row * LDC1 + dcol] = f2bf(O[i][r] * inv * silu(bf2f(graw[r][i])));
      }
    }
  }
  __syncthreads();
}

DI void phase_ckv(const Params& p, int t) {
  const int id = t * NT + threadIdx.x;
  const int arr = id >> 16, v = id & 65535;
  const float* src = p.in[3 + arr] + (size_t)v * 8;
  float4 a = *(const float4*)src, c = *(const float4*)(src + 4);
  float f[8] = {a.x, a.y, a.z, a.w, c.x, c.y, c.z, c.w};
  u16* dst = (u16*)((unsigned char*)p.out + OUT_CKV) + (size_t)arr * 524288 + (size_t)v * 8;
  *(u32x4*)dst = pack8(f);
}


DI void phase_ssd_out_grp(const Params& p, int item, unsigned char* smem, bool dry) {
  u16* Cs = (u16*)smem;
  u16* Bs = Cs + 128 * 136;
  u16* xT = Bs + 128 * 136;
  u16* St = xT + 64 * 136;
  float* sdt = (float*)(St + 2 * 64 * 136);
  float* scs = sdt + 2048;
  const int tid = threadIdx.x, lane = tid & 63, w = tid >> 6;
  const int l15 = lane & 15, l4 = lane >> 4;
  const int cgi = item >> 1, grp = item & 1;
  int row0, has_prev, has_next;
  if (cgi < 64) { int seq = cgi >> 1, c = cgi & 1; row0 = seq * 256 + c * 128; has_prev = c > 0; has_next = c < 1; }
  else { int q = cgi - 64; int seq = q >> 5, c = q & 31; row0 = NPROMPT + seq * 4096 + c * 128; has_prev = c > 0; has_next = c < 31; }
  const u16* C0 = (const u16*)(p.ws + OFF_C0A);
  const int xchunk = tid & 7, xrg = tid >> 3;
  const int bchunk = tid & 15, brg = tid >> 4;
  u32x4 rawb[6], rawc[6];
  conv_load<4>(p, row0, brg * 4, 1024 + grp * 128 + bchunk * 8, has_prev, has_next, rawb);
  conv_load<4>(p, row0, brg * 4, 1280 + grp * 128 + bchunk * 8, has_prev, has_next, rawc);
  float rdt[4];
#pragma unroll
  for (int i = 0; i < 4; ++i) {
    const int id = tid + i * NT; const int h8 = id >> 8, d = (id >> 7) & 1, l = id & 127;
    rdt[i] = bf2f(C0[(size_t)(row0 + l) * LDC0 + 2560 + d * 16 + grp * 8 + h8]);
  }
#pragma unroll
  for (int i = 0; i < 4; ++i) {
    const int id = tid + i * NT; const int h8 = id >> 8, d = (id >> 7) & 1;
    const int hh = grp * 8 + h8;
    float x = rdt[i] + p.in[14][d * 16 + hh];
    float dt = x > 20.f ? x : log1pf(expf(x));
    float a = -expf(p.in[15][d * 16 + hh]);
    sdt[id] = dt; scs[id] = a * dt;
  }
  __syncthreads();
#pragma unroll
  for (int k = 0; k < 2; ++k) {
    const int sq = 2 * w + k; const int d = sq & 1;
    float* base = scs + sq * 128;
    int p0 = d == 0 ? 2 * lane : 127 - 2 * lane;
    int p1 = d == 0 ? 2 * lane + 1 : 126 - 2 * lane;
    float v0 = base[p0], v1 = base[p1];
    float sacc = v0 + v1;
#pragma unroll
    for (int off = 1; off < 64; off <<= 1) {
      float tv = __shfl_up(sacc, off);
      if (lane >= off) sacc += tv;
    }
    float excl = sacc - (v0 + v1);
    base[p0] = excl + v0;
    base[p1] = excl + v0 + v1;
  }
  {
    float o[4][8];
    conv_compute<4>(p, 1024 + grp * 128 + bchunk * 8, rawb, o);
#pragma unroll
    for (int i = 0; i < 4; ++i) *(u32x4*)(Bs + (brg * 4 + i) * 136 + bchunk * 8) = pack8(o[i]);
    conv_compute<4>(p, 1280 + grp * 128 + bchunk * 8, rawc, o);
#pragma unroll
    for (int i = 0; i < 4; ++i) *(u32x4*)(Cs + (brg * 4 + i) * 136 + bchunk * 8) = pack8(o[i]);
  }
  __syncthreads();
  f32x4 cb[8];
#pragma unroll
  for (int j = 0; j < 8; ++j) cb[j] = (f32x4){0.f, 0.f, 0.f, 0.f};
#pragma unroll
  for (int ks = 0; ks < 4; ++ks) {
    bf16x8 a = *(const bf16x8*)(Cs + (16 * w + l15) * 136 + ks * 32 + l4 * 8);
#pragma unroll
    for (int j = 0; j < 8; ++j) {
      bf16x8 b = *(const bf16x8*)(Bs + (j * 16 + l15) * 136 + ks * 32 + l4 * 8);
      cb[j] = MFMA16(b, a, cb[j]);
    }
  }
  __syncthreads();
  const int lrow = 16 * w + l15;
#pragma unroll 1
  for (int h8 = 0; h8 < 8; ++h8) {
    const int h = grp * 8 + h8;
    const float* sdh = sdt + h8 * 256;
    const float* sch = scs + h8 * 256;
    u32x4 rawx[4], rawst[4];
    u16 zraw[4][4];
    conv_load<2>(p, row0, xrg * 2, h * 64 + xchunk * 8, has_prev, has_next, rawx);
    {
      const u16* S = (const u16*)((const unsigned char*)p.out + OUT_SBUF) + (size_t)(cgi * 16 + h) * 2 * 8192;
#pragma unroll
      for (int v = 0; v < 4; ++v) {
        int id = tid + 512 * v;
        int dd = id >> 10, pp = (id >> 4) & 63, nv = (id & 15) * 8;
        rawst[v] = *(const u32x4*)(S + dd * 8192 + pp * 128 + nv);
      }
#pragma unroll
      for (int i = 0; i < 4; ++i)
#pragma unroll
        for (int r = 0; r < 4; ++r)
          zraw[i][r] = C0[(size_t)(row0 + 16 * w + l4 * 4 + r) * LDC0 + h * 64 + i * 16 + l15];
    }
    {
      const float cs0l = sch[lrow], cs1l = sch[128 + lrow];
#pragma unroll
      for (int j = 0; j < 8; ++j) {
        const int s0 = j * 16 + l4 * 4;
        float f[4];
        if (j < w) {
          const float4 c4 = *(const float4*)(sch + s0), d4 = *(const float4*)(sdh + s0);
          f[0] = __expf(cs0l - c4.x) * d4.x; f[1] = __expf(cs0l - c4.y) * d4.y; f[2] = __expf(cs0l - c4.z) * d4.z; f[3] = __expf(cs0l - c4.w) * d4.w;
        } else if (j > w) {
          const float4 c4 = *(const float4*)(sch + 128 + s0), d4 = *(const float4*)(sdh + 128 + s0);
          f[0] = __expf(cs1l - c4.x) * d4.x; f[1] = __expf(cs1l - c4.y) * d4.y; f[2] = __expf(cs1l - c4.z) * d4.z; f[3] = __expf(cs1l - c4.w) * d4.w;
        } else {
          const float4 c4 = *(const float4*)(sch + s0), d4 = *(const float4*)(sdh + s0);
          const float4 e4 = *(const float4*)(sch + 128 + s0), g4 = *(const float4*)(sdh + 128 + s0);
          const float c0[4] = {c4.x, c4.y, c4.z, c4.w}, d0[4] = {d4.x, d4.y, d4.z, d4.w};
          const float c1[4] = {e4.x, e4.y, e4.z, e4.w}, d1[4] = {g4.x, g4.y, g4.z, g4.w};
#pragma unroll
          for (int jj = 0; jj < 4; ++jj) {
            const int sidx = s0 + jj;
            float v;
            if (lrow > sidx) v = __expf(cs0l - c0[jj]) * d0[jj];
            else if (lrow < sidx) v = __expf(cs1l - c1[jj]) * d1[jj];
            else v = d0[jj] + d1[jj];
            f[jj] = v;
          }
        }
        u32x2 o; o[0] = pk2(cb[j][0] * f[0], cb[j][1] * f[1]); o[1] = pk2(cb[j][2] * f[2], cb[j][3] * f[3]);
        *(u32x2*)(Bs + lrow * 136 + s0) = o;
      }
    }
    {
      float o[2][8];
      conv_compute<2>(p, h * 64 + xchunk * 8, rawx, o);
#pragma unroll
      for (int e = 0; e < 8; ++e) *(unsigned*)(xT + (xchunk * 8 + e) * 136 + xrg * 2) = pk2(o[0][e], o[1][e]);
#pragma unroll
      for (int v = 0; v < 4; ++v) {
        int id = tid + 512 * v;
        int dd = id >> 10, pp = (id >> 4) & 63, nv = (id & 15) * 8;
        *(u32x4*)(St + dd * 64 * 136 + pp * 136 + nv) = rawst[v];
      }
    }
    __syncthreads();
    f32x4 af[4], ab[4], Y[4];
#pragma unroll
    for (int i = 0; i < 4; ++i) { af[i] = (f32x4){0.f, 0.f, 0.f, 0.f}; ab[i] = (f32x4){0.f, 0.f, 0.f, 0.f}; }
#pragma unroll
    for (int ks = 0; ks < 4; ++ks) {
      bf16x8 a = *(const bf16x8*)(Cs + (16 * w + l15) * 136 + ks * 32 + l4 * 8);
#pragma unroll
      for (int i = 0; i < 4; ++i) {
        bf16x8 b0 = *(const bf16x8*)(St + (i * 16 + l15) * 136 + ks * 32 + l4 * 8);
        bf16x8 b1 = *(const bf16x8*)(St + 64 * 136 + (i * 16 + l15) * 136 + ks * 32 + l4 * 8);
        af[i] = MFMA16(a, b0, af[i]);
        ab[i] = MFMA16(a, b1, ab[i]);
      }
    }
#pragma unroll
    for (int r = 0; r < 4; ++r) {
      const int l = 16 * w + l4 * 4 + r;
      float e0 = __expf(sch[l]), e1 = __expf(sch[128 + l]);
#pragma unroll
      for (int i = 0; i < 4; ++i) Y[i][r] = af[i][r] * e0 + ab[i][r] * e1;
    }
#pragma unroll
    for (int ks = 0; ks < 4; ++ks) {
      bf16x8 a = *(const bf16x8*)(Bs + (16 * w + l15) * 136 + ks * 32 + l4 * 8);
#pragma unroll
      for (int i = 0; i < 4; ++i) {
        bf16x8 b = *(const bf16x8*)(xT + (i * 16 + l15) * 136 + ks * 32 + l4 * 8);
        Y[i] = MFMA16(a, b, Y[i]);
      }
    }
    {
      u16* YAB = dry ? (u16*)(p.ws + OFF_DUMMY) + (size_t)(blockIdx.x & 15) * 400000 - (size_t)row0 * 2048 : (u16*)((unsigned char*)p.out + OUT_YB);
      const float dsk = p.in[16][h] + p.in[16][16 + h];
      float ss[4] = {0.f, 0.f, 0.f, 0.f};
#pragma unroll
      for (int i = 0; i < 4; ++i) {
        const int pp = i * 16 + l15;
#pragma unroll
        for (int r = 0; r < 4; ++r) {
          const int l = 16 * w + l4 * 4 + r;
          float xv = bf2f(xT[pp * 136 + l]);
          float y = Y[i][r] + xv * dsk;
          float gv = y * silu(bf2f(zraw[i][r]));
          YAB[(size_t)(row0 + l) * 2048 + h * 64 + pp] = f2bf(gv);
          ss[r] += gv * gv;
        }
      }
      float* rss = (float*)(p.ws + OFF_ROWSS);
#pragma unroll
      for (int r = 0; r < 4; ++r) {
        float sv = dpp_rowsum(ss[r]);
        if (l15 == 0) rss[(size_t)(row0 + 16 * w + l4 * 4 + r) * 16 + h] = sv;
      }
    }
    __syncthreads();
  }
}

DI void phase_ssd_states_grp(const Params& p, int item, unsigned char* smem) {
  u16* BT = (u16*)smem;
  u16* xTs = BT + 128 * 136;
  float* sdt = (float*)(xTs + 2 * 64 * 136);
  float* scs = sdt + 2048;
  float* sw = scs + 2048;
  float* stot = sw + 2048;
  const int tid = threadIdx.x, lane = tid & 63, w = tid >> 6;
  const int l15 = lane & 15, l4 = lane >> 4;
  const int cgi = item >> 1, grp = item & 1;
  int row0, has_prev, has_next;
  if (cgi < 64) { int seq = cgi >> 1, c = cgi & 1; row0 = seq * 256 + c * 128; has_prev = c > 0; has_next = c < 1; }
  else { int q = cgi - 64; int seq = q >> 5, c = q & 31; row0 = NPROMPT + seq * 4096 + c * 128; has_prev = c > 0; has_next = c < 31; }
  const u16* C0 = (const u16*)(p.ws + OFF_C0A);
  const int xchunk = tid & 7, xrg = tid >> 3;
  const int bchunk = tid & 15, brg = tid >> 4;
  u32x4 rawb[6];
  conv_load<4>(p, row0, brg * 4, 1024 + grp * 128 + bchunk * 8, has_prev, has_next, rawb);
  float rdt[4];
#pragma unroll
  for (int i = 0; i < 4; ++i) {
    const int id = tid + i * NT; const int h8 = id >> 8, d = (id >> 7) & 1, l = id & 127;
    rdt[i] = bf2f(C0[(size_t)(row0 + l) * LDC0 + 2560 + d * 16 + grp * 8 + h8]);
  }
#pragma unroll
  for (int i = 0; i < 4; ++i) {
    const int id = tid + i * NT; const int h8 = id >> 8, d = (id >> 7) & 1;
    const int hh = grp * 8 + h8;
    float x = rdt[i] + p.in[14][d * 16 + hh];
    float dt = x > 20.f ? x : log1pf(expf(x));
    float a = -expf(p.in[15][d * 16 + hh]);
    sdt[id] = dt; scs[id] = a * dt;
  }
  __syncthreads();
#pragma unroll
  for (int k = 0; k < 2; ++k) {
    const int sq = 2 * w + k; const int d = sq & 1;
    float* base = scs + sq * 128;
    int p0 = d == 0 ? 2 * lane : 127 - 2 * lane;
    int p1 = d == 0 ? 2 * lane + 1 : 126 - 2 * lane;
    float v0 = base[p0], v1 = base[p1];
    float sacc = v0 + v1;
#pragma unroll
    for (int off = 1; off < 64; off <<= 1) {
      float tv = __shfl_up(sacc, off);
      if (lane >= off) sacc += tv;
    }
    float excl = sacc - (v0 + v1);
    base[p0] = excl + v0;
    base[p1] = excl + v0 + v1;
    if (lane == 63) stot[sq] = sacc;
  }
  {
    float o[4][8];
    conv_compute<4>(p, 1024 + grp * 128 + bchunk * 8, rawb, o);
#pragma unroll
    for (int e = 0; e < 8; ++e) {
      u32x2 v; v[0] = pk2(o[0][e], o[1][e]); v[1] = pk2(o[2][e], o[3][e]);
      *(u32x2*)(BT + (bchunk * 8 + e) * 136 + brg * 4) = v;
    }
  }
  __syncthreads();
#pragma unroll
  for (int i = 0; i < 4; ++i) {
    const int id = tid + i * NT; const int sq = id >> 7;
    sw[id] = sdt[id] * __expf(stot[sq] - scs[id]);
  }
  if (tid < 16) {
    float* cdec = (float*)(p.ws + OFF_CDEC);
    const int h8 = tid >> 1, d = tid & 1;
    cdec[(cgi * 16 + grp * 8 + h8) * 2 + d] = __expf(stot[tid]);
  }
  __syncthreads();
  const int d = w >> 2, nq = w & 3;
#pragma unroll 1
  for (int h8 = 0; h8 < 8; ++h8) {
    const int h = grp * 8 + h8;
    u32x4 rawx[4];
    conv_load<2>(p, row0, xrg * 2, h * 64 + xchunk * 8, has_prev, has_next, rawx);
    {
      float o[2][8];
      conv_compute<2>(p, h * 64 + xchunk * 8, rawx, o);
#pragma unroll
      for (int dd = 0; dd < 2; ++dd) {
        const float s0 = sw[h8 * 256 + dd * 128 + xrg * 2], s1 = sw[h8 * 256 + dd * 128 + xrg * 2 + 1];
#pragma unroll
        for (int e = 0; e < 8; ++e) *(unsigned*)(xTs + dd * 64 * 136 + (xchunk * 8 + e) * 136 + xrg * 2) = pk2(o[0][e] * s0, o[1][e] * s1);
      }
    }
    __syncthreads();
    f32x4 acc[4][2];
#pragma unroll
    for (int i = 0; i < 4; ++i) { acc[i][0] = (f32x4){0.f, 0.f, 0.f, 0.f}; acc[i][1] = (f32x4){0.f, 0.f, 0.f, 0.f}; }
#pragma unroll
    for (int ks = 0; ks < 4; ++ks) {
      bf16x8 a[4], b[2];
#pragma unroll
      for (int i = 0; i < 4; ++i) a[i] = *(const bf16x8*)(xTs + d * 64 * 136 + (i * 16 + l15) * 136 + ks * 32 + l4 * 8);
#pragma unroll
      for (int j = 0; j < 2; ++j) b[j] = *(const bf16x8*)(BT + (nq * 32 + j * 16 + l15) * 136 + ks * 32 + l4 * 8);
#pragma unroll
      for (int i = 0; i < 4; ++i)
#pragma unroll
        for (int j = 0; j < 2; ++j) acc[i][j] = MFMA16(b[j], a[i], acc[i][j]);
    }
    u16* S = (u16*)((unsigned char*)p.out + OUT_SBUF) + ((size_t)(cgi * 16 + h) * 2 + d) * 8192;
#pragma unroll
    for (int i = 0; i < 4; ++i)
#pragma unroll
      for (int j = 0; j < 2; ++j) {
        const int pp = i * 16 + l15, n = nq * 32 + j * 16 + l4 * 4;
        u32x2 o; o[0] = pk2(acc[i][j][0], acc[i][j][1]); o[1] = pk2(acc[i][j][2], acc[i][j][3]);
        *(u32x2*)(S + pp * 128 + n) = o;
      }
    __syncthreads();
  }
}
#define OFF_BAR 268419072ul
#define XB_TMO      128
#define XB_XCNT(j)  (256  + 64 * (j))
#define XB_XSUB(j)  (1280 + 64 * (j))
#define XB_XGEN(j)  (2304 + 64 * (j))
#define XB_TOP      3328
#define XB_TOPGEN   3392
#define XCD_BAR_WORDS 3456
#define XB_SPIN_CAP (1u << 18)
#define LAS __attribute__((address_space(3)))
DI unsigned xb_ld(unsigned* p) { return __hip_atomic_load(p, __ATOMIC_RELAXED, __HIP_MEMORY_SCOPE_AGENT); }
DI unsigned xb_add(unsigned* p, unsigned v) { return __hip_atomic_fetch_add(p, v, __ATOMIC_RELAXED, __HIP_MEMORY_SCOPE_AGENT); }
DI unsigned xb_xcc_id() { return (unsigned)__builtin_amdgcn_s_getreg((3 << 11) | 20) & 0xFu; }
#define XB_SPIN(cond, bar) do { unsigned _sp = 0; while (cond) { __builtin_amdgcn_s_sleep(1); \
    if ((++_sp & 255u) == 0u) { if (xb_ld(&(bar)[XB_TMO])) break; if (_sp > XB_SPIN_CAP) { atomicAdd(&(bar)[XB_TMO], 1u); break; } } } } while (0)
struct XcdBarrier { unsigned* bar; unsigned x; volatile LAS unsigned* st; };
DI XcdBarrier xcd_barrier_post(unsigned* bar, volatile LAS unsigned* st) {
  XcdBarrier b; b.bar = bar; b.x = xb_xcc_id(); b.st = st;
  if (threadIdx.x == 0) (void)xb_add(&bar[XB_XCNT(b.x)], 1u);
  return b;
}
DI void xcd_barrier_complete(unsigned* bar, unsigned x, unsigned& nloc, unsigned& nx) {
  const unsigned G = gridDim.x * gridDim.y * gridDim.z;
  unsigned sum, cnt, mine, sp = 0u;
  for (;;) {
    sum = 0u; cnt = 0u; mine = 0u;
#pragma unroll
    for (unsigned j = 0; j < 16; ++j) { const unsigned c = xb_ld(&bar[XB_XCNT(j)]); sum += c; cnt += (c > 0u) ? 1u : 0u; mine = (j == x) ? c : mine; }
    if (sum == G) break;
    __builtin_amdgcn_s_sleep(1);
    if ((++sp & 255u) == 0u) { if (xb_ld(&bar[XB_TMO])) break; if (sp > XB_SPIN_CAP) { atomicAdd(&bar[XB_TMO], 1u); break; } }
  }
  nloc = mine > 0u ? mine : 1u; nx = cnt > 0u ? cnt : 1u;
}
DI void xcd_barrier(const XcdBarrier& b) {
  asm volatile("s_waitcnt vmcnt(0)" ::: "memory");
  __syncthreads();
  if (threadIdx.x == 0) {
    unsigned* bar = b.bar;
    __builtin_amdgcn_s_waitcnt(0);
    unsigned nloc = b.st[0], nx = b.st[1];
    if (nloc == 0u) { xcd_barrier_complete(bar, b.x, nloc, nx); b.st[0] = nloc; b.st[1] = nx; }
    const unsigned old = xb_add(&bar[XB_XSUB(b.x)], 1u);
    const unsigned gen = old / nloc;
    if (old + 1u == (gen + 1u) * nloc) {
      __builtin_amdgcn_fence(__ATOMIC_RELEASE, "agent");
      asm volatile("s_waitcnt vmcnt(0)" ::: "memory");
      const unsigned og = xb_add(&bar[XB_TOP], 1u);
      const unsigned tg = og / nx;
      if (og + 1u == (tg + 1u) * nx) xb_add(&bar[XB_TOPGEN], 1u);
      else XB_SPIN(xb_ld(&bar[XB_TOPGEN]) == tg, bar);
      __builtin_amdgcn_fence(__ATOMIC_ACQUIRE, "agent");
      xb_add(&bar[XB_XGEN(b.x)], 1u);
      asm volatile("s_waitcnt vmcnt(0)" ::: "memory");
    } else {
      XB_SPIN(xb_ld(&bar[XB_XGEN(b.x)]) == gen, bar);
      __builtin_amdgcn_fence(__ATOMIC_ACQUIRE, "agent");
      asm volatile("s_waitcnt vmcnt(0)" ::: "memory");
    }
  }
  __syncthreads();
}
#define NPHASE 12
__global__ void __launch_bounds__(NT) mega(Params p, int ph0, int ph1) {
  __shared__ __attribute__((aligned(16))) unsigned char smem[SMEM_BYTES];
  __shared__ __attribute__((aligned(16))) unsigned xb_st[4];
  const int nb = gridDim.x, bid = blockIdx.x;
  if (threadIdx.x < 4) xb_st[threadIdx.x] = 0u;
  __syncthreads();
  const XcdBarrier xb = xcd_barrier_post((unsigned*)(p.ws + OFF_BAR), (volatile LAS unsigned*)xb_st);
  if (ph1 > 4096) cg::this_grid().sync();
#define PH_BEGIN(k) if (ph0 <= (k) && (k) < ph1) { if ((k) > ph0) xcd_barrier(xb); \
  for (int rep = (REP_MASK >> (k)) & 1; rep >= 0; --rep) { const bool dry = rep > 0; (void)dry;
#define PH_END if (rep > 0) xcd_barrier(xb); } }
  {
    {
      PH_BEGIN(0) {
        for (int ft = bid; ft < 256; ft += nb) phase_filter(p, ft, smem);
        {
          for (int q0 = bid; q0 < 192 + 880; q0 += nb) {
            if (q0 < 192) phase_ada(p, q0, smem);
            else {
              int q = q0 - 192;
              if (q < 432) transpose_tile<float>(p.in[10], 6688, 6688, (u16*)(p.ws + OFF_WINE), 1024, q & 15, q >> 4, nullptr, 0, smem);
              else if (q < 560) { q -= 432; transpose_tile<float>(p.in[11], 1024, 1024, (u16*)(p.ws + OFF_WOUTE), 2048, q & 31, q >> 5, p.in[17], 1024, smem); }
              else if (q < 816) { q -= 560; transpose_tile<float>(p.in[27], 4096, 4096, (u16*)(p.ws + OFF_WINO), 1024, q & 15, q >> 4, nullptr, 0, smem); }
              else { q -= 816; transpose_tile<float>(p.in[28], 1024, 1024, (u16*)(p.ws + OFF_WOUTO), 1024, q & 15, q >> 4, nullptr, 0, smem); }
            }
          }
        }
      } PH_END
      PH_BEGIN(1) {
        for (int t = bid; t < 512; t += nb) phase_norm(p, t, 0, p.in[0], p.in[1], (u16*)((unsigned char*)p.out + OUT_H0));
      } PH_END
      PH_BEGIN(2) {
        GemmArgs g; g.A1 = (const u16*)((const unsigned char*)p.out + OUT_H0); g.lda1 = 1024; g.A2 = g.A1; g.lda2 = 1024; g.ksplit = 1 << 30;
        g.Bt = (const u16*)(p.ws + OFF_WINE); g.K = 1024;
        for (int rd = 0; rd * 256 < 64 * 27; ++rd) { int pm, pn; if (gemm_tile_coord(rd, 27, 64 * 27, pm, pn)) { if (pn <= 9) gemm256<0, true>(p, g, pm * 256, pn * 256, smem); else gemm256<0, false>(p, g, pm * 256, pn * 256, smem); } }
      } PH_END
      PH_BEGIN(3) {
        for (int t = bid; t < 512 + 256; t += nb) {
          if (dry && (REP_SUB == 1 || REP_SUB == 4) && t >= 256) continue;
          if (dry && REP_SUB == 2 && (t < 256 || t >= 512)) continue;
          if (dry && REP_SUB == 3 && t < 512) continue;
          if (t < 512) phase_hyena(p, t, smem, dry);
          else phase_ssd_states_grp(p, t - 512, smem);
        }
      } PH_END
      PH_BEGIN(4) {
        for (int t = bid; t < 34 * 64; t += nb) phase_scan(p, t);
      } PH_END
      PH_BEGIN(5) {
        for (int t = bid; t < 256 + 1024; t += nb) {
          if (t < 256) phase_ssd_out_grp(p, t, smem, dry);
          else {
            int q = t - 256;
            transpose_tile<u16>((const u16*)(p.ws + OFF_UT) + (size_t)3072 * UTP, MROWS, UTP,
                                (u16*)((unsigned char*)p.out + OUT_YB) + 1024, 2048, q & 15, q >> 4, nullptr, 0, smem);
          }
        }
      } PH_END
      PH_BEGIN(6) {
        GemmArgs g; g.A1 = (const u16*)((const unsigned char*)p.out + OUT_YB); g.lda1 = 2048;
        g.A2 = g.A1; g.lda2 = 2048; g.ksplit = 1024;
        g.Bt = (const u16*)(p.ws + OFF_WOUTE); g.K = 2048;
        for (int rd = 0; rd * 256 < 64 * 4; ++rd) { int pm, pn; if (gemm_tile_coord(rd, 4, 64 * 4, pm, pn)) gemm256<1, true>(p, g, pm * 256, pn * 256, smem); }
      } PH_END
      PH_BEGIN(7) {
        const float* x1 = (const float*)(p.ws + OFF_X1);
        for (int t = bid; t < 512 + 256; t += nb) { if (t < 512) phase_norm(p, t, 1, x1, x1 + (size_t)NPROMPT * 1024, (u16*)(p.ws + OFF_H1)); else phase_ckv(p, t - 512); }
      } PH_END
      PH_BEGIN(8) {
        GemmArgs g; g.A1 = (const u16*)(p.ws + OFF_H1); g.lda1 = 1024; g.A2 = g.A1; g.lda2 = 1024; g.ksplit = 1 << 30;
        g.Bt = (const u16*)(p.ws + OFF_WINO); g.K = 1024;
        for (int rd = 0; rd * 256 < 64 * 16; ++rd) { int pm, pn; if (gemm_tile_coord(rd, 16, 64 * 16, pm, pn)) gemm256<2, true>(p, g, pm * 256, pn * 256, smem); }
      } PH_END
      PH_BEGIN(9) {
        for (int t = bid; t < 2048; t += nb) phase_attn(p, t, smem, dry);
      } PH_END
      PH_BEGIN(10) {
        GemmArgs g; g.A1 = (const u16*)(p.ws + OFF_C1); g.lda1 = LDC1; g.A2 = g.A1; g.lda2 = LDC1; g.ksplit = 1 << 30;
        g.Bt = (const u16*)(p.ws + OFF_WOUTO); g.K = 1024;
        for (int rd = 0; rd * 256 < 64 * 4; ++rd) { int pm, pn; if (gemm_tile_coord(rd, 4, 64 * 4, pm, pn)) gemm256<3, true>(p, g, pm * 256, pn * 256, smem); }
      } PH_END
      PH_BEGIN(11) {
        for (int t = bid; t < 512; t += nb) phase_final_norm(p, t);
      } PH_END
    }
  }
}

extern "C" void kernel_launch(void* const* d_in, const int* in_sizes, int n_in, void* d_out, int out_size,
                              void* d_ws, size_t ws_size, hipStream_t stream) {
  static int grid_blocks = 0;
  if (!grid_blocks) {
    int dev = 0, cus = 0, per_cu = 0;
    hipGetDevice(&dev);
    hipDeviceGetAttribute(&cus, hipDeviceAttributeMultiprocessorCount, dev);
    hipOccupancyMaxActiveBlocksPerMultiprocessor(&per_cu, mega, NT, 0);
    if (per_cu < 1) per_cu = 1;
    grid_blocks = cus * per_cu;
  }
  Params p{};
  for (int i = 0; i < 31; ++i) p.in[i] = (const float*)d_in[i];
  p.out = (float*)d_out;
  p.ws = (unsigned char*)d_ws;
#if MULTI
  for (int ph = 0; ph < NPHASE; ++ph) {
    hipLaunchKernelGGL(mega, dim3(grid_blocks), dim3(NT), 0, stream, p, ph, ph + 1);
  }
#else
  hipMemsetAsync((unsigned char*)d_ws + OFF_BAR, 0, XCD_BAR_WORDS * sizeof(unsigned), stream);
  int ph0 = 0, ph1 = NPHASE;
  void* args[] = {&p, &ph0, &ph1};
  hipError_t e = hipLaunchCooperativeKernel((void*)mega, dim3(grid_blocks), dim3(NT), args, 0, stream);
  if (e != hipSuccess) fprintf(stderr, "cooperative launch failed: %s (grid %d)\n", hipGetErrorString(e), grid_blocks);
#endif
}
```

```cpp
#include <hip/hip_runtime.h>
#include <hip/hip_cooperative_groups.h>
#include <cstdio>
namespace cg = cooperative_groups;

#ifndef REP_MASK
#define REP_MASK 0
#endif
#ifndef REP_SUB
#define REP_SUB 0
#endif
#define OFF_DUMMY 249651200ul
#ifndef MULTI
#define MULTI 0
#endif

#define NT 512
#define DI __device__ __forceinline__
typedef unsigned short u16;
typedef __attribute__((ext_vector_type(8))) short bf16x8;
typedef __attribute__((ext_vector_type(4))) float f32x4;
typedef __attribute__((ext_vector_type(16))) float f32x16;
typedef __attribute__((ext_vector_type(4))) unsigned u32x4;
typedef __attribute__((ext_vector_type(2))) unsigned u32x2;

#define MFMA16(a, b, c) __builtin_amdgcn_mfma_f32_16x16x32_bf16((a), (b), (c), 0, 0, 0)
#define MFMA32(a, b, c) __builtin_amdgcn_mfma_f32_32x32x16_bf16((a), (b), (c), 0, 0, 0)

#define MROWS 16384
#define NPROMPT 8192
#define UTP 16448
#define LDC1 4160
#define LDC0 2592
#define NPAD0 6784
#define SMEM_BYTES 151552

#define OFF_WINE   0ul
#define OFF_WOUTE  14155776ul
#define OFF_WINO   18350080ul
#define OFF_WOUTO  26738688ul
#define OFF_MOD    28835840ul
#define OFF_ROWSS  28909568ul
#define OFF_CDEC   29958144ul
#define OFF_UT     29974528ul
#define OFF_C0A    164716544ul
#define OFF_X1     OFF_UT
#define OFF_C1     97083392ul
#define OFF_H1     233398272ul
#define OUT_H0     0ul
#define OUT_YB     0ul
#define OUT_HF4096 33554432ul
#define OUT_HF256  (33554432ul + 16777216ul)
#define OUT_SBUF   100663296ul
#define O_YP 0ul
#define O_YS 8388608ul
#define O_ST 16777216ul
#define O_NK 25165824ul
#define O_NV 33554432ul

struct Params {
  const float* in[31];
  float* out;
  unsigned char* ws;
};

typedef float f32x2_t __attribute__((ext_vector_type(2)));
typedef __bf16 bf16x2_t __attribute__((ext_vector_type(2)));
DI unsigned pk2(float a, float b) {
  f32x2_t v = {a, b};
  bf16x2_t r = __builtin_convertvector(v, bf16x2_t);
  return __builtin_bit_cast(unsigned, r);
}
DI u16 f2bf(float x) { return (u16)(pk2(x, x) & 0xffffu); }
DI float bf2f(u16 h) { return __uint_as_float(((unsigned)h) << 16); }
DI float silu(float x) { return x * __builtin_amdgcn_rcpf(1.f + __expf(-x)); }
DI float bflo(unsigned u) { return __uint_as_float(u << 16); }
DI float bfhi(unsigned u) { return __uint_as_float(u & 0xffff0000u); }
DI void unpack8(const u32x4& v, float* f) {
  f[0] = bflo(v[0]); f[1] = bfhi(v[0]); f[2] = bflo(v[1]); f[3] = bfhi(v[1]);
  f[4] = bflo(v[2]); f[5] = bfhi(v[2]); f[6] = bflo(v[3]); f[7] = bfhi(v[3]);
}
DI u32x4 pack8(const float* f) {
  u32x4 o; o[0] = pk2(f[0], f[1]); o[1] = pk2(f[2], f[3]); o[2] = pk2(f[4], f[5]); o[3] = pk2(f[6], f[7]); return o;
}
DI int row_group(int row) { return row < NPROMPT ? 0 : 1 + ((row - NPROMPT) >> 12); }

DI void phase_ada(const Params& p, int t, unsigned char* smem) {
  float* sc = (float*)smem;
  float* red = sc + 3072;
  const int layer = t / 96, cc = t % 96;
  const int tid = threadIdx.x;
  for (int i = tid; i < 3072; i += NT) {
    int g = i >> 10, k = i & 1023;
    float v = (g == 0) ? p.in[6][k] : p.in[5][(g - 1) * 1024 + k];
    sc[i] = silu(v);
  }
  __syncthreads();
  const int col = tid & 31, kg = tid >> 5;
  const float* w = p.in[8] + (size_t)layer * 1024 * 3072 + cc * 32 + col;
  float a0 = 0.f, a1 = 0.f, a2 = 0.f;
#pragma unroll 8
  for (int k = kg * 64; k < kg * 64 + 64; ++k) {
    float wv = w[(size_t)k * 3072];
    a0 += sc[k] * wv; a1 += sc[1024 + k] * wv; a2 += sc[2048 + k] * wv;
  }
  red[(kg * 3 + 0) * 32 + col] = a0;
  red[(kg * 3 + 1) * 32 + col] = a1;
  red[(kg * 3 + 2) * 32 + col] = a2;
  __syncthreads();
  if (tid < 96) {
    int g = tid >> 5, c = tid & 31;
    float s = 0.f;
    for (int q = 0; q < 16; ++q) s += red[(q * 3 + g) * 32 + c];
    int colg = cc * 32 + c;
    float* mod = (float*)(p.ws + OFF_MOD);
    mod[(layer * 3 + g) * 3072 + colg] = s + p.in[9][layer * 3072 + colg];
  }
  __syncthreads();
}

DI float ld_src(const float* q) { return *q; }
DI float ld_src(const u16* q) { return bf2f(*q); }
template <typename ST>
DI void transpose_tile(const ST* src, int N, int ldsrc, u16* dst, int lddst, int kt, int nt4,
                       const float* kscale, int kscale_n, unsigned char* smem) {
  float* tile = (float*)smem;
  const int tid = threadIdx.x;
  const int c = tid & 63, r0 = tid >> 6;
  float v[4][8];
#pragma unroll
  for (int q = 0; q < 4; ++q)
#pragma unroll
    for (int i = 0; i < 8; ++i) {
      int r = r0 + 8 * i;
      int k = kt * 64 + r, n = (nt4 * 4 + q) * 64 + c;
      v[q][i] = 0.f;
      if (n < N) v[q][i] = ld_src(src + (size_t)k * ldsrc + n);
    }
#pragma unroll
  for (int q = 0; q < 4; ++q)
#pragma unroll
    for (int i = 0; i < 8; ++i) {
      int r = r0 + 8 * i;
      int k = kt * 64 + r;
      float x = v[q][i];
      if (kscale != nullptr && k < kscale_n) x *= kscale[k];
      tile[q * 4160 + r * 65 + c] = x;
    }
  __syncthreads();
  const int rr = tid >> 3, c8 = (tid & 7) * 8;
#pragma unroll
  for (int q = 0; q < 4; ++q) {
    float f[8];
#pragma unroll
    for (int e = 0; e < 8; ++e) f[e] = tile[q * 4160 + (c8 + e) * 65 + rr];
    *(u32x4*)(dst + (size_t)((nt4 * 4 + q) * 64 + rr) * lddst + kt * 64 + c8) = pack8(f);
  }
  __syncthreads();
}

DI void phase_filter(const Params& p, int t, unsigned char* smem) {
  const int L = 4096;
  const int t0 = t * 16;
  float* feats = (float*)smem;
  float* h1 = feats + 18 * 36;
  float* h2 = h1 + 18 * 64;
  const float* w1 = p.in[20]; const float* b1 = p.in[21]; const float* w2 = p.in[22];
  const float* b2 = p.in[23]; const float* w3 = p.in[24]; const float* fr = p.in[25];
  const int tid = threadIdx.x;
  float* w1s = h2 + 64 * 20;
  float* w2s = w1s + 33 * 64;
  {
    float r1[5], r2[8];
#pragma unroll
    for (int i = 0; i < 5; ++i) { const int id = tid + i * NT; r1[i] = id < 33 * 64 ? w1[id] : 0.f; }
#pragma unroll
    for (int i = 0; i < 8; ++i) r2[i] = w2[tid + i * NT];
#pragma unroll
    for (int i = 0; i < 5; ++i) { const int id = tid + i * NT; if (id < 33 * 64) w1s[id] = r1[i]; }
#pragma unroll
    for (int i = 0; i < 8; ++i) w2s[tid + i * NT] = r2[i];
  }
  for (int id = tid; id < 18 * 33; id += NT) {
    int tt = id / 33, i = id % 33;
    const int Lr = tt < 17 ? 4096 : 256;
    const int tpos = tt < 17 ? t0 + tt : t;
    float tv = (float)tpos / (float)(Lr - 1);
    float wv = 6.283185307179586f * (float)tpos / (float)Lr;
    float f;
    if (i == 0) f = tv;
    else if (i <= 16) { float fi = 1e-4f + (float)(i - 1) * ((15.f - 1e-4f) / 15.f); f = cosf(fi * wv); }
    else { float fi = 1e-4f + (float)(i - 17) * ((15.f - 1e-4f) / 15.f); f = -sinf(fi * wv); }
    feats[tt * 36 + i] = f;
  }
  __syncthreads();
  for (int id = tid; id < 18 * 64; id += NT) {
    int tt = id >> 6, j = id & 63;
    float s = b1[j];
#pragma unroll 11
    for (int i = 0; i < 33; ++i) s += feats[tt * 36 + i] * w1s[i * 64 + j];
    h1[tt * 64 + j] = sinf(fr[j] * s);
  }
  __syncthreads();
  for (int id = tid; id < 18 * 64; id += NT) {
    int tt = id >> 6, j = id & 63;
    float s = b2[j];
#pragma unroll 16
    for (int i = 0; i < 64; ++i) s += h1[tt * 64 + i] * w2s[i * 64 + j];
    h2[j * 20 + tt] = sinf(fr[j] * s);
  }
  __syncthreads();
  float acc[4][18];
#pragma unroll
  for (int q = 0; q < 4; ++q)
#pragma unroll
    for (int tt = 0; tt < 18; ++tt) acc[q][tt] = 0.f;
#pragma unroll 1
  for (int k0 = 0; k0 < 64; k0 += 4) {
    float wv[4][4];
    float4 hq[4][5];
#pragma unroll
    for (int kk = 0; kk < 4; ++kk) {
#pragma unroll
      for (int q = 0; q < 4; ++q) wv[kk][q] = w3[(k0 + kk) * 2048 + tid + 512 * q];
#pragma unroll
      for (int v = 0; v < 5; ++v) hq[kk][v] = *(const float4*)(h2 + (k0 + kk) * 20 + v * 4);
    }
#pragma unroll
    for (int kk = 0; kk < 4; ++kk) {
      const float hv[20] = {hq[kk][0].x, hq[kk][0].y, hq[kk][0].z, hq[kk][0].w, hq[kk][1].x, hq[kk][1].y, hq[kk][1].z, hq[kk][1].w,
                            hq[kk][2].x, hq[kk][2].y, hq[kk][2].z, hq[kk][2].w, hq[kk][3].x, hq[kk][3].y, hq[kk][3].z, hq[kk][3].w,
                            hq[kk][4].x, hq[kk][4].y, hq[kk][4].z, hq[kk][4].w};
#pragma unroll
      for (int tt = 0; tt < 18; ++tt)
#pragma unroll
        for (int q = 0; q < 4; ++q) acc[q][tt] += hv[tt] * wv[kk][q];
    }
  }
  u16* HF = (u16*)((unsigned char*)p.out + OUT_HF4096);
  u16* HFp = (u16*)((unsigned char*)p.out + OUT_HF256);
  const float lo = -15.350567286626973f;
  const float hi = -3.0701134573253945f;
#pragma unroll
  for (int q = 0; q < 4; ++q) {
    int col = tid + 512 * q;
    int dir = col >> 10, c = col & 1023;
    float ad = fabsf(lo + (float)c * ((hi - lo) / 1023.f));
    u16* hc = HF + (size_t)c * (2 * L);
    float v[16];
    if (dir == 0) {
#pragma unroll
      for (int e = 0; e < 16; ++e) {
        const int j = 15 - e; const int tpos = t0 + j;
        v[e] = acc[q][j] * __expf(-((float)tpos / (float)(L - 1)) * ad);
      }
      *(u32x4*)(hc + (L - 16 - t0)) = pack8(v);
      *(u32x4*)(hc + (L - 8 - t0)) = pack8(v + 8);
    } else {
#pragma unroll
      for (int e = 0; e < 16; ++e) {
        const int tpos = t0 + 1 + e;
        v[e] = (tpos < L) ? acc[q][e + 1] * __expf(-((float)tpos / (float)(L - 1)) * ad) : 0.f;
      }
      *(u32x4*)(hc + (L + t0)) = pack8(v);
      *(u32x4*)(hc + (L + t0 + 8)) = pack8(v + 8);
    }
    {
      u16* hp = HFp + (size_t)c * 512;
      const float val = acc[q][17] * __expf(-((float)t / 255.f) * ad);
      if (dir == 0) hp[255 - t] = f2bf(val);
      else { if (t > 0) hp[255 + t] = f2bf(val); else hp[511] = 0; }
    }
  }
  __syncthreads();
}

DI float wave_sum(float v) {
#pragma unroll
  for (int o = 32; o >= 1; o >>= 1) v += __shfl_xor(v, o);
  return v;
}
DI void phase_norm(const Params& p, int t, int layer, const float* xa, const float* xb, u16* dst) {
  const int lane = threadIdx.x & 63, w = threadIdx.x >> 6;
  const int row0 = t * 32 + w * 4;
  float4 v[4][4];
#pragma unroll
  for (int rr = 0; rr < 4; ++rr) {
    const int row = row0 + rr;
    const float* src = row < NPROMPT ? xa + (size_t)row * 1024 : xb + (size_t)(row - NPROMPT) * 1024;
#pragma unroll
    for (int i = 0; i < 4; ++i) v[rr][i] = *(const float4*)(src + i * 256 + lane * 4);
  }
  const float* nw = p.in[7] + layer * 1024;
#pragma unroll
  for (int rr = 0; rr < 4; ++rr) {
    const int row = row0 + rr;
    const int g = row_group(row);
    float ss = 0.f;
#pragma unroll
    for (int i = 0; i < 4; ++i) ss += v[rr][i].x * v[rr][i].x + v[rr][i].y * v[rr][i].y + v[rr][i].z * v[rr][i].z + v[rr][i].w * v[rr][i].w;
    ss = wave_sum(ss);
    const float rstd = rsqrtf(ss * (1.f / 1024.f) + 1e-6f);
    const float* shift = (const float*)(p.ws + OFF_MOD) + (layer * 3 + g) * 3072;
    const float* scale = shift + 1024;
#pragma unroll
    for (int i = 0; i < 4; ++i) {
      int col = i * 256 + lane * 4;
      float4 nwv = *(const float4*)(nw + col);
      float4 sc = *(const float4*)(scale + col);
      float4 sh = *(const float4*)(shift + col);
      float o0 = v[rr][i].x * rstd * nwv.x * (1.f + sc.x) + sh.x;
      float o1 = v[rr][i].y * rstd * nwv.y * (1.f + sc.y) + sh.y;
      float o2 = v[rr][i].z * rstd * nwv.z * (1.f + sc.z) + sh.z;
      float o3 = v[rr][i].w * rstd * nwv.w * (1.f + sc.w) + sh.w;
      u32x2 o; o[0] = pk2(o0, o1); o[1] = pk2(o2, o3);
      *(u32x2*)(dst + (size_t)row * 1024 + col) = o;
    }
  }
}
DI void phase_final_norm(const Params& p, int t) {
  const int lane = threadIdx.x & 63, w = threadIdx.x >> 6;
  const int row0 = t * 32 + w * 4;
  float4 v[4][4];
#pragma unroll
  for (int rr = 0; rr < 4; ++rr) {
    const float* src = p.out + (size_t)(row0 + rr) * 1024;
#pragma unroll
    for (int i = 0; i < 4; ++i) v[rr][i] = *(const float4*)(src + i * 256 + lane * 4);
  }
  const float* nw = p.in[30];
#pragma unroll
  for (int rr = 0; rr < 4; ++rr) {
    float* src = p.out + (size_t)(row0 + rr) * 1024;
    float ss = 0.f;
#pragma unroll
    for (int i = 0; i < 4; ++i) ss += v[rr][i].x * v[rr][i].x + v[rr][i].y * v[rr][i].y + v[rr][i].z * v[rr][i].z + v[rr][i].w * v[rr][i].w;
    ss = wave_sum(ss);
    const float rstd = rsqrtf(ss * (1.f / 1024.f) + 1e-6f);
#pragma unroll
    for (int i = 0; i < 4; ++i) {
      int col = i * 256 + lane * 4;
      float4 nwv = *(const float4*)(nw + col);
      float4 o;
      o.x = v[rr][i].x * rstd * nwv.x; o.y = v[rr][i].y * rstd * nwv.y; o.z = v[rr][i].z * rstd * nwv.z; o.w = v[rr][i].w * rstd * nwv.w;
      *(float4*)(src + col) = o;
    }
  }
}

struct GemmArgs {
  const u16* A1; int lda1;
  const u16* A2; int lda2;
  int ksplit;
  const u16* Bt; int K;
};
template <int EPI>
DI void gemm_tile(const Params& p, const GemmArgs& g, int m0, int n0, unsigned char* smem) {
  u16* As = (u16*)smem;
  u16* Bs = As + 256 * 72;
  float* rs = (float*)(Bs + 128 * 72);
  const int tid = threadIdx.x, lane = tid & 63, w = tid >> 6;
  const int wm = (w >> 1) * 64, wn = (w & 1) * 64;
  const int l15 = lane & 15, l4 = lane >> 4;
  f32x4 acc[4][4];
#pragma unroll
  for (int i = 0; i < 4; ++i)
#pragma unroll
    for (int j = 0; j < 4; ++j) acc[i][j] = (f32x4){0.f, 0.f, 0.f, 0.f};
  if (EPI == 1) {
    if (tid < 256) {
      const float* rss = (const float*)(p.ws + OFF_ROWSS) + (size_t)(m0 + tid) * 16;
      float s = 0.f;
#pragma unroll
      for (int q = 0; q < 16; ++q) s += rss[q];
      rs[tid] = rsqrtf(s * (1.f / 1024.f) + 1e-6f);
    }
  }
  u32x4 ra[4], rb[2];
  const int KT = g.K >> 6;
  auto loadg = [&](int kt) {
    const int k0 = kt << 6;
    const u16* Ab; int lda; int kk;
    if (k0 < g.ksplit) { Ab = g.A1; lda = g.lda1; kk = k0; } else { Ab = g.A2; lda = g.lda2; kk = k0 - g.ksplit; }
#pragma unroll
    for (int i = 0; i < 4; ++i) {
      int id = tid + 512 * i; int r = id >> 3, c = (id & 7) * 8;
      ra[i] = *(const u32x4*)(Ab + (size_t)(m0 + r) * lda + kk + c);
    }
#pragma unroll
    for (int i = 0; i < 2; ++i) {
      int id = tid + 512 * i; int r = id >> 3, c = (id & 7) * 8;
      rb[i] = *(const u32x4*)(g.Bt + (size_t)(n0 + r) * g.K + k0 + c);
    }
  };
  loadg(0);
  for (int kt = 0; kt < KT; ++kt) {
#pragma unroll
    for (int i = 0; i < 4; ++i) {
      int id = tid + 512 * i; int r = id >> 3, c = (id & 7) * 8;
      *(u32x4*)(As + r * 72 + c) = ra[i];
    }
#pragma unroll
    for (int i = 0; i < 2; ++i) {
      int id = tid + 512 * i; int r = id >> 3, c = (id & 7) * 8;
      *(u32x4*)(Bs + r * 72 + c) = rb[i];
    }
    __syncthreads();
    if (kt + 1 < KT) loadg(kt + 1);
    if (EPI == 1) {
      if ((kt << 6) == g.ksplit) {
#pragma unroll
        for (int i = 0; i < 4; ++i)
#pragma unroll
          for (int r = 0; r < 4; ++r) {
            float sc = rs[wm + i * 16 + l4 * 4 + r];
#pragma unroll
            for (int j = 0; j < 4; ++j) acc[i][j][r] *= sc;
          }
      }
    }
#pragma unroll
    for (int ks = 0; ks < 2; ++ks) {
      bf16x8 a[4], b[4];
#pragma unroll
      for (int i = 0; i < 4; ++i) a[i] = *(const bf16x8*)(As + (wm + i * 16 + l15) * 72 + ks * 32 + l4 * 8);
#pragma unroll
      for (int j = 0; j < 4; ++j) b[j] = *(const bf16x8*)(Bs + (wn + j * 16 + l15) * 72 + ks * 32 + l4 * 8);
#pragma unroll
      for (int i = 0; i < 4; ++i)
#pragma unroll
        for (int j = 0; j < 4; ++j) acc[i][j] = MFMA16(a[i], b[j], acc[i][j]);
    }
    __syncthreads();
  }
#pragma unroll
  for (int i = 0; i < 4; ++i) {
    const int rbase = m0 + wm + i * 16 + l4 * 4;
#pragma unroll
    for (int j = 0; j < 4; ++j) {
      const int col = n0 + wn + j * 16 + l15;
      if (EPI == 0) {
        if (col < LDC0) {
          u16* C = (u16*)(p.ws + OFF_C0A);
#pragma unroll
          for (int r = 0; r < 4; ++r) C[(size_t)(rbase + r) * LDC0 + col] = f2bf(acc[i][j][r]);
        } else if (col < 6688) {
          u16* UT = (u16*)(p.ws + OFF_UT);
          u32x2 o; o[0] = pk2(acc[i][j][0], acc[i][j][1]); o[1] = pk2(acc[i][j][2], acc[i][j][3]);
          *(u32x2*)(UT + (size_t)(col - LDC0) * UTP + rbase) = o;
        }
      } else if (EPI == 1) {
        float* X1 = (float*)(p.ws + OFF_X1);
        const float* mod = (const float*)(p.ws + OFF_MOD);
#pragma unroll
        for (int r = 0; r < 4; ++r) {
          int row = rbase + r;
          const float* xs = row < NPROMPT ? p.in[0] + (size_t)row * 1024 : p.in[1] + (size_t)(row - NPROMPT) * 1024;
          float gate = mod[(0 * 3 + row_group(row)) * 3072 + 2048 + col];
          X1[(size_t)row * 1024 + col] = xs[col] + gate * acc[i][j][r];
        }
      } else if (EPI == 2) {
        u16* C1 = (u16*)(p.ws + OFF_C1);
#pragma unroll
        for (int r = 0; r < 4; ++r) {
          int row = rbase + r;
          C1[(size_t)row * LDC1 + col] = f2bf(acc[i][j][r]);
          if (row < NPROMPT && col >= 1024 && col < 3072) {
            int cc = col - 1024; int isv = cc >> 10; cc &= 1023;
            int hh = cc >> 6, d = cc & 63; int b = row >> 8, l = row & 255;
            float* o = p.out + (isv ? O_NV : O_NK);
            o[(((size_t)b * 16 + hh) * 256 + l) * 64 + d] = acc[i][j][r];
          }
        }
      } else {
        const float* X1 = (const float*)(p.ws + OFF_X1);
        const float* mod = (const float*)(p.ws + OFF_MOD);
#pragma unroll
        for (int r = 0; r < 4; ++r) {
          int row = rbase + r;
          float gate = mod[(1 * 3 + row_group(row)) * 3072 + 2048 + col];
          p.out[(size_t)row * 1024 + col] = X1[(size_t)row * 1024 + col] + gate * acc[i][j][r];
        }
      }
    }
  }
}


DI int lds_byte(int r, int c) {
  int st = (r >> 4) * 2 + (c >> 5), rr = r & 15, cc = c & 31, ob = rr * 64 + cc * 2;
  return st * 1024 + (ob ^ (((ob >> 9) & 1) << 5));
}
DI void stage_rc(int b, int& R, int& C) {
  int st = b / 1024, sb = b % 1024, swz = sb ^ (((sb >> 9) & 1) << 5);
  R = (st >> 1) * 16 + swz / 64; C = (st & 1) * 32 + (swz % 64) / 2;
}
template <int EPI>
DI void epi_store(const Params& p, int rbase, int col, const f32x4& v) {
  if (EPI == 0) {
    if (col < LDC0) {
      u16* C = (u16*)(p.ws + OFF_C0A);
#pragma unroll
      for (int r = 0; r < 4; ++r) C[(size_t)(rbase + r) * LDC0 + col] = f2bf(v[r]);
    } else if (col < 6688) {
      u16* UT = (u16*)(p.ws + OFF_UT);
      u32x2 o; o[0] = pk2(v[0], v[1]); o[1] = pk2(v[2], v[3]);
      *(u32x2*)(UT + (size_t)(col - LDC0) * UTP + rbase) = o;
    }
  } else if (EPI == 1) {
    float* X1 = (float*)(p.ws + OFF_X1);
    const float* mod = (const float*)(p.ws + OFF_MOD);
#pragma unroll
    for (int r = 0; r < 4; ++r) {
      int row = rbase + r;
      const float* xs = row < NPROMPT ? p.in[0] + (size_t)row * 1024 : p.in[1] + (size_t)(row - NPROMPT) * 1024;
      float gate = mod[(0 * 3 + row_group(row)) * 3072 + 2048 + col];
      X1[(size_t)row * 1024 + col] = xs[col] + gate * v[r];
    }
  } else if (EPI == 2) {
    u16* C1 = (u16*)(p.ws + OFF_C1);
#pragma unroll
    for (int r = 0; r < 4; ++r) {
      int row = rbase + r;
      C1[(size_t)row * LDC1 + col] = f2bf(v[r]);
      if (row < NPROMPT && col >= 1024 && col < 3072) {
        int cc = col - 1024; int isv = cc >> 10; cc &= 1023;
        int hh = cc >> 6, d = cc & 63; int b = row >> 8, l = row & 255;
        float* o = p.out + (isv ? O_NV : O_NK);
        o[(((size_t)b * 16 + hh) * 256 + l) * 64 + d] = v[r];
      }
    }
  } else {
    const float* X1 = (const float*)(p.ws + OFF_X1);
    const float* mod = (const float*)(p.ws + OFF_MOD);
#pragma unroll
    for (int r = 0; r < 4; ++r) {
      int row = rbase + r;
      float gate = mod[(1 * 3 + row_group(row)) * 3072 + 2048 + col];
      p.out[(size_t)row * 1024 + col] = X1[(size_t)row * 1024 + col] + gate * v[r];
    }
  }
}

template <int EPI>
DI void epi_store_sw(const Params& p, int row, int col, const f32x4& v) {
  if (EPI == 0) {
    u16* C = (u16*)(p.ws + OFF_C0A);
    u32x2 o; o[0] = pk2(v[0], v[1]); o[1] = pk2(v[2], v[3]);
    *(u32x2*)(C + (size_t)row * LDC0 + col) = o;
  } else if (EPI == 1) {
    float* X1 = (float*)(p.ws + OFF_X1);
    const float* mod = (const float*)(p.ws + OFF_MOD);
    const float* xs = row < NPROMPT ? p.in[0] + (size_t)row * 1024 : p.in[1] + (size_t)(row - NPROMPT) * 1024;
    const float4 xv = *(const float4*)(xs + col);
    const float4 gt = *(const float4*)(mod + (0 * 3 + row_group(row)) * 3072 + 2048 + col);
    float4 o; o.x = xv.x + gt.x * v[0]; o.y = xv.y + gt.y * v[1]; o.z = xv.z + gt.z * v[2]; o.w = xv.w + gt.w * v[3];
    *(float4*)(X1 + (size_t)row * 1024 + col) = o;
  } else if (EPI == 2) {
    u16* C1 = (u16*)(p.ws + OFF_C1);
    u32x2 o; o[0] = pk2(v[0], v[1]); o[1] = pk2(v[2], v[3]);
    *(u32x2*)(C1 + (size_t)row * LDC1 + col) = o;
    if (row < NPROMPT && col >= 1024 && col < 3072) {
      int cc = col - 1024; int isv = cc >> 10; cc &= 1023;
      int hh = cc >> 6, d = cc & 63; int b = row >> 8, l = row & 255;
      float* op = p.out + (isv ? O_NV : O_NK);
      *(float4*)(op + (((size_t)b * 16 + hh) * 256 + l) * 64 + d) = make_float4(v[0], v[1], v[2], v[3]);
    }
  } else {
    const float* X1 = (const float*)(p.ws + OFF_X1);
    const float* mod = (const float*)(p.ws + OFF_MOD);
    const float4 xv = *(const float4*)(X1 + (size_t)row * 1024 + col);
    const float4 gt = *(const float4*)(mod + (1 * 3 + row_group(row)) * 3072 + 2048 + col);
    float4 o; o.x = xv.x + gt.x * v[0]; o.y = xv.y + gt.y * v[1]; o.z = xv.z + gt.z * v[2]; o.w = xv.w + gt.w * v[3];
    *(float4*)(p.out + (size_t)row * 1024 + col) = o;
  }
}

template <int EPI, bool SWAP>
DI void gemm256(const Params& p, const GemmArgs& g, int brow, int bcol, unsigned char* smem) {
  constexpr int HT = 128 * 64;
  u16* shm = (u16*)smem;
  float* rs = (float*)(smem + 131072);
  const int K = g.K;
#define SA(b, h) (shm + ((b) * 2 + (h)) * HT)
#define SB(b, h) (shm + (4 + (b) * 2 + (h)) * HT)
#define STAGE_A(P, br, kt) do { const u16* _ub = g.A1 + (long)(br) * g.lda1 + (long)(kt) * 64; \
    for (int _i = 0; _i < 2; ++_i) { \
      __builtin_amdgcn_global_load_lds((const unsigned*)((const char*)(_ub + (long)_i * 64 * g.lda1) + aoff1), \
        (__attribute__((address_space(3))) unsigned*)((char*)(P) + threadIdx.x * 16 + _i * 8192), 16, 0, 0); } } while (0)
#define STAGE_B(P, bc, kt) do { const u16* _ub = g.Bt + (long)(bc) * K + (long)(kt) * 64; \
    for (int _i = 0; _i < 2; ++_i) { \
      __builtin_amdgcn_global_load_lds((const unsigned*)((const char*)(_ub + (long)_i * 64 * K) + boff), \
        (__attribute__((address_space(3))) unsigned*)((char*)(P) + threadIdx.x * 16 + _i * 8192), 16, 0, 0); } } while (0)
#define LDA(dst, b, h) for (int m = 0; m < 4; ++m) for (int k = 0; k < 2; ++k) \
    dst[m][k] = *reinterpret_cast<const bf16x8*>((char*)SA(b, h) + lds_byte(wr * 64 + m * 16 + fr, k * 32 + fq * 8))
#define LDB(dst, b, h) for (int n = 0; n < 2; ++n) for (int k = 0; k < 2; ++k) \
    dst[n][k] = *reinterpret_cast<const bf16x8*>((char*)SB(b, h) + lds_byte(wc * 32 + n * 16 + fr, k * 32 + fq * 8))
#define MMA(ai, bj, At_, Bt_) do { __builtin_amdgcn_s_setprio(1); \
    for (int m = 0; m < 4; ++m) for (int n = 0; n < 2; ++n) for (int k = 0; k < 2; ++k) \
      acc[ai][bj][m][n] = SWAP ? __builtin_amdgcn_mfma_f32_16x16x32_bf16(Bt_[n][k], At_[m][k], acc[ai][bj][m][n], 0, 0, 0) \
                               : __builtin_amdgcn_mfma_f32_16x16x32_bf16(At_[m][k], Bt_[n][k], acc[ai][bj][m][n], 0, 0, 0); \
    __builtin_amdgcn_s_setprio(0); } while (0)
#define WAIT_V(n) asm volatile("s_waitcnt vmcnt(" #n ")" ::: "memory")
#define WAIT_L(n) asm volatile("s_waitcnt lgkmcnt(" #n ")" ::: "memory")
#define BAR __builtin_amdgcn_s_barrier()
#define SCHED __builtin_amdgcn_sched_barrier(0)
  const int wid = threadIdx.x >> 6, lane = threadIdx.x & 63, wr = wid >> 2, wc = wid & 3, fr = lane & 15, fq = lane >> 4;
  unsigned aoff1, boff;
  {
    int r_, c_; stage_rc(threadIdx.x * 16, r_, c_);
    aoff1 = (unsigned)(r_ * g.lda1 + c_) * 2u;
    boff = (unsigned)(r_ * K + c_) * 2u;
  }
  if (EPI == 1) {
    if (threadIdx.x < 256) {
      const float* rss = (const float*)(p.ws + OFF_ROWSS) + (size_t)(brow + threadIdx.x) * 16;
      float s = 0.f;
#pragma unroll
      for (int q = 0; q < 16; ++q) s += rss[q];
      rs[threadIdx.x] = rsqrtf(s * (1.f / 1024.f) + 1e-6f);
    }
  }
  WAIT_V(0);
  __syncthreads();
  f32x4 acc[2][2][4][2];
#pragma unroll
  for (int a = 0; a < 2; ++a)
#pragma unroll
    for (int b = 0; b < 2; ++b)
#pragma unroll
      for (int m = 0; m < 4; ++m)
#pragma unroll
        for (int n = 0; n < 2; ++n) acc[a][b][m][n] = (f32x4){0.f, 0.f, 0.f, 0.f};
  bf16x8 At[4][2], B0[2][2], B1[2][2];
  const int nt = K / 64;
  const int tscale = (EPI == 1) ? (g.ksplit >> 6) : -1;
  STAGE_B(SB(0, 0), bcol, 0); STAGE_A(SA(0, 0), brow, 0);
  STAGE_B(SB(0, 1), bcol + 128, 0); STAGE_A(SA(0, 1), brow + 128, 0);
  if (wr == 1) BAR;
  WAIT_V(4); BAR;
  STAGE_B(SB(1, 0), bcol, 1); STAGE_A(SA(1, 0), brow, 1); STAGE_B(SB(1, 1), bcol + 128, 1);
  WAIT_V(6); BAR;
  for (int t = 0; t < nt - 2; t += 2) {
    if (EPI == 1) {
      if (t == tscale) {
#pragma unroll
        for (int a = 0; a < 2; ++a)
#pragma unroll
          for (int m = 0; m < 4; ++m)
#pragma unroll
            for (int j = 0; j < 4; ++j) {
              float sc = SWAP ? rs[a * 128 + wr * 64 + m * 16 + fr] : rs[a * 128 + wr * 64 + m * 16 + fq * 4 + j];
#pragma unroll
              for (int b = 0; b < 2; ++b)
#pragma unroll
                for (int n = 0; n < 2; ++n) acc[a][b][m][n][j] *= sc;
            }
      }
    }
    LDB(B0, 0, 0); SCHED; LDA(At, 0, 0); STAGE_A(SA(1, 1), brow + 128, t + 1);
    WAIT_L(8); BAR; WAIT_L(0); MMA(0, 0, At, B0); BAR; SCHED;
    LDB(B1, 0, 1); STAGE_B(SB(0, 0), bcol, t + 2);
    BAR; WAIT_L(0); MMA(0, 1, At, B1); BAR;
    LDA(At, 0, 1); STAGE_A(SA(0, 0), brow, t + 2);
    BAR; WAIT_L(0); MMA(1, 0, At, B0); BAR; SCHED;
    STAGE_B(SB(0, 1), bcol + 128, t + 2);
    WAIT_V(6); BAR; MMA(1, 1, At, B1); BAR;
    LDB(B0, 1, 0); SCHED; LDA(At, 1, 0); STAGE_A(SA(0, 1), brow + 128, t + 2);
    WAIT_L(8); BAR; WAIT_L(0); MMA(0, 0, At, B0); BAR; SCHED;
    LDB(B1, 1, 1); STAGE_B(SB(1, 0), bcol, t + 3);
    BAR; WAIT_L(0); MMA(0, 1, At, B1); BAR;
    LDA(At, 1, 1); STAGE_A(SA(1, 0), brow, t + 3);
    BAR; WAIT_L(0); MMA(1, 0, At, B0); BAR; SCHED;
    STAGE_B(SB(1, 1), bcol + 128, t + 3);
    WAIT_V(6); BAR; MMA(1, 1, At, B1); BAR;
  }
  { LDB(B0, 0, 0); LDA(At, 0, 0); STAGE_A(SA(1, 1), brow + 128, nt - 1);
    BAR; WAIT_L(0); MMA(0, 0, At, B0); BAR;
    LDB(B1, 0, 1); BAR; WAIT_L(0); MMA(0, 1, At, B1); BAR;
    LDA(At, 0, 1); WAIT_V(4); BAR; WAIT_L(0); MMA(1, 0, At, B0); MMA(1, 1, At, B1); BAR; }
  { LDB(B0, 1, 0); LDA(At, 1, 0); WAIT_V(2); BAR; WAIT_L(0); MMA(0, 0, At, B0); BAR;
    LDB(B1, 1, 1); WAIT_V(0); BAR; WAIT_L(0); MMA(0, 1, At, B1); BAR;
    LDA(At, 1, 1); BAR; WAIT_L(0); MMA(1, 0, At, B0); MMA(1, 1, At, B1); BAR; }
  if (wr == 0) BAR;
  int e_tid = threadIdx.x, e_brow = brow, e_bcol = bcol;
  asm volatile("" : "+v"(e_tid), "+s"(e_brow), "+s"(e_bcol));
  const int e_row = SWAP ? e_brow + ((e_tid >> 8) & 1) * 64 + (e_tid & 15) : e_brow + ((e_tid >> 8) & 1) * 64 + ((e_tid >> 4) & 3) * 4;
  const int e_col = SWAP ? e_bcol + ((e_tid >> 6) & 3) * 32 + ((e_tid >> 4) & 3) * 4 : e_bcol + ((e_tid >> 6) & 3) * 32 + (e_tid & 15);
#pragma unroll
  for (int ai = 0; ai < 2; ++ai)
#pragma unroll
    for (int bj = 0; bj < 2; ++bj)
#pragma unroll
      for (int m = 0; m < 4; ++m)
#pragma unroll
        for (int n = 0; n < 2; ++n) {
          if (SWAP) epi_store_sw<EPI>(p, e_row + ai * 128 + m * 16, e_col + bj * 128 + n * 16, acc[ai][bj][m][n]);
          else epi_store<EPI>(p, e_row + ai * 128 + m * 16, e_col + bj * 128 + n * 16, acc[ai][bj][m][n]);
        }
  __syncthreads();
#undef SA
#undef SB
#undef STAGE_A
#undef STAGE_B
#undef LDA
#undef LDB
#undef MMA
#undef WAIT_V
#undef WAIT_L
#undef BAR
#undef SCHED
}
DI bool gemm_tile_coord(int round, int NN, int ntiles, int& pm, int& pn) {
  const int b = blockIdx.x;
  const int v = round * 256 + (b & 7) * 32 + (b >> 3);
  if (v >= ntiles) return false;
  pm = (v / (8 * NN)) * 8 + (v & 7);
  pn = (v >> 3) % NN;
  return true;
}
struct SsdItem { int row0; int h; int has_prev; int has_next; };
DI SsdItem ssd_item(int item) {
  SsdItem s;
  int cgi = item >> 4; s.h = item & 15;
  if (cgi < 64) { int seq = cgi >> 1, c = cgi & 1; s.row0 = seq * 256 + c * 128; s.has_prev = c > 0; s.has_next = c < 1; }
  else { int q = cgi - 64; int seq = q >> 5, c = q & 31; s.row0 = NPROMPT + seq * 4096 + c * 128; s.has_prev = c > 0; s.has_next = c < 31; }
  return s;
}
DI float ssd_load_dt(const Params& p, int row0, int h) {
  const int tid = threadIdx.x;
  const u16* C0 = (const u16*)(p.ws + OFF_C0A);
  float raw = 0.f;
  if (tid < 256) { int d = tid >> 7, l = tid & 127; raw = bf2f(C0[(size_t)(row0 + l) * LDC0 + 2560 + d * 16 + h]); }
  return raw;
}
DI void ssd_prep_dt(const Params& p, float raw, int h, float* sdt, float* scs, float* stot) {
  const int tid = threadIdx.x, lane = tid & 63, w = tid >> 6;
  if (tid < 256) {
    int d = tid >> 7, l = tid & 127;
    float x = raw + p.in[14][d * 16 + h];
    float dt = x > 20.f ? x : log1pf(expf(x));
    float a = -expf(p.in[15][d * 16 + h]);
    sdt[d * 128 + l] = dt;
    scs[d * 128 + l] = a * dt;
  }
  __syncthreads();
  if (w < 2) {
    const int d = w;
    int p0 = d == 0 ? 2 * lane : 127 - 2 * lane;
    int p1 = d == 0 ? 2 * lane + 1 : 126 - 2 * lane;
    float v0 = scs[d * 128 + p0], v1 = scs[d * 128 + p1];
    float s = v0 + v1;
#pragma unroll
    for (int off = 1; off < 64; off <<= 1) {
      float tv = __shfl_up(s, off);
      if (lane >= off) s += tv;
    }
    float excl = s - (v0 + v1);
    scs[d * 128 + p0] = excl + v0;
    scs[d * 128 + p1] = excl + v0 + v1;
    if (lane == 63) stot[d] = s;
  }
  __syncthreads();
}
DI void conv_silu8(const Params& p, int row, int ch0, bool hp, bool hn, float* out) {
  const u16* C0 = (const u16*)(p.ws + OFF_C0A);
  const u16* q = C0 + (size_t)row * LDC0 + 1024 + ch0;
  const float* cw = p.in[12]; const float* cb = p.in[13];
  float xm[8], xc[8], xp[8];
  u32x4 vc = *(const u32x4*)q;
  unpack8(vc, xc);
  if (hp) { u32x4 v = *(const u32x4*)(q - LDC0); unpack8(v, xm); } else {
#pragma unroll
    for (int e = 0; e < 8; ++e) xm[e] = 0.f;
  }
  if (hn) { u32x4 v = *(const u32x4*)(q + LDC0); unpack8(v, xp); } else {
#pragma unroll
    for (int e = 0; e < 8; ++e) xp[e] = 0.f;
  }
  float4 w0a = *(const float4*)(cw + ch0), w0b = *(const float4*)(cw + ch0 + 4);
  float4 w1a = *(const float4*)(cw + 1536 + ch0), w1b = *(const float4*)(cw + 1536 + ch0 + 4);
  float4 w2a = *(const float4*)(cw + 3072 + ch0), w2b = *(const float4*)(cw + 3072 + ch0 + 4);
  float4 ba = *(const float4*)(cb + ch0), bb = *(const float4*)(cb + ch0 + 4);
  float w0[8] = {w0a.x, w0a.y, w0a.z, w0a.w, w0b.x, w0b.y, w0b.z, w0b.w};
  float w1[8] = {w1a.x, w1a.y, w1a.z, w1a.w, w1b.x, w1b.y, w1b.z, w1b.w};
  float w2[8] = {w2a.x, w2a.y, w2a.z, w2a.w, w2b.x, w2b.y, w2b.z, w2b.w};
  float bv[8] = {ba.x, ba.y, ba.z, ba.w, bb.x, bb.y, bb.z, bb.w};
#pragma unroll
  for (int e = 0; e < 8; ++e) out[e] = silu(bv[e] + w0[e] * xm[e] + w1[e] * xc[e] + w2[e] * xp[e]);
}


template <int R>
DI void conv_load(const Params& p, int row0, int l0, int ch0, bool prev_chunk, bool next_chunk, u32x4 (&raw)[R + 2]) {
  const u16* C0 = (const u16*)(p.ws + OFF_C0A);
  const u16* q = C0 + (size_t)(row0 + l0) * LDC0 + 1024 + ch0;
  const bool hp = (l0 > 0) || prev_chunk;
  const bool hn = (l0 + R < 128) || next_chunk;
#pragma unroll
  for (int i = 0; i < R + 2; ++i) {
    const bool ok = (i == 0) ? hp : ((i == R + 1) ? hn : true);
    raw[i] = (u32x4){0u, 0u, 0u, 0u};
    if (ok) raw[i] = *(const u32x4*)(q + (long)(i - 1) * LDC0);
  }
}
template <int R>
DI void conv_compute(const Params& p, int ch0, const u32x4 (&raw)[R + 2], float (&out)[R][8]) {
  const float* cw = p.in[12]; const float* cb = p.in[13];
  float4 w0a = *(const float4*)(cw + ch0), w0b = *(const float4*)(cw + ch0 + 4);
  float4 w1a = *(const float4*)(cw + 1536 + ch0), w1b = *(const float4*)(cw + 1536 + ch0 + 4);
  float4 w2a = *(const float4*)(cw + 3072 + ch0), w2b = *(const float4*)(cw + 3072 + ch0 + 4);
  float4 ba = *(const float4*)(cb + ch0), bb = *(const float4*)(cb + ch0 + 4);
  const float w0[8] = {w0a.x, w0a.y, w0a.z, w0a.w, w0b.x, w0b.y, w0b.z, w0b.w};
  const float w1[8] = {w1a.x, w1a.y, w1a.z, w1a.w, w1b.x, w1b.y, w1b.z, w1b.w};
  const float w2[8] = {w2a.x, w2a.y, w2a.z, w2a.w, w2b.x, w2b.y, w2b.z, w2b.w};
  const float bv[8] = {ba.x, ba.y, ba.z, ba.w, bb.x, bb.y, bb.z, bb.w};
  float xm[8], xc[8], xp[8];
  unpack8(raw[0], xm); unpack8(raw[1], xc);
#pragma unroll
  for (int i = 0; i < R; ++i) {
    unpack8(raw[i + 2], xp);
#pragma unroll
    for (int e = 0; e < 8; ++e) {
      out[i][e] = silu(bv[e] + w0[e] * xm[e] + w1[e] * xc[e] + w2[e] * xp[e]);
      xm[e] = xc[e]; xc[e] = xp[e];
    }
  }
}
DI void phase_ssd_states(const Params& p, int item, unsigned char* smem) {
  u16* xT = (u16*)smem;
  u16* BTs = xT + 64 * 136;
  float* sdt = (float*)(BTs + 2 * 128 * 136);
  float* scs = sdt + 256;
  float* sw = scs + 256;
  float* stot = sw + 256;
  const int tid = threadIdx.x, lane = tid & 63, w = tid >> 6;
  const int l15 = lane & 15, l4 = lane >> 4;
  const SsdItem it = ssd_item(item);
  const int h = it.h, grp = h >> 3;
  const int xchunk = tid & 7, xrg = tid >> 3;
  const int bchunk = tid & 15, brg = tid >> 4;
  u32x4 rawx[4], rawb[6];
  const float rawdt = ssd_load_dt(p, it.row0, h);
  conv_load<2>(p, it.row0, xrg * 2, h * 64 + xchunk * 8, it.has_prev, it.has_next, rawx);
  conv_load<4>(p, it.row0, brg * 4, 1024 + grp * 128 + bchunk * 8, it.has_prev, it.has_next, rawb);
  ssd_prep_dt(p, rawdt, h, sdt, scs, stot);
  if (tid < 256) {
    int d = tid >> 7;
    sw[tid] = sdt[tid] * __expf(stot[d] - scs[tid]);
  }
  __syncthreads();
  {
    {
      float o[2][8];
      conv_compute<2>(p, h * 64 + xchunk * 8, rawx, o);
#pragma unroll
      for (int e = 0; e < 8; ++e) *(unsigned*)(xT + (xchunk * 8 + e) * 136 + xrg * 2) = pk2(o[0][e], o[1][e]);
    }
    {
      float o[4][8];
      conv_compute<4>(p, 1024 + grp * 128 + bchunk * 8, rawb, o);
#pragma unroll
      for (int dd = 0; dd < 2; ++dd) {
        const float s0 = sw[dd * 128 + brg * 4], s1 = sw[dd * 128 + brg * 4 + 1], s2 = sw[dd * 128 + brg * 4 + 2], s3 = sw[dd * 128 + brg * 4 + 3];
#pragma unroll
        for (int e = 0; e < 8; ++e) {
          u32x2 v; v[0] = pk2(o[0][e] * s0, o[1][e] * s1); v[1] = pk2(o[2][e] * s2, o[3][e] * s3);
          *(u32x2*)(BTs + dd * 128 * 136 + (bchunk * 8 + e) * 136 + brg * 4) = v;
        }
      }
    }
  }
  __syncthreads();
  const int d = w >> 2, nq = w & 3;
  f32x4 acc[4][2];
#pragma unroll
  for (int i = 0; i < 4; ++i) { acc[i][0] = (f32x4){0.f, 0.f, 0.f, 0.f}; acc[i][1] = (f32x4){0.f, 0.f, 0.f, 0.f}; }
#pragma unroll
  for (int ks = 0; ks < 4; ++ks) {
    bf16x8 a[4], b[2];
#pragma unroll
    for (int i = 0; i < 4; ++i) a[i] = *(const bf16x8*)(xT + (i * 16 + l15) * 136 + ks * 32 + l4 * 8);
#pragma unroll
    for (int j = 0; j < 2; ++j) b[j] = *(const bf16x8*)(BTs + d * 128 * 136 + (nq * 32 + j * 16 + l15) * 136 + ks * 32 + l4 * 8);
#pragma unroll
    for (int i = 0; i < 4; ++i)
#pragma unroll
      for (int j = 0; j < 2; ++j) acc[i][j] = MFMA16(a[i], b[j], acc[i][j]);
  }
  u16* S = (u16*)((unsigned char*)p.out + OUT_SBUF) + ((size_t)item * 2 + d) * 8192;
#pragma unroll
  for (int i = 0; i < 4; ++i)
#pragma unroll
    for (int j = 0; j < 2; ++j)
#pragma unroll
      for (int r = 0; r < 4; ++r) {
        int pp = i * 16 + l4 * 4 + r, n = nq * 32 + j * 16 + l15;
        S[pp * 128 + n] = f2bf(acc[i][j][r]);
      }
  if (tid < 2) {
    float* cdec = (float*)(p.ws + OFF_CDEC);
    cdec[item * 2 + tid] = __expf(stot[tid]);
  }
  __syncthreads();
}

DI void phase_scan(const Params& p, int t) {
  const int part = t & 1, d = (t >> 1) & 1, h = (t >> 2) & 15, seq = t >> 6;
  const int tid = threadIdx.x;
  const int e0 = part * 4096 + tid * 8;
  const int nc = seq < 32 ? 2 : 32;
  const int cg0 = seq < 32 ? seq * 2 : 64 + (seq - 32) * 32;
  float st[8];
  if (seq < 32) {
#pragma unroll
    for (int e = 0; e < 8; ++e) st[e] = 0.f;
  } else {
    const float* init = p.in[2] + ((((size_t)(seq - 32) * 1 + 0) * 2 + d) * 16 + h) * 8192 + e0;
    float4 a = *(const float4*)init, b = *(const float4*)(init + 4);
    st[0] = a.x; st[1] = a.y; st[2] = a.z; st[3] = a.w; st[4] = b.x; st[5] = b.y; st[6] = b.z; st[7] = b.w;
  }
  u16* Sb = (u16*)((unsigned char*)p.out + OUT_SBUF);
  const float* cdec = (const float*)(p.ws + OFF_CDEC);
  for (int cb0 = 0; cb0 < nc; cb0 += 8) {
    u32x4 vv[8]; float dec[8];
#pragma unroll
    for (int i = 0; i < 8; ++i) {
      if (cb0 + i < nc) {
        const int ci = cb0 + i;
        const int c = d == 0 ? ci : nc - 1 - ci;
        const int item = (cg0 + c) * 16 + h;
        vv[i] = *(const u32x4*)(Sb + ((size_t)item * 2 + d) * 8192 + e0);
        dec[i] = cdec[item * 2 + d];
      }
    }
#pragma unroll
    for (int i = 0; i < 8; ++i) {
      if (cb0 + i < nc) {
        const int ci = cb0 + i;
        const int c = d == 0 ? ci : nc - 1 - ci;
        const int item = (cg0 + c) * 16 + h;
        float sc[8]; unpack8(vv[i], sc);
        *(u32x4*)(Sb + ((size_t)item * 2 + d) * 8192 + e0) = pack8(st);
#pragma unroll
        for (int e = 0; e < 8; ++e) st[e] = st[e] * dec[i] + sc[e];
      }
    }
  }
  if (seq < 32) {
    float* o = p.out + O_ST + ((((size_t)seq * 1 + 0) * 2 + d) * 16 + h) * 8192 + e0;
    *(float4*)o = make_float4(st[0], st[1], st[2], st[3]);
    *(float4*)(o + 4) = make_float4(st[4], st[5], st[6], st[7]);
  }
}

DI void phase_ssd_out(const Params& p, int item, unsigned char* smem, bool dry) {
  u16* Cs = (u16*)smem;
  u16* Bs = Cs + 128 * 136;
  u16* xT = Bs + 128 * 136;
  u16* St = xT + 64 * 136;
  float* sdt = (float*)(St + 2 * 64 * 136);
  float* scs = sdt + 256;
  float* stot = scs + 256;
  const int tid = threadIdx.x, lane = tid & 63, w = tid >> 6;
  const int l15 = lane & 15, l4 = lane >> 4;
  const SsdItem it = ssd_item(item);
  const int h = it.h, grp = h >> 3;
  const int xchunk = tid & 7, xrg = tid >> 3;
  const int bchunk = tid & 15, brg = tid >> 4;
  u32x4 rawx[4], rawb[6], rawc[6], rawst[4];
  u16 zraw[4][4];
  const float rawdt = ssd_load_dt(p, it.row0, h);
  conv_load<2>(p, it.row0, xrg * 2, h * 64 + xchunk * 8, it.has_prev, it.has_next, rawx);
  conv_load<4>(p, it.row0, brg * 4, 1024 + grp * 128 + bchunk * 8, it.has_prev, it.has_next, rawb);
  conv_load<4>(p, it.row0, brg * 4, 1280 + grp * 128 + bchunk * 8, it.has_prev, it.has_next, rawc);
  {
    const u16* S = (const u16*)((const unsigned char*)p.out + OUT_SBUF) + (size_t)item * 2 * 8192;
#pragma unroll
    for (int v = 0; v < 4; ++v) {
      int id = tid + 512 * v;
      int dd = id >> 10, pp = (id >> 4) & 63, nv = (id & 15) * 8;
      rawst[v] = *(const u32x4*)(S + dd * 8192 + pp * 128 + nv);
    }
  }
  ssd_prep_dt(p, rawdt, h, sdt, scs, stot);
  {
    {
      float o[2][8];
      conv_compute<2>(p, h * 64 + xchunk * 8, rawx, o);
#pragma unroll
      for (int e = 0; e < 8; ++e) *(unsigned*)(xT + (xchunk * 8 + e) * 136 + xrg * 2) = pk2(o[0][e], o[1][e]);
    }
    {
      float o[4][8];
      conv_compute<4>(p, 1024 + grp * 128 + bchunk * 8, rawb, o);
#pragma unroll
      for (int i = 0; i < 4; ++i) *(u32x4*)(Bs + (brg * 4 + i) * 136 + bchunk * 8) = pack8(o[i]);
      conv_compute<4>(p, 1280 + grp * 128 + bchunk * 8, rawc, o);
#pragma unroll
      for (int i = 0; i < 4; ++i) *(u32x4*)(Cs + (brg * 4 + i) * 136 + bchunk * 8) = pack8(o[i]);
    }
#pragma unroll
    for (int v = 0; v < 4; ++v) {
      int id = tid + 512 * v;
      int dd = id >> 10, pp = (id >> 4) & 63, nv = (id & 15) * 8;
      *(u32x4*)(St + dd * 64 * 136 + pp * 136 + nv) = rawst[v];
    }
  }
  __syncthreads();
  {
    const u16* C0z = (const u16*)(p.ws + OFF_C0A);
#pragma unroll
    for (int i = 0; i < 4; ++i)
#pragma unroll
      for (int r = 0; r < 4; ++r)
        zraw[i][r] = C0z[(size_t)(it.row0 + 16 * w + l4 * 4 + r) * LDC0 + h * 64 + i * 16 + l15];
  }
  f32x4 cb[8], af[4], ab[4];
#pragma unroll
  for (int j = 0; j < 8; ++j) cb[j] = (f32x4){0.f, 0.f, 0.f, 0.f};
#pragma unroll
  for (int i = 0; i < 4; ++i) { af[i] = (f32x4){0.f, 0.f, 0.f, 0.f}; ab[i] = (f32x4){0.f, 0.f, 0.f, 0.f}; }
#pragma unroll
  for (int ks = 0; ks < 4; ++ks) {
    bf16x8 a = *(const bf16x8*)(Cs + (16 * w + l15) * 136 + ks * 32 + l4 * 8);
#pragma unroll
    for (int j = 0; j < 8; ++j) {
      bf16x8 b = *(const bf16x8*)(Bs + (j * 16 + l15) * 136 + ks * 32 + l4 * 8);
      cb[j] = MFMA16(b, a, cb[j]);
    }
#pragma unroll
    for (int i = 0; i < 4; ++i) {
      bf16x8 b0 = *(const bf16x8*)(St + (i * 16 + l15) * 136 + ks * 32 + l4 * 8);
      bf16x8 b1 = *(const bf16x8*)(St + 64 * 136 + (i * 16 + l15) * 136 + ks * 32 + l4 * 8);
      af[i] = MFMA16(a, b0, af[i]);
      ab[i] = MFMA16(a, b1, ab[i]);
    }
  }
  __syncthreads();
  f32x4 Y[4];
  {
    const int lrow = 16 * w + l15;
    const float cs0l = scs[lrow], cs1l = scs[128 + lrow];
#pragma unroll
    for (int j = 0; j < 8; ++j) {
      const int s0 = j * 16 + l4 * 4;
      float f[4];
      if (j < w) {
        const float4 c4 = *(const float4*)(scs + s0), d4 = *(const float4*)(sdt + s0);
        f[0] = __expf(cs0l - c4.x) * d4.x; f[1] = __expf(cs0l - c4.y) * d4.y; f[2] = __expf(cs0l - c4.z) * d4.z; f[3] = __expf(cs0l - c4.w) * d4.w;
      } else if (j > w) {
        const float4 c4 = *(const float4*)(scs + 128 + s0), d4 = *(const float4*)(sdt + 128 + s0);
        f[0] = __expf(cs1l - c4.x) * d4.x; f[1] = __expf(cs1l - c4.y) * d4.y; f[2] = __expf(cs1l - c4.z) * d4.z; f[3] = __expf(cs1l - c4.w) * d4.w;
      } else {
        const float4 c4 = *(const float4*)(scs + s0), d4 = *(const float4*)(sdt + s0);
        const float4 e4 = *(const float4*)(scs + 128 + s0), g4 = *(const float4*)(sdt + 128 + s0);
        const float c0[4] = {c4.x, c4.y, c4.z, c4.w}, d0[4] = {d4.x, d4.y, d4.z, d4.w};
        const float c1[4] = {e4.x, e4.y, e4.z, e4.w}, d1[4] = {g4.x, g4.y, g4.z, g4.w};
#pragma unroll
        for (int jj = 0; jj < 4; ++jj) {
          const int sidx = s0 + jj;
          float v;
          if (lrow > sidx) v = __expf(cs0l - c0[jj]) * d0[jj];
          else if (lrow < sidx) v = __expf(cs1l - c1[jj]) * d1[jj];
          else v = d0[jj] + d1[jj];
          f[jj] = v;
        }
      }
      u32x2 o; o[0] = pk2(cb[j][0] * f[0], cb[j][1] * f[1]); o[1] = pk2(cb[j][2] * f[2], cb[j][3] * f[3]);
      *(u32x2*)(Bs + lrow * 136 + s0) = o;
    }
#pragma unroll
    for (int r = 0; r < 4; ++r) {
      const int l = 16 * w + l4 * 4 + r;
      float e0 = __expf(scs[l]), e1 = __expf(scs[128 + l]);
#pragma unroll
      for (int i = 0; i < 4; ++i) Y[i][r] = af[i][r] * e0 + ab[i][r] * e1;
    }
  }
  __syncthreads();
#pragma unroll
  for (int ks = 0; ks < 4; ++ks) {
    bf16x8 a = *(const bf16x8*)(Bs + (16 * w + l15) * 136 + ks * 32 + l4 * 8);
#pragma unroll
    for (int i = 0; i < 4; ++i) {
      bf16x8 b = *(const bf16x8*)(xT + (i * 16 + l15) * 136 + ks * 32 + l4 * 8);
      Y[i] = MFMA16(a, b, Y[i]);
    }
  }
  {
    const u16* C0 = (const u16*)(p.ws + OFF_C0A);
    u16* YAB = dry ? (u16*)(p.ws + OFF_DUMMY) + (size_t)(blockIdx.x & 15) * 400000 - (size_t)it.row0 * 2048 : (u16*)((unsigned char*)p.out + OUT_YB);
    const float dsk = p.in[16][h] + p.in[16][16 + h];
    float ss[4] = {0.f, 0.f, 0.f, 0.f};
#pragma unroll
    for (int i = 0; i < 4; ++i) {
      const int pp = i * 16 + l15;
#pragma unroll
      for (int r = 0; r < 4; ++r) {
        const int l = 16 * w + l4 * 4 + r;
        const size_t off = (size_t)(it.row0 + l) * LDC0 + h * 64 + pp;
        float xv = bf2f(xT[pp * 136 + l]);
        float y = Y[i][r] + xv * dsk;
        float z = bf2f(zraw[i][r]);
        float gv = y * silu(z);
        YAB[(size_t)(it.row0 + l) * 2048 + h * 64 + pp] = f2bf(gv);
        ss[r] += gv * gv;
      }
    }
    float* rss = (float*)(p.ws + OFF_ROWSS);
#pragma unroll
    for (int r = 0; r < 4; ++r) {
      float s = ss[r];
      s += __shfl_xor(s, 1); s += __shfl_xor(s, 2); s += __shfl_xor(s, 4); s += __shfl_xor(s, 8);
      if (l15 == 0) rss[(size_t)(it.row0 + 16 * w + l4 * 4 + r) * 16 + h] = s;
    }
  }
  __syncthreads();
}


typedef const __attribute__((address_space(3))) char* lds_cptr;
template <int MASK, int PART>
DI void hy_seg(int dlo, int dhi, int L, int A, const u16* hr, const u16* vx, const int (&ncol)[4], const int (&acol)[4],
               int l31, int kh, f32x16 (&acc)[4]) {
  const lds_cptr hr3 = (lds_cptr)hr;
  const lds_cptr vx3 = (lds_cptr)vx;
  lds_cptr aaddr = hr3 + 2 * (L - 1 - 32 * dlo - l31 + 8 * kh);
  lds_cptr baddr[4], bsafe[4]; int asrc[4];
#pragma unroll
  for (int j = 0; j < 4; ++j) {
    bsafe[j] = vx3 + ncol[j] * 80 + 16 * kh;
    baddr[j] = bsafe[j] - dlo * 80;
    asrc[j] = acol[j] - dlo;
  }
#pragma unroll 1
  for (int d = dlo; d <= dhi; ++d) {
    bf16x8 bfr[4][2];
#pragma unroll
    for (int j = 0; j < 4; ++j) {
      if (MASK & (1 << j)) {
        if (PART & (1 << j)) {
          const bool valid = (unsigned)asrc[j] < (unsigned)A;
          const lds_cptr ba = valid ? baddr[j] : bsafe[j];
#pragma unroll
          for (int khalf = 0; khalf < 2; ++khalf) {
            bf16x8 t = *(const __attribute__((address_space(3))) bf16x8*)(ba + 32 * khalf);
            if (!valid) t = (bf16x8){0, 0, 0, 0, 0, 0, 0, 0};
            bfr[j][khalf] = t;
          }
        } else {
#pragma unroll
          for (int khalf = 0; khalf < 2; ++khalf)
            bfr[j][khalf] = *(const __attribute__((address_space(3))) bf16x8*)(baddr[j] + 32 * khalf);
        }
      }
    }
    unsigned e0, e1, e2, e3, e4, e5, e6, e7, e8, e9, e10, e11, e12, e13, e14, e15;
    asm volatile(
        "ds_read_u16 %0, %16\n\tds_read_u16 %1, %16 offset:2\n\t"
        "ds_read_u16 %2, %16 offset:4\n\tds_read_u16 %3, %16 offset:6\n\t"
        "ds_read_u16 %4, %16 offset:8\n\tds_read_u16 %5, %16 offset:10\n\t"
        "ds_read_u16 %6, %16 offset:12\n\tds_read_u16 %7, %16 offset:14\n\t"
        "ds_read_u16 %8, %16 offset:32\n\tds_read_u16 %9, %16 offset:34\n\t"
        "ds_read_u16 %10, %16 offset:36\n\tds_read_u16 %11, %16 offset:38\n\t"
        "ds_read_u16 %12, %16 offset:40\n\tds_read_u16 %13, %16 offset:42\n\t"
        "ds_read_u16 %14, %16 offset:44\n\tds_read_u16 %15, %16 offset:46\n\t"
        "s_waitcnt lgkmcnt(0)"
        : "=&v"(e0), "=&v"(e1), "=&v"(e2), "=&v"(e3), "=&v"(e4), "=&v"(e5), "=&v"(e6), "=&v"(e7),
          "=&v"(e8), "=&v"(e9), "=&v"(e10), "=&v"(e11), "=&v"(e12), "=&v"(e13), "=&v"(e14), "=&v"(e15)
        : "v"(aaddr) : "memory");
    bf16x8 af[2];
    { u32x4 q0 = {e0 | (e1 << 16), e2 | (e3 << 16), e4 | (e5 << 16), e6 | (e7 << 16)};
      u32x4 q1 = {e8 | (e9 << 16), e10 | (e11 << 16), e12 | (e13 << 16), e14 | (e15 << 16)};
      af[0] = __builtin_bit_cast(bf16x8, q0); af[1] = __builtin_bit_cast(bf16x8, q1); }
#pragma unroll
    for (int khalf = 0; khalf < 2; ++khalf)
#pragma unroll
      for (int j = 0; j < 4; ++j)
        if (MASK & (1 << j)) acc[j] = MFMA32(af[khalf], bfr[j][khalf], acc[j]);
    aaddr -= 64;
#pragma unroll
    for (int j = 0; j < 4; ++j) { baddr[j] -= 80; asrc[j] -= 1; }
  }
}

DI void phase_hyena(const Params& p, int it, unsigned char* smem, bool dry) {
  const int cfg = it < 256 ? 1 : 0;
  const int c0 = (it & 255) * 4;
  const int L = cfg ? 4096 : 256;
  const int A = L >> 5;
  const int lgA = cfg ? 7 : 3;
  const int rowbase = cfg ? NPROMPT : 0;
  u16* vxs = (u16*)smem;
  u16* hrs = vxs + 4 * 10240;
  const int tid = threadIdx.x, lane = tid & 63, w = tid >> 6;
  const u16* UT = (const u16*)(p.ws + OFF_UT);
  const float* cw = p.in[18]; const float* cbv = p.in[19];
  {
    const u16* HF = (const u16*)((const unsigned char*)p.out + (cfg ? OUT_HF4096 : OUT_HF256));
    const int nv = (2 * L) >> 3;
    const int lgnv = cfg ? 10 : 6;
    {
      u32x4 fv[8];
#pragma unroll
      for (int it8 = 0; it8 < 8; ++it8) {
        const int id = tid + it8 * NT;
        fv[it8] = (u32x4){0u, 0u, 0u, 0u};
        if (id < 4 * nv) { int chh = id >> lgnv, v8 = id & (nv - 1); fv[it8] = *(const u32x4*)(HF + (size_t)(c0 + chh) * 2 * L + v8 * 8); }
      }
#pragma unroll
      for (int it8 = 0; it8 < 8; ++it8) {
        const int id = tid + it8 * NT;
        if (id < 4 * nv) { int chh = id >> lgnv, v8 = id & (nv - 1); *(u32x4*)(hrs + chh * 2 * L + v8 * 8) = fv[it8]; }
      }
    }
#pragma unroll 1
    for (int hb4 = 0; hb4 < 2; ++hb4) {
    u32x4 rv[4][2]; float hm[4][2], hp[4][2];
#pragma unroll
    for (int it8 = 0; it8 < 4; ++it8) {
      const int id = tid + (hb4 * 4 + it8) * NT;
      const int chh = id >> 10, blk8 = id & 1023;
      const int pos = blk8 * 8, tl = pos & (L - 1);
#pragma unroll
      for (int which = 1; which <= 2; ++which) {
        const u16* q = UT + (size_t)(which * 1024 + c0 + chh) * UTP + rowbase + pos;
        rv[it8][which - 1] = *(const u32x4*)q;
        hm[it8][which - 1] = (tl > 0) ? bf2f(q[-1]) : 0.f;
        hp[it8][which - 1] = (tl + 8 < L) ? bf2f(q[8]) : 0.f;
      }
    }
#pragma unroll
    for (int it8 = 0; it8 < 4; ++it8) {
      const int id = tid + (hb4 * 4 + it8) * NT;
      const int chh = id >> 10, blk8 = id & 1023;
      const int pos = blk8 * 8;
      float res[8];
#pragma unroll
      for (int e = 0; e < 8; ++e) res[e] = 1.f;
#pragma unroll
      for (int which = 1; which <= 2; ++which) {
        const int uc = which * 1024 + c0 + chh;
        float xv[10];
        unpack8(rv[it8][which - 1], xv + 1);
        xv[0] = hm[it8][which - 1]; xv[9] = hp[it8][which - 1];
        const float w0 = cw[uc], w1 = cw[3072 + uc], w2 = cw[6144 + uc], bb = cbv[uc];
#pragma unroll
        for (int e = 0; e < 8; ++e) res[e] *= (bb + w0 * xv[e] + w1 * xv[e + 1] + w2 * xv[e + 2]);
      }
      const int n = pos >> 5, k = pos & 31;
      *(u32x4*)(vxs + chh * 10240 + n * 40 + k) = pack8(res);
    }
    }
  }
  __syncthreads();
  const int ch = w >> 1, wv = w & 1;
  const int l31 = lane & 31, kh = lane >> 5;
  const u16* vx = vxs + ch * 10240;
  const u16* hr = hrs + ch * 2 * L;
  f32x16 acc[4];
#pragma unroll
  for (int j = 0; j < 4; ++j)
#pragma unroll
    for (int r = 0; r < 16; ++r) acc[j][r] = 0.f;
  int ncol[4], acol[4];
#pragma unroll
  for (int j = 0; j < 4; ++j) { ncol[j] = 128 * wv + 32 * j + l31; acol[j] = ncol[j] & (A - 1); }
  if (!(dry && REP_SUB == 4)) {
  if (cfg) {
    hy_seg<1, 1>(-127, -96, L, A, hr, vx, ncol, acol, l31, kh, acc);
    hy_seg<3, 2>(-95, -64, L, A, hr, vx, ncol, acol, l31, kh, acc);
    hy_seg<7, 4>(-63, -32, L, A, hr, vx, ncol, acol, l31, kh, acc);
    hy_seg<15, 9>(-31, 31, L, A, hr, vx, ncol, acol, l31, kh, acc);
    hy_seg<14, 2>(32, 63, L, A, hr, vx, ncol, acol, l31, kh, acc);
    hy_seg<12, 4>(64, 95, L, A, hr, vx, ncol, acol, l31, kh, acc);
    hy_seg<8, 8>(96, 127, L, A, hr, vx, ncol, acol, l31, kh, acc);
  } else {
    hy_seg<15, 15>(-7, 7, L, A, hr, vx, ncol, acol, l31, kh, acc);
  }
  }
  {
    const float hb = p.in[26][c0 + ch];
#pragma unroll
    for (int j = 0; j < 4; ++j) {
      const int n = ncol[j];
#pragma unroll
      for (int q = 0; q < 4; ++q) {
        u32x2 vr = *(const u32x2*)(vx + n * 40 + 8 * q + 4 * kh);
        acc[j][4 * q + 0] += bflo(vr[0]) * hb; acc[j][4 * q + 1] += bfhi(vr[0]) * hb;
        acc[j][4 * q + 2] += bflo(vr[1]) * hb; acc[j][4 * q + 3] += bfhi(vr[1]) * hb;
      }
    }
  }
  __syncthreads();
  float* FL = (float*)smem;
  {
#pragma unroll
    for (int j = 0; j < 4; ++j) {
      const int n = ncol[j];
#pragma unroll
      for (int q = 0; q < 4; ++q) {
        const int pos = 32 * n + 8 * q + 4 * kh;
        *(float4*)(FL + ch * 9216 + pos + (pos >> 5) * 4) = make_float4(acc[j][4 * q], acc[j][4 * q + 1], acc[j][4 * q + 2], acc[j][4 * q + 3]);
      }
    }
  }
  __syncthreads();
#pragma unroll 2
  for (int it8 = 0; it8 < 8; ++it8) {
    const int chh = it8 >> 1;
    const int c = c0 + chh;
    const int pos = ((tid + it8 * NT) & 1023) * 8;
    const int tl = pos & (L - 1);
    const u16* x0row = UT + (size_t)c * UTP + rowbase;
    const u16* grow = UT + (size_t)(3072 + c) * UTP + rowbase;
    u16* groww = dry ? (u16*)(p.ws + OFF_DUMMY) + (size_t)blockIdx.x * 32768 + chh * 8192
                     : (u16*)(p.ws + OFF_UT) + (size_t)(3072 + c) * UTP + rowbase;
    const u32x4 xr = *(const u32x4*)(x0row + pos);
    const u32x4 gr = *(const u32x4*)(grow + pos);
    float xv[10], gv[8];
    unpack8(xr, xv + 1); unpack8(gr, gv);
    xv[0] = tl > 0 ? bf2f(x0row[pos - 1]) : 0.f;
    xv[9] = (tl + 8 < L) ? bf2f(x0row[pos + 8]) : 0.f;
    const float w0 = cw[c], w1 = cw[3072 + c], w2 = cw[6144 + c], bb = cbv[c];
    const float* fl = FL + chh * 9216 + pos + (pos >> 5) * 4;
    const float4 a0 = *(const float4*)fl, a1 = *(const float4*)(fl + 4);
    const float av[8] = {a0.x, a0.y, a0.z, a0.w, a1.x, a1.y, a1.z, a1.w};
    float y[8];
#pragma unroll
    for (int e = 0; e < 8; ++e) {
      float x0 = bb + w0 * xv[e] + w1 * xv[e + 1] + w2 * xv[e + 2];
      y[e] = x0 * av[e] * silu(gv[e]);
    }
    *(u32x4*)(groww + pos) = pack8(y);
  }
  (void)lgA;
  __syncthreads();
}

#define VSP 72
typedef __attribute__((ext_vector_type(4))) short v4i16_t;
DI float dpp_rowmax(float v) {
  v = fmaxf(v, __builtin_bit_cast(float, __builtin_amdgcn_update_dpp(0, __builtin_bit_cast(int, v), 0x128, 0xf, 0xf, false)));
  v = fmaxf(v, __builtin_bit_cast(float, __builtin_amdgcn_update_dpp(0, __builtin_bit_cast(int, v), 0x124, 0xf, 0xf, false)));
  v = fmaxf(v, __builtin_bit_cast(float, __builtin_amdgcn_update_dpp(0, __builtin_bit_cast(int, v), 0x122, 0xf, 0xf, false)));
  v = fmaxf(v, __builtin_bit_cast(float, __builtin_amdgcn_update_dpp(0, __builtin_bit_cast(int, v), 0x121, 0xf, 0xf, false)));
  return v;
}
DI float dpp_rowsum(float v) {
  v += __builtin_bit_cast(float, __builtin_amdgcn_update_dpp(0, __builtin_bit_cast(int, v), 0x128, 0xf, 0xf, false));
  v += __builtin_bit_cast(float, __builtin_amdgcn_update_dpp(0, __builtin_bit_cast(int, v), 0x124, 0xf, 0xf, false));
  v += __builtin_bit_cast(float, __builtin_amdgcn_update_dpp(0, __builtin_bit_cast(int, v), 0x122, 0xf, 0xf, false));
  v += __builtin_bit_cast(float, __builtin_amdgcn_update_dpp(0, __builtin_bit_cast(int, v), 0x121, 0xf, 0xf, false));
  return v;
}
#define OUT_CKV 0ul
DI void phase_attn(const Params& p, int item, unsigned char* smem, bool dry) {
  u16* VS = (u16*)smem;
  u16* Pb = VS + 832 * VSP;
  float* rp = (float*)(Pb + 8 * 16 * 72);
  const int tid = threadIdx.x, lane = tid & 63, w = tid >> 6;
  const int l15 = lane & 15, l4 = lane >> 4;
  const u16* C1 = (const u16*)(p.ws + OFF_C1);
  const u16* CK = (const u16*)((const unsigned char*)p.out + OUT_CKV);
  const u16* CV = CK + 524288;
  const bool lat = item < 1024;
  int b, h, myr = 0, rows0w = 0, vrow0 = 0, nvrows = 0, qbase, jq = w & 3;
  if (lat) {
    b = item >> 9; h = (item >> 5) & 15; const int r0 = (item & 31) * 2;
    myr = r0 + (w >> 2);
    rows0w = min(max(myr - 4, 0), 56);
    vrow0 = min(max(r0 - 4, 0), 56);
    nvrows = min(9, 64 - vrow0);
    qbase = NPROMPT + b * 4096 + myr * 64 + jq * 16;
  } else {
    const int q = item - 1024; b = q >> 5; h = (q >> 1) & 15;
    qbase = b * 256 + (q & 1) * 128 + w * 16;
  }
  const int cstart = min(max(16 * jq - 8, 0), 32);
  const int ntile = lat ? 8 : 4;
  bf16x8 qa[2];
#pragma unroll
  for (int ks = 0; ks < 2; ++ks) qa[ks] = *(const bf16x8*)(C1 + (size_t)(qbase + l15) * LDC1 + h * 64 + ks * 32 + l4 * 8);
  auto loadk = [&](int tt, bf16x8 (&kb)[4][2]) {
#pragma unroll
    for (int jt = 0; jt < 4; ++jt) {
      const u16* src;
      if (lat) {
        if (tt < 4) src = C1 + (size_t)(NPROMPT + b * 4096 + (rows0w + tt * 2 + (jt >> 1)) * 64 + cstart + (jt & 1) * 16 + l15) * LDC1 + 1024 + h * 64;
        else src = CK + ((size_t)(b * 16 + h) * 256 + (tt - 4) * 64 + jt * 16 + l15) * 64;
      } else {
        src = C1 + (size_t)(b * 256 + tt * 64 + jt * 16 + l15) * LDC1 + 1024 + h * 64;
      }
#pragma unroll
      for (int ks = 0; ks < 2; ++ks) kb[jt][ks] = *(const bf16x8*)(src + ks * 32 + l4 * 8);
    }
  };
  bf16x8 kn[4][2], kn2[4][2];
  loadk(0, kn);
  loadk(1, kn2);
  u16 graw[4][4];
#pragma unroll
  for (int r = 0; r < 4; ++r)
#pragma unroll
    for (int i = 0; i < 4; ++i)
      graw[r][i] = C1[(size_t)(qbase + l4 * 4 + r) * LDC1 + 3072 + h * 64 + i * 16 + l15];
  {
    const int nloc = lat ? nvrows * 64 : 256;
    const int keyrow0 = lat ? NPROMPT + b * 4096 + vrow0 * 64 : b * 256;
    u32x4 vv[9], cvv[4];
#pragma unroll
    for (int i = 0; i < 9; ++i) {
      const int id = tid + i * NT;
      vv[i] = (u32x4){0u, 0u, 0u, 0u};
      if (id < nloc * 8) { int key = id >> 3, d0 = (id & 7) * 8; vv[i] = *(const u32x4*)(C1 + (size_t)(keyrow0 + key) * LDC1 + 2048 + h * 64 + d0); }
    }
    if (lat) {
#pragma unroll
      for (int i = 0; i < 4; ++i) {
        const int id = tid + i * NT; int key = id >> 3, d0 = (id & 7) * 8;
        cvv[i] = *(const u32x4*)(CV + ((size_t)(b * 16 + h) * 256 + key) * 64 + d0);
      }
    }
#pragma unroll
    for (int i = 0; i < 9; ++i) {
      const int id = tid + i * NT;
      if (id < nloc * 8) { int key = id >> 3, d0 = (id & 7) * 8; *(u32x4*)(VS + key * VSP + d0) = vv[i]; }
    }
    if (lat) {
#pragma unroll
      for (int i = 0; i < 4; ++i) {
        const int id = tid + i * NT; int key = id >> 3, d0 = (id & 7) * 8;
        *(u32x4*)(VS + (576 + key) * VSP + d0) = cvv[i];
      }
      for (int id = tid; id < 465; id += NT) rp[id] = p.in[29][h * 465 + id] * 1.4426950408889634f;
    }
  }
  __syncthreads();
  float mrow[4], lrow[4];
  f32x4 O[4];
#pragma unroll
  for (int r = 0; r < 4; ++r) { mrow[r] = -1e30f; lrow[r] = 0.f; }
#pragma unroll
  for (int i = 0; i < 4; ++i) O[i] = (f32x4){0.f, 0.f, 0.f, 0.f};
  u16* Pw = Pb + w * 16 * 72;
  const __attribute__((address_space(3))) char* vs3 = (const __attribute__((address_space(3))) char*)VS;
  int dcv[2][4]; bool okv[2][4];
#pragma unroll
  for (int hf = 0; hf < 2; ++hf)
#pragma unroll
    for (int r = 0; r < 4; ++r) {
      const int kcn = cstart + hf * 16 + l15;
      const int qc = jq * 16 + l4 * 4 + r;
      const int col0 = min(max(qc - 8, 0), 48);
      dcv[hf][r] = min(max(kcn - qc + 15, 0), 30);
      okv[hf][r] = (kcn >= col0) && (kcn < col0 + 16);
    }
#pragma unroll 1
  for (int tt = 0; tt < ntile; ++tt) {
    bf16x8 kc[4][2];
#pragma unroll
    for (int jt = 0; jt < 4; ++jt)
#pragma unroll
      for (int ks = 0; ks < 2; ++ks) { kc[jt][ks] = kn[jt][ks]; kn[jt][ks] = kn2[jt][ks]; }
    if (tt + 2 < ntile) loadk(tt + 2, kn2);
    const bool local = lat && tt < 4;
    f32x4 S[4];
#pragma unroll
    for (int jt = 0; jt < 4; ++jt) {
      S[jt] = (f32x4){0.f, 0.f, 0.f, 0.f};
      S[jt] = MFMA16(qa[0], kc[jt][0], S[jt]);
      S[jt] = MFMA16(qa[1], kc[jt][1], S[jt]);
    }
    float sv[4][4];
#pragma unroll
    for (int jt = 0; jt < 4; ++jt)
#pragma unroll
      for (int r = 0; r < 4; ++r) {
        float s = S[jt][r] * 0.18033688011112042f;
        if (local) {
          const int dr = rows0w + tt * 2 + (jt >> 1) - myr + 7;
          s += rp[dr * 31 + dcv[jt & 1][r]];
          if (!okv[jt & 1][r]) s = -INFINITY;
        }
        sv[jt][r] = s;
      }
    float alpha[4];
#pragma unroll
    for (int r = 0; r < 4; ++r) {
      float mx = fmaxf(fmaxf(sv[0][r], sv[1][r]), fmaxf(sv[2][r], sv[3][r]));
      mx = dpp_rowmax(mx);
      float mn = fmaxf(mrow[r], mx);
      alpha[r] = __builtin_amdgcn_exp2f(mrow[r] - mn);
      mrow[r] = mn;
      float ps = 0.f;
#pragma unroll
      for (int jt = 0; jt < 4; ++jt) {
        float pv = __builtin_amdgcn_exp2f(sv[jt][r] - mn);
        ps += pv;
        Pw[(l4 * 4 + r) * 72 + jt * 16 + l15] = f2bf(pv);
      }
      lrow[r] = lrow[r] * alpha[r] + ps;
    }
#pragma unroll
    for (int i = 0; i < 4; ++i)
#pragma unroll
      for (int r = 0; r < 4; ++r) O[i][r] *= alpha[r];
    asm volatile("s_waitcnt lgkmcnt(0)" ::: "memory");
#pragma unroll
    for (int ks2 = 0; ks2 < 2; ++ks2) {
      bf16x8 pa = *(const bf16x8*)(Pw + l15 * 72 + ks2 * 32 + l4 * 8);
      int keyoff;
      if (lat) keyoff = tt < 4 ? (rows0w - vrow0 + tt * 2 + ks2) * 64 + cstart : 576 + (tt - 4) * 64 + ks2 * 32;
      else keyoff = tt * 64 + ks2 * 32;
#pragma unroll
      for (int i = 0; i < 4; ++i) {
        const int rowa = keyoff + 8 * l4 + (l15 >> 2);
        const int cola = i * 16 + 4 * (l15 & 3);
        v4i16_t lo = __builtin_amdgcn_ds_read_tr16_b64_v4i16((__attribute__((address_space(3))) v4i16_t*)(vs3 + (rowa * VSP + cola) * 2));
        v4i16_t hi = __builtin_amdgcn_ds_read_tr16_b64_v4i16((__attribute__((address_space(3))) v4i16_t*)(vs3 + ((rowa + 4) * VSP + cola) * 2));
        bf16x8 vb = __builtin_shufflevector(lo, hi, 0, 1, 2, 3, 4, 5, 6, 7);
        O[i] = MFMA16(pa, vb, O[i]);
      }
    }
    asm volatile("s_waitcnt lgkmcnt(0)" ::: "memory");
  }
  {
    u16* C1w = dry ? (u16*)(p.ws + OFF_DUMMY) + (size_t)(blockIdx.x & 15) * 300000 + (size_t)w * 16 * LDC1 - (size_t)qbase * LDC1 : (u16*)(p.ws + OFF_C1);
#pragma unroll
    for (int r = 0; r < 4; ++r) {
      const float inv = 1.f / dpp_rowsum(lrow[r]);
      const int row = qbase + l4 * 4 + r;
#pragma unroll
      for (int i = 0; i < 4; ++i) {
        const int dcol = h * 64 + i * 16 + l15;
        C1w[(size_t)row * LDC1 + dcol] = f2bf(O[i][r] * inv * silu(bf2f(graw[r][i])));
      }
    }
  }
  __syncthreads();
}

DI void phase_ckv(const Params& p, int t) {
  const int id = t * NT + threadIdx.x;
  const int arr = id >> 16, v = id & 65535;
  const float* src = p.in[3 + arr] + (size_t)v * 8;
  float4 a = *(const float4*)src, c = *(const float4*)(src + 4);
  float f[8] = {a.x, a.y, a.z, a.w, c.x, c.y, c.z, c.w};
  u16* dst = (u16*)((unsigned char*)p.out + OUT_CKV) + (size_t)arr * 524288 + (size_t)v * 8;
  *(u32x4*)dst = pack8(f);
}


DI void phase_ssd_out_grp(const Params& p, int item, unsigned char* smem, bool dry) {
  u16* Cs = (u16*)smem;
  u16* Bs = Cs + 128 * 136;
  u16* xT = Bs + 128 * 136;
  u16* St = xT + 64 * 136;
  float* sdt = (float*)(St + 2 * 64 * 136);
  float* scs = sdt + 2048;
  const int tid = threadIdx.x, lane = tid & 63, w = tid >> 6;
  const int l15 = lane & 15, l4 = lane >> 4;
  const int cgi = item >> 1, grp = item & 1;
  int row0, has_prev, has_next;
  if (cgi < 64) { int seq = cgi >> 1, c = cgi & 1; row0 = seq * 256 + c * 128; has_prev = c > 0; has_next = c < 1; }
  else { int q = cgi - 64; int seq = q >> 5, c = q & 31; row0 = NPROMPT + seq * 4096 + c * 128; has_prev = c > 0; has_next = c < 31; }
  const u16* C0 = (const u16*)(p.ws + OFF_C0A);
  const int xchunk = tid & 7, xrg = tid >> 3;
  const int bchunk = tid & 15, brg = tid >> 4;
  u32x4 rawb[6], rawc[6];
  conv_load<4>(p, row0, brg * 4, 1024 + grp * 128 + bchunk * 8, has_prev, has_next, rawb);
  conv_load<4>(p, row0, brg * 4, 1280 + grp * 128 + bchunk * 8, has_prev, has_next, rawc);
  float rdt[4];
#pragma unroll
  for (int i = 0; i < 4; ++i) {
    const int id = tid + i * NT; const int h8 = id >> 8, d = (id >> 7) & 1, l = id & 127;
    rdt[i] = bf2f(C0[(size_t)(row0 + l) * LDC0 + 2560 + d * 16 + grp * 8 + h8]);
  }
#pragma unroll
  for (int i = 0; i < 4; ++i) {
    const int id = tid + i * NT; const int h8 = id >> 8, d = (id >> 7) & 1;
    const int hh = grp * 8 + h8;
    float x = rdt[i] + p.in[14][d * 16 + hh];
    float dt = x > 20.f ? x : log1pf(expf(x));
    float a = -expf(p.in[15][d * 16 + hh]);
    sdt[id] = dt; scs[id] = a * dt;
  }
  __syncthreads();
#pragma unroll
  for (int k = 0; k < 2; ++k) {
    const int sq = 2 * w + k; const int d = sq & 1;
    float* base = scs + sq * 128;
    int p0 = d == 0 ? 2 * lane : 127 - 2 * lane;
    int p1 = d == 0 ? 2 * lane + 1 : 126 - 2 * lane;
    float v0 = base[p0], v1 = base[p1];
    float sacc = v0 + v1;
#pragma unroll
    for (int off = 1; off < 64; off <<= 1) {
      float tv = __shfl_up(sacc, off);
      if (lane >= off) sacc += tv;
    }
    float excl = sacc - (v0 + v1);
    base[p0] = excl + v0;
    base[p1] = excl + v0 + v1;
  }
  {
    float o[4][8];
    conv_compute<4>(p, 1024 + grp * 128 + bchunk * 8, rawb, o);
#pragma unroll
    for (int i = 0; i < 4; ++i) *(u32x4*)(Bs + (brg * 4 + i) * 136 + bchunk * 8) = pack8(o[i]);
    conv_compute<4>(p, 1280 + grp * 128 + bchunk * 8, rawc, o);
#pragma unroll
    for (int i = 0; i < 4; ++i) *(u32x4*)(Cs + (brg * 4 + i) * 136 + bchunk * 8) = pack8(o[i]);
  }
  __syncthreads();
  f32x4 cb[8];
#pragma unroll
  for (int j = 0; j < 8; ++j) cb[j] = (f32x4){0.f, 0.f, 0.f, 0.f};
#pragma unroll
  for (int ks = 0; ks < 4; ++ks) {
    bf16x8 a = *(const bf16x8*)(Cs + (16 * w + l15) * 136 + ks * 32 + l4 * 8);
#pragma unroll
    for (int j = 0; j < 8; ++j) {
      bf16x8 b = *(const bf16x8*)(Bs + (j * 16 + l15) * 136 + ks * 32 + l4 * 8);
      cb[j] = MFMA16(b, a, cb[j]);
    }
  }
  __syncthreads();
  const int lrow = 16 * w + l15;
#pragma unroll 1
  for (int h8 = 0; h8 < 8; ++h8) {
    const int h = grp * 8 + h8;
    const float* sdh = sdt + h8 * 256;
    const float* sch = scs + h8 * 256;
    u32x4 rawx[4], rawst[4];
    u16 zraw[4][4];
    conv_load<2>(p, row0, xrg * 2, h * 64 + xchunk * 8, has_prev, has_next, rawx);
    {
      const u16* S = (const u16*)((const unsigned char*)p.out + OUT_SBUF) + (size_t)(cgi * 16 + h) * 2 * 8192;
#pragma unroll
      for (int v = 0; v < 4; ++v) {
        int id = tid + 512 * v;
        int dd = id >> 10, pp = (id >> 4) & 63, nv = (id & 15) * 8;
        rawst[v] = *(const u32x4*)(S + dd * 8192 + pp * 128 + nv);
      }
#pragma unroll
      for (int i = 0; i < 4; ++i)
#pragma unroll
        for (int r = 0; r < 4; ++r)
          zraw[i][r] = C0[(size_t)(row0 + 16 * w + l4 * 4 + r) * LDC0 + h * 64 + i * 16 + l15];
    }
    {
      const float cs0l = sch[lrow], cs1l = sch[128 + lrow];
#pragma unroll
      for (int j = 0; j < 8; ++j) {
        const int s0 = j * 16 + l4 * 4;
        float f[4];
        if (j < w) {
          const float4 c4 = *(const float4*)(sch + s0), d4 = *(const float4*)(sdh + s0);
          f[0] = __expf(cs0l - c4.x) * d4.x; f[1] = __expf(cs0l - c4.y) * d4.y; f[2] = __expf(cs0l - c4.z) * d4.z; f[3] = __expf(cs0l - c4.w) * d4.w;
        } else if (j > w) {
          const float4 c4 = *(const float4*)(sch + 128 + s0), d4 = *(const float4*)(sdh + 128 + s0);
          f[0] = __expf(cs1l - c4.x) * d4.x; f[1] = __expf(cs1l - c4.y) * d4.y; f[2] = __expf(cs1l - c4.z) * d4.z; f[3] = __expf(cs1l - c4.w) * d4.w;
        } else {
          const float4 c4 = *(const float4*)(sch + s0), d4 = *(const float4*)(sdh + s0);
          const float4 e4 = *(const float4*)(sch + 128 + s0), g4 = *(const float4*)(sdh + 128 + s0);
          const float c0[4] = {c4.x, c4.y, c4.z, c4.w}, d0[4] = {d4.x, d4.y, d4.z, d4.w};
          const float c1[4] = {e4.x, e4.y, e4.z, e4.w}, d1[4] = {g4.x, g4.y, g4.z, g4.w};
#pragma unroll
          for (int jj = 0; jj < 4; ++jj) {
            const int sidx = s0 + jj;
            float v;
            if (lrow > sidx) v = __expf(cs0l - c0[jj]) * d0[jj];
            else if (lrow < sidx) v = __expf(cs1l - c1[jj]) * d1[jj];
            else v = d0[jj] + d1[jj];
            f[jj] = v;
          }
        }
        u32x2 o; o[0] = pk2(cb[j][0] * f[0], cb[j][1] * f[1]); o[1] = pk2(cb[j][2] * f[2], cb[j][3] * f[3]);
        *(u32x2*)(Bs + lrow * 136 + s0) = o;
      }
    }
    {
      float o[2][8];
      conv_compute<2>(p, h * 64 + xchunk * 8, rawx, o);
#pragma unroll
      for (int e = 0; e < 8; ++e) *(unsigned*)(xT + (xchunk * 8 + e) * 136 + xrg * 2) = pk2(o[0][e], o[1][e]);
#pragma unroll
      for (int v = 0; v < 4; ++v) {
        int id = tid + 512 * v;
        int dd = id >> 10, pp = (id >> 4) & 63, nv = (id & 15) * 8;
        *(u32x4*)(St + dd * 64 * 136 + pp * 136 + nv) = rawst[v];
      }
    }
    __syncthreads();
    f32x4 af[4], ab[4], Y[4];
#pragma unroll
    for (int i = 0; i < 4; ++i) { af[i] = (f32x4){0.f, 0.f, 0.f, 0.f}; ab[i] = (f32x4){0.f, 0.f, 0.f, 0.f}; }
#pragma unroll
    for (int ks = 0; ks < 4; ++ks) {
      bf16x8 a = *(const bf16x8*)(Cs + (16 * w + l15) * 136 + ks * 32 + l4 * 8);
#pragma unroll
      for (int i = 0; i < 4; ++i) {
        bf16x8 b0 = *(const bf16x8*)(St + (i * 16 + l15) * 136 + ks * 32 + l4 * 8);
        bf16x8 b1 = *(const bf16x8*)(St + 64 * 136 + (i * 16 + l15) * 136 + ks * 32 + l4 * 8);
        af[i] = MFMA16(a, b0, af[i]);
        ab[i] = MFMA16(a, b1, ab[i]);
      }
    }
#pragma unroll
    for (int r = 0; r < 4; ++r) {
      const int l = 16 * w + l4 * 4 + r;
      float e0 = __expf(sch[l]), e1 = __expf(sch[128 + l]);
#pragma unroll
      for (int i = 0; i < 4; ++i) Y[i][r] = af[i][r] * e0 + ab[i][r] * e1;
    }
#pragma unroll
    for (int ks = 0; ks < 4; ++ks) {
      bf16x8 a = *(const bf16x8*)(Bs + (16 * w + l15) * 136 + ks * 32 + l4 * 8);
#pragma unroll
      for (int i = 0; i < 4; ++i) {
        bf16x8 b = *(const bf16x8*)(xT + (i * 16 + l15) * 136 + ks * 32 + l4 * 8);
        Y[i] = MFMA16(a, b, Y[i]);
      }
    }
    {
      u16* YAB = dry ? (u16*)(p.ws + OFF_DUMMY) + (size_t)(blockIdx.x & 15) * 400000 - (size_t)row0 * 2048 : (u16*)((unsigned char*)p.out + OUT_YB);
      const float dsk = p.in[16][h] + p.in[16][16 + h];
      float ss[4] = {0.f, 0.f, 0.f, 0.f};
#pragma unroll
      for (int i = 0; i < 4; ++i) {
        const int pp = i * 16 + l15;
#pragma unroll
        for (int r = 0; r < 4; ++r) {
          const int l = 16 * w + l4 * 4 + r;
          float xv = bf2f(xT[pp * 136 + l]);
          float y = Y[i][r] + xv * dsk;
          float gv = y * silu(bf2f(zraw[i][r]));
          YAB[(size_t)(row0 + l) * 2048 + h * 64 + pp] = f2bf(gv);
          ss[r] += gv * gv;
        }
      }
      float* rss = (float*)(p.ws + OFF_ROWSS);
#pragma unroll
      for (int r = 0; r < 4; ++r) {
        float sv = dpp_rowsum(ss[r]);
        if (l15 == 0) rss[(size_t)(row0 + 16 * w + l4 * 4 + r) * 16 + h] = sv;
      }
    }
    __syncthreads();
  }
}

DI void phase_ssd_states_grp(const Params& p, int item, unsigned char* smem) {
  u16* BT = (u16*)smem;
  u16* xTs = BT + 128 * 136;
  float* sdt = (float*)(xTs + 2 * 64 * 136);
  float* scs = sdt + 2048;
  float* sw = scs + 2048;
  float* stot = sw + 2048;
  const int tid = threadIdx.x, lane = tid & 63, w = tid >> 6;
  const int l15 = lane & 15, l4 = lane >> 4;
  const int cgi = item >> 1, grp = item & 1;
  int row0, has_prev, has_next;
  if (cgi < 64) { int seq = cgi >> 1, c = cgi & 1; row0 = seq * 256 + c * 128; has_prev = c > 0; has_next = c < 1; }
  else { int q = cgi - 64; int seq = q >> 5, c = q & 31; row0 = NPROMPT + seq * 4096 + c * 128; has_prev = c > 0; has_next = c < 31; }
  const u16* C0 = (const u16*)(p.ws + OFF_C0A);
  const int xchunk = tid & 7, xrg = tid >> 3;
  const int bchunk = tid & 15, brg = tid >> 4;
  u32x4 rawb[6];
  conv_load<4>(p, row0, brg * 4, 1024 + grp * 128 + bchunk * 8, has_prev, has_next, rawb);
  float rdt[4];
#pragma unroll
  for (int i = 0; i < 4; ++i) {
    const int id = tid + i * NT; const int h8 = id >> 8, d = (id >> 7) & 1, l = id & 127;
    rdt[i] = bf2f(C0[(size_t)(row0 + l) * LDC0 + 2560 + d * 16 + grp * 8 + h8]);
  }
#pragma unroll
  for (int i = 0; i < 4; ++i) {
    const int id = tid + i * NT; const int h8 = id >> 8, d = (id >> 7) & 1;
    const int hh = grp * 8 + h8;
    float x = rdt[i] + p.in[14][d * 16 + hh];
    float dt = x > 20.f ? x : log1pf(expf(x));
    float a = -expf(p.in[15][d * 16 + hh]);
    sdt[id] = dt; scs[id] = a * dt;
  }
  __syncthreads();
#pragma unroll
  for (int k = 0; k < 2; ++k) {
    const int sq = 2 * w + k; const int d = sq & 1;
    float* base = scs + sq * 128;
    int p0 = d == 0 ? 2 * lane : 127 - 2 * lane;
    int p1 = d == 0 ? 2 * lane + 1 : 126 - 2 * lane;
    float v0 = base[p0], v1 = base[p1];
    float sacc = v0 + v1;
#pragma unroll
    for (int off = 1; off < 64; off <<= 1) {
      float tv = __shfl_up(sacc, off);
      if (lane >= off) sacc += tv;
    }
    float excl = sacc - (v0 + v1);
    base[p0] = excl + v0;
    base[p1] = excl + v0 + v1;
    if (lane == 63) stot[sq] = sacc;
  }
  {
    float o[4][8];
    conv_compute<4>(p, 1024 + grp * 128 + bchunk * 8, rawb, o);
#pragma unroll
    for (int e = 0; e < 8; ++e) {
      u32x2 v; v[0] = pk2(o[0][e], o[1][e]); v[1] = pk2(o[2][e], o[3][e]);
      *(u32x2*)(BT + (bchunk * 8 + e) * 136 + brg * 4) = v;
    }
  }
  __syncthreads();
#pragma unroll
  for (int i = 0; i < 4; ++i) {
    const int id = tid + i * NT; const int sq = id >> 7;
    sw[id] = sdt[id] * __expf(stot[sq] - scs[id]);
  }
  if (tid < 16) {
    float* cdec = (float*)(p.ws + OFF_CDEC);
    const int h8 = tid >> 1, d = tid & 1;
    cdec[(cgi * 16 + grp * 8 + h8) * 2 + d] = __expf(stot[tid]);
  }
  __syncthreads();
  const int d = w >> 2, nq = w & 3;
#pragma unroll 1
  for (int h8 = 0; h8 < 8; ++h8) {
    const int h = grp * 8 + h8;
    u32x4 rawx[4];
    conv_load<2>(p, row0, xrg * 2, h * 64 + xchunk * 8, has_prev, has_next, rawx);
    {
      float o[2][8];
      conv_compute<2>(p, h * 64 + xchunk * 8, rawx, o);
#pragma unroll
      for (int dd = 0; dd < 2; ++dd) {
        const float s0 = sw[h8 * 256 + dd * 128 + xrg * 2], s1 = sw[h8 * 256 + dd * 128 + xrg * 2 + 1];
#pragma unroll
        for (int e = 0; e < 8; ++e) *(unsigned*)(xTs + dd * 64 * 136 + (xchunk * 8 + e) * 136 + xrg * 2) = pk2(o[0][e] * s0, o[1][e] * s1);
      }
    }
    __syncthreads();
    f32x4 acc[4][2];
#pragma unroll
    for (int i = 0; i < 4; ++i) { acc[i][0] = (f32x4){0.f, 0.f, 0.f, 0.f}; acc[i][1] = (f32x4){0.f, 0.f, 0.f, 0.f}; }
#pragma unroll
    for (int ks = 0; ks < 4; ++ks) {
      bf16x8 a[4], b[2];
#pragma unroll
      for (int i = 0; i < 4; ++i) a[i] = *(const bf16x8*)(xTs + d * 64 * 136 + (i * 16 + l15) * 136 + ks * 32 + l4 * 8);
#pragma unroll
      for (int j = 0; j < 2; ++j) b[j] = *(const bf16x8*)(BT + (nq * 32 + j * 16 + l15) * 136 + ks * 32 + l4 * 8);
#pragma unroll
      for (int i = 0; i < 4; ++i)
#pragma unroll
        for (int j = 0; j < 2; ++j) acc[i][j] = MFMA16(b[j], a[i], acc[i][j]);
    }
    u16* S = (u16*)((unsigned char*)p.out + OUT_SBUF) + ((size_t)(cgi * 16 + h) * 2 + d) * 8192;
#pragma unroll
    for (int i = 0; i < 4; ++i)
#pragma unroll
      for (int j = 0; j < 2; ++j) {
        const int pp = i * 16 + l15, n = nq * 32 + j * 16 + l4 * 4;
        u32x2 o; o[0] = pk2(acc[i][j][0], acc[i][j][1]); o[1] = pk2(acc[i][j][2], acc[i][j][3]);
        *(u32x2*)(S + pp * 128 + n) = o;
      }
    __syncthreads();
  }
}
#define OFF_BAR 268419072ul
#define XB_TMO      128
#define XB_XCNT(j)  (256  + 64 * (j))
#define XB_XSUB(j)  (1280 + 64 * (j))
#define XB_XGEN(j)  (2304 + 64 * (j))
#define XB_TOP      3328
#define XB_TOPGEN   3392
#define XCD_BAR_WORDS 3456
#define XB_SPIN_CAP (1u << 18)
#define LAS __attribute__((address_space(3)))
DI unsigned xb_ld(unsigned* p) { return __hip_atomic_load(p, __ATOMIC_RELAXED, __HIP_MEMORY_SCOPE_AGENT); }
DI unsigned xb_add(unsigned* p, unsigned v) { return __hip_atomic_fetch_add(p, v, __ATOMIC_RELAXED, __HIP_MEMORY_SCOPE_AGENT); }
DI unsigned xb_xcc_id() { return (unsigned)__builtin_amdgcn_s_getreg((3 << 11) | 20) & 0xFu; }
#define XB_SPIN(cond, bar) do { unsigned _sp = 0; while (cond) { __builtin_amdgcn_s_sleep(1); \
    if ((++_sp & 255u) == 0u) { if (xb_ld(&(bar)[XB_TMO])) break; if (_sp > XB_SPIN_CAP) { atomicAdd(&(bar)[XB_TMO], 1u); break; } } } } while (0)
struct XcdBarrier { unsigned* bar; unsigned x; volatile LAS unsigned* st; };
DI XcdBarrier xcd_barrier_post(unsigned* bar, volatile LAS unsigned* st) {
  XcdBarrier b; b.bar = bar; b.x = xb_xcc_id(); b.st = st;
  if (threadIdx.x == 0) (void)xb_add(&bar[XB_XCNT(b.x)], 1u);
  return b;
}
DI void xcd_barrier_complete(unsigned* bar, unsigned x, unsigned& nloc, unsigned& nx) {
  const unsigned G = gridDim.x * gridDim.y * gridDim.z;
  unsigned sum, cnt, mine, sp = 0u;
  for (;;) {
    sum = 0u; cnt = 0u; mine = 0u;
#pragma unroll
    for (unsigned j = 0; j < 16; ++j) { const unsigned c = xb_ld(&bar[XB_XCNT(j)]); sum += c; cnt += (c > 0u) ? 1u : 0u; mine = (j == x) ? c : mine; }
    if (sum == G) break;
    __builtin_amdgcn_s_sleep(1);
    if ((++sp & 255u) == 0u) { if (xb_ld(&bar[XB_TMO])) break; if (sp > XB_SPIN_CAP) { atomicAdd(&bar[XB_TMO], 1u); break; } }
  }
  nloc = mine > 0u ? mine : 1u; nx = cnt > 0u ? cnt : 1u;
}
DI void xcd_barrier(const XcdBarrier& b) {
  asm volatile("s_waitcnt vmcnt(0)" ::: "memory");
  __syncthreads();
  if (threadIdx.x == 0) {
    unsigned* bar = b.bar;
    __builtin_amdgcn_s_waitcnt(0);
    unsigned nloc = b.st[0], nx = b.st[1];
    if (nloc == 0u) { xcd_barrier_complete(bar, b.x, nloc, nx); b.st[0] = nloc; b.st[1] = nx; }
    const unsigned old = xb_add(&bar[XB_XSUB(b.x)], 1u);
    const unsigned gen = old / nloc;
    if (old + 1u == (gen + 1u) * nloc) {
      __builtin_amdgcn_fence(__ATOMIC_RELEASE, "agent");
      asm volatile("s_waitcnt vmcnt(0)" ::: "memory");
      const unsigned og = xb_add(&bar[XB_TOP], 1u);
      const unsigned tg = og / nx;
      if (og + 1u == (tg + 1u) * nx) xb_add(&bar[XB_TOPGEN], 1u);
      else XB_SPIN(xb_ld(&bar[XB_TOPGEN]) == tg, bar);
      __builtin_amdgcn_fence(__ATOMIC_ACQUIRE, "agent");
      xb_add(&bar[XB_XGEN(b.x)], 1u);
      asm volatile("s_waitcnt vmcnt(0)" ::: "memory");
    } else {
      XB_SPIN(xb_ld(&bar[XB_XGEN(b.x)]) == gen, bar);
      __builtin_amdgcn_fence(__ATOMIC_ACQUIRE, "agent");
      asm volatile("s_waitcnt vmcnt(0)" ::: "memory");
    }
  }
  __syncthreads();
}
#define NPHASE 12
__global__ void __launch_bounds__(NT) mega(Params p, int ph0, int ph1) {
  __shared__ __attribute__((aligned(16))) unsigned char smem[SMEM_BYTES];
  __shared__ __attribute__((aligned(16))) unsigned xb_st[4];
  const int nb = gridDim.x, bid = blockIdx.x;
  if (threadIdx.x < 4) xb_st[threadIdx.x] = 0u;
  __syncthreads();
  const XcdBarrier xb = xcd_barrier_post((unsigned*)(p.ws + OFF_BAR), (volatile LAS unsigned*)xb_st);
  if (ph1 > 4096) cg::this_grid().sync();
#define PH_BEGIN(k) if (ph0 <= (k) && (k) < ph1) { if ((k) > ph0) xcd_barrier(xb); \
  for (int rep = (REP_MASK >> (k)) & 1; rep >= 0; --rep) { const bool dry = rep > 0; (void)dry;
#define PH_END if (rep > 0) xcd_barrier(xb); } }
  {
    {
      PH_BEGIN(0) {
        for (int ft = bid; ft < 256; ft += nb) phase_filter(p, ft, smem);
        {
          for (int q0 = bid; q0 < 192 + 880; q0 += nb) {
            if (q0 < 192) phase_ada(p, q0, smem);
            else {
              int q = q0 - 192;
              if (q < 432) transpose_tile<float>(p.in[10], 6688, 6688, (u16*)(p.ws + OFF_WINE), 1024, q & 15, q >> 4, nullptr, 0, smem);
              else if (q < 560) { q -= 432; transpose_tile<float>(p.in[11], 1024, 1024, (u16*)(p.ws + OFF_WOUTE), 2048, q & 31, q >> 5, p.in[17], 1024, smem); }
              else if (q < 816) { q -= 560; transpose_tile<float>(p.in[27], 4096, 4096, (u16*)(p.ws + OFF_WINO), 1024, q & 15, q >> 4, nullptr, 0, smem); }
              else { q -= 816; transpose_tile<float>(p.in[28], 1024, 1024, (u16*)(p.ws + OFF_WOUTO), 1024, q & 15, q >> 4, nullptr, 0, smem); }
            }
          }
        }
      } PH_END
      PH_BEGIN(1) {
        for (int t = bid; t < 512; t += nb) phase_norm(p, t, 0, p.in[0], p.in[1], (u16*)((unsigned char*)p.out + OUT_H0));
      } PH_END
      PH_BEGIN(2) {
        GemmArgs g; g.A1 = (const u16*)((const unsigned char*)p.out + OUT_H0); g.lda1 = 1024; g.A2 = g.A1; g.lda2 = 1024; g.ksplit = 1 << 30;
        g.Bt = (const u16*)(p.ws + OFF_WINE); g.K = 1024;
        for (int rd = 0; rd * 256 < 64 * 27; ++rd) { int pm, pn; if (gemm_tile_coord(rd, 27, 64 * 27, pm, pn)) { if (pn <= 9) gemm256<0, true>(p, g, pm * 256, pn * 256, smem); else gemm256<0, false>(p, g, pm * 256, pn * 256, smem); } }
      } PH_END
      PH_BEGIN(3) {
        for (int t = bid; t < 512 + 256; t += nb) {
          if (dry && (REP_SUB == 1 || REP_SUB == 4) && t >= 256) continue;
          if (dry && REP_SUB == 2 && (t < 256 || t >= 512)) continue;
          if (dry && REP_SUB == 3 && t < 512) continue;
          if (t < 512) phase_hyena(p, t, smem, dry);
          else phase_ssd_states_grp(p, t - 512, smem);
        }
      } PH_END
      PH_BEGIN(4) {
        for (int t = bid; t < 34 * 64; t += nb) phase_scan(p, t);
      } PH_END
      PH_BEGIN(5) {
        for (int t = bid; t < 256 + 1024; t += nb) {
          if (t < 256) phase_ssd_out_grp(p, t, smem, dry);
          else {
            int q = t - 256;
            transpose_tile<u16>((const u16*)(p.ws + OFF_UT) + (size_t)3072 * UTP, MROWS, UTP,
                                (u16*)((unsigned char*)p.out + OUT_YB) + 1024, 2048, q & 15, q >> 4, nullptr, 0, smem);
          }
        }
      } PH_END
      PH_BEGIN(6) {
        GemmArgs g; g.A1 = (const u16*)((const unsigned char*)p.out + OUT_YB); g.lda1 = 2048;
        g.A2 = g.A1; g.lda2 = 2048; g.ksplit = 1024;
        g.Bt = (const u16*)(p.ws + OFF_WOUTE); g.K = 2048;
        for (int rd = 0; rd * 256 < 64 * 4; ++rd) { int pm, pn; if (gemm_tile_coord(rd, 4, 64 * 4, pm, pn)) gemm256<1, true>(p, g, pm * 256, pn * 256, smem); }
      } PH_END
      PH_BEGIN(7) {
        const float* x1 = (const float*)(p.ws + OFF_X1);
        for (int t = bid; t < 512 + 256; t += nb) { if (t < 512) phase_norm(p, t, 1, x1, x1 + (size_t)NPROMPT * 1024, (u16*)(p.ws + OFF_H1)); else phase_ckv(p, t - 512); }
      } PH_END
      PH_BEGIN(8) {
        GemmArgs g; g.A1 = (const u16*)(p.ws + OFF_H1); g.lda1 = 1024; g.A2 = g.A1; g.lda2 = 1024; g.ksplit = 1 << 30;
        g.Bt = (const u16*)(p.ws + OFF_WINO); g.K = 1024;
        for (int rd = 0; rd * 256 < 64 * 16; ++rd) { int pm, pn; if (gemm_tile_coord(rd, 16, 64 * 16, pm, pn)) gemm256<2, true>(p, g, pm * 256, pn * 256, smem); }
      } PH_END
      PH_BEGIN(9) {
        for (int t = bid; t < 2048; t += nb) phase_attn(p, t, smem, dry);
      } PH_END
      PH_BEGIN(10) {
        GemmArgs g; g.A1 = (const u16*)(p.ws + OFF_C1); g.lda1 = LDC1; g.A2 = g.A1; g.lda2 = LDC1; g.ksplit = 1 << 30;
        g.Bt = (const u16*)(p.ws + OFF_WOUTO); g.K = 1024;
        for (int rd = 0; rd * 256 < 64 * 4; ++rd) { int pm, pn; if (gemm_tile_coord(rd, 4, 64 * 4, pm, pn)) gemm256<3, true>(p, g, pm * 256, pn * 256, smem); }
      } PH_END
      PH_BEGIN(11) {
        for (int t = bid; t < 512; t += nb) phase_final_norm(p, t);
      } PH_END
    }
  }
}

extern "C" void kernel_launch(void* const* d_in, const int* in_sizes, int n_in, void* d_out, int out_size,
                              void* d_ws, size_t ws_size, hipStream_t stream) {
  static int grid_blocks = 0;
  if (!grid_blocks) {
    int dev = 0, cus = 0, per_cu = 0;
    hipGetDevice(&dev);
    hipDeviceGetAttribute(&cus, hipDeviceAttributeMultiprocessorCount, dev);
    hipOccupancyMaxActiveBlocksPerMultiprocessor(&per_cu, mega, NT, 0);
    if (per_cu < 1) per_cu = 1;
    grid_blocks = cus * per_cu;
  }
  Params p{};
  for (int i = 0; i < 31; ++i) p.in[i] = (const float*)d_in[i];
  p.out = (float*)d_out;
  p.ws = (unsigned char*)d_ws;
#if MULTI
  for (int ph = 0; ph < NPHASE; ++ph) {
    hipLaunchKernelGGL(mega, dim3(grid_blocks), dim3(NT), 0, stream, p, ph, ph + 1);
  }
#else
  hipMemsetAsync((unsigned char*)d_ws + OFF_BAR, 0, XCD_BAR_WORDS * sizeof(unsigned), stream);
  int ph0 = 0, ph1 = NPHASE;
  void* args[] = {&p, &ph0, &ph1};
  hipError_t e = hipLaunchCooperativeKernel((void*)mega, dim3(grid_blocks), dim3(NT), args, 0, stream);
  if (e != hipSuccess) fprintf(stderr, "cooperative launch failed: %s (grid %d)\n", hipGetErrorString(e), grid_blocks);
#endif
}
```

```cpp
#include <hip/hip_runtime.h>
#include <hip/hip_cooperative_groups.h>
#include <cstdio>
namespace cg = cooperative_groups;

#ifndef REP_MASK
#define REP_MASK 0
#endif
#ifndef REP_SUB
#define REP_SUB 0
#endif
#define OFF_DUMMY 249651200ul
#ifndef MULTI
#define MULTI 0
#endif

#define NT 512
#define DI __device__ __forceinline__
typedef unsigned short u16;
typedef __attribute__((ext_vector_type(8))) short bf16x8;
typedef __attribute__((ext_vector_type(4))) float f32x4;
typedef __attribute__((ext_vector_type(16))) float f32x16;
typedef __attribute__((ext_vector_type(4))) unsigned u32x4;
typedef __attribute__((ext_vector_type(2))) unsigned u32x2;

#define MFMA16(a, b, c) __builtin_amdgcn_mfma_f32_16x16x32_bf16((a), (b), (c), 0, 0, 0)
#define MFMA32(a, b, c) __builtin_amdgcn_mfma_f32_32x32x16_bf16((a), (b), (c), 0, 0, 0)

#define MROWS 16384
#define NPROMPT 8192
#define UTP 16448
#define LDC1 4160
#define LDC0 2592
#define NPAD0 6784
#define SMEM_BYTES 151552

#define OFF_WINE   0ul
#define OFF_WOUTE  14155776ul
#define OFF_WINO   18350080ul
#define OFF_WOUTO  26738688ul
#define OFF_MOD    28835840ul
#define OFF_ROWSS  28909568ul
#define OFF_CDEC   29958144ul
#define OFF_UT     29974528ul
#define OFF_C0A    164716544ul
#define OFF_X1     OFF_UT
#define OFF_C1     97083392ul
#define OFF_H1     233398272ul
#define OUT_H0     0ul
#define OUT_YB     0ul
#define OUT_HF4096 33554432ul
#define OUT_HF256  (33554432ul + 16777216ul)
#define OUT_SBUF   100663296ul
#define O_YP 0ul
#define O_YS 8388608ul
#define O_ST 16777216ul
#define O_NK 25165824ul
#define O_NV 33554432ul

struct Params {
  const float* in[31];
  float* out;
  unsigned char* ws;
};

typedef float f32x2_t __attribute__((ext_vector_type(2)));
typedef __bf16 bf16x2_t __attribute__((ext_vector_type(2)));
DI unsigned pk2(float a, float b) {
  f32x2_t v = {a, b};
  bf16x2_t r = __builtin_convertvector(v, bf16x2_t);
  return __builtin_bit_cast(unsigned, r);
}
DI u16 f2bf(float x) { return (u16)(pk2(x, x) & 0xffffu); }
DI float bf2f(u16 h) { return __uint_as_float(((unsigned)h) << 16); }
DI float silu(float x) { return x * __builtin_amdgcn_rcpf(1.f + __expf(-x)); }
DI float bflo(unsigned u) { return __uint_as_float(u << 16); }
DI float bfhi(unsigned u) { return __uint_as_float(u & 0xffff0000u); }
DI void unpack8(const u32x4& v, float* f) {
  f[0] = bflo(v[0]); f[1] = bfhi(v[0]); f[2] = bflo(v[1]); f[3] = bfhi(v[1]);
  f[4] = bflo(v[2]); f[5] = bfhi(v[2]); f[6] = bflo(v[3]); f[7] = bfhi(v[3]);
}
DI u32x4 pack8(const float* f) {
  u32x4 o; o[0] = pk2(f[0], f[1]); o[1] = pk2(f[2], f[3]); o[2] = pk2(f[4], f[5]); o[3] = pk2(f[6], f[7]); return o;
}
DI int row_group(int row) { return row < NPROMPT ? 0 : 1 + ((row - NPROMPT) >> 12); }

DI void phase_ada(const Params& p, int t, unsigned char* smem) {
  float* sc = (float*)smem;
  float* red = sc + 3072;
  const int layer = t / 96, cc = t % 96;
  const int tid = threadIdx.x;
  for (int i = tid; i < 3072; i += NT) {
    int g = i >> 10, k = i & 1023;
    float v = (g == 0) ? p.in[6][k] : p.in[5][(g - 1) * 1024 + k];
    sc[i] = silu(v);
  }
  __syncthreads();
  const int col = tid & 31, kg = tid >> 5;
  const float* w = p.in[8] + (size_t)layer * 1024 * 3072 + cc * 32 + col;
  float a0 = 0.f, a1 = 0.f, a2 = 0.f;
#pragma unroll 8
  for (int k = kg * 64; k < kg * 64 + 64; ++k) {
    float wv = w[(size_t)k * 3072];
    a0 += sc[k] * wv; a1 += sc[1024 + k] * wv; a2 += sc[2048 + k] * wv;
  }
  red[(kg * 3 + 0) * 32 + col] = a0;
  red[(kg * 3 + 1) * 32 + col] = a1;
  red[(kg * 3 + 2) * 32 + col] = a2;
  __syncthreads();
  if (tid < 96) {
    int g = tid >> 5, c = tid & 31;
    float s = 0.f;
    for (int q = 0; q < 16; ++q) s += red[(q * 3 + g) * 32 + c];
    int colg = cc * 32 + c;
    float* mod = (float*)(p.ws + OFF_MOD);
    mod[(layer * 3 + g) * 3072 + colg] = s + p.in[9][layer * 3072 + colg];
  }
  __syncthreads();
}

DI float ld_src(const float* q) { return *q; }
DI float ld_src(const u16* q) { return bf2f(*q); }
template <typename ST>
DI void transpose_tile(const ST* src, int N, int ldsrc, u16* dst, int lddst, int kt, int nt4,
                       const float* kscale, int kscale_n, unsigned char* smem) {
  float* tile = (float*)smem;
  const int tid = threadIdx.x;
  const int c = tid & 63, r0 = tid >> 6;
  float v[4][8];
#pragma unroll
  for (int q = 0; q < 4; ++q)
#pragma unroll
    for (int i = 0; i < 8; ++i) {
      int r = r0 + 8 * i;
      int k = kt * 64 + r, n = (nt4 * 4 + q) * 64 + c;
      v[q][i] = 0.f;
      if (n < N) v[q][i] = ld_src(src + (size_t)k * ldsrc + n);
    }
#pragma unroll
  for (int q = 0; q < 4; ++q)
#pragma unroll
    for (int i = 0; i < 8; ++i) {
      int r = r0 + 8 * i;
      int k = kt * 64 + r;
      float x = v[q][i];
      if (kscale != nullptr && k < kscale_n) x *= kscale[k];
      tile[q * 4160 + r * 65 + c] = x;
    }
  __syncthreads();
  const int rr = tid >> 3, c8 = (tid & 7) * 8;
#pragma unroll
  for (int q = 0; q < 4; ++q) {
    float f[8];
#pragma unroll
    for (int e = 0; e < 8; ++e) f[e] = tile[q * 4160 + (c8 + e) * 65 + rr];
    *(u32x4*)(dst + (size_t)((nt4 * 4 + q) * 64 + rr) * lddst + kt * 64 + c8) = pack8(f);
  }
  __syncthreads();
}

DI void phase_filter(const Params& p, int t, unsigned char* smem) {
  const int L = 4096;
  const int t0 = t * 16;
  float* feats = (float*)smem;
  float* h1 = feats + 18 * 36;
  float* h2 = h1 + 18 * 64;
  const float* w1 = p.in[20]; const float* b1 = p.in[21]; const float* w2 = p.in[22];
  const float* b2 = p.in[23]; const float* w3 = p.in[24]; const float* fr = p.in[25];
  int tid = threadIdx.x;
  asm volatile("" : "+v"(tid));
  float* w1s = h2 + 64 * 20;
  float* w2s = w1s + 33 * 64;
  {
    float r1[5], r2[8];
#pragma unroll
    for (int i = 0; i < 5; ++i) { const int id = tid + i * NT; r1[i] = id < 33 * 64 ? w1[id] : 0.f; }
#pragma unroll
    for (int i = 0; i < 8; ++i) r2[i] = w2[tid + i * NT];
#pragma unroll
    for (int i = 0; i < 5; ++i) { const int id = tid + i * NT; if (id < 33 * 64) w1s[id] = r1[i]; }
#pragma unroll
    for (int i = 0; i < 8; ++i) w2s[tid + i * NT] = r2[i];
  }
  for (int id = tid; id < 18 * 33; id += NT) {
    int tt = id / 33, i = id % 33;
    const int Lr = tt < 17 ? 4096 : 256;
    const int tpos = tt < 17 ? t0 + tt : t;
    float tv = (float)tpos / (float)(Lr - 1);
    float wv = 6.283185307179586f * (float)tpos / (float)Lr;
    float f;
    if (i == 0) f = tv;
    else if (i <= 16) { float fi = 1e-4f + (float)(i - 1) * ((15.f - 1e-4f) / 15.f); f = cosf(fi * wv); }
    else { float fi = 1e-4f + (float)(i - 17) * ((15.f - 1e-4f) / 15.f); f = -sinf(fi * wv); }
    feats[tt * 36 + i] = f;
  }
  __syncthreads();
  for (int id = tid; id < 18 * 64; id += NT) {
    int tt = id >> 6, j = id & 63;
    float s = b1[j];
#pragma unroll 11
    for (int i = 0; i < 33; ++i) s += feats[tt * 36 + i] * w1s[i * 64 + j];
    h1[tt * 64 + j] = sinf(fr[j] * s);
  }
  __syncthreads();
  for (int id = tid; id < 18 * 64; id += NT) {
    int tt = id >> 6, j = id & 63;
    float s = b2[j];
#pragma unroll 16
    for (int i = 0; i < 64; ++i) s += h1[tt * 64 + i] * w2s[i * 64 + j];
    h2[j * 20 + tt] = sinf(fr[j] * s);
  }
  __syncthreads();
  float acc[4][18];
#pragma unroll
  for (int q = 0; q < 4; ++q)
#pragma unroll
    for (int tt = 0; tt < 18; ++tt) acc[q][tt] = 0.f;
  {
    const float* w3t = w3 + tid;
    float wa[4][4], wb[4][4];
#pragma unroll
    for (int kk = 0; kk < 4; ++kk)
#pragma unroll
      for (int q = 0; q < 4; ++q) wa[kk][q] = w3t[kk * 2048 + 512 * q];
#pragma unroll 1
    for (int k0 = 0; k0 < 64; k0 += 8) {
#pragma unroll
      for (int kk = 0; kk < 4; ++kk)
#pragma unroll
        for (int q = 0; q < 4; ++q) wb[kk][q] = w3t[(k0 + 4 + kk) * 2048 + 512 * q];
#pragma unroll
      for (int kk = 0; kk < 4; ++kk) {
        float hv[20];
#pragma unroll
        for (int v = 0; v < 5; ++v) { const float4 h4 = *(const float4*)(h2 + (k0 + kk) * 20 + v * 4); hv[v * 4] = h4.x; hv[v * 4 + 1] = h4.y; hv[v * 4 + 2] = h4.z; hv[v * 4 + 3] = h4.w; }
#pragma unroll
        for (int tt = 0; tt < 18; ++tt)
#pragma unroll
          for (int q = 0; q < 4; ++q) acc[q][tt] += hv[tt] * wa[kk][q];
      }
      const int kn = (k0 + 8) & 63;
#pragma unroll
      for (int kk = 0; kk < 4; ++kk)
#pragma unroll
        for (int q = 0; q < 4; ++q) wa[kk][q] = w3t[(kn + kk) * 2048 + 512 * q];
#pragma unroll
      for (int kk = 0; kk < 4; ++kk) {
        float hv[20];
#pragma unroll
        for (int v = 0; v < 5; ++v) { const float4 h4 = *(const float4*)(h2 + (k0 + 4 + kk) * 20 + v * 4); hv[v * 4] = h4.x; hv[v * 4 + 1] = h4.y; hv[v * 4 + 2] = h4.z; hv[v * 4 + 3] = h4.w; }
#pragma unroll
        for (int tt = 0; tt < 18; ++tt)
#pragma unroll
          for (int q = 0; q < 4; ++q) acc[q][tt] += hv[tt] * wb[kk][q];
      }
    }
  }
  u16* HF = (u16*)((unsigned char*)p.out + OUT_HF4096);
  u16* HFp = (u16*)((unsigned char*)p.out + OUT_HF256);
  const float lo = -15.350567286626973f;
  const float hi = -3.0701134573253945f;
#pragma unroll
  for (int q = 0; q < 4; ++q) {
    int col = tid + 512 * q;
    int dir = col >> 10, c = col & 1023;
    float ad = fabsf(lo + (float)c * ((hi - lo) / 1023.f));
    u16* hc = HF + (size_t)c * (2 * L);
    float v[16];
    if (dir == 0) {
#pragma unroll
      for (int e = 0; e < 16; ++e) {
        const int j = 15 - e; const int tpos = t0 + j;
        v[e] = acc[q][j] * __expf(-((float)tpos / (float)(L - 1)) * ad);
      }
      *(u32x4*)(hc + (L - 16 - t0)) = pack8(v);
      *(u32x4*)(hc + (L - 8 - t0)) = pack8(v + 8);
    } else {
#pragma unroll
      for (int e = 0; e < 16; ++e) {
        const int tpos = t0 + 1 + e;
        v[e] = (tpos < L) ? acc[q][e + 1] * __expf(-((float)tpos / (float)(L - 1)) * ad) : 0.f;
      }
      *(u32x4*)(hc + (L + t0)) = pack8(v);
      *(u32x4*)(hc + (L + t0 + 8)) = pack8(v + 8);
    }
    {
      u16* hp = HFp + (size_t)c * 512;
      const float val = acc[q][17] * __expf(-((float)t / 255.f) * ad);
      if (dir == 0) hp[255 - t] = f2bf(val);
      else { if (t > 0) hp[255 + t] = f2bf(val); else hp[511] = 0; }
    }
  }
  __syncthreads();
}

DI float wave_sum(float v) {
#pragma unroll
  for (int o = 32; o >= 1; o >>= 1) v += __shfl_xor(v, o);
  return v;
}
DI void phase_norm(const Params& p, int t, int layer, const float* xa, const float* xb, u16* dst) {
  const int lane = threadIdx.x & 63, w = threadIdx.x >> 6;
  const int row0 = t * 32 + w * 4;
  float4 v[4][4];
#pragma unroll
  for (int rr = 0; rr < 4; ++rr) {
    const int row = row0 + rr;
    const float* src = row < NPROMPT ? xa + (size_t)row * 1024 : xb + (size_t)(row - NPROMPT) * 1024;
#pragma unroll
    for (int i = 0; i < 4; ++i) v[rr][i] = *(const float4*)(src + i * 256 + lane * 4);
  }
  const float* nw = p.in[7] + layer * 1024;
#pragma unroll
  for (int rr = 0; rr < 4; ++rr) {
    const int row = row0 + rr;
    const int g = row_group(row);
    float ss = 0.f;
#pragma unroll
    for (int i = 0; i < 4; ++i) ss += v[rr][i].x * v[rr][i].x + v[rr][i].y * v[rr][i].y + v[rr][i].z * v[rr][i].z + v[rr][i].w * v[rr][i].w;
    ss = wave_sum(ss);
    const float rstd = rsqrtf(ss * (1.f / 1024.f) + 1e-6f);
    const float* shift = (const float*)(p.ws + OFF_MOD) + (layer * 3 + g) * 3072;
    const float* scale = shift + 1024;
#pragma unroll
    for (int i = 0; i < 4; ++i) {
      int col = i * 256 + lane * 4;
      float4 nwv = *(const float4*)(nw + col);
      float4 sc = *(const float4*)(scale + col);
      float4 sh = *(const float4*)(shift + col);
      float o0 = v[rr][i].x * rstd * nwv.x * (1.f + sc.x) + sh.x;
      float o1 = v[rr][i].y * rstd * nwv.y * (1.f + sc.y) + sh.y;
      float o2 = v[rr][i].z * rstd * nwv.z * (1.f + sc.z) + sh.z;
      float o3 = v[rr][i].w * rstd * nwv.w * (1.f + sc.w) + sh.w;
      u32x2 o; o[0] = pk2(o0, o1); o[1] = pk2(o2, o3);
      *(u32x2*)(dst + (size_t)row * 1024 + col) = o;
    }
  }
}

DI void phase_norm_b(const Params& p, int t, const u16* x1, u16* dst) {
  const int lane = threadIdx.x & 63, w = threadIdx.x >> 6;
  const int row0 = t * 32 + w * 4;
  u32x4 v[4][2];
#pragma unroll
  for (int rr = 0; rr < 4; ++rr)
#pragma unroll
    for (int i = 0; i < 2; ++i) v[rr][i] = *(const u32x4*)(x1 + (size_t)(row0 + rr) * 1024 + i * 512 + lane * 8);
  const float* nw = p.in[7] + 1024;
#pragma unroll
  for (int rr = 0; rr < 4; ++rr) {
    const int row = row0 + rr;
    const int g = row_group(row);
    float f[2][8];
    unpack8(v[rr][0], f[0]); unpack8(v[rr][1], f[1]);
    float ss = 0.f;
#pragma unroll
    for (int i = 0; i < 2; ++i)
#pragma unroll
      for (int e = 0; e < 8; ++e) ss += f[i][e] * f[i][e];
    ss = wave_sum(ss);
    const float rstd = rsqrtf(ss * (1.f / 1024.f) + 1e-6f);
    const float* shift = (const float*)(p.ws + OFF_MOD) + (1 * 3 + g) * 3072;
    const float* scale = shift + 1024;
#pragma unroll
    for (int i = 0; i < 2; ++i) {
      const int col = i * 512 + lane * 8;
      float o[8];
#pragma unroll
      for (int hv = 0; hv < 2; ++hv) {
        const float4 nwv = *(const float4*)(nw + col + hv * 4);
        const float4 sc = *(const float4*)(scale + col + hv * 4);
        const float4 sh = *(const float4*)(shift + col + hv * 4);
        o[hv * 4 + 0] = f[i][hv * 4 + 0] * rstd * nwv.x * (1.f + sc.x) + sh.x;
        o[hv * 4 + 1] = f[i][hv * 4 + 1] * rstd * nwv.y * (1.f + sc.y) + sh.y;
        o[hv * 4 + 2] = f[i][hv * 4 + 2] * rstd * nwv.z * (1.f + sc.z) + sh.z;
        o[hv * 4 + 3] = f[i][hv * 4 + 3] * rstd * nwv.w * (1.f + sc.w) + sh.w;
      }
      *(u32x4*)(dst + (size_t)row * 1024 + col) = pack8(o);
    }
  }
}
DI void phase_final_norm(const Params& p, int t) {
  const int lane = threadIdx.x & 63, w = threadIdx.x >> 6;
  const int row0 = t * 32 + w * 4;
  float4 v[4][4];
#pragma unroll
  for (int rr = 0; rr < 4; ++rr) {
    const float* src = p.out + (size_t)(row0 + rr) * 1024;
#pragma unroll
    for (int i = 0; i < 4; ++i) v[rr][i] = *(const float4*)(src + i * 256 + lane * 4);
  }
  const float* nw = p.in[30];
#pragma unroll
  for (int rr = 0; rr < 4; ++rr) {
    float* src = p.out + (size_t)(row0 + rr) * 1024;
    float ss = 0.f;
#pragma unroll
    for (int i = 0; i < 4; ++i) ss += v[rr][i].x * v[rr][i].x + v[rr][i].y * v[rr][i].y + v[rr][i].z * v[rr][i].z + v[rr][i].w * v[rr][i].w;
    ss = wave_sum(ss);
    const float rstd = rsqrtf(ss * (1.f / 1024.f) + 1e-6f);
#pragma unroll
    for (int i = 0; i < 4; ++i) {
      int col = i * 256 + lane * 4;
      float4 nwv = *(const float4*)(nw + col);
      float4 o;
      o.x = v[rr][i].x * rstd * nwv.x; o.y = v[rr][i].y * rstd * nwv.y; o.z = v[rr][i].z * rstd * nwv.z; o.w = v[rr][i].w * rstd * nwv.w;
      *(float4*)(src + col) = o;
    }
  }
}

struct GemmArgs {
  const u16* A1; int lda1;
  const u16* A2; int lda2;
  int ksplit;
  const u16* Bt; int K;
};
template <int EPI>
DI void gemm_tile(const Params& p, const GemmArgs& g, int m0, int n0, unsigned char* smem) {
  u16* As = (u16*)smem;
  u16* Bs = As + 256 * 72;
  float* rs = (float*)(Bs + 128 * 72);
  const int tid = threadIdx.x, lane = tid & 63, w = tid >> 6;
  const int wm = (w >> 1) * 64, wn = (w & 1) * 64;
  const int l15 = lane & 15, l4 = lane >> 4;
  f32x4 acc[4][4];
#pragma unroll
  for (int i = 0; i < 4; ++i)
#pragma unroll
    for (int j = 0; j < 4; ++j) acc[i][j] = (f32x4){0.f, 0.f, 0.f, 0.f};
  if (EPI == 1) {
    if (tid < 256) {
      const float* rss = (const float*)(p.ws + OFF_ROWSS) + (size_t)(m0 + tid) * 16;
      float s = 0.f;
#pragma unroll
      for (int q = 0; q < 16; ++q) s += rss[q];
      rs[tid] = rsqrtf(s * (1.f / 1024.f) + 1e-6f);
    }
  }
  u32x4 ra[4], rb[2];
  const int KT = g.K >> 6;
  auto loadg = [&](int kt) {
    const int k0 = kt << 6;
    const u16* Ab; int lda; int kk;
    if (k0 < g.ksplit) { Ab = g.A1; lda = g.lda1; kk = k0; } else { Ab = g.A2; lda = g.lda2; kk = k0 - g.ksplit; }
#pragma unroll
    for (int i = 0; i < 4; ++i) {
      int id = tid + 512 * i; int r = id >> 3, c = (id & 7) * 8;
      ra[i] = *(const u32x4*)(Ab + (size_t)(m0 + r) * lda + kk + c);
    }
#pragma unroll
    for (int i = 0; i < 2; ++i) {
      int id = tid + 512 * i; int r = id >> 3, c = (id & 7) * 8;
      rb[i] = *(const u32x4*)(g.Bt + (size_t)(n0 + r) * g.K + k0 + c);
    }
  };
  loadg(0);
  for (int kt = 0; kt < KT; ++kt) {
#pragma unroll
    for (int i = 0; i < 4; ++i) {
      int id = tid + 512 * i; int r = id >> 3, c = (id & 7) * 8;
      *(u32x4*)(As + r * 72 + c) = ra[i];
    }
#pragma unroll
    for (int i = 0; i < 2; ++i) {
      int id = tid + 512 * i; int r = id >> 3, c = (id & 7) * 8;
      *(u32x4*)(Bs + r * 72 + c) = rb[i];
    }
    __syncthreads();
    if (kt + 1 < KT) loadg(kt + 1);
    if (EPI == 1) {
      if ((kt << 6) == g.ksplit) {
#pragma unroll
        for (int i = 0; i < 4; ++i)
#pragma unroll
          for (int r = 0; r < 4; ++r) {
            float sc = rs[wm + i * 16 + l4 * 4 + r];
#pragma unroll
            for (int j = 0; j < 4; ++j) acc[i][j][r] *= sc;
          }
      }
    }
#pragma unroll
    for (int ks = 0; ks < 2; ++ks) {
      bf16x8 a[4], b[4];
#pragma unroll
      for (int i = 0; i < 4; ++i) a[i] = *(const bf16x8*)(As + (wm + i * 16 + l15) * 72 + ks * 32 + l4 * 8);
#pragma unroll
      for (int j = 0; j < 4; ++j) b[j] = *(const bf16x8*)(Bs + (wn + j * 16 + l15) * 72 + ks * 32 + l4 * 8);
#pragma unroll
      for (int i = 0; i < 4; ++i)
#pragma unroll
        for (int j = 0; j < 4; ++j) acc[i][j] = MFMA16(a[i], b[j], acc[i][j]);
    }
    __syncthreads();
  }
#pragma unroll
  for (int i = 0; i < 4; ++i) {
    const int rbase = m0 + wm + i * 16 + l4 * 4;
#pragma unroll
    for (int j = 0; j < 4; ++j) {
      const int col = n0 + wn + j * 16 + l15;
      if (EPI == 0) {
        if (col < LDC0) {
          u16* C = (u16*)(p.ws + OFF_C0A);
#pragma unroll
          for (int r = 0; r < 4; ++r) C[(size_t)(rbase + r) * LDC0 + col] = f2bf(acc[i][j][r]);
        } else if (col < 6688) {
          u16* UT = (u16*)(p.ws + OFF_UT);
          u32x2 o; o[0] = pk2(acc[i][j][0], acc[i][j][1]); o[1] = pk2(acc[i][j][2], acc[i][j][3]);
          *(u32x2*)(UT + (size_t)(col - LDC0) * UTP + rbase) = o;
        }
      } else if (EPI == 1) {
        float* X1 = (float*)(p.ws + OFF_X1);
        const float* mod = (const float*)(p.ws + OFF_MOD);
#pragma unroll
        for (int r = 0; r < 4; ++r) {
          int row = rbase + r;
          const float* xs = row < NPROMPT ? p.in[0] + (size_t)row * 1024 : p.in[1] + (size_t)(row - NPROMPT) * 1024;
          float gate = mod[(0 * 3 + row_group(row)) * 3072 + 2048 + col];
          X1[(size_t)row * 1024 + col] = xs[col] + gate * acc[i][j][r];
        }
      } else if (EPI == 2) {
        u16* C1 = (u16*)(p.ws + OFF_C1);
#pragma unroll
        for (int r = 0; r < 4; ++r) {
          int row = rbase + r;
          C1[(size_t)row * LDC1 + col] = f2bf(acc[i][j][r]);
          if (row < NPROMPT && col >= 1024 && col < 3072) {
            int cc = col - 1024; int isv = cc >> 10; cc &= 1023;
            int hh = cc >> 6, d = cc & 63; int b = row >> 8, l = row & 255;
            float* o = p.out + (isv ? O_NV : O_NK);
            o[(((size_t)b * 16 + hh) * 256 + l) * 64 + d] = acc[i][j][r];
          }
        }
      } else {
        const float* X1 = (const float*)(p.ws + OFF_X1);
        const float* mod = (const float*)(p.ws + OFF_MOD);
#pragma unroll
        for (int r = 0; r < 4; ++r) {
          int row = rbase + r;
          float gate = mod[(1 * 3 + row_group(row)) * 3072 + 2048 + col];
          p.out[(size_t)row * 1024 + col] = X1[(size_t)row * 1024 + col] + gate * acc[i][j][r];
        }
      }
    }
  }
}


DI int lds_byte(int r, int c) {
  int st = (r >> 4) * 2 + (c >> 5), rr = r & 15, cc = c & 31, ob = rr * 64 + cc * 2;
  return st * 1024 + (ob ^ (((ob >> 9) & 1) << 5));
}
DI void stage_rc(int b, int& R, int& C) {
  int st = b / 1024, sb = b % 1024, swz = sb ^ (((sb >> 9) & 1) << 5);
  R = (st >> 1) * 16 + swz / 64; C = (st & 1) * 32 + (swz % 64) / 2;
}
template <int EPI>
DI void epi_store(const Params& p, int rbase, int col, const f32x4& v) {
  if (EPI == 0) {
    if (col < LDC0) {
      u16* C = (u16*)(p.ws + OFF_C0A);
#pragma unroll
      for (int r = 0; r < 4; ++r) C[(size_t)(rbase + r) * LDC0 + col] = f2bf(v[r]);
    } else if (col < 6688) {
      u16* UT = (u16*)(p.ws + OFF_UT);
      u32x2 o; o[0] = pk2(v[0], v[1]); o[1] = pk2(v[2], v[3]);
      *(u32x2*)(UT + (size_t)(col - LDC0) * UTP + rbase) = o;
    }
  } else if (EPI == 1) {
    float* X1 = (float*)(p.ws + OFF_X1);
    const float* mod = (const float*)(p.ws + OFF_MOD);
#pragma unroll
    for (int r = 0; r < 4; ++r) {
      int row = rbase + r;
      const float* xs = row < NPROMPT ? p.in[0] + (size_t)row * 1024 : p.in[1] + (size_t)(row - NPROMPT) * 1024;
      float gate = mod[(0 * 3 + row_group(row)) * 3072 + 2048 + col];
      X1[(size_t)row * 1024 + col] = xs[col] + gate * v[r];
    }
  } else if (EPI == 2) {
    u16* C1 = (u16*)(p.ws + OFF_C1);
#pragma unroll
    for (int r = 0; r < 4; ++r) {
      int row = rbase + r;
      C1[(size_t)row * LDC1 + col] = f2bf(v[r]);
      if (row < NPROMPT && col >= 1024 && col < 3072) {
        int cc = col - 1024; int isv = cc >> 10; cc &= 1023;
        int hh = cc >> 6, d = cc & 63; int b = row >> 8, l = row & 255;
        float* o = p.out + (isv ? O_NV : O_NK);
        o[(((size_t)b * 16 + hh) * 256 + l) * 64 + d] = v[r];
      }
    }
  } else {
    const float* X1 = (const float*)(p.ws + OFF_X1);
    const float* mod = (const float*)(p.ws + OFF_MOD);
#pragma unroll
    for (int r = 0; r < 4; ++r) {
      int row = rbase + r;
      float gate = mod[(1 * 3 + row_group(row)) * 3072 + 2048 + col];
      p.out[(size_t)row * 1024 + col] = X1[(size_t)row * 1024 + col] + gate * v[r];
    }
  }
}

template <int EPI>
DI void epi_store_sw(const Params& p, int row, int col, const f32x4& v) {
  if (EPI == 0) {
    u16* C = (u16*)(p.ws + OFF_C0A);
    u32x2 o; o[0] = pk2(v[0], v[1]); o[1] = pk2(v[2], v[3]);
    *(u32x2*)(C + (size_t)row * LDC0 + col) = o;
  } else if (EPI == 1) {
    float* X1 = (float*)(p.ws + OFF_X1);
    const float* mod = (const float*)(p.ws + OFF_MOD);
    const float* xs = row < NPROMPT ? p.in[0] + (size_t)row * 1024 : p.in[1] + (size_t)(row - NPROMPT) * 1024;
    const float4 xv = *(const float4*)(xs + col);
    const float4 gt = *(const float4*)(mod + (0 * 3 + row_group(row)) * 3072 + 2048 + col);
    u32x2 ob; ob[0] = pk2(xv.x + gt.x * v[0], xv.y + gt.y * v[1]); ob[1] = pk2(xv.z + gt.z * v[2], xv.w + gt.w * v[3]);
    *(u32x2*)((u16*)X1 + (size_t)row * 1024 + col) = ob;
  } else if (EPI == 2) {
    u16* C1 = (u16*)(p.ws + OFF_C1);
    u32x2 o; o[0] = pk2(v[0], v[1]); o[1] = pk2(v[2], v[3]);
    *(u32x2*)(C1 + (size_t)row * LDC1 + col) = o;
    if (row < NPROMPT && col >= 1024 && col < 3072) {
      int cc = col - 1024; int isv = cc >> 10; cc &= 1023;
      int hh = cc >> 6, d = cc & 63; int b = row >> 8, l = row & 255;
      float* op = p.out + (isv ? O_NV : O_NK);
      *(float4*)(op + (((size_t)b * 16 + hh) * 256 + l) * 64 + d) = make_float4(v[0], v[1], v[2], v[3]);
    }
  } else {
    const float* X1 = (const float*)(p.ws + OFF_X1);
    const float* mod = (const float*)(p.ws + OFF_MOD);
    const u32x2 xb = *(const u32x2*)((const u16*)X1 + (size_t)row * 1024 + col);
    const float4 xv = make_float4(bflo(xb[0]), bfhi(xb[0]), bflo(xb[1]), bfhi(xb[1]));
    const float4 gt = *(const float4*)(mod + (1 * 3 + row_group(row)) * 3072 + 2048 + col);
    float4 o; o.x = xv.x + gt.x * v[0]; o.y = xv.y + gt.y * v[1]; o.z = xv.z + gt.z * v[2]; o.w = xv.w + gt.w * v[3];
    *(float4*)(p.out + (size_t)row * 1024 + col) = o;
  }
}

template <int EPI, bool SWAP>
DI void gemm256(const Params& p, const GemmArgs& g, int brow, int bcol, unsigned char* smem) {
  constexpr int HT = 128 * 64;
  u16* shm = (u16*)smem;
  float* rs = (float*)(smem + 131072);
  const int K = g.K;
#define SA(b, h) (shm + ((b) * 2 + (h)) * HT)
#define SB(b, h) (shm + (4 + (b) * 2 + (h)) * HT)
#define STAGE_A(P, br, kt) do { const u16* _ub = g.A1 + (long)(br) * g.lda1 + (long)(kt) * 64; \
    for (int _i = 0; _i < 2; ++_i) { \
      __builtin_amdgcn_global_load_lds((const unsigned*)((const char*)(_ub + (long)_i * 64 * g.lda1) + aoff1), \
        (__attribute__((address_space(3))) unsigned*)((char*)(P) + threadIdx.x * 16 + _i * 8192), 16, 0, 0); } } while (0)
#define STAGE_B(P, bc, kt) do { const u16* _ub = g.Bt + (long)(bc) * K + (long)(kt) * 64; \
    for (int _i = 0; _i < 2; ++_i) { \
      __builtin_amdgcn_global_load_lds((const unsigned*)((const char*)(_ub + (long)_i * 64 * K) + boff), \
        (__attribute__((address_space(3))) unsigned*)((char*)(P) + threadIdx.x * 16 + _i * 8192), 16, 0, 0); } } while (0)
#define LDA(dst, b, h) for (int m = 0; m < 4; ++m) for (int k = 0; k < 2; ++k) \
    dst[m][k] = *reinterpret_cast<const bf16x8*>((char*)SA(b, h) + lds_byte(wr * 64 + m * 16 + fr, k * 32 + fq * 8))
#define LDB(dst, b, h) for (int n = 0; n < 2; ++n) for (int k = 0; k < 2; ++k) \
    dst[n][k] = *reinterpret_cast<const bf16x8*>((char*)SB(b, h) + lds_byte(wc * 32 + n * 16 + fr, k * 32 + fq * 8))
#define MMA(ai, bj, At_, Bt_) do { __builtin_amdgcn_s_setprio(1); \
    for (int m = 0; m < 4; ++m) for (int n = 0; n < 2; ++n) for (int k = 0; k < 2; ++k) \
      acc[ai][bj][m][n] = SWAP ? __builtin_amdgcn_mfma_f32_16x16x32_bf16(Bt_[n][k], At_[m][k], acc[ai][bj][m][n], 0, 0, 0) \
                               : __builtin_amdgcn_mfma_f32_16x16x32_bf16(At_[m][k], Bt_[n][k], acc[ai][bj][m][n], 0, 0, 0); \
    __builtin_amdgcn_s_setprio(0); } while (0)
#define WAIT_V(n) asm volatile("s_waitcnt vmcnt(" #n ")" ::: "memory")
#define WAIT_L(n) asm volatile("s_waitcnt lgkmcnt(" #n ")" ::: "memory")
#define BAR __builtin_amdgcn_s_barrier()
#define SCHED __builtin_amdgcn_sched_barrier(0)
  const int wid = threadIdx.x >> 6, lane = threadIdx.x & 63, wr = wid >> 2, wc = wid & 3, fr = lane & 15, fq = lane >> 4;
  unsigned aoff1, boff;
  {
    int r_, c_; stage_rc(threadIdx.x * 16, r_, c_);
    aoff1 = (unsigned)(r_ * g.lda1 + c_) * 2u;
    boff = (unsigned)(r_ * K + c_) * 2u;
  }
  if (EPI == 1) {
    if (threadIdx.x < 256) {
      const float* rss = (const float*)(p.ws + OFF_ROWSS) + (size_t)(brow + threadIdx.x) * 16;
      float s = 0.f;
#pragma unroll
      for (int q = 0; q < 16; ++q) s += rss[q];
      rs[threadIdx.x] = rsqrtf(s * (1.f / 1024.f) + 1e-6f);
    }
  }
  WAIT_V(0);
  __syncthreads();
  f32x4 acc[2][2][4][2];
#pragma unroll
  for (int a = 0; a < 2; ++a)
#pragma unroll
    for (int b = 0; b < 2; ++b)
#pragma unroll
      for (int m = 0; m < 4; ++m)
#pragma unroll
        for (int n = 0; n < 2; ++n) acc[a][b][m][n] = (f32x4){0.f, 0.f, 0.f, 0.f};
  bf16x8 At[4][2], B0[2][2], B1[2][2];
  const int nt = K / 64;
  const int tscale = (EPI == 1) ? (g.ksplit >> 6) : -1;
  STAGE_B(SB(0, 0), bcol, 0); STAGE_A(SA(0, 0), brow, 0);
  STAGE_B(SB(0, 1), bcol + 128, 0); STAGE_A(SA(0, 1), brow + 128, 0);
  if (wr == 1) BAR;
  WAIT_V(4); BAR;
  STAGE_B(SB(1, 0), bcol, 1); STAGE_A(SA(1, 0), brow, 1); STAGE_B(SB(1, 1), bcol + 128, 1);
  WAIT_V(6); BAR;
  for (int t = 0; t < nt - 2; t += 2) {
    if (EPI == 1) {
      if (t == tscale) {
#pragma unroll
        for (int a = 0; a < 2; ++a)
#pragma unroll
          for (int m = 0; m < 4; ++m)
#pragma unroll
            for (int j = 0; j < 4; ++j) {
              float sc = SWAP ? rs[a * 128 + wr * 64 + m * 16 + fr] : rs[a * 128 + wr * 64 + m * 16 + fq * 4 + j];
#pragma unroll
              for (int b = 0; b < 2; ++b)
#pragma unroll
                for (int n = 0; n < 2; ++n) acc[a][b][m][n][j] *= sc;
            }
      }
    }
    LDB(B0, 0, 0); SCHED; LDA(At, 0, 0); STAGE_A(SA(1, 1), brow + 128, t + 1);
    WAIT_L(8); BAR; WAIT_L(0); MMA(0, 0, At, B0); BAR; SCHED;
    LDB(B1, 0, 1); STAGE_B(SB(0, 0), bcol, t + 2);
    BAR; WAIT_L(0); MMA(0, 1, At, B1); BAR;
    LDA(At, 0, 1); STAGE_A(SA(0, 0), brow, t + 2);
    BAR; WAIT_L(0); MMA(1, 0, At, B0); BAR; SCHED;
    STAGE_B(SB(0, 1), bcol + 128, t + 2);
    WAIT_V(6); BAR; MMA(1, 1, At, B1); BAR;
    LDB(B0, 1, 0); SCHED; LDA(At, 1, 0); STAGE_A(SA(0, 1), brow + 128, t + 2);
    WAIT_L(8); BAR; WAIT_L(0); MMA(0, 0, At, B0); BAR; SCHED;
    LDB(B1, 1, 1); STAGE_B(SB(1, 0), bcol, t + 3);
    BAR; WAIT_L(0); MMA(0, 1, At, B1); BAR;
    LDA(At, 1, 1); STAGE_A(SA(1, 0), brow, t + 3);
    BAR; WAIT_L(0); MMA(1, 0, At, B0); BAR; SCHED;
    STAGE_B(SB(1, 1), bcol + 128, t + 3);
    WAIT_V(6); BAR; MMA(1, 1, At, B1); BAR;
  }
  { LDB(B0, 0, 0); LDA(At, 0, 0); STAGE_A(SA(1, 1), brow + 128, nt - 1);
    BAR; WAIT_L(0); MMA(0, 0, At, B0); BAR;
    LDB(B1, 0, 1); BAR; WAIT_L(0); MMA(0, 1, At, B1); BAR;
    LDA(At, 0, 1); WAIT_V(4); BAR; WAIT_L(0); MMA(1, 0, At, B0); MMA(1, 1, At, B1); BAR; }
  { LDB(B0, 1, 0); LDA(At, 1, 0); WAIT_V(2); BAR; WAIT_L(0); MMA(0, 0, At, B0); BAR;
    LDB(B1, 1, 1); WAIT_V(0); BAR; WAIT_L(0); MMA(0, 1, At, B1); BAR;
    LDA(At, 1, 1); BAR; WAIT_L(0); MMA(1, 0, At, B0); MMA(1, 1, At, B1); BAR; }
  if (wr == 0) BAR;
  int e_tid = threadIdx.x, e_brow = brow, e_bcol = bcol;
  asm volatile("" : "+v"(e_tid), "+s"(e_brow), "+s"(e_bcol));
  const int e_row = SWAP ? e_brow + ((e_tid >> 8) & 1) * 64 + (e_tid & 15) : e_brow + ((e_tid >> 8) & 1) * 64 + ((e_tid >> 4) & 3) * 4;
  const int e_col = SWAP ? e_bcol + ((e_tid >> 6) & 3) * 32 + ((e_tid >> 4) & 3) * 4 : e_bcol + ((e_tid >> 6) & 3) * 32 + (e_tid & 15);
#pragma unroll
  for (int ai = 0; ai < 2; ++ai)
#pragma unroll
    for (int bj = 0; bj < 2; ++bj)
#pragma unroll
      for (int m = 0; m < 4; ++m)
#pragma unroll
        for (int n = 0; n < 2; ++n) {
          if (SWAP) epi_store_sw<EPI>(p, e_row + ai * 128 + m * 16, e_col + bj * 128 + n * 16, acc[ai][bj][m][n]);
          else epi_store<EPI>(p, e_row + ai * 128 + m * 16, e_col + bj * 128 + n * 16, acc[ai][bj][m][n]);
        }
  __syncthreads();
#undef SA
#undef SB
#undef STAGE_A
#undef STAGE_B
#undef LDA
#undef LDB
#undef MMA
#undef WAIT_V
#undef WAIT_L
#undef BAR
#undef SCHED
}
DI bool gemm_tile_coord(int round, int NN, int ntiles, int& pm, int& pn) {
  const int b = blockIdx.x;
  const int v = round * 256 + (b & 7) * 32 + (b >> 3);
  if (v >= ntiles) return false;
  pm = (v / (8 * NN)) * 8 + (v & 7);
  pn = (v >> 3) % NN;
  return true;
}
struct SsdItem { int row0; int h; int has_prev; int has_next; };
DI SsdItem ssd_item(int item) {
  SsdItem s;
  int cgi = item >> 4; s.h = item & 15;
  if (cgi < 64) { int seq = cgi >> 1, c = cgi & 1; s.row0 = seq * 256 + c * 128; s.has_prev = c > 0; s.has_next = c < 1; }
  else { int q = cgi - 64; int seq = q >> 5, c = q & 31; s.row0 = NPROMPT + seq * 4096 + c * 128; s.has_prev = c > 0; s.has_next = c < 31; }
  return s;
}
DI float ssd_load_dt(const Params& p, int row0, int h) {
  const int tid = threadIdx.x;
  const u16* C0 = (const u16*)(p.ws + OFF_C0A);
  float raw = 0.f;
  if (tid < 256) { int d = tid >> 7, l = tid & 127; raw = bf2f(C0[(size_t)(row0 + l) * LDC0 + 2560 + d * 16 + h]); }
  return raw;
}
DI void ssd_prep_dt(const Params& p, float raw, int h, float* sdt, float* scs, float* stot) {
  const int tid = threadIdx.x, lane = tid & 63, w = tid >> 6;
  if (tid < 256) {
    int d = tid >> 7, l = tid & 127;
    float x = raw + p.in[14][d * 16 + h];
    float dt = x > 20.f ? x : log1pf(expf(x));
    float a = -expf(p.in[15][d * 16 + h]);
    sdt[d * 128 + l] = dt;
    scs[d * 128 + l] = a * dt;
  }
  __syncthreads();
  if (w < 2) {
    const int d = w;
    int p0 = d == 0 ? 2 * lane : 127 - 2 * lane;
    int p1 = d == 0 ? 2 * lane + 1 : 126 - 2 * lane;
    float v0 = scs[d * 128 + p0], v1 = scs[d * 128 + p1];
    float s = v0 + v1;
#pragma unroll
    for (int off = 1; off < 64; off <<= 1) {
      float tv = __shfl_up(s, off);
      if (lane >= off) s += tv;
    }
    float excl = s - (v0 + v1);
    scs[d * 128 + p0] = excl + v0;
    scs[d * 128 + p1] = excl + v0 + v1;
    if (lane == 63) stot[d] = s;
  }
  __syncthreads();
}
DI void conv_silu8(const Params& p, int row, int ch0, bool hp, bool hn, float* out) {
  const u16* C0 = (const u16*)(p.ws + OFF_C0A);
  const u16* q = C0 + (size_t)row * LDC0 + 1024 + ch0;
  const float* cw = p.in[12]; const float* cb = p.in[13];
  float xm[8], xc[8], xp[8];
  u32x4 vc = *(const u32x4*)q;
  unpack8(vc, xc);
  if (hp) { u32x4 v = *(const u32x4*)(q - LDC0); unpack8(v, xm); } else {
#pragma unroll
    for (int e = 0; e < 8; ++e) xm[e] = 0.f;
  }
  if (hn) { u32x4 v = *(const u32x4*)(q + LDC0); unpack8(v, xp); } else {
#pragma unroll
    for (int e = 0; e < 8; ++e) xp[e] = 0.f;
  }
  float4 w0a = *(const float4*)(cw + ch0), w0b = *(const float4*)(cw + ch0 + 4);
  float4 w1a = *(const float4*)(cw + 1536 + ch0), w1b = *(const float4*)(cw + 1536 + ch0 + 4);
  float4 w2a = *(const float4*)(cw + 3072 + ch0), w2b = *(const float4*)(cw + 3072 + ch0 + 4);
  float4 ba = *(const float4*)(cb + ch0), bb = *(const float4*)(cb + ch0 + 4);
  float w0[8] = {w0a.x, w0a.y, w0a.z, w0a.w, w0b.x, w0b.y, w0b.z, w0b.w};
  float w1[8] = {w1a.x, w1a.y, w1a.z, w1a.w, w1b.x, w1b.y, w1b.z, w1b.w};
  float w2[8] = {w2a.x, w2a.y, w2a.z, w2a.w, w2b.x, w2b.y, w2b.z, w2b.w};
  float bv[8] = {ba.x, ba.y, ba.z, ba.w, bb.x, bb.y, bb.z, bb.w};
#pragma unroll
  for (int e = 0; e < 8; ++e) out[e] = silu(bv[e] + w0[e] * xm[e] + w1[e] * xc[e] + w2[e] * xp[e]);
}


template <int R>
DI void conv_load(const Params& p, int row0, int l0, int ch0, bool prev_chunk, bool next_chunk, u32x4 (&raw)[R + 2]) {
  const u16* C0 = (const u16*)(p.ws + OFF_C0A);
  const u16* q = C0 + (size_t)(row0 + l0) * LDC0 + 1024 + ch0;
  const bool hp = (l0 > 0) || prev_chunk;
  const bool hn = (l0 + R < 128) || next_chunk;
#pragma unroll
  for (int i = 0; i < R + 2; ++i) {
    const bool ok = (i == 0) ? hp : ((i == R + 1) ? hn : true);
    raw[i] = (u32x4){0u, 0u, 0u, 0u};
    if (ok) raw[i] = *(const u32x4*)(q + (long)(i - 1) * LDC0);
  }
}
template <int R>
DI void conv_compute(const Params& p, int ch0, const u32x4 (&raw)[R + 2], float (&out)[R][8]) {
  const float* cw = p.in[12]; const float* cb = p.in[13];
  float4 w0a = *(const float4*)(cw + ch0), w0b = *(const float4*)(cw + ch0 + 4);
  float4 w1a = *(const float4*)(cw + 1536 + ch0), w1b = *(const float4*)(cw + 1536 + ch0 + 4);
  float4 w2a = *(const float4*)(cw + 3072 + ch0), w2b = *(const float4*)(cw + 3072 + ch0 + 4);
  float4 ba = *(const float4*)(cb + ch0), bb = *(const float4*)(cb + ch0 + 4);
  const float w0[8] = {w0a.x, w0a.y, w0a.z, w0a.w, w0b.x, w0b.y, w0b.z, w0b.w};
  const float w1[8] = {w1a.x, w1a.y, w1a.z, w1a.w, w1b.x, w1b.y, w1b.z, w1b.w};
  const float w2[8] = {w2a.x, w2a.y, w2a.z, w2a.w, w2b.x, w2b.y, w2b.z, w2b.w};
  const float bv[8] = {ba.x, ba.y, ba.z, ba.w, bb.x, bb.y, bb.z, bb.w};
  float xm[8], xc[8], xp[8];
  unpack8(raw[0], xm); unpack8(raw[1], xc);
#pragma unroll
  for (int i = 0; i < R; ++i) {
    unpack8(raw[i + 2], xp);
#pragma unroll
    for (int e = 0; e < 8; ++e) {
      out[i][e] = silu(bv[e] + w0[e] * xm[e] + w1[e] * xc[e] + w2[e] * xp[e]);
      xm[e] = xc[e]; xc[e] = xp[e];
    }
  }
}
DI void phase_ssd_states(const Params& p, int item, unsigned char* smem) {
  u16* xT = (u16*)smem;
  u16* BTs = xT + 64 * 136;
  float* sdt = (float*)(BTs + 2 * 128 * 136);
  float* scs = sdt + 256;
  float* sw = scs + 256;
  float* stot = sw + 256;
  const int tid = threadIdx.x, lane = tid & 63, w = tid >> 6;
  const int l15 = lane & 15, l4 = lane >> 4;
  const SsdItem it = ssd_item(item);
  const int h = it.h, grp = h >> 3;
  const int xchunk = tid & 7, xrg = tid >> 3;
  const int bchunk = tid & 15, brg = tid >> 4;
  u32x4 rawx[4], rawb[6];
  const float rawdt = ssd_load_dt(p, it.row0, h);
  conv_load<2>(p, it.row0, xrg * 2, h * 64 + xchunk * 8, it.has_prev, it.has_next, rawx);
  conv_load<4>(p, it.row0, brg * 4, 1024 + grp * 128 + bchunk * 8, it.has_prev, it.has_next, rawb);
  ssd_prep_dt(p, rawdt, h, sdt, scs, stot);
  if (tid < 256) {
    int d = tid >> 7;
    sw[tid] = sdt[tid] * __expf(stot[d] - scs[tid]);
  }
  __syncthreads();
  {
    {
      float o[2][8];
      conv_compute<2>(p, h * 64 + xchunk * 8, rawx, o);
#pragma unroll
      for (int e = 0; e < 8; ++e) *(unsigned*)(xT + (xchunk * 8 + e) * 136 + xrg * 2) = pk2(o[0][e], o[1][e]);
    }
    {
      float o[4][8];
      conv_compute<4>(p, 1024 + grp * 128 + bchunk * 8, rawb, o);
#pragma unroll
      for (int dd = 0; dd < 2; ++dd) {
        const float s0 = sw[dd * 128 + brg * 4], s1 = sw[dd * 128 + brg * 4 + 1], s2 = sw[dd * 128 + brg * 4 + 2], s3 = sw[dd * 128 + brg * 4 + 3];
#pragma unroll
        for (int e = 0; e < 8; ++e) {
          u32x2 v; v[0] = pk2(o[0][e] * s0, o[1][e] * s1); v[1] = pk2(o[2][e] * s2, o[3][e] * s3);
          *(u32x2*)(BTs + dd * 128 * 136 + (bchunk * 8 + e) * 136 + brg * 4) = v;
        }
      }
    }
  }
  __syncthreads();
  const int d = w >> 2, nq = w & 3;
  f32x4 acc[4][2];
#pragma unroll
  for (int i = 0; i < 4; ++i) { acc[i][0] = (f32x4){0.f, 0.f, 0.f, 0.f}; acc[i][1] = (f32x4){0.f, 0.f, 0.f, 0.f}; }
#pragma unroll
  for (int ks = 0; ks < 4; ++ks) {
    bf16x8 a[4], b[2];
#pragma unroll
    for (int i = 0; i < 4; ++i) a[i] = *(const bf16x8*)(xT + (i * 16 + l15) * 136 + ks * 32 + l4 * 8);
#pragma unroll
    for (int j = 0; j < 2; ++j) b[j] = *(const bf16x8*)(BTs + d * 128 * 136 + (nq * 32 + j * 16 + l15) * 136 + ks * 32 + l4 * 8);
#pragma unroll
    for (int i = 0; i < 4; ++i)
#pragma unroll
      for (int j = 0; j < 2; ++j) acc[i][j] = MFMA16(a[i], b[j], acc[i][j]);
  }
  u16* S = (u16*)((unsigned char*)p.out + OUT_SBUF) + ((size_t)item * 2 + d) * 8192;
#pragma unroll
  for (int i = 0; i < 4; ++i)
#pragma unroll
    for (int j = 0; j < 2; ++j)
#pragma unroll
      for (int r = 0; r < 4; ++r) {
        int pp = i * 16 + l4 * 4 + r, n = nq * 32 + j * 16 + l15;
        S[pp * 128 + n] = f2bf(acc[i][j][r]);
      }
  if (tid < 2) {
    float* cdec = (float*)(p.ws + OFF_CDEC);
    cdec[item * 2 + tid] = __expf(stot[tid]);
  }
  __syncthreads();
}

DI void phase_scan(const Params& p, int t) {
  const int part = t & 1, d = (t >> 1) & 1, h = (t >> 2) & 15, seq = t >> 6;
  const int tid = threadIdx.x;
  const int e0 = part * 4096 + tid * 8;
  const int nc = seq < 32 ? 2 : 32;
  const int cg0 = seq < 32 ? seq * 2 : 64 + (seq - 32) * 32;
  float st[8];
  if (seq < 32) {
#pragma unroll
    for (int e = 0; e < 8; ++e) st[e] = 0.f;
  } else {
    const float* init = p.in[2] + ((((size_t)(seq - 32) * 1 + 0) * 2 + d) * 16 + h) * 8192 + e0;
    float4 a = *(const float4*)init, b = *(const float4*)(init + 4);
    st[0] = a.x; st[1] = a.y; st[2] = a.z; st[3] = a.w; st[4] = b.x; st[5] = b.y; st[6] = b.z; st[7] = b.w;
  }
  u16* Sb = (u16*)((unsigned char*)p.out + OUT_SBUF);
  const float* cdec = (const float*)(p.ws + OFF_CDEC);
  for (int cb0 = 0; cb0 < nc; cb0 += 8) {
    u32x4 vv[8]; float dec[8];
#pragma unroll
    for (int i = 0; i < 8; ++i) {
      if (cb0 + i < nc) {
        const int ci = cb0 + i;
        const int c = d == 0 ? ci : nc - 1 - ci;
        const int item = (cg0 + c) * 16 + h;
        vv[i] = *(const u32x4*)(Sb + ((size_t)item * 2 + d) * 8192 + e0);
        dec[i] = cdec[item * 2 + d];
      }
    }
#pragma unroll
    for (int i = 0; i < 8; ++i) {
      if (cb0 + i < nc) {
        const int ci = cb0 + i;
        const int c = d == 0 ? ci : nc - 1 - ci;
        const int item = (cg0 + c) * 16 + h;
        float sc[8]; unpack8(vv[i], sc);
        *(u32x4*)(Sb + ((size_t)item * 2 + d) * 8192 + e0) = pack8(st);
#pragma unroll
        for (int e = 0; e < 8; ++e) st[e] = st[e] * dec[i] + sc[e];
      }
    }
  }
  if (seq < 32) {
    float* o = p.out + O_ST + ((((size_t)seq * 1 + 0) * 2 + d) * 16 + h) * 8192 + e0;
    *(float4*)o = make_float4(st[0], st[1], st[2], st[3]);
    *(float4*)(o + 4) = make_float4(st[4], st[5], st[6], st[7]);
  }
}

DI void phase_ssd_out(const Params& p, int item, unsigned char* smem, bool dry) {
  u16* Cs = (u16*)smem;
  u16* Bs = Cs + 128 * 136;
  u16* xT = Bs + 128 * 136;
  u16* St = xT + 64 * 136;
  float* sdt = (float*)(St + 2 * 64 * 136);
  float* scs = sdt + 256;
  float* stot = scs + 256;
  const int tid = threadIdx.x, lane = tid & 63, w = tid >> 6;
  const int l15 = lane & 15, l4 = lane >> 4;
  const SsdItem it = ssd_item(item);
  const int h = it.h, grp = h >> 3;
  const int xchunk = tid & 7, xrg = tid >> 3;
  const int bchunk = tid & 15, brg = tid >> 4;
  u32x4 rawx[4], rawb[6], rawc[6], rawst[4];
  u16 zraw[4][4];
  const float rawdt = ssd_load_dt(p, it.row0, h);
  conv_load<2>(p, it.row0, xrg * 2, h * 64 + xchunk * 8, it.has_prev, it.has_next, rawx);
  conv_load<4>(p, it.row0, brg * 4, 1024 + grp * 128 + bchunk * 8, it.has_prev, it.has_next, rawb);
  conv_load<4>(p, it.row0, brg * 4, 1280 + grp * 128 + bchunk * 8, it.has_prev, it.has_next, rawc);
  {
    const u16* S = (const u16*)((const unsigned char*)p.out + OUT_SBUF) + (size_t)item * 2 * 8192;
#pragma unroll
    for (int v = 0; v < 4; ++v) {
      int id = tid + 512 * v;
      int dd = id >> 10, pp = (id >> 4) & 63, nv = (id & 15) * 8;
      rawst[v] = *(const u32x4*)(S + dd * 8192 + pp * 128 + nv);
    }
  }
  ssd_prep_dt(p, rawdt, h, sdt, scs, stot);
  {
    {
      float o[2][8];
      conv_compute<2>(p, h * 64 + xchunk * 8, rawx, o);
#pragma unroll
      for (int e = 0; e < 8; ++e) *(unsigned*)(xT + (xchunk * 8 + e) * 136 + xrg * 2) = pk2(o[0][e], o[1][e]);
    }
    {
      float o[4][8];
      conv_compute<4>(p, 1024 + grp * 128 + bchunk * 8, rawb, o);
#pragma unroll
      for (int i = 0; i < 4; ++i) *(u32x4*)(Bs + (brg * 4 + i) * 136 + bchunk * 8) = pack8(o[i]);
      conv_compute<4>(p, 1280 + grp * 128 + bchunk * 8, rawc, o);
#pragma unroll
      for (int i = 0; i < 4; ++i) *(u32x4*)(Cs + (brg * 4 + i) * 136 + bchunk * 8) = pack8(o[i]);
    }
#pragma unroll
    for (int v = 0; v < 4; ++v) {
      int id = tid + 512 * v;
      int dd = id >> 10, pp = (id >> 4) & 63, nv = (id & 15) * 8;
      *(u32x4*)(St + dd * 64 * 136 + pp * 136 + nv) = rawst[v];
    }
  }
  __syncthreads();
  {
    const u16* C0z = (const u16*)(p.ws + OFF_C0A);
#pragma unroll
    for (int i = 0; i < 4; ++i)
#pragma unroll
      for (int r = 0; r < 4; ++r)
        zraw[i][r] = C0z[(size_t)(it.row0 + 16 * w + l4 * 4 + r) * LDC0 + h * 64 + i * 16 + l15];
  }
  f32x4 cb[8], af[4], ab[4];
#pragma unroll
  for (int j = 0; j < 8; ++j) cb[j] = (f32x4){0.f, 0.f, 0.f, 0.f};
#pragma unroll
  for (int i = 0; i < 4; ++i) { af[i] = (f32x4){0.f, 0.f, 0.f, 0.f}; ab[i] = (f32x4){0.f, 0.f, 0.f, 0.f}; }
#pragma unroll
  for (int ks = 0; ks < 4; ++ks) {
    bf16x8 a = *(const bf16x8*)(Cs + (16 * w + l15) * 136 + ks * 32 + l4 * 8);
#pragma unroll
    for (int j = 0; j < 8; ++j) {
      bf16x8 b = *(const bf16x8*)(Bs + (j * 16 + l15) * 136 + ks * 32 + l4 * 8);
      cb[j] = MFMA16(b, a, cb[j]);
    }
#pragma unroll
    for (int i = 0; i < 4; ++i) {
      bf16x8 b0 = *(const bf16x8*)(St + (i * 16 + l15) * 136 + ks * 32 + l4 * 8);
      bf16x8 b1 = *(const bf16x8*)(St + 64 * 136 + (i * 16 + l15) * 136 + ks * 32 + l4 * 8);
      af[i] = MFMA16(a, b0, af[i]);
      ab[i] = MFMA16(a, b1, ab[i]);
    }
  }
  __syncthreads();
  f32x4 Y[4];
  {
    const int lrow = 16 * w + l15;
    const float cs0l = scs[lrow], cs1l = scs[128 + lrow];
#pragma unroll
    for (int j = 0; j < 8; ++j) {
      const int s0 = j * 16 + l4 * 4;
      float f[4];
      if (j < w) {
        const float4 c4 = *(const float4*)(scs + s0), d4 = *(const float4*)(sdt + s0);
        f[0] = __expf(cs0l - c4.x) * d4.x; f[1] = __expf(cs0l - c4.y) * d4.y; f[2] = __expf(cs0l - c4.z) * d4.z; f[3] = __expf(cs0l - c4.w) * d4.w;
      } else if (j > w) {
        const float4 c4 = *(const float4*)(scs + 128 + s0), d4 = *(const float4*)(sdt + 128 + s0);
        f[0] = __expf(cs1l - c4.x) * d4.x; f[1] = __expf(cs1l - c4.y) * d4.y; f[2] = __expf(cs1l - c4.z) * d4.z; f[3] = __expf(cs1l - c4.w) * d4.w;
      } else {
        const float4 c4 = *(const float4*)(scs + s0), d4 = *(const float4*)(sdt + s0);
        const float4 e4 = *(const float4*)(scs + 128 + s0), g4 = *(const float4*)(sdt + 128 + s0);
        const float c0[4] = {c4.x, c4.y, c4.z, c4.w}, d0[4] = {d4.x, d4.y, d4.z, d4.w};
        const float c1[4] = {e4.x, e4.y, e4.z, e4.w}, d1[4] = {g4.x, g4.y, g4.z, g4.w};
#pragma unroll
        for (int jj = 0; jj < 4; ++jj) {
          const int sidx = s0 + jj;
          float v;
          if (lrow > sidx) v = __expf(cs0l - c0[jj]) * d0[jj];
          else if (lrow < sidx) v = __expf(cs1l - c1[jj]) * d1[jj];
          else v = d0[jj] + d1[jj];
          f[jj] = v;
        }
      }
      u32x2 o; o[0] = pk2(cb[j][0] * f[0], cb[j][1] * f[1]); o[1] = pk2(cb[j][2] * f[2], cb[j][3] * f[3]);
      *(u32x2*)(Bs + lrow * 136 + s0) = o;
    }
#pragma unroll
    for (int r = 0; r < 4; ++r) {
      const int l = 16 * w + l4 * 4 + r;
      float e0 = __expf(scs[l]), e1 = __expf(scs[128 + l]);
#pragma unroll
      for (int i = 0; i < 4; ++i) Y[i][r] = af[i][r] * e0 + ab[i][r] * e1;
    }
  }
  __syncthreads();
#pragma unroll
  for (int ks = 0; ks < 4; ++ks) {
    bf16x8 a = *(const bf16x8*)(Bs + (16 * w + l15) * 136 + ks * 32 + l4 * 8);
#pragma unroll
    for (int i = 0; i < 4; ++i) {
      bf16x8 b = *(const bf16x8*)(xT + (i * 16 + l15) * 136 + ks * 32 + l4 * 8);
      Y[i] = MFMA16(a, b, Y[i]);
    }
  }
  {
    const u16* C0 = (const u16*)(p.ws + OFF_C0A);
    u16* YAB = dry ? (u16*)(p.ws + OFF_DUMMY) + (size_t)(blockIdx.x & 15) * 400000 - (size_t)it.row0 * 2048 : (u16*)((unsigned char*)p.out + OUT_YB);
    const float dsk = p.in[16][h] + p.in[16][16 + h];
    float ss[4] = {0.f, 0.f, 0.f, 0.f};
#pragma unroll
    for (int i = 0; i < 4; ++i) {
      const int pp = i * 16 + l15;
#pragma unroll
      for (int r = 0; r < 4; ++r) {
        const int l = 16 * w + l4 * 4 + r;
        const size_t off = (size_t)(it.row0 + l) * LDC0 + h * 64 + pp;
        float xv = bf2f(xT[pp * 136 + l]);
        float y = Y[i][r] + xv * dsk;
        float z = bf2f(zraw[i][r]);
        float gv = y * silu(z);
        YAB[(size_t)(it.row0 + l) * 2048 + h * 64 + pp] = f2bf(gv);
        ss[r] += gv * gv;
      }
    }
    float* rss = (float*)(p.ws + OFF_ROWSS);
#pragma unroll
    for (int r = 0; r < 4; ++r) {
      float s = ss[r];
      s += __shfl_xor(s, 1); s += __shfl_xor(s, 2); s += __shfl_xor(s, 4); s += __shfl_xor(s, 8);
      if (l15 == 0) rss[(size_t)(it.row0 + 16 * w + l4 * 4 + r) * 16 + h] = s;
    }
  }
  __syncthreads();
}


typedef const __attribute__((address_space(3))) char* lds_cptr;
template <int MASK, int PART>
DI void hy_seg(int dlo, int dhi, int L, int A, const u16* hr, const u16* vx, const int (&ncol)[4], const int (&acol)[4],
               int l31, int kh, f32x16 (&acc)[4]) {
  const lds_cptr hr3 = (lds_cptr)hr;
  const lds_cptr vx3 = (lds_cptr)vx;
  lds_cptr aaddr = hr3 + 2 * (L - 1 - 32 * dlo - l31 + 8 * kh);
  lds_cptr baddr[4], bsafe[4]; int asrc[4];
#pragma unroll
  for (int j = 0; j < 4; ++j) {
    bsafe[j] = vx3 + ncol[j] * 80 + 16 * kh;
    baddr[j] = bsafe[j] - dlo * 80;
    asrc[j] = acol[j] - dlo;
  }
#pragma unroll 1
  for (int d = dlo; d <= dhi; ++d) {
    bf16x8 bfr[4][2];
#pragma unroll
    for (int j = 0; j < 4; ++j) {
      if (MASK & (1 << j)) {
        if (PART & (1 << j)) {
          const bool valid = (unsigned)asrc[j] < (unsigned)A;
          const lds_cptr ba = valid ? baddr[j] : bsafe[j];
#pragma unroll
          for (int khalf = 0; khalf < 2; ++khalf) {
            bf16x8 t = *(const __attribute__((address_space(3))) bf16x8*)(ba + 32 * khalf);
            if (!valid) t = (bf16x8){0, 0, 0, 0, 0, 0, 0, 0};
            bfr[j][khalf] = t;
          }
        } else {
#pragma unroll
          for (int khalf = 0; khalf < 2; ++khalf)
            bfr[j][khalf] = *(const __attribute__((address_space(3))) bf16x8*)(baddr[j] + 32 * khalf);
        }
      }
    }
    unsigned e0, e1, e2, e3, e4, e5, e6, e7, e8, e9, e10, e11, e12, e13, e14, e15;
    asm volatile(
        "ds_read_u16 %0, %16\n\tds_read_u16 %1, %16 offset:2\n\t"
        "ds_read_u16 %2, %16 offset:4\n\tds_read_u16 %3, %16 offset:6\n\t"
        "ds_read_u16 %4, %16 offset:8\n\tds_read_u16 %5, %16 offset:10\n\t"
        "ds_read_u16 %6, %16 offset:12\n\tds_read_u16 %7, %16 offset:14\n\t"
        "ds_read_u16 %8, %16 offset:32\n\tds_read_u16 %9, %16 offset:34\n\t"
        "ds_read_u16 %10, %16 offset:36\n\tds_read_u16 %11, %16 offset:38\n\t"
        "ds_read_u16 %12, %16 offset:40\n\tds_read_u16 %13, %16 offset:42\n\t"
        "ds_read_u16 %14, %16 offset:44\n\tds_read_u16 %15, %16 offset:46\n\t"
        "s_waitcnt lgkmcnt(0)"
        : "=&v"(e0), "=&v"(e1), "=&v"(e2), "=&v"(e3), "=&v"(e4), "=&v"(e5), "=&v"(e6), "=&v"(e7),
          "=&v"(e8), "=&v"(e9), "=&v"(e10), "=&v"(e11), "=&v"(e12), "=&v"(e13), "=&v"(e14), "=&v"(e15)
        : "v"(aaddr) : "memory");
    bf16x8 af[2];
    { u32x4 q0 = {e0 | (e1 << 16), e2 | (e3 << 16), e4 | (e5 << 16), e6 | (e7 << 16)};
      u32x4 q1 = {e8 | (e9 << 16), e10 | (e11 << 16), e12 | (e13 << 16), e14 | (e15 << 16)};
      af[0] = __builtin_bit_cast(bf16x8, q0); af[1] = __builtin_bit_cast(bf16x8, q1); }
#pragma unroll
    for (int khalf = 0; khalf < 2; ++khalf)
#pragma unroll
      for (int j = 0; j < 4; ++j)
        if (MASK & (1 << j)) acc[j] = MFMA32(af[khalf], bfr[j][khalf], acc[j]);
    aaddr -= 64;
#pragma unroll
    for (int j = 0; j < 4; ++j) { baddr[j] -= 80; asrc[j] -= 1; }
  }
}

DI void phase_hyena(const Params& p, int it, unsigned char* smem, bool dry) {
  const int cfg = it < 256 ? 1 : 0;
  const int c0 = (it & 255) * 4;
  const int L = cfg ? 4096 : 256;
  const int A = L >> 5;
  const int lgA = cfg ? 7 : 3;
  const int rowbase = cfg ? NPROMPT : 0;
  u16* vxs = (u16*)smem;
  u16* hrs = vxs + 4 * 10240;
  int tid = threadIdx.x;
  asm volatile("" : "+v"(tid));
  const int lane = tid & 63, w = tid >> 6;
  const u16* UT = (const u16*)(p.ws + OFF_UT);
  const float* cw = p.in[18]; const float* cbv = p.in[19];
  {
    const u16* HF = (const u16*)((const unsigned char*)p.out + (cfg ? OUT_HF4096 : OUT_HF256));
    const int nv = (2 * L) >> 3;
    const int lgnv = cfg ? 10 : 6;
    {
      u32x4 fv[8];
#pragma unroll
      for (int it8 = 0; it8 < 8; ++it8) {
        const int id = tid + it8 * NT;
        fv[it8] = (u32x4){0u, 0u, 0u, 0u};
        if (id < 4 * nv) { int chh = id >> lgnv, v8 = id & (nv - 1); fv[it8] = *(const u32x4*)(HF + (size_t)(c0 + chh) * 2 * L + v8 * 8); }
      }
#pragma unroll
      for (int it8 = 0; it8 < 8; ++it8) {
        const int id = tid + it8 * NT;
        if (id < 4 * nv) { int chh = id >> lgnv, v8 = id & (nv - 1); *(u32x4*)(hrs + chh * 2 * L + v8 * 8) = fv[it8]; }
      }
    }
#pragma unroll 1
    for (int hb4 = 0; hb4 < 2; ++hb4) {
    u32x4 rv[4][2]; float hm[4][2], hp[4][2];
#pragma unroll
    for (int it8 = 0; it8 < 4; ++it8) {
      const int id = tid + (hb4 * 4 + it8) * NT;
      const int chh = id >> 10, blk8 = id & 1023;
      const int pos = blk8 * 8, tl = pos & (L - 1);
#pragma unroll
      for (int which = 1; which <= 2; ++which) {
        const u16* q = UT + (size_t)(which * 1024 + c0 + chh) * UTP + rowbase + pos;
        rv[it8][which - 1] = *(const u32x4*)q;
        hm[it8][which - 1] = (tl > 0) ? bf2f(q[-1]) : 0.f;
        hp[it8][which - 1] = (tl + 8 < L) ? bf2f(q[8]) : 0.f;
      }
    }
#pragma unroll
    for (int it8 = 0; it8 < 4; ++it8) {
      const int id = tid + (hb4 * 4 + it8) * NT;
      const int chh = id >> 10, blk8 = id & 1023;
      const int pos = blk8 * 8;
      float res[8];
#pragma unroll
      for (int e = 0; e < 8; ++e) res[e] = 1.f;
#pragma unroll
      for (int which = 1; which <= 2; ++which) {
        const int uc = which * 1024 + c0 + chh;
        float xv[10];
        unpack8(rv[it8][which - 1], xv + 1);
        xv[0] = hm[it8][which - 1]; xv[9] = hp[it8][which - 1];
        const float w0 = cw[uc], w1 = cw[3072 + uc], w2 = cw[6144 + uc], bb = cbv[uc];
#pragma unroll
        for (int e = 0; e < 8; ++e) res[e] *= (bb + w0 * xv[e] + w1 * xv[e + 1] + w2 * xv[e + 2]);
      }
      const int n = pos >> 5, k = pos & 31;
      *(u32x4*)(vxs + chh * 10240 + n * 40 + k) = pack8(res);
    }
    }
  }
  __syncthreads();
  const int ch = w >> 1, wv = w & 1;
  const int l31 = lane & 31, kh = lane >> 5;
  const u16* vx = vxs + ch * 10240;
  const u16* hr = hrs + ch * 2 * L;
  f32x16 acc[4];
#pragma unroll
  for (int j = 0; j < 4; ++j)
#pragma unroll
    for (int r = 0; r < 16; ++r) acc[j][r] = 0.f;
  int ncol[4], acol[4];
#pragma unroll
  for (int j = 0; j < 4; ++j) { ncol[j] = 128 * wv + 32 * j + l31; acol[j] = ncol[j] & (A - 1); }
  if (!(dry && REP_SUB == 4)) {
  if (cfg) {
    hy_seg<1, 1>(-127, -96, L, A, hr, vx, ncol, acol, l31, kh, acc);
    hy_seg<3, 2>(-95, -64, L, A, hr, vx, ncol, acol, l31, kh, acc);
    hy_seg<7, 4>(-63, -32, L, A, hr, vx, ncol, acol, l31, kh, acc);
    hy_seg<15, 9>(-31, 31, L, A, hr, vx, ncol, acol, l31, kh, acc);
    hy_seg<14, 2>(32, 63, L, A, hr, vx, ncol, acol, l31, kh, acc);
    hy_seg<12, 4>(64, 95, L, A, hr, vx, ncol, acol, l31, kh, acc);
    hy_seg<8, 8>(96, 127, L, A, hr, vx, ncol, acol, l31, kh, acc);
  } else {
    hy_seg<15, 15>(-7, 7, L, A, hr, vx, ncol, acol, l31, kh, acc);
  }
  }
  {
    const float hb = p.in[26][c0 + ch];
#pragma unroll
    for (int j = 0; j < 4; ++j) {
      const int n = ncol[j];
#pragma unroll
      for (int q = 0; q < 4; ++q) {
        u32x2 vr = *(const u32x2*)(vx + n * 40 + 8 * q + 4 * kh);
        acc[j][4 * q + 0] += bflo(vr[0]) * hb; acc[j][4 * q + 1] += bfhi(vr[0]) * hb;
        acc[j][4 * q + 2] += bflo(vr[1]) * hb; acc[j][4 * q + 3] += bfhi(vr[1]) * hb;
      }
    }
  }
  __syncthreads();
  float* FL = (float*)smem;
  {
#pragma unroll
    for (int j = 0; j < 4; ++j) {
      const int n = ncol[j];
#pragma unroll
      for (int q = 0; q < 4; ++q) {
        const int pos = 32 * n + 8 * q + 4 * kh;
        *(float4*)(FL + ch * 9216 + pos + (pos >> 5) * 4) = make_float4(acc[j][4 * q], acc[j][4 * q + 1], acc[j][4 * q + 2], acc[j][4 * q + 3]);
      }
    }
  }
  __syncthreads();
  {
    int e_tid = threadIdx.x;
    asm volatile("" : "+v"(e_tid));
    u32x4 xr[8], gr[8]; float xm[8], xp[8];
#pragma unroll
    for (int it8 = 0; it8 < 8; ++it8) {
      const int c = c0 + (it8 >> 1);
      const int pos = ((e_tid + it8 * NT) & 1023) * 8;
      const int tl = pos & (L - 1);
      const u16* x0row = UT + (size_t)c * UTP + rowbase;
      const u16* grow = UT + (size_t)(3072 + c) * UTP + rowbase;
      xr[it8] = *(const u32x4*)(x0row + pos);
      gr[it8] = *(const u32x4*)(grow + pos);
      xm[it8] = tl > 0 ? bf2f(x0row[pos - 1]) : 0.f;
      xp[it8] = (tl + 8 < L) ? bf2f(x0row[pos + 8]) : 0.f;
    }
#pragma unroll
    for (int it8 = 0; it8 < 8; ++it8) {
      const int chh = it8 >> 1;
      const int c = c0 + chh;
      const int pos = ((e_tid + it8 * NT) & 1023) * 8;
      u16* groww = dry ? (u16*)(p.ws + OFF_DUMMY) + (size_t)blockIdx.x * 32768 + chh * 8192
                       : (u16*)(p.ws + OFF_UT) + (size_t)(3072 + c) * UTP + rowbase;
      float xv[10], gv[8];
      unpack8(xr[it8], xv + 1); unpack8(gr[it8], gv);
      xv[0] = xm[it8]; xv[9] = xp[it8];
      const float w0 = cw[c], w1 = cw[3072 + c], w2 = cw[6144 + c], bb = cbv[c];
      const float* fl = FL + chh * 9216 + pos + (pos >> 5) * 4;
      const float4 a0 = *(const float4*)fl, a1 = *(const float4*)(fl + 4);
      const float av[8] = {a0.x, a0.y, a0.z, a0.w, a1.x, a1.y, a1.z, a1.w};
      float y[8];
#pragma unroll
      for (int e = 0; e < 8; ++e) {
        float x0 = bb + w0 * xv[e] + w1 * xv[e + 1] + w2 * xv[e + 2];
        y[e] = x0 * av[e] * silu(gv[e]);
      }
      *(u32x4*)(groww + pos) = pack8(y);
      __builtin_amdgcn_sched_barrier(0);
    }
  }
  (void)lgA;
  __syncthreads();
}

#define VSP 72
typedef __attribute__((ext_vector_type(4))) short v4i16_t;
DI float dpp_rowmax(float v) {
  v = fmaxf(v, __builtin_bit_cast(float, __builtin_amdgcn_update_dpp(0, __builtin_bit_cast(int, v), 0x128, 0xf, 0xf, false)));
  v = fmaxf(v, __builtin_bit_cast(float, __builtin_amdgcn_update_dpp(0, __builtin_bit_cast(int, v), 0x124, 0xf, 0xf, false)));
  v = fmaxf(v, __builtin_bit_cast(float, __builtin_amdgcn_update_dpp(0, __builtin_bit_cast(int, v), 0x122, 0xf, 0xf, false)));
  v = fmaxf(v, __builtin_bit_cast(float, __builtin_amdgcn_update_dpp(0, __builtin_bit_cast(int, v), 0x121, 0xf, 0xf, false)));
  return v;
}
DI float dpp_rowsum(float v) {
  v += __builtin_bit_cast(float, __builtin_amdgcn_update_dpp(0, __builtin_bit_cast(int, v), 0x128, 0xf, 0xf, false));
  v += __builtin_bit_cast(float, __builtin_amdgcn_update_dpp(0, __builtin_bit_cast(int, v), 0x124, 0xf, 0xf, false));
  v += __builtin_bit_cast(float, __builtin_amdgcn_update_dpp(0, __builtin_bit_cast(int, v), 0x122, 0xf, 0xf, false));
  v += __builtin_bit_cast(float, __builtin_amdgcn_update_dpp(0, __builtin_bit_cast(int, v), 0x121, 0xf, 0xf, false));
  return v;
}
#define OUT_CKV 0ul
DI void phase_attn(const Params& p, int item, unsigned char* smem, bool dry) {
  u16* VS = (u16*)smem;
  u16* Pb = VS + 832 * VSP;
  float* rp = (float*)(Pb + 8 * 16 * 72);
  int tid = threadIdx.x;
  asm volatile("" : "+v"(tid));
  const int lane = tid & 63, w = tid >> 6;
  const int l15 = lane & 15, l4 = lane >> 4;
  const u16* C1 = (const u16*)(p.ws + OFF_C1);
  const u16* CK = (const u16*)((const unsigned char*)p.out + OUT_CKV);
  const u16* CV = CK + 524288;
  const bool lat = item < 1024;
  int b, h, myr = 0, rows0w = 0, vrow0 = 0, nvrows = 0, qbase, jq = w & 3;
  if (lat) {
    b = item >> 9; h = (item >> 5) & 15; const int r0 = (item & 31) * 2;
    myr = r0 + (w >> 2);
    rows0w = min(max(myr - 4, 0), 56);
    vrow0 = min(max(r0 - 4, 0), 56);
    nvrows = min(9, 64 - vrow0);
    qbase = NPROMPT + b * 4096 + myr * 64 + jq * 16;
  } else {
    const int q = item - 1024; b = q >> 5; h = (q >> 1) & 15;
    qbase = b * 256 + (q & 1) * 128 + w * 16;
  }
  const int cstart = min(max(16 * jq - 8, 0), 32);
  const int ntile = lat ? 8 : 4;
  bf16x8 qa[2];
#pragma unroll
  for (int ks = 0; ks < 2; ++ks) qa[ks] = *(const bf16x8*)(C1 + (size_t)(qbase + l15) * LDC1 + h * 64 + ks * 32 + l4 * 8);
  auto loadk = [&](int tt, bf16x8 (&kb)[4][2]) {
#pragma unroll
    for (int jt = 0; jt < 4; ++jt) {
      const u16* src;
      if (lat) {
        if (tt < 4) src = C1 + (size_t)(NPROMPT + b * 4096 + (rows0w + tt * 2 + (jt >> 1)) * 64 + cstart + (jt & 1) * 16 + l15) * LDC1 + 1024 + h * 64;
        else src = CK + ((size_t)(b * 16 + h) * 256 + (tt - 4) * 64 + jt * 16 + l15) * 64;
      } else {
        src = C1 + (size_t)(b * 256 + tt * 64 + jt * 16 + l15) * LDC1 + 1024 + h * 64;
      }
#pragma unroll
      for (int ks = 0; ks < 2; ++ks) kb[jt][ks] = *(const bf16x8*)(src + ks * 32 + l4 * 8);
    }
  };
  bf16x8 kn[4][2], kn2[4][2];
  loadk(0, kn);
  loadk(1, kn2);
  u16 graw[4][4];
#pragma unroll
  for (int r = 0; r < 4; ++r)
#pragma unroll
    for (int i = 0; i < 4; ++i)
      graw[r][i] = C1[(size_t)(qbase + l4 * 4 + r) * LDC1 + 3072 + h * 64 + i * 16 + l15];
  {
    const int nloc = lat ? nvrows * 64 : 256;
    const int keyrow0 = lat ? NPROMPT + b * 4096 + vrow0 * 64 : b * 256;
    u32x4 vv[9], cvv[4];
#pragma unroll
    for (int i = 0; i < 9; ++i) {
      const int id = tid + i * NT;
      vv[i] = (u32x4){0u, 0u, 0u, 0u};
      if (id < nloc * 8) { int key = id >> 3, d0 = (id & 7) * 8; vv[i] = *(const u32x4*)(C1 + (size_t)(keyrow0 + key) * LDC1 + 2048 + h * 64 + d0); }
    }
    if (lat) {
#pragma unroll
      for (int i = 0; i < 4; ++i) {
        const int id = tid + i * NT; int key = id >> 3, d0 = (id & 7) * 8;
        cvv[i] = *(const u32x4*)(CV + ((size_t)(b * 16 + h) * 256 + key) * 64 + d0);
      }
    }
#pragma unroll
    for (int i = 0; i < 9; ++i) {
      const int id = tid + i * NT;
      if (id < nloc * 8) { int key = id >> 3, d0 = (id & 7) * 8; *(u32x4*)(VS + key * VSP + d0) = vv[i]; }
    }
    if (lat) {
#pragma unroll
      for (int i = 0; i < 4; ++i) {
        const int id = tid + i * NT; int key = id >> 3, d0 = (id & 7) * 8;
        *(u32x4*)(VS + (576 + key) * VSP + d0) = cvv[i];
      }
      for (int id = tid; id < 465; id += NT) rp[id] = p.in[29][h * 465 + id] * 1.4426950408889634f;
    }
  }
  __syncthreads();
  float mrow[4], lrow[4];
  f32x4 O[4];
#pragma unroll
  for (int r = 0; r < 4; ++r) { mrow[r] = -1e30f; lrow[r] = 0.f; }
#pragma unroll
  for (int i = 0; i < 4; ++i) O[i] = (f32x4){0.f, 0.f, 0.f, 0.f};
  u16* Pw = Pb + w * 16 * 72;
  const __attribute__((address_space(3))) char* vs3 = (const __attribute__((address_space(3))) char*)VS;
  int dcv[2][4]; bool okv[2][4];
#pragma unroll
  for (int hf = 0; hf < 2; ++hf)
#pragma unroll
    for (int r = 0; r < 4; ++r) {
      const int kcn = cstart + hf * 16 + l15;
      const int qc = jq * 16 + l4 * 4 + r;
      const int col0 = min(max(qc - 8, 0), 48);
      dcv[hf][r] = min(max(kcn - qc + 15, 0), 30);
      okv[hf][r] = (kcn >= col0) && (kcn < col0 + 16);
    }
#pragma unroll 1
  for (int tt = 0; tt < ntile; ++tt) {
    bf16x8 kc[4][2];
#pragma unroll
    for (int jt = 0; jt < 4; ++jt)
#pragma unroll
      for (int ks = 0; ks < 2; ++ks) { kc[jt][ks] = kn[jt][ks]; kn[jt][ks] = kn2[jt][ks]; }
    if (tt + 2 < ntile) loadk(tt + 2, kn2);
    const bool local = lat && tt < 4;
    f32x4 S[4];
#pragma unroll
    for (int jt = 0; jt < 4; ++jt) {
      S[jt] = (f32x4){0.f, 0.f, 0.f, 0.f};
      S[jt] = MFMA16(qa[0], kc[jt][0], S[jt]);
      S[jt] = MFMA16(qa[1], kc[jt][1], S[jt]);
    }
    float sv[4][4];
#pragma unroll
    for (int jt = 0; jt < 4; ++jt)
#pragma unroll
      for (int r = 0; r < 4; ++r) {
        float s = S[jt][r] * 0.18033688011112042f;
        if (local) {
          const int dr = rows0w + tt * 2 + (jt >> 1) - myr + 7;
          s += rp[dr * 31 + dcv[jt & 1][r]];
          if (!okv[jt & 1][r]) s = -INFINITY;
        }
        sv[jt][r] = s;
      }
    float alpha[4];
#pragma unroll
    for (int r = 0; r < 4; ++r) {
      float mx = fmaxf(fmaxf(sv[0][r], sv[1][r]), fmaxf(sv[2][r], sv[3][r]));
      mx = dpp_rowmax(mx);
      float mn = fmaxf(mrow[r], mx);
      alpha[r] = __builtin_amdgcn_exp2f(mrow[r] - mn);
      mrow[r] = mn;
      float ps = 0.f;
#pragma unroll
      for (int jt = 0; jt < 4; ++jt) {
        float pv = __builtin_amdgcn_exp2f(sv[jt][r] - mn);
        ps += pv;
        Pw[(l4 * 4 + r) * 72 + jt * 16 + l15] = f2bf(pv);
      }
      lrow[r] = lrow[r] * alpha[r] + ps;
    }
#pragma unroll
    for (int i = 0; i < 4; ++i)
#pragma unroll
      for (int r = 0; r < 4; ++r) O[i][r] *= alpha[r];
    asm volatile("s_waitcnt lgkmcnt(0)" ::: "memory");
#pragma unroll
    for (int ks2 = 0; ks2 < 2; ++ks2) {
      bf16x8 pa = *(const bf16x8*)(Pw + l15 * 72 + ks2 * 32 + l4 * 8);
      int keyoff;
      if (lat) keyoff = tt < 4 ? (rows0w - vrow0 + tt * 2 + ks2) * 64 + cstart : 576 + (tt - 4) * 64 + ks2 * 32;
      else keyoff = tt * 64 + ks2 * 32;
#pragma unroll
      for (int i = 0; i < 4; ++i) {
        const int rowa = keyoff + 8 * l4 + (l15 >> 2);
        const int cola = i * 16 + 4 * (l15 & 3);
        v4i16_t lo = __builtin_amdgcn_ds_read_tr16_b64_v4i16((__attribute__((address_space(3))) v4i16_t*)(vs3 + (rowa * VSP + cola) * 2));
        v4i16_t hi = __builtin_amdgcn_ds_read_tr16_b64_v4i16((__attribute__((address_space(3))) v4i16_t*)(vs3 + ((rowa + 4) * VSP + cola) * 2));
        bf16x8 vb = __builtin_shufflevector(lo, hi, 0, 1, 2, 3, 4, 5, 6, 7);
        O[i] = MFMA16(pa, vb, O[i]);
      }
    }
    asm volatile("s_waitcnt lgkmcnt(0)" ::: "memory");
  }
  {
    u16* C1w = dry ? (u16*)(p.ws + OFF_DUMMY) + (size_t)(blockIdx.x & 15) * 300000 + (size_t)w * 16 * LDC1 - (size_t)qbase * LDC1 : (u16*)(p.ws + OFF_C1);
#pragma unroll
    for (int r = 0; r < 4; ++r) {
      const float inv = 1.f / dpp_rowsum(lrow[r]);
      const int row = qbase + l4 * 4 + r;
#pragma unroll
      for (int i = 0; i < 4; ++i) {
        const int dcol = h * 64 + i * 16 + l15;
        C1w[(size_t)row * LDC1 + dcol] = f2bf(O[i][r] * inv * silu(bf2f(graw[r][i])));
      }
    }
  }
  __syncthreads();
}

DI void phase_ckv(const Params& p, int t) {
  const int id = t * NT + threadIdx.x;
  const int arr = id >> 16, v = id & 65535;
  const float* src = p.in[3 + arr] + (size_t)v * 8;
  float4 a = *(const float4*)src, c = *(const float4*)(src + 4);
  float f[8] = {a.x, a.y, a.z, a.w, c.x, c.y, c.z, c.w};
  u16* dst = (u16*)((unsigned char*)p.out + OUT_CKV) + (size_t)arr * 524288 + (size_t)v * 8;
  *(u32x4*)dst = pack8(f);
}


DI void phase_ssd_out_grp(const Params& p, int item, unsigned char* smem, bool dry) {
  u16* Cs = (u16*)smem;
  u16* Bs = Cs + 128 * 136;
  u16* xT = Bs + 128 * 136;
  u16* St = xT + 64 * 136;
  float* sdt = (float*)(St + 2 * 64 * 136);
  float* scs = sdt + 2048;
  int tid = threadIdx.x;
  asm volatile("" : "+v"(tid));
  const int lane = tid & 63, w = tid >> 6;
  const int l15 = lane & 15, l4 = lane >> 4;
  const int cgi = item >> 1, grp = item & 1;
  int row0, has_prev, has_next;
  if (cgi < 64) { int seq = cgi >> 1, c = cgi & 1; row0 = seq * 256 + c * 128; has_prev = c > 0; has_next = c < 1; }
  else { int q = cgi - 64; int seq = q >> 5, c = q & 31; row0 = NPROMPT + seq * 4096 + c * 128; has_prev = c > 0; has_next = c < 31; }
  const u16* C0 = (const u16*)(p.ws + OFF_C0A);
  const int xchunk = tid & 7, xrg = tid >> 3;
  const int bchunk = tid & 15, brg = tid >> 4;
  u32x4 rawb[6], rawc[6];
  conv_load<4>(p, row0, brg * 4, 1024 + grp * 128 + bchunk * 8, has_prev, has_next, rawb);
  conv_load<4>(p, row0, brg * 4, 1280 + grp * 128 + bchunk * 8, has_prev, has_next, rawc);
  float rdt[4];
#pragma unroll
  for (int i = 0; i < 4; ++i) {
    const int id = tid + i * NT; const int h8 = id >> 8, d = (id >> 7) & 1, l = id & 127;
    rdt[i] = bf2f(C0[(size_t)(row0 + l) * LDC0 + 2560 + d * 16 + grp * 8 + h8]);
  }
#pragma unroll
  for (int i = 0; i < 4; ++i) {
    const int id = tid + i * NT; const int h8 = id >> 8, d = (id >> 7) & 1;
    const int hh = grp * 8 + h8;
    float x = rdt[i] + p.in[14][d * 16 + hh];
    float dt = x > 20.f ? x : log1pf(expf(x));
    float a = -expf(p.in[15][d * 16 + hh]);
    sdt[id] = dt; scs[id] = a * dt;
  }
  __syncthreads();
#pragma unroll
  for (int k = 0; k < 2; ++k) {
    const int sq = 2 * w + k; const int d = sq & 1;
    float* base = scs + sq * 128;
    int p0 = d == 0 ? 2 * lane : 127 - 2 * lane;
    int p1 = d == 0 ? 2 * lane + 1 : 126 - 2 * lane;
    float v0 = base[p0], v1 = base[p1];
    float sacc = v0 + v1;
#pragma unroll
    for (int off = 1; off < 64; off <<= 1) {
      float tv = __shfl_up(sacc, off);
      if (lane >= off) sacc += tv;
    }
    float excl = sacc - (v0 + v1);
    base[p0] = excl + v0;
    base[p1] = excl + v0 + v1;
  }
  {
    float o[4][8];
    conv_compute<4>(p, 1024 + grp * 128 + bchunk * 8, rawb, o);
#pragma unroll
    for (int i = 0; i < 4; ++i) *(u32x4*)(Bs + (brg * 4 + i) * 136 + bchunk * 8) = pack8(o[i]);
    conv_compute<4>(p, 1280 + grp * 128 + bchunk * 8, rawc, o);
#pragma unroll
    for (int i = 0; i < 4; ++i) *(u32x4*)(Cs + (brg * 4 + i) * 136 + bchunk * 8) = pack8(o[i]);
  }
  __syncthreads();
  f32x4 cb[8];
#pragma unroll
  for (int j = 0; j < 8; ++j) cb[j] = (f32x4){0.f, 0.f, 0.f, 0.f};
#pragma unroll
  for (int ks = 0; ks < 4; ++ks) {
    bf16x8 a = *(const bf16x8*)(Cs + (16 * w + l15) * 136 + ks * 32 + l4 * 8);
#pragma unroll
    for (int j = 0; j < 8; ++j) {
      bf16x8 b = *(const bf16x8*)(Bs + (j * 16 + l15) * 136 + ks * 32 + l4 * 8);
      cb[j] = MFMA16(b, a, cb[j]);
    }
  }
  __syncthreads();
  const int lrow = 16 * w + l15;
#pragma unroll 1
  for (int h8 = 0; h8 < 8; ++h8) {
    const int h = grp * 8 + h8;
    const float* sdh = sdt + h8 * 256;
    const float* sch = scs + h8 * 256;
    u32x4 rawx[4], rawst[4];
    u16 zraw[4][4];
    conv_load<2>(p, row0, xrg * 2, h * 64 + xchunk * 8, has_prev, has_next, rawx);
    {
      const u16* S = (const u16*)((const unsigned char*)p.out + OUT_SBUF) + (size_t)(cgi * 16 + h) * 2 * 8192;
#pragma unroll
      for (int v = 0; v < 4; ++v) {
        int id = tid + 512 * v;
        int dd = id >> 10, pp = (id >> 4) & 63, nv = (id & 15) * 8;
        rawst[v] = *(const u32x4*)(S + dd * 8192 + pp * 128 + nv);
      }
#pragma unroll
      for (int i = 0; i < 4; ++i)
#pragma unroll
        for (int r = 0; r < 4; ++r)
          zraw[i][r] = C0[(size_t)(row0 + 16 * w + l4 * 4 + r) * LDC0 + h * 64 + i * 16 + l15];
    }
    {
      const float cs0l = sch[lrow], cs1l = sch[128 + lrow];
#pragma unroll
      for (int j = 0; j < 8; ++j) {
        const int s0 = j * 16 + l4 * 4;
        float f[4];
        if (j < w) {
          const float4 c4 = *(const float4*)(sch + s0), d4 = *(const float4*)(sdh + s0);
          f[0] = __expf(cs0l - c4.x) * d4.x; f[1] = __expf(cs0l - c4.y) * d4.y; f[2] = __expf(cs0l - c4.z) * d4.z; f[3] = __expf(cs0l - c4.w) * d4.w;
        } else if (j > w) {
          const float4 c4 = *(const float4*)(sch + 128 + s0), d4 = *(const float4*)(sdh + 128 + s0);
          f[0] = __expf(cs1l - c4.x) * d4.x; f[1] = __expf(cs1l - c4.y) * d4.y; f[2] = __expf(cs1l - c4.z) * d4.z; f[3] = __expf(cs1l - c4.w) * d4.w;
        } else {
          const float4 c4 = *(const float4*)(sch + s0), d4 = *(const float4*)(sdh + s0);
          const float4 e4 = *(const float4*)(sch + 128 + s0), g4 = *(const float4*)(sdh + 128 + s0);
          const float c0[4] = {c4.x, c4.y, c4.z, c4.w}, d0[4] = {d4.x, d4.y, d4.z, d4.w};
          const float c1[4] = {e4.x, e4.y, e4.z, e4.w}, d1[4] = {g4.x, g4.y, g4.z, g4.w};
#pragma unroll
          for (int jj = 0; jj < 4; ++jj) {
            const int sidx = s0 + jj;
            float v;
            if (lrow > sidx) v = __expf(cs0l - c0[jj]) * d0[jj];
            else if (lrow < sidx) v = __expf(cs1l - c1[jj]) * d1[jj];
            else v = d0[jj] + d1[jj];
            f[jj] = v;
          }
        }
        u32x2 o; o[0] = pk2(cb[j][0] * f[0], cb[j][1] * f[1]); o[1] = pk2(cb[j][2] * f[2], cb[j][3] * f[3]);
        *(u32x2*)(Bs + lrow * 136 + s0) = o;
      }
    }
    {
      float o[2][8];
      conv_compute<2>(p, h * 64 + xchunk * 8, rawx, o);
#pragma unroll
      for (int e = 0; e < 8; ++e) *(unsigned*)(xT + (xchunk * 8 + e) * 136 + xrg * 2) = pk2(o[0][e], o[1][e]);
#pragma unroll
      for (int v = 0; v < 4; ++v) {
        int id = tid + 512 * v;
        int dd = id >> 10, pp = (id >> 4) & 63, nv = (id & 15) * 8;
        *(u32x4*)(St + dd * 64 * 136 + pp * 136 + nv) = rawst[v];
      }
    }
    __syncthreads();
    f32x4 af[4], ab[4], Y[4];
#pragma unroll
    for (int i = 0; i < 4; ++i) { af[i] = (f32x4){0.f, 0.f, 0.f, 0.f}; ab[i] = (f32x4){0.f, 0.f, 0.f, 0.f}; }
#pragma unroll
    for (int ks = 0; ks < 4; ++ks) {
      bf16x8 a = *(const bf16x8*)(Cs + (16 * w + l15) * 136 + ks * 32 + l4 * 8);
#pragma unroll
      for (int i = 0; i < 4; ++i) {
        bf16x8 b0 = *(const bf16x8*)(St + (i * 16 + l15) * 136 + ks * 32 + l4 * 8);
        bf16x8 b1 = *(const bf16x8*)(St + 64 * 136 + (i * 16 + l15) * 136 + ks * 32 + l4 * 8);
        af[i] = MFMA16(a, b0, af[i]);
        ab[i] = MFMA16(a, b1, ab[i]);
      }
    }
#pragma unroll
    for (int r = 0; r < 4; ++r) {
      const int l = 16 * w + l4 * 4 + r;
      float e0 = __expf(sch[l]), e1 = __expf(sch[128 + l]);
#pragma unroll
      for (int i = 0; i < 4; ++i) Y[i][r] = af[i][r] * e0 + ab[i][r] * e1;
    }
#pragma unroll
    for (int ks = 0; ks < 4; ++ks) {
      bf16x8 a = *(const bf16x8*)(Bs + (16 * w + l15) * 136 + ks * 32 + l4 * 8);
#pragma unroll
      for (int i = 0; i < 4; ++i) {
        bf16x8 b = *(const bf16x8*)(xT + (i * 16 + l15) * 136 + ks * 32 + l4 * 8);
        Y[i] = MFMA16(a, b, Y[i]);
      }
    }
    {
      u16* YAB = dry ? (u16*)(p.ws + OFF_DUMMY) + (size_t)(blockIdx.x & 15) * 400000 - (size_t)row0 * 2048 : (u16*)((unsigned char*)p.out + OUT_YB);
      const float dsk = p.in[16][h] + p.in[16][16 + h];
      float ss[4] = {0.f, 0.f, 0.f, 0.f};
#pragma unroll
      for (int i = 0; i < 4; ++i) {
        const int pp = i * 16 + l15;
#pragma unroll
        for (int r = 0; r < 4; ++r) {
          const int l = 16 * w + l4 * 4 + r;
          float xv = bf2f(xT[pp * 136 + l]);
          float y = Y[i][r] + xv * dsk;
          float gv = y * silu(bf2f(zraw[i][r]));
          YAB[(size_t)(row0 + l) * 2048 + h * 64 + pp] = f2bf(gv);
          ss[r] += gv * gv;
        }
      }
      float* rss = (float*)(p.ws + OFF_ROWSS);
#pragma unroll
      for (int r = 0; r < 4; ++r) {
        float sv = dpp_rowsum(ss[r]);
        if (l15 == 0) rss[(size_t)(row0 + 16 * w + l4 * 4 + r) * 16 + h] = sv;
      }
    }
    __syncthreads();
  }
}

DI void phase_ssd_states_grp(const Params& p, int item, unsigned char* smem) {
  u16* BT = (u16*)smem;
  u16* xTs = BT + 128 * 136;
  float* sdt = (float*)(xTs + 2 * 64 * 136);
  float* scs = sdt + 2048;
  float* sw = scs + 2048;
  float* stot = sw + 2048;
  int tid = threadIdx.x;
  asm volatile("" : "+v"(tid));
  const int lane = tid & 63, w = tid >> 6;
  const int l15 = lane & 15, l4 = lane >> 4;
  const int cgi = item >> 1, grp = item & 1;
  int row0, has_prev, has_next;
  if (cgi < 64) { int seq = cgi >> 1, c = cgi & 1; row0 = seq * 256 + c * 128; has_prev = c > 0; has_next = c < 1; }
  else { int q = cgi - 64; int seq = q >> 5, c = q & 31; row0 = NPROMPT + seq * 4096 + c * 128; has_prev = c > 0; has_next = c < 31; }
  const u16* C0 = (const u16*)(p.ws + OFF_C0A);
  const int xchunk = tid & 7, xrg = tid >> 3;
  const int bchunk = tid & 15, brg = tid >> 4;
  u32x4 rawb[6];
  conv_load<4>(p, row0, brg * 4, 1024 + grp * 128 + bchunk * 8, has_prev, has_next, rawb);
  float rdt[4];
#pragma unroll
  for (int i = 0; i < 4; ++i) {
    const int id = tid + i * NT; const int h8 = id >> 8, d = (id >> 7) & 1, l = id & 127;
    rdt[i] = bf2f(C0[(size_t)(row0 + l) * LDC0 + 2560 + d * 16 + grp * 8 + h8]);
  }
#pragma unroll
  for (int i = 0; i < 4; ++i) {
    const int id = tid + i * NT; const int h8 = id >> 8, d = (id >> 7) & 1;
    const int hh = grp * 8 + h8;
    float x = rdt[i] + p.in[14][d * 16 + hh];
    float dt = x > 20.f ? x : log1pf(expf(x));
    float a = -expf(p.in[15][d * 16 + hh]);
    sdt[id] = dt; scs[id] = a * dt;
  }
  __syncthreads();
#pragma unroll
  for (int k = 0; k < 2; ++k) {
    const int sq = 2 * w + k; const int d = sq & 1;
    float* base = scs + sq * 128;
    int p0 = d == 0 ? 2 * lane : 127 - 2 * lane;
    int p1 = d == 0 ? 2 * lane + 1 : 126 - 2 * lane;
    float v0 = base[p0], v1 = base[p1];
    float sacc = v0 + v1;
#pragma unroll
    for (int off = 1; off < 64; off <<= 1) {
      float tv = __shfl_up(sacc, off);
      if (lane >= off) sacc += tv;
    }
    float excl = sacc - (v0 + v1);
    base[p0] = excl + v0;
    base[p1] = excl + v0 + v1;
    if (lane == 63) stot[sq] = sacc;
  }
  {
    float o[4][8];
    conv_compute<4>(p, 1024 + grp * 128 + bchunk * 8, rawb, o);
#pragma unroll
    for (int e = 0; e < 8; ++e) {
      u32x2 v; v[0] = pk2(o[0][e], o[1][e]); v[1] = pk2(o[2][e], o[3][e]);
      *(u32x2*)(BT + (bchunk * 8 + e) * 136 + brg * 4) = v;
    }
  }
  __syncthreads();
#pragma unroll
  for (int i = 0; i < 4; ++i) {
    const int id = tid + i * NT; const int sq = id >> 7;
    sw[id] = sdt[id] * __expf(stot[sq] - scs[id]);
  }
  if (tid < 16) {
    float* cdec = (float*)(p.ws + OFF_CDEC);
    const int h8 = tid >> 1, d = tid & 1;
    cdec[(cgi * 16 + grp * 8 + h8) * 2 + d] = __expf(stot[tid]);
  }
  __syncthreads();
  const int d = w >> 2, nq = w & 3;
#pragma unroll 1
  for (int h8 = 0; h8 < 8; ++h8) {
    const int h = grp * 8 + h8;
    u32x4 rawx[4];
    conv_load<2>(p, row0, xrg * 2, h * 64 + xchunk * 8, has_prev, has_next, rawx);
    {
      float o[2][8];
      conv_compute<2>(p, h * 64 + xchunk * 8, rawx, o);
#pragma unroll
      for (int dd = 0; dd < 2; ++dd) {
        const float s0 = sw[h8 * 256 + dd * 128 + xrg * 2], s1 = sw[h8 * 256 + dd * 128 + xrg * 2 + 1];
#pragma unroll
        for (int e = 0; e < 8; ++e) *(unsigned*)(xTs + dd * 64 * 136 + (xchunk * 8 + e) * 136 + xrg * 2) = pk2(o[0][e] * s0, o[1][e] * s1);
      }
    }
    __syncthreads();
    f32x4 acc[4][2];
#pragma unroll
    for (int i = 0; i < 4; ++i) { acc[i][0] = (f32x4){0.f, 0.f, 0.f, 0.f}; acc[i][1] = (f32x4){0.f, 0.f, 0.f, 0.f}; }
#pragma unroll
    for (int ks = 0; ks < 4; ++ks) {
      bf16x8 a[4], b[2];
#pragma unroll
      for (int i = 0; i < 4; ++i) a[i] = *(const bf16x8*)(xTs + d * 64 * 136 + (i * 16 + l15) * 136 + ks * 32 + l4 * 8);
#pragma unroll
      for (int j = 0; j < 2; ++j) b[j] = *(const bf16x8*)(BT + (nq * 32 + j * 16 + l15) * 136 + ks * 32 + l4 * 8);
#pragma unroll
      for (int i = 0; i < 4; ++i)
#pragma unroll
        for (int j = 0; j < 2; ++j) acc[i][j] = MFMA16(b[j], a[i], acc[i][j]);
    }
    u16* S = (u16*)((unsigned char*)p.out + OUT_SBUF) + ((size_t)(cgi * 16 + h) * 2 + d) * 8192;
#pragma unroll
    for (int i = 0; i < 4; ++i)
#pragma unroll
      for (int j = 0; j < 2; ++j) {
        const int pp = i * 16 + l15, n = nq * 32 + j * 16 + l4 * 4;
        u32x2 o; o[0] = pk2(acc[i][j][0], acc[i][j][1]); o[1] = pk2(acc[i][j][2], acc[i][j][3]);
        *(u32x2*)(S + pp * 128 + n) = o;
      }
    __syncthreads();
  }
}
#define OFF_BAR 268419072ul
#define XB_TMO      128
#define XB_XCNT(j)  (256  + 64 * (j))
#define XB_XSUB(j)  (1280 + 64 * (j))
#define XB_XGEN(j)  (2304 + 64 * (j))
#define XB_TOP      3328
#define XB_TOPGEN   3392
#define XCD_BAR_WORDS 3456
#define XB_SPIN_CAP (1u << 18)
#define LAS __attribute__((address_space(3)))
DI unsigned xb_ld(unsigned* p) { return __hip_atomic_load(p, __ATOMIC_RELAXED, __HIP_MEMORY_SCOPE_AGENT); }
DI unsigned xb_add(unsigned* p, unsigned v) { return __hip_atomic_fetch_add(p, v, __ATOMIC_RELAXED, __HIP_MEMORY_SCOPE_AGENT); }
DI unsigned xb_xcc_id() { return (unsigned)__builtin_amdgcn_s_getreg((3 << 11) | 20) & 0xFu; }
#define XB_SPIN(cond, bar) do { unsigned _sp = 0; while (cond) { __builtin_amdgcn_s_sleep(1); \
    if ((++_sp & 255u) == 0u) { if (xb_ld(&(bar)[XB_TMO])) break; if (_sp > XB_SPIN_CAP) { atomicAdd(&(bar)[XB_TMO], 1u); break; } } } } while (0)
struct XcdBarrier { unsigned* bar; unsigned x; volatile LAS unsigned* st; };
DI XcdBarrier xcd_barrier_post(unsigned* bar, volatile LAS unsigned* st) {
  XcdBarrier b; b.bar = bar; b.x = xb_xcc_id(); b.st = st;
  if (threadIdx.x == 0) (void)xb_add(&bar[XB_XCNT(b.x)], 1u);
  return b;
}
DI void xcd_barrier_complete(unsigned* bar, unsigned x, unsigned& nloc, unsigned& nx) {
  const unsigned G = gridDim.x * gridDim.y * gridDim.z;
  unsigned sum, cnt, mine, sp = 0u;
  for (;;) {
    sum = 0u; cnt = 0u; mine = 0u;
#pragma unroll
    for (unsigned j = 0; j < 16; ++j) { const unsigned c = xb_ld(&bar[XB_XCNT(j)]); sum += c; cnt += (c > 0u) ? 1u : 0u; mine = (j == x) ? c : mine; }
    if (sum == G) break;
    __builtin_amdgcn_s_sleep(1);
    if ((++sp & 255u) == 0u) { if (xb_ld(&bar[XB_TMO])) break; if (sp > XB_SPIN_CAP) { atomicAdd(&bar[XB_TMO], 1u); break; } }
  }
  nloc = mine > 0u ? mine : 1u; nx = cnt > 0u ? cnt : 1u;
}
DI void xcd_barrier(const XcdBarrier& b) {
  asm volatile("s_waitcnt vmcnt(0)" ::: "memory");
  __syncthreads();
  if (threadIdx.x == 0) {
    unsigned* bar = b.bar;
    __builtin_amdgcn_s_waitcnt(0);
    unsigned nloc = b.st[0], nx = b.st[1];
    if (nloc == 0u) { xcd_barrier_complete(bar, b.x, nloc, nx); b.st[0] = nloc; b.st[1] = nx; }
    const unsigned old = xb_add(&bar[XB_XSUB(b.x)], 1u);
    const unsigned gen = old / nloc;
    if (old + 1u == (gen + 1u) * nloc) {
      __builtin_amdgcn_fence(__ATOMIC_RELEASE, "agent");
      asm volatile("s_waitcnt vmcnt(0)" ::: "memory");
      const unsigned og = xb_add(&bar[XB_TOP], 1u);
      const unsigned tg = og / nx;
      if (og + 1u == (tg + 1u) * nx) xb_add(&bar[XB_TOPGEN], 1u);
      else XB_SPIN(xb_ld(&bar[XB_TOPGEN]) == tg, bar);
      __builtin_amdgcn_fence(__ATOMIC_ACQUIRE, "agent");
      xb_add(&bar[XB_XGEN(b.x)], 1u);
      asm volatile("s_waitcnt vmcnt(0)" ::: "memory");
    } else {
      XB_SPIN(xb_ld(&bar[XB_XGEN(b.x)]) == gen, bar);
      __builtin_amdgcn_fence(__ATOMIC_ACQUIRE, "agent");
      asm volatile("s_waitcnt vmcnt(0)" ::: "memory");
    }
  }
  __syncthreads();
}

DI int xcd_item(int t) {
  return (gridDim.x == 256) ? ((t & ~255) | ((t & 7) << 5) | ((t & 255) >> 3)) : t;
}
#define NPHASE 12
__global__ void __launch_bounds__(NT) mega(Params p, int ph0, int ph1) {
  __shared__ __attribute__((aligned(16))) unsigned char smem[SMEM_BYTES];
  __shared__ __attribute__((aligned(16))) unsigned xb_st[4];
  const int nb = gridDim.x, bid = blockIdx.x;
  if (threadIdx.x < 4) xb_st[threadIdx.x] = 0u;
  __syncthreads();
  const XcdBarrier xb = xcd_barrier_post((unsigned*)(p.ws + OFF_BAR), (volatile LAS unsigned*)xb_st);
  if (ph1 > 4096) cg::this_grid().sync();
#define PH_BEGIN(k) if (ph0 <= (k) && (k) < ph1) { if ((k) > ph0) xcd_barrier(xb); \
  for (int rep = (REP_MASK >> (k)) & 1; rep >= 0; --rep) { const bool dry = rep > 0; (void)dry;
#define PH_END if (rep > 0) xcd_barrier(xb); } }
  {
    {
      PH_BEGIN(0) {
        for (int ft = bid; ft < 256; ft += nb) phase_filter(p, ft, smem);
        {
          int lim0 = 192 + 432;
          asm volatile("" : "+s"(lim0));
          for (int q0 = bid; q0 < lim0; q0 += nb) {
            if (q0 < 192) phase_ada(p, q0, smem);
            else {
              int q = q0 - 192;
              if (q < 432) transpose_tile<float>(p.in[10], 6688, 6688, (u16*)(p.ws + OFF_WINE), 1024, q & 15, q >> 4, nullptr, 0, smem);
              else if (q < 560) { q -= 432; transpose_tile<float>(p.in[11], 1024, 1024, (u16*)(p.ws + OFF_WOUTE), 2048, q & 31, q >> 5, p.in[17], 1024, smem); }
              else if (q < 816) { q -= 560; transpose_tile<float>(p.in[27], 4096, 4096, (u16*)(p.ws + OFF_WINO), 1024, q & 15, q >> 4, nullptr, 0, smem); }
              else { q -= 816; transpose_tile<float>(p.in[28], 1024, 1024, (u16*)(p.ws + OFF_WOUTO), 1024, q & 15, q >> 4, nullptr, 0, smem); }
            }
          }
        }
      } PH_END
      PH_BEGIN(1) {
        for (int t = bid; t < 512; t += nb) phase_norm(p, t, 0, p.in[0], p.in[1], (u16*)((unsigned char*)p.out + OUT_H0));
      } PH_END
      PH_BEGIN(2) {
        GemmArgs g; g.A1 = (const u16*)((const unsigned char*)p.out + OUT_H0); g.lda1 = 1024; g.A2 = g.A1; g.lda2 = 1024; g.ksplit = 1 << 30;
        g.Bt = (const u16*)(p.ws + OFF_WINE); g.K = 1024;
        for (int rd = 0; rd * 256 < 64 * 27; ++rd) { int pm, pn; if (gemm_tile_coord(rd, 27, 64 * 27, pm, pn)) { if (pn <= 9) gemm256<0, true>(p, g, pm * 256, pn * 256, smem); else gemm256<0, false>(p, g, pm * 256, pn * 256, smem); } }
        {
          int q0, qstep;
          if (nb == 256) { q0 = ((bid & 7) >= 6) ? ((bid & 7) - 6) * 32 + (bid >> 3) : 448; qstep = 64; }
          else { q0 = bid; qstep = nb; }
#pragma unroll 1
          for (int q = q0; q < 448; q += qstep) {
            const float* src; u16* dst; int N, ldd, kt, nt4, ksn; const float* ksc = nullptr;
            if (q < 128) { src = p.in[11]; dst = (u16*)(p.ws + OFF_WOUTE); N = 1024; ldd = 2048; kt = q & 31; nt4 = q >> 5; ksc = p.in[17]; ksn = 1024; }
            else if (q < 384) { const int r = q - 128; src = p.in[27]; dst = (u16*)(p.ws + OFF_WINO); N = 4096; ldd = 1024; kt = r & 15; nt4 = r >> 4; ksn = 0; }
            else { const int r = q - 384; src = p.in[28]; dst = (u16*)(p.ws + OFF_WOUTO); N = 1024; ldd = 1024; kt = r & 15; nt4 = r >> 4; ksn = 0; }
            transpose_tile<float>(src, N, N, dst, ldd, kt, nt4, ksc, ksn, smem);
          }
        }
      } PH_END
      PH_BEGIN(3) {
        for (int t = bid; t < 512 + 256; t += nb) {
          if (dry && (REP_SUB == 1 || REP_SUB == 4) && t >= 256) continue;
          if (dry && REP_SUB == 2 && (t < 256 || t >= 512)) continue;
          if (dry && REP_SUB == 3 && t < 512) continue;
          if (t < 512) phase_hyena(p, t, smem, dry);
          else phase_ssd_states_grp(p, xcd_item(t - 512), smem);
        }
      } PH_END
      PH_BEGIN(4) {
        for (int t = bid; t < 34 * 64; t += nb) phase_scan(p, t);
      } PH_END
      PH_BEGIN(5) {
        for (int t = bid; t < 256 + 1024; t += nb) {
          if (t < 256) phase_ssd_out_grp(p, xcd_item(t), smem, dry);
          else {
            int q = xcd_item(t - 256);
            transpose_tile<u16>((const u16*)(p.ws + OFF_UT) + (size_t)3072 * UTP, MROWS, UTP,
                                (u16*)((unsigned char*)p.out + OUT_YB) + 1024, 2048, q & 15, q >> 4, nullptr, 0, smem);
          }
        }
      } PH_END
      PH_BEGIN(6) {
        GemmArgs g; g.A1 = (const u16*)((const unsigned char*)p.out + OUT_YB); g.lda1 = 2048;
        g.A2 = g.A1; g.lda2 = 2048; g.ksplit = 1024;
        g.Bt = (const u16*)(p.ws + OFF_WOUTE); g.K = 2048;
        for (int rd = 0; rd * 256 < 64 * 4; ++rd) { int pm, pn; if (gemm_tile_coord(rd, 4, 64 * 4, pm, pn)) gemm256<1, true>(p, g, pm * 256, pn * 256, smem); }
      } PH_END
      PH_BEGIN(7) {
        const u16* x1 = (const u16*)(p.ws + OFF_X1);
        for (int t = bid; t < 512 + 256; t += nb) { if (t < 512) phase_norm_b(p, t, x1, (u16*)(p.ws + OFF_H1)); else phase_ckv(p, t - 512); }
      } PH_END
      PH_BEGIN(8) {
        GemmArgs g; g.A1 = (const u16*)(p.ws + OFF_H1); g.lda1 = 1024; g.A2 = g.A1; g.lda2 = 1024; g.ksplit = 1 << 30;
        g.Bt = (const u16*)(p.ws + OFF_WINO); g.K = 1024;
        for (int rd = 0; rd * 256 < 64 * 16; ++rd) { int pm, pn; if (gemm_tile_coord(rd, 16, 64 * 16, pm, pn)) gemm256<2, true>(p, g, pm * 256, pn * 256, smem); }
      } PH_END
      PH_BEGIN(9) {
        for (int t = bid; t < 2048; t += nb) phase_attn(p, xcd_item(t), smem, dry);
      } PH_END
      PH_BEGIN(10) {
        GemmArgs g; g.A1 = (const u16*)(p.ws + OFF_C1); g.lda1 = LDC1; g.A2 = g.A1; g.lda2 = LDC1; g.ksplit = 1 << 30;
        g.Bt = (const u16*)(p.ws + OFF_WOUTO); g.K = 1024;
        for (int rd = 0; rd * 256 < 64 * 4; ++rd) { int pm, pn; if (gemm_tile_coord(rd, 4, 64 * 4, pm, pn)) gemm256<3, true>(p, g, pm * 256, pn * 256, smem); }
      } PH_END
      PH_BEGIN(11) {
        for (int t = bid; t < 512; t += nb) phase_final_norm(p, t);
      } PH_END
    }
  }
}

extern "C" void kernel_launch(void* const* d_in, const int* in_sizes, int n_in, void* d_out, int out_size,
                              void* d_ws, size_t ws_size, hipStream_t stream) {
  static int grid_blocks = 0;
  if (!grid_blocks) {
    int dev = 0, cus = 0, per_cu = 0;
    hipGetDevice(&dev);
    hipDeviceGetAttribute(&cus, hipDeviceAttributeMultiprocessorCount, dev);
    hipOccupancyMaxActiveBlocksPerMultiprocessor(&per_cu, mega, NT, 0);
    if (per_cu < 1) per_cu = 1;
    grid_blocks = cus * per_cu;
  }
  Params p{};
  for (int i = 0; i < 31; ++i) p.in[i] = (const float*)d_in[i];
  p.out = (float*)d_out;
  p.ws = (unsigned char*)d_ws;
#if MULTI
  for (int ph = 0; ph < NPHASE; ++ph) {
    hipLaunchKernelGGL(mega, dim3(grid_blocks), dim3(NT), 0, stream, p, ph, ph + 1);
  }
#else
  hipMemsetAsync((unsigned char*)d_ws + OFF_BAR, 0, XCD_BAR_WORDS * sizeof(unsigned), stream);
  int ph0 = 0, ph1 = NPHASE;
  void* args[] = {&p, &ph0, &ph1};
  hipError_t e = hipLaunchCooperativeKernel((void*)mega, dim3(grid_blocks), dim3(NT), args, 0, stream);
  if (e != hipSuccess) fprintf(stderr, "cooperative launch failed: %s (grid %d)\n", hipGetErrorString(e), grid_blocks);
#endif
}
```

```cpp
#include <hip/hip_runtime.h>
#include <hip/hip_cooperative_groups.h>
#include <cstdio>
namespace cg = cooperative_groups;

#ifndef REP_MASK
#define REP_MASK 0
#endif
#ifndef REP_SUB
#define REP_SUB 0
#endif
#define OFF_DUMMY 249651200ul
#ifndef MULTI
#define MULTI 0
#endif

#define NT 512
#define DI __device__ __forceinline__
typedef unsigned short u16;
typedef __attribute__((ext_vector_type(8))) short bf16x8;
typedef __attribute__((ext_vector_type(4))) float f32x4;
typedef __attribute__((ext_vector_type(16))) float f32x16;
typedef __attribute__((ext_vector_type(4))) unsigned u32x4;
typedef __attribute__((ext_vector_type(2))) unsigned u32x2;

#define MFMA16(a, b, c) __builtin_amdgcn_mfma_f32_16x16x32_bf16((a), (b), (c), 0, 0, 0)
#define MFMA32(a, b, c) __builtin_amdgcn_mfma_f32_32x32x16_bf16((a), (b), (c), 0, 0, 0)

#define MROWS 16384
#define NPROMPT 8192
#define UTP 16448
#define LDC1 4160
#define LDC0 2592
#define NPAD0 6784
#define SMEM_BYTES 151552

#define OFF_WINE   0ul
#define OFF_WOUTE  14155776ul
#define OFF_WINO   18350080ul
#define OFF_WOUTO  26738688ul
#define OFF_MOD    28835840ul
#define OFF_ROWSS  28909568ul
#define OFF_CDEC   29958144ul
#define OFF_UT     29974528ul
#define OFF_C0A    164716544ul
#define OFF_X1     OFF_UT
#define OFF_C1     97083392ul
#define OFF_H1     233398272ul
#define OUT_H0     0ul
#define OUT_YB     0ul
#define OUT_HF4096 33554432ul
#define OUT_HF256  (33554432ul + 16777216ul)
#define OUT_SBUF   100663296ul
#define O_YP 0ul
#define O_YS 8388608ul
#define O_ST 16777216ul
#define O_NK 25165824ul
#define O_NV 33554432ul

struct Params {
  const float* in[31];
  float* out;
  unsigned char* ws;
};

typedef float f32x2_t __attribute__((ext_vector_type(2)));
typedef __bf16 bf16x2_t __attribute__((ext_vector_type(2)));
DI unsigned pk2(float a, float b) {
  f32x2_t v = {a, b};
  bf16x2_t r = __builtin_convertvector(v, bf16x2_t);
  return __builtin_bit_cast(unsigned, r);
}
DI u16 f2bf(float x) { return (u16)(pk2(x, x) & 0xffffu); }
DI float bf2f(u16 h) { return __uint_as_float(((unsigned)h) << 16); }
DI float silu(float x) { return x * __builtin_amdgcn_rcpf(1.f + __expf(-x)); }
DI float bflo(unsigned u) { return __uint_as_float(u << 16); }
DI float bfhi(unsigned u) { return __uint_as_float(u & 0xffff0000u); }
DI void unpack8(const u32x4& v, float* f) {
  f[0] = bflo(v[0]); f[1] = bfhi(v[0]); f[2] = bflo(v[1]); f[3] = bfhi(v[1]);
  f[4] = bflo(v[2]); f[5] = bfhi(v[2]); f[6] = bflo(v[3]); f[7] = bfhi(v[3]);
}
DI u32x4 pack8(const float* f) {
  u32x4 o; o[0] = pk2(f[0], f[1]); o[1] = pk2(f[2], f[3]); o[2] = pk2(f[4], f[5]); o[3] = pk2(f[6], f[7]); return o;
}
DI int row_group(int row) { return row < NPROMPT ? 0 : 1 + ((row - NPROMPT) >> 12); }

DI void phase_ada(const Params& p, int t, unsigned char* smem) {
  float* sc = (float*)smem;
  float* red = sc + 3072;
  const int layer = t / 96, cc = t % 96;
  const int tid = threadIdx.x;
  for (int i = tid; i < 3072; i += NT) {
    int g = i >> 10, k = i & 1023;
    float v = (g == 0) ? p.in[6][k] : p.in[5][(g - 1) * 1024 + k];
    sc[i] = silu(v);
  }
  __syncthreads();
  const int col = tid & 31, kg = tid >> 5;
  const float* w = p.in[8] + (size_t)layer * 1024 * 3072 + cc * 32 + col;
  float a0 = 0.f, a1 = 0.f, a2 = 0.f;
#pragma unroll 8
  for (int k = kg * 64; k < kg * 64 + 64; ++k) {
    float wv = w[(size_t)k * 3072];
    a0 += sc[k] * wv; a1 += sc[1024 + k] * wv; a2 += sc[2048 + k] * wv;
  }
  red[(kg * 3 + 0) * 32 + col] = a0;
  red[(kg * 3 + 1) * 32 + col] = a1;
  red[(kg * 3 + 2) * 32 + col] = a2;
  __syncthreads();
  if (tid < 96) {
    int g = tid >> 5, c = tid & 31;
    float s = 0.f;
    for (int q = 0; q < 16; ++q) s += red[(q * 3 + g) * 32 + c];
    int colg = cc * 32 + c;
    float* mod = (float*)(p.ws + OFF_MOD);
    mod[(layer * 3 + g) * 3072 + colg] = s + p.in[9][layer * 3072 + colg];
  }
  __syncthreads();
}

DI float ld_src(const float* q) { return *q; }
DI float ld_src(const u16* q) { return bf2f(*q); }
template <typename ST>
DI void transpose_tile(const ST* src, int N, int ldsrc, u16* dst, int lddst, int kt, int nt4,
                       const float* kscale, int kscale_n, unsigned char* smem) {
  float* tile = (float*)smem;
  const int tid = threadIdx.x;
  const int c = tid & 63, r0 = tid >> 6;
  float v[4][8];
#pragma unroll
  for (int q = 0; q < 4; ++q)
#pragma unroll
    for (int i = 0; i < 8; ++i) {
      int r = r0 + 8 * i;
      int k = kt * 64 + r, n = (nt4 * 4 + q) * 64 + c;
      v[q][i] = 0.f;
      if (n < N) v[q][i] = ld_src(src + (size_t)k * ldsrc + n);
    }
#pragma unroll
  for (int q = 0; q < 4; ++q)
#pragma unroll
    for (int i = 0; i < 8; ++i) {
      int r = r0 + 8 * i;
      int k = kt * 64 + r;
      float x = v[q][i];
      if (kscale != nullptr && k < kscale_n) x *= kscale[k];
      tile[q * 4160 + r * 65 + c] = x;
    }
  __syncthreads();
  const int rr = tid >> 3, c8 = (tid & 7) * 8;
#pragma unroll
  for (int q = 0; q < 4; ++q) {
    float f[8];
#pragma unroll
    for (int e = 0; e < 8; ++e) f[e] = tile[q * 4160 + (c8 + e) * 65 + rr];
    *(u32x4*)(dst + (size_t)((nt4 * 4 + q) * 64 + rr) * lddst + kt * 64 + c8) = pack8(f);
  }
  __syncthreads();
}

DI void phase_filter(const Params& p, int t, unsigned char* smem) {
  const int L = 4096;
  const int t0 = t * 16;
  float* feats = (float*)smem;
  float* h1 = feats + 18 * 36;
  float* h2 = h1 + 18 * 64;
  const float* w1 = p.in[20]; const float* b1 = p.in[21]; const float* w2 = p.in[22];
  const float* b2 = p.in[23]; const float* w3 = p.in[24]; const float* fr = p.in[25];
  int tid = threadIdx.x;
  asm volatile("" : "+v"(tid));
  float* w1s = h2 + 64 * 20;
  float* w2s = w1s + 33 * 64;
  {
    float r1[5], r2[8];
#pragma unroll
    for (int i = 0; i < 5; ++i) { const int id = tid + i * NT; r1[i] = id < 33 * 64 ? w1[id] : 0.f; }
#pragma unroll
    for (int i = 0; i < 8; ++i) r2[i] = w2[tid + i * NT];
#pragma unroll
    for (int i = 0; i < 5; ++i) { const int id = tid + i * NT; if (id < 33 * 64) w1s[id] = r1[i]; }
#pragma unroll
    for (int i = 0; i < 8; ++i) w2s[tid + i * NT] = r2[i];
  }
  for (int id = tid; id < 18 * 33; id += NT) {
    int tt = id / 33, i = id % 33;
    const int Lr = tt < 17 ? 4096 : 256;
    const int tpos = tt < 17 ? t0 + tt : t;
    float tv = (float)tpos / (float)(Lr - 1);
    float wv = 6.283185307179586f * (float)tpos / (float)Lr;
    float f;
    if (i == 0) f = tv;
    else if (i <= 16) { float fi = 1e-4f + (float)(i - 1) * ((15.f - 1e-4f) / 15.f); f = cosf(fi * wv); }
    else { float fi = 1e-4f + (float)(i - 17) * ((15.f - 1e-4f) / 15.f); f = -sinf(fi * wv); }
    feats[tt * 36 + i] = f;
  }
  __syncthreads();
  for (int id = tid; id < 18 * 64; id += NT) {
    int tt = id >> 6, j = id & 63;
    float s = b1[j];
#pragma unroll 11
    for (int i = 0; i < 33; ++i) s += feats[tt * 36 + i] * w1s[i * 64 + j];
    h1[tt * 64 + j] = sinf(fr[j] * s);
  }
  __syncthreads();
  for (int id = tid; id < 18 * 64; id += NT) {
    int tt = id >> 6, j = id & 63;
    float s = b2[j];
#pragma unroll 16
    for (int i = 0; i < 64; ++i) s += h1[tt * 64 + i] * w2s[i * 64 + j];
    h2[j * 20 + tt] = sinf(fr[j] * s);
  }
  __syncthreads();
  float acc[4][18];
#pragma unroll
  for (int q = 0; q < 4; ++q)
#pragma unroll
    for (int tt = 0; tt < 18; ++tt) acc[q][tt] = 0.f;
  {
    const float* w3t = w3 + tid;
    float wa[4][4], wb[4][4];
#pragma unroll
    for (int kk = 0; kk < 4; ++kk)
#pragma unroll
      for (int q = 0; q < 4; ++q) wa[kk][q] = w3t[kk * 2048 + 512 * q];
#pragma unroll 1
    for (int k0 = 0; k0 < 64; k0 += 8) {
#pragma unroll
      for (int kk = 0; kk < 4; ++kk)
#pragma unroll
        for (int q = 0; q < 4; ++q) wb[kk][q] = w3t[(k0 + 4 + kk) * 2048 + 512 * q];
#pragma unroll
      for (int kk = 0; kk < 4; ++kk) {
        float hv[20];
#pragma unroll
        for (int v = 0; v < 5; ++v) { const float4 h4 = *(const float4*)(h2 + (k0 + kk) * 20 + v * 4); hv[v * 4] = h4.x; hv[v * 4 + 1] = h4.y; hv[v * 4 + 2] = h4.z; hv[v * 4 + 3] = h4.w; }
#pragma unroll
        for (int tt = 0; tt < 18; ++tt)
#pragma unroll
          for (int q = 0; q < 4; ++q) acc[q][tt] += hv[tt] * wa[kk][q];
      }
      const int kn = (k0 + 8) & 63;
#pragma unroll
      for (int kk = 0; kk < 4; ++kk)
#pragma unroll
        for (int q = 0; q < 4; ++q) wa[kk][q] = w3t[(kn + kk) * 2048 + 512 * q];
#pragma unroll
      for (int kk = 0; kk < 4; ++kk) {
        float hv[20];
#pragma unroll
        for (int v = 0; v < 5; ++v) { const float4 h4 = *(const float4*)(h2 + (k0 + 4 + kk) * 20 + v * 4); hv[v * 4] = h4.x; hv[v * 4 + 1] = h4.y; hv[v * 4 + 2] = h4.z; hv[v * 4 + 3] = h4.w; }
#pragma unroll
        for (int tt = 0; tt < 18; ++tt)
#pragma unroll
          for (int q = 0; q < 4; ++q) acc[q][tt] += hv[tt] * wb[kk][q];
      }
    }
  }
  u16* HF = (u16*)((unsigned char*)p.out + OUT_HF4096);
  u16* HFp = (u16*)((unsigned char*)p.out + OUT_HF256);
  const float lo = -15.350567286626973f;
  const float hi = -3.0701134573253945f;
#pragma unroll
  for (int q = 0; q < 4; ++q) {
    int col = tid + 512 * q;
    int dir = col >> 10, c = col & 1023;
    float ad = fabsf(lo + (float)c * ((hi - lo) / 1023.f));
    u16* hc = HF + (size_t)c * (2 * L);
    float v[16];
    if (dir == 0) {
#pragma unroll
      for (int e = 0; e < 16; ++e) {
        const int j = 15 - e; const int tpos = t0 + j;
        v[e] = acc[q][j] * __expf(-((float)tpos / (float)(L - 1)) * ad);
      }
      *(u32x4*)(hc + (L - 16 - t0)) = pack8(v);
      *(u32x4*)(hc + (L - 8 - t0)) = pack8(v + 8);
    } else {
#pragma unroll
      for (int e = 0; e < 16; ++e) {
        const int tpos = t0 + 1 + e;
        v[e] = (tpos < L) ? acc[q][e + 1] * __expf(-((float)tpos / (float)(L - 1)) * ad) : 0.f;
      }
      *(u32x4*)(hc + (L + t0)) = pack8(v);
      *(u32x4*)(hc + (L + t0 + 8)) = pack8(v + 8);
    }
    {
      u16* hp = HFp + (size_t)c * 512;
      const float val = acc[q][17] * __expf(-((float)t / 255.f) * ad);
      if (dir == 0) hp[255 - t] = f2bf(val);
      else { if (t > 0) hp[255 + t] = f2bf(val); else hp[511] = 0; }
    }
  }
  __syncthreads();
}

DI float wave_sum(float v) {
#pragma unroll
  for (int o = 32; o >= 1; o >>= 1) v += __shfl_xor(v, o);
  return v;
}
DI void phase_norm(const Params& p, int t, int layer, const float* xa, const float* xb, u16* dst) {
  const int lane = threadIdx.x & 63, w = threadIdx.x >> 6;
  const int row0 = t * 32 + w * 4;
  float4 v[4][4];
#pragma unroll
  for (int rr = 0; rr < 4; ++rr) {
    const int row = row0 + rr;
    const float* src = row < NPROMPT ? xa + (size_t)row * 1024 : xb + (size_t)(row - NPROMPT) * 1024;
#pragma unroll
    for (int i = 0; i < 4; ++i) v[rr][i] = *(const float4*)(src + i * 256 + lane * 4);
  }
  const float* nw = p.in[7] + layer * 1024;
#pragma unroll
  for (int rr = 0; rr < 4; ++rr) {
    const int row = row0 + rr;
    const int g = row_group(row);
    float ss = 0.f;
#pragma unroll
    for (int i = 0; i < 4; ++i) ss += v[rr][i].x * v[rr][i].x + v[rr][i].y * v[rr][i].y + v[rr][i].z * v[rr][i].z + v[rr][i].w * v[rr][i].w;
    ss = wave_sum(ss);
    const float rstd = rsqrtf(ss * (1.f / 1024.f) + 1e-6f);
    const float* shift = (const float*)(p.ws + OFF_MOD) + (layer * 3 + g) * 3072;
    const float* scale = shift + 1024;
#pragma unroll
    for (int i = 0; i < 4; ++i) {
      int col = i * 256 + lane * 4;
      float4 nwv = *(const float4*)(nw + col);
      float4 sc = *(const float4*)(scale + col);
      float4 sh = *(const float4*)(shift + col);
      float o0 = v[rr][i].x * rstd * nwv.x * (1.f + sc.x) + sh.x;
      float o1 = v[rr][i].y * rstd * nwv.y * (1.f + sc.y) + sh.y;
      float o2 = v[rr][i].z * rstd * nwv.z * (1.f + sc.z) + sh.z;
      float o3 = v[rr][i].w * rstd * nwv.w * (1.f + sc.w) + sh.w;
      u32x2 o; o[0] = pk2(o0, o1); o[1] = pk2(o2, o3);
      *(u32x2*)(dst + (size_t)row * 1024 + col) = o;
    }
  }
}

DI void phase_norm_b(const Params& p, int t, const u16* x1, u16* dst) {
  const int lane = threadIdx.x & 63, w = threadIdx.x >> 6;
  const int row0 = t * 32 + w * 4;
  u32x4 v[4][2];
#pragma unroll
  for (int rr = 0; rr < 4; ++rr)
#pragma unroll
    for (int i = 0; i < 2; ++i) v[rr][i] = *(const u32x4*)(x1 + (size_t)(row0 + rr) * 1024 + i * 512 + lane * 8);
  const float* nw = p.in[7] + 1024;
#pragma unroll
  for (int rr = 0; rr < 4; ++rr) {
    const int row = row0 + rr;
    const int g = row_group(row);
    float f[2][8];
    unpack8(v[rr][0], f[0]); unpack8(v[rr][1], f[1]);
    float ss = 0.f;
#pragma unroll
    for (int i = 0; i < 2; ++i)
#pragma unroll
      for (int e = 0; e < 8; ++e) ss += f[i][e] * f[i][e];
    ss = wave_sum(ss);
    const float rstd = rsqrtf(ss * (1.f / 1024.f) + 1e-6f);
    const float* shift = (const float*)(p.ws + OFF_MOD) + (1 * 3 + g) * 3072;
    const float* scale = shift + 1024;
#pragma unroll
    for (int i = 0; i < 2; ++i) {
      const int col = i * 512 + lane * 8;
      float o[8];
#pragma unroll
      for (int hv = 0; hv < 2; ++hv) {
        const float4 nwv = *(const float4*)(nw + col + hv * 4);
        const float4 sc = *(const float4*)(scale + col + hv * 4);
        const float4 sh = *(const float4*)(shift + col + hv * 4);
        o[hv * 4 + 0] = f[i][hv * 4 + 0] * rstd * nwv.x * (1.f + sc.x) + sh.x;
        o[hv * 4 + 1] = f[i][hv * 4 + 1] * rstd * nwv.y * (1.f + sc.y) + sh.y;
        o[hv * 4 + 2] = f[i][hv * 4 + 2] * rstd * nwv.z * (1.f + sc.z) + sh.z;
        o[hv * 4 + 3] = f[i][hv * 4 + 3] * rstd * nwv.w * (1.f + sc.w) + sh.w;
      }
      *(u32x4*)(dst + (size_t)row * 1024 + col) = pack8(o);
    }
  }
}
DI void phase_final_norm(const Params& p, int t) {
  const int lane = threadIdx.x & 63, w = threadIdx.x >> 6;
  const int row0 = t * 32 + w * 4;
  float4 v[4][4];
#pragma unroll
  for (int rr = 0; rr < 4; ++rr) {
    const float* src = p.out + (size_t)(row0 + rr) * 1024;
#pragma unroll
    for (int i = 0; i < 4; ++i) v[rr][i] = *(const float4*)(src + i * 256 + lane * 4);
  }
  const float* nw = p.in[30];
#pragma unroll
  for (int rr = 0; rr < 4; ++rr) {
    float* src = p.out + (size_t)(row0 + rr) * 1024;
    float ss = 0.f;
#pragma unroll
    for (int i = 0; i < 4; ++i) ss += v[rr][i].x * v[rr][i].x + v[rr][i].y * v[rr][i].y + v[rr][i].z * v[rr][i].z + v[rr][i].w * v[rr][i].w;
    ss = wave_sum(ss);
    const float rstd = rsqrtf(ss * (1.f / 1024.f) + 1e-6f);
#pragma unroll
    for (int i = 0; i < 4; ++i) {
      int col = i * 256 + lane * 4;
      float4 nwv = *(const float4*)(nw + col);
      float4 o;
      o.x = v[rr][i].x * rstd * nwv.x; o.y = v[rr][i].y * rstd * nwv.y; o.z = v[rr][i].z * rstd * nwv.z; o.w = v[rr][i].w * rstd * nwv.w;
      *(float4*)(src + col) = o;
    }
  }
}

struct GemmArgs {
  const u16* A1; int lda1;
  const u16* A2; int lda2;
  int ksplit;
  const u16* Bt; int K;
};
template <int EPI>
DI void gemm_tile(const Params& p, const GemmArgs& g, int m0, int n0, unsigned char* smem) {
  u16* As = (u16*)smem;
  u16* Bs = As + 256 * 72;
  float* rs = (float*)(Bs + 128 * 72);
  const int tid = threadIdx.x, lane = tid & 63, w = tid >> 6;
  const int wm = (w >> 1) * 64, wn = (w & 1) * 64;
  const int l15 = lane & 15, l4 = lane >> 4;
  f32x4 acc[4][4];
#pragma unroll
  for (int i = 0; i < 4; ++i)
#pragma unroll
    for (int j = 0; j < 4; ++j) acc[i][j] = (f32x4){0.f, 0.f, 0.f, 0.f};
  if (EPI == 1) {
    if (tid < 256) {
      const float* rss = (const float*)(p.ws + OFF_ROWSS) + (size_t)(m0 + tid) * 16;
      float s = 0.f;
#pragma unroll
      for (int q = 0; q < 16; ++q) s += rss[q];
      rs[tid] = rsqrtf(s * (1.f / 1024.f) + 1e-6f);
    }
  }
  u32x4 ra[4], rb[2];
  const int KT = g.K >> 6;
  auto loadg = [&](int kt) {
    const int k0 = kt << 6;
    const u16* Ab; int lda; int kk;
    if (k0 < g.ksplit) { Ab = g.A1; lda = g.lda1; kk = k0; } else { Ab = g.A2; lda = g.lda2; kk = k0 - g.ksplit; }
#pragma unroll
    for (int i = 0; i < 4; ++i) {
      int id = tid + 512 * i; int r = id >> 3, c = (id & 7) * 8;
      ra[i] = *(const u32x4*)(Ab + (size_t)(m0 + r) * lda + kk + c);
    }
#pragma unroll
    for (int i = 0; i < 2; ++i) {
      int id = tid + 512 * i; int r = id >> 3, c = (id & 7) * 8;
      rb[i] = *(const u32x4*)(g.Bt + (size_t)(n0 + r) * g.K + k0 + c);
    }
  };
  loadg(0);
  for (int kt = 0; kt < KT; ++kt) {
#pragma unroll
    for (int i = 0; i < 4; ++i) {
      int id = tid + 512 * i; int r = id >> 3, c = (id & 7) * 8;
      *(u32x4*)(As + r * 72 + c) = ra[i];
    }
#pragma unroll
    for (int i = 0; i < 2; ++i) {
      int id = tid + 512 * i; int r = id >> 3, c = (id & 7) * 8;
      *(u32x4*)(Bs + r * 72 + c) = rb[i];
    }
    __syncthreads();
    if (kt + 1 < KT) loadg(kt + 1);
    if (EPI == 1) {
      if ((kt << 6) == g.ksplit) {
#pragma unroll
        for (int i = 0; i < 4; ++i)
#pragma unroll
          for (int r = 0; r < 4; ++r) {
            float sc = rs[wm + i * 16 + l4 * 4 + r];
#pragma unroll
            for (int j = 0; j < 4; ++j) acc[i][j][r] *= sc;
          }
      }
    }
#pragma unroll
    for (int ks = 0; ks < 2; ++ks) {
      bf16x8 a[4], b[4];
#pragma unroll
      for (int i = 0; i < 4; ++i) a[i] = *(const bf16x8*)(As + (wm + i * 16 + l15) * 72 + ks * 32 + l4 * 8);
#pragma unroll
      for (int j = 0; j < 4; ++j) b[j] = *(const bf16x8*)(Bs + (wn + j * 16 + l15) * 72 + ks * 32 + l4 * 8);
#pragma unroll
      for (int i = 0; i < 4; ++i)
#pragma unroll
        for (int j = 0; j < 4; ++j) acc[i][j] = MFMA16(a[i], b[j], acc[i][j]);
    }
    __syncthreads();
  }
#pragma unroll
  for (int i = 0; i < 4; ++i) {
    const int rbase = m0 + wm + i * 16 + l4 * 4;
#pragma unroll
    for (int j = 0; j < 4; ++j) {
      const int col = n0 + wn + j * 16 + l15;
      if (EPI == 0) {
        if (col < LDC0) {
          u16* C = (u16*)(p.ws + OFF_C0A);
#pragma unroll
          for (int r = 0; r < 4; ++r) C[(size_t)(rbase + r) * LDC0 + col] = f2bf(acc[i][j][r]);
        } else if (col < 6688) {
          u16* UT = (u16*)(p.ws + OFF_UT);
          u32x2 o; o[0] = pk2(acc[i][j][0], acc[i][j][1]); o[1] = pk2(acc[i][j][2], acc[i][j][3]);
          *(u32x2*)(UT + (size_t)(col - LDC0) * UTP + rbase) = o;
        }
      } else if (EPI == 1) {
        float* X1 = (float*)(p.ws + OFF_X1);
        const float* mod = (const float*)(p.ws + OFF_MOD);
#pragma unroll
        for (int r = 0; r < 4; ++r) {
          int row = rbase + r;
          const float* xs = row < NPROMPT ? p.in[0] + (size_t)row * 1024 : p.in[1] + (size_t)(row - NPROMPT) * 1024;
          float gate = mod[(0 * 3 + row_group(row)) * 3072 + 2048 + col];
          X1[(size_t)row * 1024 + col] = xs[col] + gate * acc[i][j][r];
        }
      } else if (EPI == 2) {
        u16* C1 = (u16*)(p.ws + OFF_C1);
#pragma unroll
        for (int r = 0; r < 4; ++r) {
          int row = rbase + r;
          C1[(size_t)row * LDC1 + col] = f2bf(acc[i][j][r]);
          if (row < NPROMPT && col >= 1024 && col < 3072) {
            int cc = col - 1024; int isv = cc >> 10; cc &= 1023;
            int hh = cc >> 6, d = cc & 63; int b = row >> 8, l = row & 255;
            float* o = p.out + (isv ? O_NV : O_NK);
            o[(((size_t)b * 16 + hh) * 256 + l) * 64 + d] = acc[i][j][r];
          }
        }
      } else {
        const float* X1 = (const float*)(p.ws + OFF_X1);
        const float* mod = (const float*)(p.ws + OFF_MOD);
#pragma unroll
        for (int r = 0; r < 4; ++r) {
          int row = rbase + r;
          float gate = mod[(1 * 3 + row_group(row)) * 3072 + 2048 + col];
          p.out[(size_t)row * 1024 + col] = X1[(size_t)row * 1024 + col] + gate * acc[i][j][r];
        }
      }
    }
  }
}


DI int lds_byte(int r, int c) {
  int st = (r >> 4) * 2 + (c >> 5), rr = r & 15, cc = c & 31, ob = rr * 64 + cc * 2;
  return st * 1024 + (ob ^ (((ob >> 9) & 1) << 5));
}
DI void stage_rc(int b, int& R, int& C) {
  int st = b / 1024, sb = b % 1024, swz = sb ^ (((sb >> 9) & 1) << 5);
  R = (st >> 1) * 16 + swz / 64; C = (st & 1) * 32 + (swz % 64) / 2;
}
template <int EPI>
DI void epi_store(const Params& p, int rbase, int col, const f32x4& v) {
  if (EPI == 0) {
    if (col < LDC0) {
      u16* C = (u16*)(p.ws + OFF_C0A);
#pragma unroll
      for (int r = 0; r < 4; ++r) C[(size_t)(rbase + r) * LDC0 + col] = f2bf(v[r]);
    } else if (col < 6688) {
      u16* UT = (u16*)(p.ws + OFF_UT);
      u32x2 o; o[0] = pk2(v[0], v[1]); o[1] = pk2(v[2], v[3]);
      *(u32x2*)(UT + (size_t)(col - LDC0) * UTP + rbase) = o;
    }
  } else if (EPI == 1) {
    float* X1 = (float*)(p.ws + OFF_X1);
    const float* mod = (const float*)(p.ws + OFF_MOD);
#pragma unroll
    for (int r = 0; r < 4; ++r) {
      int row = rbase + r;
      const float* xs = row < NPROMPT ? p.in[0] + (size_t)row * 1024 : p.in[1] + (size_t)(row - NPROMPT) * 1024;
      float gate = mod[(0 * 3 + row_group(row)) * 3072 + 2048 + col];
      X1[(size_t)row * 1024 + col] = xs[col] + gate * v[r];
    }
  } else if (EPI == 2) {
    u16* C1 = (u16*)(p.ws + OFF_C1);
#pragma unroll
    for (int r = 0; r < 4; ++r) {
      int row = rbase + r;
      C1[(size_t)row * LDC1 + col] = f2bf(v[r]);
      if (row < NPROMPT && col >= 1024 && col < 3072) {
        int cc = col - 1024; int isv = cc >> 10; cc &= 1023;
        int hh = cc >> 6, d = cc & 63; int b = row >> 8, l = row & 255;
        float* o = p.out + (isv ? O_NV : O_NK);
        o[(((size_t)b * 16 + hh) * 256 + l) * 64 + d] = v[r];
      }
    }
  } else {
    const float* X1 = (const float*)(p.ws + OFF_X1);
    const float* mod = (const float*)(p.ws + OFF_MOD);
#pragma unroll
    for (int r = 0; r < 4; ++r) {
      int row = rbase + r;
      float gate = mod[(1 * 3 + row_group(row)) * 3072 + 2048 + col];
      p.out[(size_t)row * 1024 + col] = X1[(size_t)row * 1024 + col] + gate * v[r];
    }
  }
}

template <int EPI>
DI void epi_store_sw(const Params& p, int row, int col, const f32x4& v) {
  if (EPI == 0) {
    u16* C = (u16*)(p.ws + OFF_C0A);
    u32x2 o; o[0] = pk2(v[0], v[1]); o[1] = pk2(v[2], v[3]);
    *(u32x2*)(C + (size_t)row * LDC0 + col) = o;
  } else if (EPI == 1) {
    float* X1 = (float*)(p.ws + OFF_X1);
    const float* mod = (const float*)(p.ws + OFF_MOD);
    const float* xs = row < NPROMPT ? p.in[0] + (size_t)row * 1024 : p.in[1] + (size_t)(row - NPROMPT) * 1024;
    const float4 xv = *(const float4*)(xs + col);
    const float4 gt = *(const float4*)(mod + (0 * 3 + row_group(row)) * 3072 + 2048 + col);
    u32x2 ob; ob[0] = pk2(xv.x + gt.x * v[0], xv.y + gt.y * v[1]); ob[1] = pk2(xv.z + gt.z * v[2], xv.w + gt.w * v[3]);
    *(u32x2*)((u16*)X1 + (size_t)row * 1024 + col) = ob;
  } else if (EPI == 2) {
    u16* C1 = (u16*)(p.ws + OFF_C1);
    u32x2 o; o[0] = pk2(v[0], v[1]); o[1] = pk2(v[2], v[3]);
    *(u32x2*)(C1 + (size_t)row * LDC1 + col) = o;
    if (row < NPROMPT && col >= 1024 && col < 3072) {
      int cc = col - 1024; int isv = cc >> 10; cc &= 1023;
      int hh = cc >> 6, d = cc & 63; int b = row >> 8, l = row & 255;
      float* op = p.out + (isv ? O_NV : O_NK);
      *(float4*)(op + (((size_t)b * 16 + hh) * 256 + l) * 64 + d) = make_float4(v[0], v[1], v[2], v[3]);
    }
  } else {
    const float* X1 = (const float*)(p.ws + OFF_X1);
    const float* mod = (const float*)(p.ws + OFF_MOD);
    const u32x2 xb = *(const u32x2*)((const u16*)X1 + (size_t)row * 1024 + col);
    const float4 xv = make_float4(bflo(xb[0]), bfhi(xb[0]), bflo(xb[1]), bfhi(xb[1]));
    const float4 gt = *(const float4*)(mod + (1 * 3 + row_group(row)) * 3072 + 2048 + col);
    float4 o; o.x = xv.x + gt.x * v[0]; o.y = xv.y + gt.y * v[1]; o.z = xv.z + gt.z * v[2]; o.w = xv.w + gt.w * v[3];
    *(float4*)(p.out + (size_t)row * 1024 + col) = o;
  }
}

template <int EPI, bool SWAP>
DI void gemm256(const Params& p, const GemmArgs& g, int brow, int bcol, unsigned char* smem) {
  constexpr int HT = 128 * 64;
  u16* shm = (u16*)smem;
  float* rs = (float*)(smem + 131072);
  const int K = g.K;
#define SA(b, h) (shm + ((b) * 2 + (h)) * HT)
#define SB(b, h) (shm + (4 + (b) * 2 + (h)) * HT)
#define STAGE_A(P, br, kt) do { const u16* _ub = g.A1 + (long)(br) * g.lda1 + (long)(kt) * 64; \
    for (int _i = 0; _i < 2; ++_i) { \
      __builtin_amdgcn_global_load_lds((const unsigned*)((const char*)(_ub + (long)_i * 64 * g.lda1) + aoff1), \
        (__attribute__((address_space(3))) unsigned*)((char*)(P) + threadIdx.x * 16 + _i * 8192), 16, 0, 0); } } while (0)
#define STAGE_B(P, bc, kt) do { const u16* _ub = g.Bt + (long)(bc) * K + (long)(kt) * 64; \
    for (int _i = 0; _i < 2; ++_i) { \
      __builtin_amdgcn_global_load_lds((const unsigned*)((const char*)(_ub + (long)_i * 64 * K) + boff), \
        (__attribute__((address_space(3))) unsigned*)((char*)(P) + threadIdx.x * 16 + _i * 8192), 16, 0, 0); } } while (0)
#define LDA(dst, b, h) for (int m = 0; m < 4; ++m) for (int k = 0; k < 2; ++k) \
    dst[m][k] = *reinterpret_cast<const bf16x8*>((char*)SA(b, h) + lds_byte(wr * 64 + m * 16 + fr, k * 32 + fq * 8))
#define LDB(dst, b, h) for (int n = 0; n < 2; ++n) for (int k = 0; k < 2; ++k) \
    dst[n][k] = *reinterpret_cast<const bf16x8*>((char*)SB(b, h) + lds_byte(wc * 32 + n * 16 + fr, k * 32 + fq * 8))
#define MMA(ai, bj, At_, Bt_) do { __builtin_amdgcn_s_setprio(1); \
    for (int m = 0; m < 4; ++m) for (int n = 0; n < 2; ++n) for (int k = 0; k < 2; ++k) \
      acc[ai][bj][m][n] = SWAP ? __builtin_amdgcn_mfma_f32_16x16x32_bf16(Bt_[n][k], At_[m][k], acc[ai][bj][m][n], 0, 0, 0) \
                               : __builtin_amdgcn_mfma_f32_16x16x32_bf16(At_[m][k], Bt_[n][k], acc[ai][bj][m][n], 0, 0, 0); \
    __builtin_amdgcn_s_setprio(0); } while (0)
#define WAIT_V(n) asm volatile("s_waitcnt vmcnt(" #n ")" ::: "memory")
#define WAIT_L(n) asm volatile("s_waitcnt lgkmcnt(" #n ")" ::: "memory")
#define BAR __builtin_amdgcn_s_barrier()
#define SCHED __builtin_amdgcn_sched_barrier(0)
  const int wid = threadIdx.x >> 6, lane = threadIdx.x & 63, wr = wid >> 2, wc = wid & 3, fr = lane & 15, fq = lane >> 4;
  unsigned aoff1, boff;
  {
    int r_, c_; stage_rc(threadIdx.x * 16, r_, c_);
    aoff1 = (unsigned)(r_ * g.lda1 + c_) * 2u;
    boff = (unsigned)(r_ * K + c_) * 2u;
  }
  if (EPI == 1) {
    if (threadIdx.x < 256) {
      const float* rss = (const float*)(p.ws + OFF_ROWSS) + (size_t)(brow + threadIdx.x) * 16;
      float s = 0.f;
#pragma unroll
      for (int q = 0; q < 16; ++q) s += rss[q];
      rs[threadIdx.x] = rsqrtf(s * (1.f / 1024.f) + 1e-6f);
    }
  }
  WAIT_V(0);
  __syncthreads();
  f32x4 acc[2][2][4][2];
#pragma unroll
  for (int a = 0; a < 2; ++a)
#pragma unroll
    for (int b = 0; b < 2; ++b)
#pragma unroll
      for (int m = 0; m < 4; ++m)
#pragma unroll
        for (int n = 0; n < 2; ++n) acc[a][b][m][n] = (f32x4){0.f, 0.f, 0.f, 0.f};
  bf16x8 At[4][2], B0[2][2], B1[2][2];
  const int nt = K / 64;
  const int tscale = (EPI == 1) ? (g.ksplit >> 6) : -1;
  STAGE_B(SB(0, 0), bcol, 0); STAGE_A(SA(0, 0), brow, 0);
  STAGE_B(SB(0, 1), bcol + 128, 0); STAGE_A(SA(0, 1), brow + 128, 0);
  if (wr == 1) BAR;
  WAIT_V(4); BAR;
  STAGE_B(SB(1, 0), bcol, 1); STAGE_A(SA(1, 0), brow, 1); STAGE_B(SB(1, 1), bcol + 128, 1);
  WAIT_V(6); BAR;
  for (int t = 0; t < nt - 2; t += 2) {
    if (EPI == 1) {
      if (t == tscale) {
#pragma unroll
        for (int a = 0; a < 2; ++a)
#pragma unroll
          for (int m = 0; m < 4; ++m)
#pragma unroll
            for (int j = 0; j < 4; ++j) {
              float sc = SWAP ? rs[a * 128 + wr * 64 + m * 16 + fr] : rs[a * 128 + wr * 64 + m * 16 + fq * 4 + j];
#pragma unroll
              for (int b = 0; b < 2; ++b)
#pragma unroll
                for (int n = 0; n < 2; ++n) acc[a][b][m][n][j] *= sc;
            }
      }
    }
    LDB(B0, 0, 0); SCHED; LDA(At, 0, 0); STAGE_A(SA(1, 1), brow + 128, t + 1);
    WAIT_L(8); BAR; WAIT_L(0); MMA(0, 0, At, B0); BAR; SCHED;
    LDB(B1, 0, 1); STAGE_B(SB(0, 0), bcol, t + 2);
    BAR; WAIT_L(0); MMA(0, 1, At, B1); BAR;
    LDA(At, 0, 1); STAGE_A(SA(0, 0), brow, t + 2);
    BAR; WAIT_L(0); MMA(1, 0, At, B0); BAR; SCHED;
    STAGE_B(SB(0, 1), bcol + 128, t + 2);
    WAIT_V(6); BAR; MMA(1, 1, At, B1); BAR;
    LDB(B0, 1, 0); SCHED; LDA(At, 1, 0); STAGE_A(SA(0, 1), brow + 128, t + 2);
    WAIT_L(8); BAR; WAIT_L(0); MMA(0, 0, At, B0); BAR; SCHED;
    LDB(B1, 1, 1); STAGE_B(SB(1, 0), bcol, t + 3);
    BAR; WAIT_L(0); MMA(0, 1, At, B1); BAR;
    LDA(At, 1, 1); STAGE_A(SA(1, 0), brow, t + 3);
    BAR; WAIT_L(0); MMA(1, 0, At, B0); BAR; SCHED;
    STAGE_B(SB(1, 1), bcol + 128, t + 3);
    WAIT_V(6); BAR; MMA(1, 1, At, B1); BAR;
  }
  { LDB(B0, 0, 0); LDA(At, 0, 0); STAGE_A(SA(1, 1), brow + 128, nt - 1);
    BAR; WAIT_L(0); MMA(0, 0, At, B0); BAR;
    LDB(B1, 0, 1); BAR; WAIT_L(0); MMA(0, 1, At, B1); BAR;
    LDA(At, 0, 1); WAIT_V(4); BAR; WAIT_L(0); MMA(1, 0, At, B0); MMA(1, 1, At, B1); BAR; }
  { LDB(B0, 1, 0); LDA(At, 1, 0); WAIT_V(2); BAR; WAIT_L(0); MMA(0, 0, At, B0); BAR;
    LDB(B1, 1, 1); WAIT_V(0); BAR; WAIT_L(0); MMA(0, 1, At, B1); BAR;
    LDA(At, 1, 1); BAR; WAIT_L(0); MMA(1, 0, At, B0); MMA(1, 1, At, B1); BAR; }
  if (wr == 0) BAR;
  int e_tid = threadIdx.x, e_brow = brow, e_bcol = bcol;
  asm volatile("" : "+v"(e_tid), "+s"(e_brow), "+s"(e_bcol));
  const int e_row = SWAP ? e_brow + ((e_tid >> 8) & 1) * 64 + (e_tid & 15) : e_brow + ((e_tid >> 8) & 1) * 64 + ((e_tid >> 4) & 3) * 4;
  const int e_col = SWAP ? e_bcol + ((e_tid >> 6) & 3) * 32 + ((e_tid >> 4) & 3) * 4 : e_bcol + ((e_tid >> 6) & 3) * 32 + (e_tid & 15);
#pragma unroll
  for (int ai = 0; ai < 2; ++ai)
#pragma unroll
    for (int bj = 0; bj < 2; ++bj)
#pragma unroll
      for (int m = 0; m < 4; ++m)
#pragma unroll
        for (int n = 0; n < 2; ++n) {
          if (SWAP) epi_store_sw<EPI>(p, e_row + ai * 128 + m * 16, e_col + bj * 128 + n * 16, acc[ai][bj][m][n]);
          else epi_store<EPI>(p, e_row + ai * 128 + m * 16, e_col + bj * 128 + n * 16, acc[ai][bj][m][n]);
        }
  __syncthreads();
#undef SA
#undef SB
#undef STAGE_A
#undef STAGE_B
#undef LDA
#undef LDB
#undef MMA
#undef WAIT_V
#undef WAIT_L
#undef BAR
#undef SCHED
}
DI bool gemm_tile_coord(int round, int NN, int ntiles, int& pm, int& pn) {
  const int b = blockIdx.x;
  const int v = round * 256 + (b & 7) * 32 + (b >> 3);
  if (v >= ntiles) return false;
  pm = (v / (8 * NN)) * 8 + (v & 7);
  pn = (v >> 3) % NN;
  return true;
}
struct SsdItem { int row0; int h; int has_prev; int has_next; };
DI SsdItem ssd_item(int item) {
  SsdItem s;
  int cgi = item >> 4; s.h = item & 15;
  if (cgi < 64) { int seq = cgi >> 1, c = cgi & 1; s.row0 = seq * 256 + c * 128; s.has_prev = c > 0; s.has_next = c < 1; }
  else { int q = cgi - 64; int seq = q >> 5, c = q & 31; s.row0 = NPROMPT + seq * 4096 + c * 128; s.has_prev = c > 0; s.has_next = c < 31; }
  return s;
}
DI float ssd_load_dt(const Params& p, int row0, int h) {
  const int tid = threadIdx.x;
  const u16* C0 = (const u16*)(p.ws + OFF_C0A);
  float raw = 0.f;
  if (tid < 256) { int d = tid >> 7, l = tid & 127; raw = bf2f(C0[(size_t)(row0 + l) * LDC0 + 2560 + d * 16 + h]); }
  return raw;
}
DI void ssd_prep_dt(const Params& p, float raw, int h, float* sdt, float* scs, float* stot) {
  const int tid = threadIdx.x, lane = tid & 63, w = tid >> 6;
  if (tid < 256) {
    int d = tid >> 7, l = tid & 127;
    float x = raw + p.in[14][d * 16 + h];
    float dt = x > 20.f ? x : log1pf(expf(x));
    float a = -expf(p.in[15][d * 16 + h]);
    sdt[d * 128 + l] = dt;
    scs[d * 128 + l] = a * dt;
  }
  __syncthreads();
  if (w < 2) {
    const int d = w;
    int p0 = d == 0 ? 2 * lane : 127 - 2 * lane;
    int p1 = d == 0 ? 2 * lane + 1 : 126 - 2 * lane;
    float v0 = scs[d * 128 + p0], v1 = scs[d * 128 + p1];
    float s = v0 + v1;
#pragma unroll
    for (int off = 1; off < 64; off <<= 1) {
      float tv = __shfl_up(s, off);
      if (lane >= off) s += tv;
    }
    float excl = s - (v0 + v1);
    scs[d * 128 + p0] = excl + v0;
    scs[d * 128 + p1] = excl + v0 + v1;
    if (lane == 63) stot[d] = s;
  }
  __syncthreads();
}
DI void conv_silu8(const Params& p, int row, int ch0, bool hp, bool hn, float* out) {
  const u16* C0 = (const u16*)(p.ws + OFF_C0A);
  const u16* q = C0 + (size_t)row * LDC0 + 1024 + ch0;
  const float* cw = p.in[12]; const float* cb = p.in[13];
  float xm[8], xc[8], xp[8];
  u32x4 vc = *(const u32x4*)q;
  unpack8(vc, xc);
  if (hp) { u32x4 v = *(const u32x4*)(q - LDC0); unpack8(v, xm); } else {
#pragma unroll
    for (int e = 0; e < 8; ++e) xm[e] = 0.f;
  }
  if (hn) { u32x4 v = *(const u32x4*)(q + LDC0); unpack8(v, xp); } else {
#pragma unroll
    for (int e = 0; e < 8; ++e) xp[e] = 0.f;
  }
  float4 w0a = *(const float4*)(cw + ch0), w0b = *(const float4*)(cw + ch0 + 4);
  float4 w1a = *(const float4*)(cw + 1536 + ch0), w1b = *(const float4*)(cw + 1536 + ch0 + 4);
  float4 w2a = *(const float4*)(cw + 3072 + ch0), w2b = *(const float4*)(cw + 3072 + ch0 + 4);
  float4 ba = *(const float4*)(cb + ch0), bb = *(const float4*)(cb + ch0 + 4);
  float w0[8] = {w0a.x, w0a.y, w0a.z, w0a.w, w0b.x, w0b.y, w0b.z, w0b.w};
  float w1[8] = {w1a.x, w1a.y, w1a.z, w1a.w, w1b.x, w1b.y, w1b.z, w1b.w};
  float w2[8] = {w2a.x, w2a.y, w2a.z, w2a.w, w2b.x, w2b.y, w2b.z, w2b.w};
  float bv[8] = {ba.x, ba.y, ba.z, ba.w, bb.x, bb.y, bb.z, bb.w};
#pragma unroll
  for (int e = 0; e < 8; ++e) out[e] = silu(bv[e] + w0[e] * xm[e] + w1[e] * xc[e] + w2[e] * xp[e]);
}


template <int R>
DI void conv_load(const Params& p, int row0, int l0, int ch0, bool prev_chunk, bool next_chunk, u32x4 (&raw)[R + 2]) {
  const u16* C0 = (const u16*)(p.ws + OFF_C0A);
  const u16* q = C0 + (size_t)(row0 + l0) * LDC0 + 1024 + ch0;
  const bool hp = (l0 > 0) || prev_chunk;
  const bool hn = (l0 + R < 128) || next_chunk;
#pragma unroll
  for (int i = 0; i < R + 2; ++i) {
    const bool ok = (i == 0) ? hp : ((i == R + 1) ? hn : true);
    raw[i] = (u32x4){0u, 0u, 0u, 0u};
    if (ok) raw[i] = *(const u32x4*)(q + (long)(i - 1) * LDC0);
  }
}
template <int R>
DI void conv_compute(const Params& p, int ch0, const u32x4 (&raw)[R + 2], float (&out)[R][8]) {
  const float* cw = p.in[12]; const float* cb = p.in[13];
  float4 w0a = *(const float4*)(cw + ch0), w0b = *(const float4*)(cw + ch0 + 4);
  float4 w1a = *(const float4*)(cw + 1536 + ch0), w1b = *(const float4*)(cw + 1536 + ch0 + 4);
  float4 w2a = *(const float4*)(cw + 3072 + ch0), w2b = *(const float4*)(cw + 3072 + ch0 + 4);
  float4 ba = *(const float4*)(cb + ch0), bb = *(const float4*)(cb + ch0 + 4);
  const float w0[8] = {w0a.x, w0a.y, w0a.z, w0a.w, w0b.x, w0b.y, w0b.z, w0b.w};
  const float w1[8] = {w1a.x, w1a.y, w1a.z, w1a.w, w1b.x, w1b.y, w1b.z, w1b.w};
  const float w2[8] = {w2a.x, w2a.y, w2a.z, w2a.w, w2b.x, w2b.y, w2b.z, w2b.w};
  const float bv[8] = {ba.x, ba.y, ba.z, ba.w, bb.x, bb.y, bb.z, bb.w};
  float xm[8], xc[8], xp[8];
  unpack8(raw[0], xm); unpack8(raw[1], xc);
#pragma unroll
  for (int i = 0; i < R; ++i) {
    unpack8(raw[i + 2], xp);
#pragma unroll
    for (int e = 0; e < 8; ++e) {
      out[i][e] = silu(bv[e] + w0[e] * xm[e] + w1[e] * xc[e] + w2[e] * xp[e]);
      xm[e] = xc[e]; xc[e] = xp[e];
    }
  }
}
DI void phase_ssd_states(const Params& p, int item, unsigned char* smem) {
  u16* xT = (u16*)smem;
  u16* BTs = xT + 64 * 136;
  float* sdt = (float*)(BTs + 2 * 128 * 136);
  float* scs = sdt + 256;
  float* sw = scs + 256;
  float* stot = sw + 256;
  const int tid = threadIdx.x, lane = tid & 63, w = tid >> 6;
  const int l15 = lane & 15, l4 = lane >> 4;
  const SsdItem it = ssd_item(item);
  const int h = it.h, grp = h >> 3;
  const int xchunk = tid & 7, xrg = tid >> 3;
  const int bchunk = tid & 15, brg = tid >> 4;
  u32x4 rawx[4], rawb[6];
  const float rawdt = ssd_load_dt(p, it.row0, h);
  conv_load<2>(p, it.row0, xrg * 2, h * 64 + xchunk * 8, it.has_prev, it.has_next, rawx);
  conv_load<4>(p, it.row0, brg * 4, 1024 + grp * 128 + bchunk * 8, it.has_prev, it.has_next, rawb);
  ssd_prep_dt(p, rawdt, h, sdt, scs, stot);
  if (tid < 256) {
    int d = tid >> 7;
    sw[tid] = sdt[tid] * __expf(stot[d] - scs[tid]);
  }
  __syncthreads();
  {
    {
      float o[2][8];
      conv_compute<2>(p, h * 64 + xchunk * 8, rawx, o);
#pragma unroll
      for (int e = 0; e < 8; ++e) *(unsigned*)(xT + (xchunk * 8 + e) * 136 + xrg * 2) = pk2(o[0][e], o[1][e]);
    }
    {
      float o[4][8];
      conv_compute<4>(p, 1024 + grp * 128 + bchunk * 8, rawb, o);
#pragma unroll
      for (int dd = 0; dd < 2; ++dd) {
        const float s0 = sw[dd * 128 + brg * 4], s1 = sw[dd * 128 + brg * 4 + 1], s2 = sw[dd * 128 + brg * 4 + 2], s3 = sw[dd * 128 + brg * 4 + 3];
#pragma unroll
        for (int e = 0; e < 8; ++e) {
          u32x2 v; v[0] = pk2(o[0][e] * s0, o[1][e] * s1); v[1] = pk2(o[2][e] * s2, o[3][e] * s3);
          *(u32x2*)(BTs + dd * 128 * 136 + (bchunk * 8 + e) * 136 + brg * 4) = v;
        }
      }
    }
  }
  __syncthreads();
  const int d = w >> 2, nq = w & 3;
  f32x4 acc[4][2];
#pragma unroll
  for (int i = 0; i < 4; ++i) { acc[i][0] = (f32x4){0.f, 0.f, 0.f, 0.f}; acc[i][1] = (f32x4){0.f, 0.f, 0.f, 0.f}; }
#pragma unroll
  for (int ks = 0; ks < 4; ++ks) {
    bf16x8 a[4], b[2];
#pragma unroll
    for (int i = 0; i < 4; ++i) a[i] = *(const bf16x8*)(xT + (i * 16 + l15) * 136 + ks * 32 + l4 * 8);
#pragma unroll
    for (int j = 0; j < 2; ++j) b[j] = *(const bf16x8*)(BTs + d * 128 * 136 + (nq * 32 + j * 16 + l15) * 136 + ks * 32 + l4 * 8);
#pragma unroll
    for (int i = 0; i < 4; ++i)
#pragma unroll
      for (int j = 0; j < 2; ++j) acc[i][j] = MFMA16(a[i], b[j], acc[i][j]);
  }
  u16* S = (u16*)((unsigned char*)p.out + OUT_SBUF) + ((size_t)item * 2 + d) * 8192;
#pragma unroll
  for (int i = 0; i < 4; ++i)
#pragma unroll
    for (int j = 0; j < 2; ++j)
#pragma unroll
      for (int r = 0; r < 4; ++r) {
        int pp = i * 16 + l4 * 4 + r, n = nq * 32 + j * 16 + l15;
        S[pp * 128 + n] = f2bf(acc[i][j][r]);
      }
  if (tid < 2) {
    float* cdec = (float*)(p.ws + OFF_CDEC);
    cdec[item * 2 + tid] = __expf(stot[tid]);
  }
  __syncthreads();
}

DI void phase_scan(const Params& p, int t) {
  const int part = t & 1, d = (t >> 1) & 1, h = (t >> 2) & 15, seq = t >> 6;
  const int tid = threadIdx.x;
  const int e0 = part * 4096 + tid * 8;
  const int nc = seq < 32 ? 2 : 32;
  const int cg0 = seq < 32 ? seq * 2 : 64 + (seq - 32) * 32;
  float st[8];
  if (seq < 32) {
#pragma unroll
    for (int e = 0; e < 8; ++e) st[e] = 0.f;
  } else {
    const float* init = p.in[2] + ((((size_t)(seq - 32) * 1 + 0) * 2 + d) * 16 + h) * 8192 + e0;
    float4 a = *(const float4*)init, b = *(const float4*)(init + 4);
    st[0] = a.x; st[1] = a.y; st[2] = a.z; st[3] = a.w; st[4] = b.x; st[5] = b.y; st[6] = b.z; st[7] = b.w;
  }
  u16* Sb = (u16*)((unsigned char*)p.out + OUT_SBUF);
  const float* cdec = (const float*)(p.ws + OFF_CDEC);
  for (int cb0 = 0; cb0 < nc; cb0 += 8) {
    u32x4 vv[8]; float dec[8];
#pragma unroll
    for (int i = 0; i < 8; ++i) {
      if (cb0 + i < nc) {
        const int ci = cb0 + i;
        const int c = d == 0 ? ci : nc - 1 - ci;
        const int item = (cg0 + c) * 16 + h;
        vv[i] = *(const u32x4*)(Sb + ((size_t)item * 2 + d) * 8192 + e0);
        dec[i] = cdec[item * 2 + d];
      }
    }
#pragma unroll
    for (int i = 0; i < 8; ++i) {
      if (cb0 + i < nc) {
        const int ci = cb0 + i;
        const int c = d == 0 ? ci : nc - 1 - ci;
        const int item = (cg0 + c) * 16 + h;
        float sc[8]; unpack8(vv[i], sc);
        *(u32x4*)(Sb + ((size_t)item * 2 + d) * 8192 + e0) = pack8(st);
#pragma unroll
        for (int e = 0; e < 8; ++e) st[e] = st[e] * dec[i] + sc[e];
      }
    }
  }
  if (seq < 32) {
    float* o = p.out + O_ST + ((((size_t)seq * 1 + 0) * 2 + d) * 16 + h) * 8192 + e0;
    *(float4*)o = make_float4(st[0], st[1], st[2], st[3]);
    *(float4*)(o + 4) = make_float4(st[4], st[5], st[6], st[7]);
  }
}


DI void phase_scan_prompt4(const Params& p, int tbase, int stride) {
  const int tid = threadIdx.x;
  u16* Sb = (u16*)((unsigned char*)p.out + OUT_SBUF);
  const float* cdec = (const float*)(p.ws + OFF_CDEC);
  u32x4 vf[4], vs[4]; float dsec[4];
#pragma unroll
  for (int i = 0; i < 4; ++i) {
    const int t = tbase + i * stride;
    const int part = t & 1, d = (t >> 1) & 1, h = (t >> 2) & 15, seq = t >> 6;
    const int e0 = part * 4096 + tid * 8;
    const int cf = d == 0 ? 0 : 1, cs = 1 - cf;
    const int itf = (seq * 2 + cf) * 16 + h, its = (seq * 2 + cs) * 16 + h;
    vf[i] = *(const u32x4*)(Sb + ((size_t)itf * 2 + d) * 8192 + e0);
    vs[i] = *(const u32x4*)(Sb + ((size_t)its * 2 + d) * 8192 + e0);
    dsec[i] = cdec[its * 2 + d];
  }
#pragma unroll
  for (int i = 0; i < 4; ++i) {
    const int t = tbase + i * stride;
    const int part = t & 1, d = (t >> 1) & 1, h = (t >> 2) & 15, seq = t >> 6;
    const int e0 = part * 4096 + tid * 8;
    const int cf = d == 0 ? 0 : 1, cs = 1 - cf;
    const int itf = (seq * 2 + cf) * 16 + h, its = (seq * 2 + cs) * 16 + h;
    float sf[8], ss[8];
    unpack8(vf[i], sf); unpack8(vs[i], ss);
    *(u32x4*)(Sb + ((size_t)itf * 2 + d) * 8192 + e0) = (u32x4){0u, 0u, 0u, 0u};
    *(u32x4*)(Sb + ((size_t)its * 2 + d) * 8192 + e0) = vf[i];
    float* o = p.out + O_ST + ((((size_t)seq * 1 + 0) * 2 + d) * 16 + h) * 8192 + e0;
    *(float4*)o = make_float4(sf[0] * dsec[i] + ss[0], sf[1] * dsec[i] + ss[1], sf[2] * dsec[i] + ss[2], sf[3] * dsec[i] + ss[3]);
    *(float4*)(o + 4) = make_float4(sf[4] * dsec[i] + ss[4], sf[5] * dsec[i] + ss[5], sf[6] * dsec[i] + ss[6], sf[7] * dsec[i] + ss[7]);
  }
}
DI void phase_ssd_out(const Params& p, int item, unsigned char* smem, bool dry) {
  u16* Cs = (u16*)smem;
  u16* Bs = Cs + 128 * 136;
  u16* xT = Bs + 128 * 136;
  u16* St = xT + 64 * 136;
  float* sdt = (float*)(St + 2 * 64 * 136);
  float* scs = sdt + 256;
  float* stot = scs + 256;
  const int tid = threadIdx.x, lane = tid & 63, w = tid >> 6;
  const int l15 = lane & 15, l4 = lane >> 4;
  const SsdItem it = ssd_item(item);
  const int h = it.h, grp = h >> 3;
  const int xchunk = tid & 7, xrg = tid >> 3;
  const int bchunk = tid & 15, brg = tid >> 4;
  u32x4 rawx[4], rawb[6], rawc[6], rawst[4];
  u16 zraw[4][4];
  const float rawdt = ssd_load_dt(p, it.row0, h);
  conv_load<2>(p, it.row0, xrg * 2, h * 64 + xchunk * 8, it.has_prev, it.has_next, rawx);
  conv_load<4>(p, it.row0, brg * 4, 1024 + grp * 128 + bchunk * 8, it.has_prev, it.has_next, rawb);
  conv_load<4>(p, it.row0, brg * 4, 1280 + grp * 128 + bchunk * 8, it.has_prev, it.has_next, rawc);
  {
    const u16* S = (const u16*)((const unsigned char*)p.out + OUT_SBUF) + (size_t)item * 2 * 8192;
#pragma unroll
    for (int v = 0; v < 4; ++v) {
      int id = tid + 512 * v;
      int dd = id >> 10, pp = (id >> 4) & 63, nv = (id & 15) * 8;
      rawst[v] = *(const u32x4*)(S + dd * 8192 + pp * 128 + nv);
    }
  }
  ssd_prep_dt(p, rawdt, h, sdt, scs, stot);
  {
    {
      float o[2][8];
      conv_compute<2>(p, h * 64 + xchunk * 8, rawx, o);
#pragma unroll
      for (int e = 0; e < 8; ++e) *(unsigned*)(xT + (xchunk * 8 + e) * 136 + xrg * 2) = pk2(o[0][e], o[1][e]);
    }
    {
      float o[4][8];
      conv_compute<4>(p, 1024 + grp * 128 + bchunk * 8, rawb, o);
#pragma unroll
      for (int i = 0; i < 4; ++i) *(u32x4*)(Bs + (brg * 4 + i) * 136 + bchunk * 8) = pack8(o[i]);
      conv_compute<4>(p, 1280 + grp * 128 + bchunk * 8, rawc, o);
#pragma unroll
      for (int i = 0; i < 4; ++i) *(u32x4*)(Cs + (brg * 4 + i) * 136 + bchunk * 8) = pack8(o[i]);
    }
#pragma unroll
    for (int v = 0; v < 4; ++v) {
      int id = tid + 512 * v;
      int dd = id >> 10, pp = (id >> 4) & 63, nv = (id & 15) * 8;
      *(u32x4*)(St + dd * 64 * 136 + pp * 136 + nv) = rawst[v];
    }
  }
  __syncthreads();
  {
    const u16* C0z = (const u16*)(p.ws + OFF_C0A);
#pragma unroll
    for (int i = 0; i < 4; ++i)
#pragma unroll
      for (int r = 0; r < 4; ++r)
        zraw[i][r] = C0z[(size_t)(it.row0 + 16 * w + l4 * 4 + r) * LDC0 + h * 64 + i * 16 + l15];
  }
  f32x4 cb[8], af[4], ab[4];
#pragma unroll
  for (int j = 0; j < 8; ++j) cb[j] = (f32x4){0.f, 0.f, 0.f, 0.f};
#pragma unroll
  for (int i = 0; i < 4; ++i) { af[i] = (f32x4){0.f, 0.f, 0.f, 0.f}; ab[i] = (f32x4){0.f, 0.f, 0.f, 0.f}; }
#pragma unroll
  for (int ks = 0; ks < 4; ++ks) {
    bf16x8 a = *(const bf16x8*)(Cs + (16 * w + l15) * 136 + ks * 32 + l4 * 8);
#pragma unroll
    for (int j = 0; j < 8; ++j) {
      bf16x8 b = *(const bf16x8*)(Bs + (j * 16 + l15) * 136 + ks * 32 + l4 * 8);
      cb[j] = MFMA16(b, a, cb[j]);
    }
#pragma unroll
    for (int i = 0; i < 4; ++i) {
      bf16x8 b0 = *(const bf16x8*)(St + (i * 16 + l15) * 136 + ks * 32 + l4 * 8);
      bf16x8 b1 = *(const bf16x8*)(St + 64 * 136 + (i * 16 + l15) * 136 + ks * 32 + l4 * 8);
      af[i] = MFMA16(a, b0, af[i]);
      ab[i] = MFMA16(a, b1, ab[i]);
    }
  }
  __syncthreads();
  f32x4 Y[4];
  {
    const int lrow = 16 * w + l15;
    const float cs0l = scs[lrow], cs1l = scs[128 + lrow];
#pragma unroll
    for (int j = 0; j < 8; ++j) {
      const int s0 = j * 16 + l4 * 4;
      float f[4];
      if (j < w) {
        const float4 c4 = *(const float4*)(scs + s0), d4 = *(const float4*)(sdt + s0);
        f[0] = __expf(cs0l - c4.x) * d4.x; f[1] = __expf(cs0l - c4.y) * d4.y; f[2] = __expf(cs0l - c4.z) * d4.z; f[3] = __expf(cs0l - c4.w) * d4.w;
      } else if (j > w) {
        const float4 c4 = *(const float4*)(scs + 128 + s0), d4 = *(const float4*)(sdt + 128 + s0);
        f[0] = __expf(cs1l - c4.x) * d4.x; f[1] = __expf(cs1l - c4.y) * d4.y; f[2] = __expf(cs1l - c4.z) * d4.z; f[3] = __expf(cs1l - c4.w) * d4.w;
      } else {
        const float4 c4 = *(const float4*)(scs + s0), d4 = *(const float4*)(sdt + s0);
        const float4 e4 = *(const float4*)(scs + 128 + s0), g4 = *(const float4*)(sdt + 128 + s0);
        const float c0[4] = {c4.x, c4.y, c4.z, c4.w}, d0[4] = {d4.x, d4.y, d4.z, d4.w};
        const float c1[4] = {e4.x, e4.y, e4.z, e4.w}, d1[4] = {g4.x, g4.y, g4.z, g4.w};
#pragma unroll
        for (int jj = 0; jj < 4; ++jj) {
          const int sidx = s0 + jj;
          float v;
          if (lrow > sidx) v = __expf(cs0l - c0[jj]) * d0[jj];
          else if (lrow < sidx) v = __expf(cs1l - c1[jj]) * d1[jj];
          else v = d0[jj] + d1[jj];
          f[jj] = v;
        }
      }
      u32x2 o; o[0] = pk2(cb[j][0] * f[0], cb[j][1] * f[1]); o[1] = pk2(cb[j][2] * f[2], cb[j][3] * f[3]);
      *(u32x2*)(Bs + lrow * 136 + s0) = o;
    }
#pragma unroll
    for (int r = 0; r < 4; ++r) {
      const int l = 16 * w + l4 * 4 + r;
      float e0 = __expf(scs[l]), e1 = __expf(scs[128 + l]);
#pragma unroll
      for (int i = 0; i < 4; ++i) Y[i][r] = af[i][r] * e0 + ab[i][r] * e1;
    }
  }
  __syncthreads();
#pragma unroll
  for (int ks = 0; ks < 4; ++ks) {
    bf16x8 a = *(const bf16x8*)(Bs + (16 * w + l15) * 136 + ks * 32 + l4 * 8);
#pragma unroll
    for (int i = 0; i < 4; ++i) {
      bf16x8 b = *(const bf16x8*)(xT + (i * 16 + l15) * 136 + ks * 32 + l4 * 8);
      Y[i] = MFMA16(a, b, Y[i]);
    }
  }
  {
    const u16* C0 = (const u16*)(p.ws + OFF_C0A);
    u16* YAB = dry ? (u16*)(p.ws + OFF_DUMMY) + (size_t)(blockIdx.x & 15) * 400000 - (size_t)it.row0 * 2048 : (u16*)((unsigned char*)p.out + OUT_YB);
    const float dsk = p.in[16][h] + p.in[16][16 + h];
    float ss[4] = {0.f, 0.f, 0.f, 0.f};
#pragma unroll
    for (int i = 0; i < 4; ++i) {
      const int pp = i * 16 + l15;
#pragma unroll
      for (int r = 0; r < 4; ++r) {
        const int l = 16 * w + l4 * 4 + r;
        const size_t off = (size_t)(it.row0 + l) * LDC0 + h * 64 + pp;
        float xv = bf2f(xT[pp * 136 + l]);
        float y = Y[i][r] + xv * dsk;
        float z = bf2f(zraw[i][r]);
        float gv = y * silu(z);
        YAB[(size_t)(it.row0 + l) * 2048 + h * 64 + pp] = f2bf(gv);
        ss[r] += gv * gv;
      }
    }
    float* rss = (float*)(p.ws + OFF_ROWSS);
#pragma unroll
    for (int r = 0; r < 4; ++r) {
      float s = ss[r];
      s += __shfl_xor(s, 1); s += __shfl_xor(s, 2); s += __shfl_xor(s, 4); s += __shfl_xor(s, 8);
      if (l15 == 0) rss[(size_t)(it.row0 + 16 * w + l4 * 4 + r) * 16 + h] = s;
    }
  }
  __syncthreads();
}


typedef const __attribute__((address_space(3))) char* lds_cptr;
template <int MASK, int PART>
DI void hy_seg(int dlo, int dhi, int L, int A, const u16* hr, const u16* vx, const int (&ncol)[4], const int (&acol)[4],
               int l31, int kh, f32x16 (&acc)[4]) {
  const lds_cptr hr3 = (lds_cptr)hr;
  const lds_cptr vx3 = (lds_cptr)vx;
  lds_cptr aaddr = hr3 + 2 * (L - 1 - 32 * dlo - l31 + 8 * kh);
  lds_cptr baddr[4], bsafe[4]; int asrc[4];
#pragma unroll
  for (int j = 0; j < 4; ++j) {
    bsafe[j] = vx3 + ncol[j] * 80 + 16 * kh;
    baddr[j] = bsafe[j] - dlo * 80;
    asrc[j] = acol[j] - dlo;
  }
#pragma unroll 1
  for (int d = dlo; d <= dhi; ++d) {
    bf16x8 bfr[4][2];
#pragma unroll
    for (int j = 0; j < 4; ++j) {
      if (MASK & (1 << j)) {
        if (PART & (1 << j)) {
          const bool valid = (unsigned)asrc[j] < (unsigned)A;
          const lds_cptr ba = valid ? baddr[j] : bsafe[j];
#pragma unroll
          for (int khalf = 0; khalf < 2; ++khalf) {
            bf16x8 t = *(const __attribute__((address_space(3))) bf16x8*)(ba + 32 * khalf);
            if (!valid) t = (bf16x8){0, 0, 0, 0, 0, 0, 0, 0};
            bfr[j][khalf] = t;
          }
        } else {
#pragma unroll
          for (int khalf = 0; khalf < 2; ++khalf)
            bfr[j][khalf] = *(const __attribute__((address_space(3))) bf16x8*)(baddr[j] + 32 * khalf);
        }
      }
    }
    unsigned e0, e1, e2, e3, e4, e5, e6, e7, e8, e9, e10, e11, e12, e13, e14, e15;
    asm volatile(
        "ds_read_u16 %0, %16\n\tds_read_u16 %1, %16 offset:2\n\t"
        "ds_read_u16 %2, %16 offset:4\n\tds_read_u16 %3, %16 offset:6\n\t"
        "ds_read_u16 %4, %16 offset:8\n\tds_read_u16 %5, %16 offset:10\n\t"
        "ds_read_u16 %6, %16 offset:12\n\tds_read_u16 %7, %16 offset:14\n\t"
        "ds_read_u16 %8, %16 offset:32\n\tds_read_u16 %9, %16 offset:34\n\t"
        "ds_read_u16 %10, %16 offset:36\n\tds_read_u16 %11, %16 offset:38\n\t"
        "ds_read_u16 %12, %16 offset:40\n\tds_read_u16 %13, %16 offset:42\n\t"
        "ds_read_u16 %14, %16 offset:44\n\tds_read_u16 %15, %16 offset:46\n\t"
        "s_waitcnt lgkmcnt(0)"
        : "=&v"(e0), "=&v"(e1), "=&v"(e2), "=&v"(e3), "=&v"(e4), "=&v"(e5), "=&v"(e6), "=&v"(e7),
          "=&v"(e8), "=&v"(e9), "=&v"(e10), "=&v"(e11), "=&v"(e12), "=&v"(e13), "=&v"(e14), "=&v"(e15)
        : "v"(aaddr) : "memory");
    bf16x8 af[2];
    { u32x4 q0 = {e0 | (e1 << 16), e2 | (e3 << 16), e4 | (e5 << 16), e6 | (e7 << 16)};
      u32x4 q1 = {e8 | (e9 << 16), e10 | (e11 << 16), e12 | (e13 << 16), e14 | (e15 << 16)};
      af[0] = __builtin_bit_cast(bf16x8, q0); af[1] = __builtin_bit_cast(bf16x8, q1); }
#pragma unroll
    for (int khalf = 0; khalf < 2; ++khalf)
#pragma unroll
      for (int j = 0; j < 4; ++j)
        if (MASK & (1 << j)) acc[j] = MFMA32(af[khalf], bfr[j][khalf], acc[j]);
    aaddr -= 64;
#pragma unroll
    for (int j = 0; j < 4; ++j) { baddr[j] -= 80; asrc[j] -= 1; }
  }
}

DI void phase_hyena(const Params& p, int it, unsigned char* smem, bool dry) {
  const int cfg = it < 256 ? 1 : 0;
  const int c0 = (it & 255) * 4;
  const int L = cfg ? 4096 : 256;
  const int A = L >> 5;
  const int lgA = cfg ? 7 : 3;
  const int rowbase = cfg ? NPROMPT : 0;
  u16* vxs = (u16*)smem;
  u16* hrs = vxs + 4 * 10240;
  int tid = threadIdx.x;
  asm volatile("" : "+v"(tid));
  const int lane = tid & 63, w = tid >> 6;
  const u16* UT = (const u16*)(p.ws + OFF_UT);
  const float* cw = p.in[18]; const float* cbv = p.in[19];
  {
    const u16* HF = (const u16*)((const unsigned char*)p.out + (cfg ? OUT_HF4096 : OUT_HF256));
    const int nv = (2 * L) >> 3;
    const int lgnv = cfg ? 10 : 6;
    {
      u32x4 fv[8];
#pragma unroll
      for (int it8 = 0; it8 < 8; ++it8) {
        const int id = tid + it8 * NT;
        fv[it8] = (u32x4){0u, 0u, 0u, 0u};
        if (id < 4 * nv) { int chh = id >> lgnv, v8 = id & (nv - 1); fv[it8] = *(const u32x4*)(HF + (size_t)(c0 + chh) * 2 * L + v8 * 8); }
      }
#pragma unroll
      for (int it8 = 0; it8 < 8; ++it8) {
        const int id = tid + it8 * NT;
        if (id < 4 * nv) { int chh = id >> lgnv, v8 = id & (nv - 1); *(u32x4*)(hrs + chh * 2 * L + v8 * 8) = fv[it8]; }
      }
    }
#pragma unroll 1
    for (int hb4 = 0; hb4 < 2; ++hb4) {
    u32x4 rv[4][2]; float hm[4][2], hp[4][2];
#pragma unroll
    for (int it8 = 0; it8 < 4; ++it8) {
      const int id = tid + (hb4 * 4 + it8) * NT;
      const int chh = id >> 10, blk8 = id & 1023;
      const int pos = blk8 * 8, tl = pos & (L - 1);
#pragma unroll
      for (int which = 1; which <= 2; ++which) {
        const u16* q = UT + (size_t)(which * 1024 + c0 + chh) * UTP + rowbase + pos;
        rv[it8][which - 1] = *(const u32x4*)q;
        hm[it8][which - 1] = (tl > 0) ? bf2f(q[-1]) : 0.f;
        hp[it8][which - 1] = (tl + 8 < L) ? bf2f(q[8]) : 0.f;
      }
    }
#pragma unroll
    for (int it8 = 0; it8 < 4; ++it8) {
      const int id = tid + (hb4 * 4 + it8) * NT;
      const int chh = id >> 10, blk8 = id & 1023;
      const int pos = blk8 * 8;
      float res[8];
#pragma unroll
      for (int e = 0; e < 8; ++e) res[e] = 1.f;
#pragma unroll
      for (int which = 1; which <= 2; ++which) {
        const int uc = which * 1024 + c0 + chh;
        float xv[10];
        unpack8(rv[it8][which - 1], xv + 1);
        xv[0] = hm[it8][which - 1]; xv[9] = hp[it8][which - 1];
        const float w0 = cw[uc], w1 = cw[3072 + uc], w2 = cw[6144 + uc], bb = cbv[uc];
#pragma unroll
        for (int e = 0; e < 8; ++e) res[e] *= (bb + w0 * xv[e] + w1 * xv[e + 1] + w2 * xv[e + 2]);
      }
      const int n = pos >> 5, k = pos & 31;
      *(u32x4*)(vxs + chh * 10240 + n * 40 + k) = pack8(res);
    }
    }
  }
  __syncthreads();
  const int ch = w >> 1, wv = w & 1;
  const int l31 = lane & 31, kh = lane >> 5;
  const u16* vx = vxs + ch * 10240;
  const u16* hr = hrs + ch * 2 * L;
  f32x16 acc[4];
#pragma unroll
  for (int j = 0; j < 4; ++j)
#pragma unroll
    for (int r = 0; r < 16; ++r) acc[j][r] = 0.f;
  int ncol[4], acol[4];
#pragma unroll
  for (int j = 0; j < 4; ++j) { ncol[j] = 128 * wv + 32 * j + l31; acol[j] = ncol[j] & (A - 1); }
  if (!(dry && REP_SUB == 4)) {
  if (cfg) {
    hy_seg<1, 1>(-127, -96, L, A, hr, vx, ncol, acol, l31, kh, acc);
    hy_seg<3, 2>(-95, -64, L, A, hr, vx, ncol, acol, l31, kh, acc);
    hy_seg<7, 4>(-63, -32, L, A, hr, vx, ncol, acol, l31, kh, acc);
    hy_seg<15, 9>(-31, 31, L, A, hr, vx, ncol, acol, l31, kh, acc);
    hy_seg<14, 2>(32, 63, L, A, hr, vx, ncol, acol, l31, kh, acc);
    hy_seg<12, 4>(64, 95, L, A, hr, vx, ncol, acol, l31, kh, acc);
    hy_seg<8, 8>(96, 127, L, A, hr, vx, ncol, acol, l31, kh, acc);
  } else {
    hy_seg<15, 15>(-7, 7, L, A, hr, vx, ncol, acol, l31, kh, acc);
  }
  }
  {
    const float hb = p.in[26][c0 + ch];
#pragma unroll
    for (int j = 0; j < 4; ++j) {
      const int n = ncol[j];
#pragma unroll
      for (int q = 0; q < 4; ++q) {
        u32x2 vr = *(const u32x2*)(vx + n * 40 + 8 * q + 4 * kh);
        acc[j][4 * q + 0] += bflo(vr[0]) * hb; acc[j][4 * q + 1] += bfhi(vr[0]) * hb;
        acc[j][4 * q + 2] += bflo(vr[1]) * hb; acc[j][4 * q + 3] += bfhi(vr[1]) * hb;
      }
    }
  }
  __syncthreads();
  float* FL = (float*)smem;
  {
#pragma unroll
    for (int j = 0; j < 4; ++j) {
      const int n = ncol[j];
#pragma unroll
      for (int q = 0; q < 4; ++q) {
        const int pos = 32 * n + 8 * q + 4 * kh;
        *(float4*)(FL + ch * 9216 + pos + (pos >> 5) * 4) = make_float4(acc[j][4 * q], acc[j][4 * q + 1], acc[j][4 * q + 2], acc[j][4 * q + 3]);
      }
    }
  }
  __syncthreads();
  {
    int e_tid = threadIdx.x;
    asm volatile("" : "+v"(e_tid));
    u32x4 xr[8], gr[8]; float xm[8], xp[8];
#pragma unroll
    for (int it8 = 0; it8 < 8; ++it8) {
      const int c = c0 + (it8 >> 1);
      const int pos = ((e_tid + it8 * NT) & 1023) * 8;
      const int tl = pos & (L - 1);
      const u16* x0row = UT + (size_t)c * UTP + rowbase;
      const u16* grow = UT + (size_t)(3072 + c) * UTP + rowbase;
      xr[it8] = *(const u32x4*)(x0row + pos);
      gr[it8] = *(const u32x4*)(grow + pos);
      xm[it8] = tl > 0 ? bf2f(x0row[pos - 1]) : 0.f;
      xp[it8] = (tl + 8 < L) ? bf2f(x0row[pos + 8]) : 0.f;
    }
#pragma unroll
    for (int it8 = 0; it8 < 8; ++it8) {
      const int chh = it8 >> 1;
      const int c = c0 + chh;
      const int pos = ((e_tid + it8 * NT) & 1023) * 8;
      u16* groww = dry ? (u16*)(p.ws + OFF_DUMMY) + (size_t)blockIdx.x * 32768 + chh * 8192
                       : (u16*)(p.ws + OFF_UT) + (size_t)(3072 + c) * UTP + rowbase;
      float xv[10], gv[8];
      unpack8(xr[it8], xv + 1); unpack8(gr[it8], gv);
      xv[0] = xm[it8]; xv[9] = xp[it8];
      const float w0 = cw[c], w1 = cw[3072 + c], w2 = cw[6144 + c], bb = cbv[c];
      const float* fl = FL + chh * 9216 + pos + (pos >> 5) * 4;
      const float4 a0 = *(const float4*)fl, a1 = *(const float4*)(fl + 4);
      const float av[8] = {a0.x, a0.y, a0.z, a0.w, a1.x, a1.y, a1.z, a1.w};
      float y[8];
#pragma unroll
      for (int e = 0; e < 8; ++e) {
        float x0 = bb + w0 * xv[e] + w1 * xv[e + 1] + w2 * xv[e + 2];
        y[e] = x0 * av[e] * silu(gv[e]);
      }
      *(u32x4*)(groww + pos) = pack8(y);
      __builtin_amdgcn_sched_barrier(0);
    }
  }
  (void)lgA;
  __syncthreads();
}

#define VSP 72
typedef __attribute__((ext_vector_type(4))) short v4i16_t;
DI float dpp_rowmax(float v) {
  v = fmaxf(v, __builtin_bit_cast(float, __builtin_amdgcn_update_dpp(0, __builtin_bit_cast(int, v), 0x128, 0xf, 0xf, false)));
  v = fmaxf(v, __builtin_bit_cast(float, __builtin_amdgcn_update_dpp(0, __builtin_bit_cast(int, v), 0x124, 0xf, 0xf, false)));
  v = fmaxf(v, __builtin_bit_cast(float, __builtin_amdgcn_update_dpp(0, __builtin_bit_cast(int, v), 0x122, 0xf, 0xf, false)));
  v = fmaxf(v, __builtin_bit_cast(float, __builtin_amdgcn_update_dpp(0, __builtin_bit_cast(int, v), 0x121, 0xf, 0xf, false)));
  return v;
}
DI float dpp_rowsum(float v) {
  v += __builtin_bit_cast(float, __builtin_amdgcn_update_dpp(0, __builtin_bit_cast(int, v), 0x128, 0xf, 0xf, false));
  v += __builtin_bit_cast(float, __builtin_amdgcn_update_dpp(0, __builtin_bit_cast(int, v), 0x124, 0xf, 0xf, false));
  v += __builtin_bit_cast(float, __builtin_amdgcn_update_dpp(0, __builtin_bit_cast(int, v), 0x122, 0xf, 0xf, false));
  v += __builtin_bit_cast(float, __builtin_amdgcn_update_dpp(0, __builtin_bit_cast(int, v), 0x121, 0xf, 0xf, false));
  return v;
}
#define OUT_CKV 0ul
DI void phase_attn(const Params& p, int item, unsigned char* smem, bool dry) {
  u16* VS = (u16*)smem;
  u16* Pb = VS + 832 * VSP;
  float* rp = (float*)(Pb + 8 * 16 * 72);
  int tid = threadIdx.x;
  asm volatile("" : "+v"(tid));
  const int lane = tid & 63, w = tid >> 6;
  const int l15 = lane & 15, l4 = lane >> 4;
  const u16* C1 = (const u16*)(p.ws + OFF_C1);
  const u16* CK = (const u16*)((const unsigned char*)p.out + OUT_CKV);
  const u16* CV = CK + 524288;
  const bool lat = item < 1024;
  int b, h, myr = 0, rows0w = 0, vrow0 = 0, nvrows = 0, qbase, jq = w & 3;
  if (lat) {
    b = item >> 9; h = (item >> 5) & 15; const int r0 = (item & 31) * 2;
    myr = r0 + (w >> 2);
    rows0w = min(max(myr - 4, 0), 56);
    vrow0 = min(max(r0 - 4, 0), 56);
    nvrows = min(9, 64 - vrow0);
    qbase = NPROMPT + b * 4096 + myr * 64 + jq * 16;
  } else {
    const int q = item - 1024; b = q >> 5; h = (q >> 1) & 15;
    qbase = b * 256 + (q & 1) * 128 + w * 16;
  }
  const int cstart = min(max(16 * jq - 8, 0), 32);
  const int ntile = lat ? 8 : 4;
  bf16x8 qa[2];
#pragma unroll
  for (int ks = 0; ks < 2; ++ks) qa[ks] = *(const bf16x8*)(C1 + (size_t)(qbase + l15) * LDC1 + h * 64 + ks * 32 + l4 * 8);
  auto loadk = [&](int tt, bf16x8 (&kb)[4][2]) {
#pragma unroll
    for (int jt = 0; jt < 4; ++jt) {
      const u16* src;
      if (lat) {
        if (tt < 4) src = C1 + (size_t)(NPROMPT + b * 4096 + (rows0w + tt * 2 + (jt >> 1)) * 64 + cstart + (jt & 1) * 16 + l15) * LDC1 + 1024 + h * 64;
        else src = CK + ((size_t)(b * 16 + h) * 256 + (tt - 4) * 64 + jt * 16 + l15) * 64;
      } else {
        src = C1 + (size_t)(b * 256 + tt * 64 + jt * 16 + l15) * LDC1 + 1024 + h * 64;
      }
#pragma unroll
      for (int ks = 0; ks < 2; ++ks) kb[jt][ks] = *(const bf16x8*)(src + ks * 32 + l4 * 8);
    }
  };
  bf16x8 kn[4][2], kn2[4][2];
  loadk(0, kn);
  loadk(1, kn2);
  u16 graw[4][4];
#pragma unroll
  for (int r = 0; r < 4; ++r)
#pragma unroll
    for (int i = 0; i < 4; ++i)
      graw[r][i] = C1[(size_t)(qbase + l4 * 4 + r) * LDC1 + 3072 + h * 64 + i * 16 + l15];
  {
    const int nloc = lat ? nvrows * 64 : 256;
    const int keyrow0 = lat ? NPROMPT + b * 4096 + vrow0 * 64 : b * 256;
    u32x4 vv[9], cvv[4];
#pragma unroll
    for (int i = 0; i < 9; ++i) {
      const int id = tid + i * NT;
      vv[i] = (u32x4){0u, 0u, 0u, 0u};
      if (id < nloc * 8) { int key = id >> 3, d0 = (id & 7) * 8; vv[i] = *(const u32x4*)(C1 + (size_t)(keyrow0 + key) * LDC1 + 2048 + h * 64 + d0); }
    }
    if (lat) {
#pragma unroll
      for (int i = 0; i < 4; ++i) {
        const int id = tid + i * NT; int key = id >> 3, d0 = (id & 7) * 8;
        cvv[i] = *(const u32x4*)(CV + ((size_t)(b * 16 + h) * 256 + key) * 64 + d0);
      }
    }
#pragma unroll
    for (int i = 0; i < 9; ++i) {
      const int id = tid + i * NT;
      if (id < nloc * 8) { int key = id >> 3, d0 = (id & 7) * 8; *(u32x4*)(VS + key * VSP + d0) = vv[i]; }
    }
    if (lat) {
#pragma unroll
      for (int i = 0; i < 4; ++i) {
        const int id = tid + i * NT; int key = id >> 3, d0 = (id & 7) * 8;
        *(u32x4*)(VS + (576 + key) * VSP + d0) = cvv[i];
      }
      for (int id = tid; id < 465; id += NT) rp[id] = p.in[29][h * 465 + id] * 1.4426950408889634f;
    }
  }
  __syncthreads();
  float mrow[4], lrow[4];
  f32x4 O[4];
#pragma unroll
  for (int r = 0; r < 4; ++r) { mrow[r] = -1e30f; lrow[r] = 0.f; }
#pragma unroll
  for (int i = 0; i < 4; ++i) O[i] = (f32x4){0.f, 0.f, 0.f, 0.f};
  u16* Pw = Pb + w * 16 * 72;
  const __attribute__((address_space(3))) char* vs3 = (const __attribute__((address_space(3))) char*)VS;
  int dcv[2][4]; bool okv[2][4];
#pragma unroll
  for (int hf = 0; hf < 2; ++hf)
#pragma unroll
    for (int r = 0; r < 4; ++r) {
      const int kcn = cstart + hf * 16 + l15;
      const int qc = jq * 16 + l4 * 4 + r;
      const int col0 = min(max(qc - 8, 0), 48);
      dcv[hf][r] = min(max(kcn - qc + 15, 0), 30);
      okv[hf][r] = (kcn >= col0) && (kcn < col0 + 16);
    }
  auto tile = [&](const int tt, bf16x8 (&kb)[4][2]) {
    const bool local = lat && tt < 4;
    f32x4 S[4];
#pragma unroll
    for (int jt = 0; jt < 4; ++jt) {
      S[jt] = (f32x4){0.f, 0.f, 0.f, 0.f};
      S[jt] = MFMA16(qa[0], kb[jt][0], S[jt]);
      S[jt] = MFMA16(qa[1], kb[jt][1], S[jt]);
    }
    if (tt + 2 < ntile) loadk(tt + 2, kb);
    float sv[4][4];
#pragma unroll
    for (int jt = 0; jt < 4; ++jt)
#pragma unroll
      for (int r = 0; r < 4; ++r) {
        float s = S[jt][r] * 0.18033688011112042f;
        if (local) {
          const int dr = rows0w + tt * 2 + (jt >> 1) - myr + 7;
          s += rp[dr * 31 + dcv[jt & 1][r]];
          if (!okv[jt & 1][r]) s = -INFINITY;
        }
        sv[jt][r] = s;
      }
    float alpha[4];
#pragma unroll
    for (int r = 0; r < 4; ++r) {
      float mx = fmaxf(fmaxf(sv[0][r], sv[1][r]), fmaxf(sv[2][r], sv[3][r]));
      mx = dpp_rowmax(mx);
      float mn = fmaxf(mrow[r], mx);
      alpha[r] = __builtin_amdgcn_exp2f(mrow[r] - mn);
      mrow[r] = mn;
      float ps = 0.f;
#pragma unroll
      for (int jt = 0; jt < 4; ++jt) {
        float pv = __builtin_amdgcn_exp2f(sv[jt][r] - mn);
        ps += pv;
        Pw[(l4 * 4 + r) * 72 + jt * 16 + l15] = f2bf(pv);
      }
      lrow[r] = lrow[r] * alpha[r] + ps;
    }
#pragma unroll
    for (int i = 0; i < 4; ++i)
#pragma unroll
      for (int r = 0; r < 4; ++r) O[i][r] *= alpha[r];
    asm volatile("s_waitcnt lgkmcnt(0)" ::: "memory");
#pragma unroll
    for (int ks2 = 0; ks2 < 2; ++ks2) {
      bf16x8 pa = *(const bf16x8*)(Pw + l15 * 72 + ks2 * 32 + l4 * 8);
      int keyoff;
      if (lat) keyoff = tt < 4 ? (rows0w - vrow0 + tt * 2 + ks2) * 64 + cstart : 576 + (tt - 4) * 64 + ks2 * 32;
      else keyoff = tt * 64 + ks2 * 32;
#pragma unroll
      for (int i = 0; i < 4; ++i) {
        const int rowa = keyoff + 8 * l4 + (l15 >> 2);
        const int cola = i * 16 + 4 * (l15 & 3);
        v4i16_t lo = __builtin_amdgcn_ds_read_tr16_b64_v4i16((__attribute__((address_space(3))) v4i16_t*)(vs3 + (rowa * VSP + cola) * 2));
        v4i16_t hi = __builtin_amdgcn_ds_read_tr16_b64_v4i16((__attribute__((address_space(3))) v4i16_t*)(vs3 + ((rowa + 4) * VSP + cola) * 2));
        bf16x8 vb = __builtin_shufflevector(lo, hi, 0, 1, 2, 3, 4, 5, 6, 7);
        O[i] = MFMA16(pa, vb, O[i]);
      }
    }
    asm volatile("s_waitcnt lgkmcnt(0)" ::: "memory");
  };
#pragma unroll 1
  for (int tt = 0; tt < ntile; tt += 2) { tile(tt, kn); tile(tt + 1, kn2); }
  {
    u16* C1w = dry ? (u16*)(p.ws + OFF_DUMMY) + (size_t)(blockIdx.x & 15) * 300000 + (size_t)w * 16 * LDC1 - (size_t)qbase * LDC1 : (u16*)(p.ws + OFF_C1);
#pragma unroll
    for (int r = 0; r < 4; ++r) {
      const float inv = 1.f / dpp_rowsum(lrow[r]);
      const int row = qbase + l4 * 4 + r;
#pragma unroll
      for (int i = 0; i < 4; ++i) {
        const int dcol = h * 64 + i * 16 + l15;
        C1w[(size_t)row * LDC1 + dcol] = f2bf(O[i][r] * inv * silu(bf2f(graw[r][i])));
      }
    }
  }
  __syncthreads();
}

DI void phase_ckv(const Params& p, int t) {
  const int id = t * NT + threadIdx.x;
  const int arr = id >> 16, v = id & 65535;
  const float* src = p.in[3 + arr] + (size_t)v * 8;
  float4 a = *(const float4*)src, c = *(const float4*)(src + 4);
  float f[8] = {a.x, a.y, a.z, a.w, c.x, c.y, c.z, c.w};
  u16* dst = (u16*)((unsigned char*)p.out + OUT_CKV) + (size_t)arr * 524288 + (size_t)v * 8;
  *(u32x4*)dst = pack8(f);
}


DI void phase_ssd_out_grp(const Params& p, int item, unsigned char* smem, bool dry) {
  u16* Cs = (u16*)smem;
  u16* Bs = Cs + 128 * 136;
  u16* xT = Bs + 128 * 136;
  u16* St = xT + 64 * 136;
  float* sdt = (float*)(St + 2 * 64 * 136);
  float* scs = sdt + 2048;
  int tid = threadIdx.x;
  asm volatile("" : "+v"(tid));
  const int lane = tid & 63, w = tid >> 6;
  const int l15 = lane & 15, l4 = lane >> 4;
  const int cgi = item >> 1, grp = item & 1;
  int row0, has_prev, has_next;
  if (cgi < 64) { int seq = cgi >> 1, c = cgi & 1; row0 = seq * 256 + c * 128; has_prev = c > 0; has_next = c < 1; }
  else { int q = cgi - 64; int seq = q >> 5, c = q & 31; row0 = NPROMPT + seq * 4096 + c * 128; has_prev = c > 0; has_next = c < 31; }
  const u16* C0 = (const u16*)(p.ws + OFF_C0A);
  const int xchunk = tid & 7, xrg = tid >> 3;
  const int bchunk = tid & 15, brg = tid >> 4;
  u32x4 rawb[6], rawc[6];
  conv_load<4>(p, row0, brg * 4, 1024 + grp * 128 + bchunk * 8, has_prev, has_next, rawb);
  conv_load<4>(p, row0, brg * 4, 1280 + grp * 128 + bchunk * 8, has_prev, has_next, rawc);
  float rdt[4];
#pragma unroll
  for (int i = 0; i < 4; ++i) {
    const int id = tid + i * NT; const int h8 = id >> 8, d = (id >> 7) & 1, l = id & 127;
    rdt[i] = bf2f(C0[(size_t)(row0 + l) * LDC0 + 2560 + d * 16 + grp * 8 + h8]);
  }
#pragma unroll
  for (int i = 0; i < 4; ++i) {
    const int id = tid + i * NT; const int h8 = id >> 8, d = (id >> 7) & 1;
    const int hh = grp * 8 + h8;
    float x = rdt[i] + p.in[14][d * 16 + hh];
    float dt = x > 20.f ? x : log1pf(expf(x));
    float a = -expf(p.in[15][d * 16 + hh]);
    sdt[id] = dt; scs[id] = a * dt;
  }
  __syncthreads();
#pragma unroll
  for (int k = 0; k < 2; ++k) {
    const int sq = 2 * w + k; const int d = sq & 1;
    float* base = scs + sq * 128;
    int p0 = d == 0 ? 2 * lane : 127 - 2 * lane;
    int p1 = d == 0 ? 2 * lane + 1 : 126 - 2 * lane;
    float v0 = base[p0], v1 = base[p1];
    float sacc = v0 + v1;
#pragma unroll
    for (int off = 1; off < 64; off <<= 1) {
      float tv = __shfl_up(sacc, off);
      if (lane >= off) sacc += tv;
    }
    float excl = sacc - (v0 + v1);
    base[p0] = excl + v0;
    base[p1] = excl + v0 + v1;
  }
  {
    float o[4][8];
    conv_compute<4>(p, 1024 + grp * 128 + bchunk * 8, rawb, o);
#pragma unroll
    for (int i = 0; i < 4; ++i) *(u32x4*)(Bs + (brg * 4 + i) * 136 + bchunk * 8) = pack8(o[i]);
    conv_compute<4>(p, 1280 + grp * 128 + bchunk * 8, rawc, o);
#pragma unroll
    for (int i = 0; i < 4; ++i) *(u32x4*)(Cs + (brg * 4 + i) * 136 + bchunk * 8) = pack8(o[i]);
  }
  __syncthreads();
  f32x4 cb[8];
#pragma unroll
  for (int j = 0; j < 8; ++j) cb[j] = (f32x4){0.f, 0.f, 0.f, 0.f};
#pragma unroll
  for (int ks = 0; ks < 4; ++ks) {
    bf16x8 a = *(const bf16x8*)(Cs + (16 * w + l15) * 136 + ks * 32 + l4 * 8);
#pragma unroll
    for (int j = 0; j < 8; ++j) {
      bf16x8 b = *(const bf16x8*)(Bs + (j * 16 + l15) * 136 + ks * 32 + l4 * 8);
      cb[j] = MFMA16(b, a, cb[j]);
    }
  }
  __syncthreads();
  const int lrow = 16 * w + l15;
#pragma unroll 1
  for (int h8 = 0; h8 < 8; ++h8) {
    const int h = grp * 8 + h8;
    const float* sdh = sdt + h8 * 256;
    const float* sch = scs + h8 * 256;
    u32x4 rawx[4], rawst[4];
    u16 zraw[4][4];
    conv_load<2>(p, row0, xrg * 2, h * 64 + xchunk * 8, has_prev, has_next, rawx);
    {
      const u16* S = (const u16*)((const unsigned char*)p.out + OUT_SBUF) + (size_t)(cgi * 16 + h) * 2 * 8192;
#pragma unroll
      for (int v = 0; v < 4; ++v) {
        int id = tid + 512 * v;
        int dd = id >> 10, pp = (id >> 4) & 63, nv = (id & 15) * 8;
        rawst[v] = *(const u32x4*)(S + dd * 8192 + pp * 128 + nv);
      }
#pragma unroll
      for (int i = 0; i < 4; ++i)
#pragma unroll
        for (int r = 0; r < 4; ++r)
          zraw[i][r] = C0[(size_t)(row0 + 16 * w + l4 * 4 + r) * LDC0 + h * 64 + i * 16 + l15];
    }
    {
      const float cs0l = sch[lrow], cs1l = sch[128 + lrow];
#pragma unroll
      for (int j = 0; j < 8; ++j) {
        const int s0 = j * 16 + l4 * 4;
        float f[4];
        if (j < w) {
          const float4 c4 = *(const float4*)(sch + s0), d4 = *(const float4*)(sdh + s0);
          f[0] = __expf(cs0l - c4.x) * d4.x; f[1] = __expf(cs0l - c4.y) * d4.y; f[2] = __expf(cs0l - c4.z) * d4.z; f[3] = __expf(cs0l - c4.w) * d4.w;
        } else if (j > w) {
          const float4 c4 = *(const float4*)(sch + 128 + s0), d4 = *(const float4*)(sdh + 128 + s0);
          f[0] = __expf(cs1l - c4.x) * d4.x; f[1] = __expf(cs1l - c4.y) * d4.y; f[2] = __expf(cs1l - c4.z) * d4.z; f[3] = __expf(cs1l - c4.w) * d4.w;
        } else {
          const float4 c4 = *(const float4*)(sch + s0), d4 = *(const float4*)(sdh + s0);
          const float4 e4 = *(const float4*)(sch + 128 + s0), g4 = *(const float4*)(sdh + 128 + s0);
          const float c0[4] = {c4.x, c4.y, c4.z, c4.w}, d0[4] = {d4.x, d4.y, d4.z, d4.w};
          const float c1[4] = {e4.x, e4.y, e4.z, e4.w}, d1[4] = {g4.x, g4.y, g4.z, g4.w};
#pragma unroll
          for (int jj = 0; jj < 4; ++jj) {
            const int sidx = s0 + jj;
            float v;
            if (lrow > sidx) v = __expf(cs0l - c0[jj]) * d0[jj];
            else if (lrow < sidx) v = __expf(cs1l - c1[jj]) * d1[jj];
            else v = d0[jj] + d1[jj];
            f[jj] = v;
          }
        }
        u32x2 o; o[0] = pk2(cb[j][0] * f[0], cb[j][1] * f[1]); o[1] = pk2(cb[j][2] * f[2], cb[j][3] * f[3]);
        *(u32x2*)(Bs + lrow * 136 + s0) = o;
      }
    }
    {
      float o[2][8];
      conv_compute<2>(p, h * 64 + xchunk * 8, rawx, o);
#pragma unroll
      for (int e = 0; e < 8; ++e) *(unsigned*)(xT + (xchunk * 8 + e) * 136 + xrg * 2) = pk2(o[0][e], o[1][e]);
#pragma unroll
      for (int v = 0; v < 4; ++v) {
        int id = tid + 512 * v;
        int dd = id >> 10, pp = (id >> 4) & 63, nv = (id & 15) * 8;
        *(u32x4*)(St + dd * 64 * 136 + pp * 136 + nv) = rawst[v];
      }
    }
    __syncthreads();
    f32x4 af[4], ab[4], Y[4];
#pragma unroll
    for (int i = 0; i < 4; ++i) { af[i] = (f32x4){0.f, 0.f, 0.f, 0.f}; ab[i] = (f32x4){0.f, 0.f, 0.f, 0.f}; }
#pragma unroll
    for (int ks = 0; ks < 4; ++ks) {
      bf16x8 a = *(const bf16x8*)(Cs + (16 * w + l15) * 136 + ks * 32 + l4 * 8);
#pragma unroll
      for (int i = 0; i < 4; ++i) {
        bf16x8 b0 = *(const bf16x8*)(St + (i * 16 + l15) * 136 + ks * 32 + l4 * 8);
        bf16x8 b1 = *(const bf16x8*)(St + 64 * 136 + (i * 16 + l15) * 136 + ks * 32 + l4 * 8);
        af[i] = MFMA16(a, b0, af[i]);
        ab[i] = MFMA16(a, b1, ab[i]);
      }
    }
#pragma unroll
    for (int r = 0; r < 4; ++r) {
      const int l = 16 * w + l4 * 4 + r;
      float e0 = __expf(sch[l]), e1 = __expf(sch[128 + l]);
#pragma unroll
      for (int i = 0; i < 4; ++i) Y[i][r] = af[i][r] * e0 + ab[i][r] * e1;
    }
#pragma unroll
    for (int ks = 0; ks < 4; ++ks) {
      bf16x8 a = *(const bf16x8*)(Bs + (16 * w + l15) * 136 + ks * 32 + l4 * 8);
#pragma unroll
      for (int i = 0; i < 4; ++i) {
        bf16x8 b = *(const bf16x8*)(xT + (i * 16 + l15) * 136 + ks * 32 + l4 * 8);
        Y[i] = MFMA16(a, b, Y[i]);
      }
    }
    {
      u16* YAB = dry ? (u16*)(p.ws + OFF_DUMMY) + (size_t)(blockIdx.x & 15) * 400000 - (size_t)row0 * 2048 : (u16*)((unsigned char*)p.out + OUT_YB);
      const float dsk = p.in[16][h] + p.in[16][16 + h];
      float ss[4] = {0.f, 0.f, 0.f, 0.f};
#pragma unroll
      for (int i = 0; i < 4; ++i) {
        const int pp = i * 16 + l15;
#pragma unroll
        for (int r = 0; r < 4; ++r) {
          const int l = 16 * w + l4 * 4 + r;
          float xv = bf2f(xT[pp * 136 + l]);
          float y = Y[i][r] + xv * dsk;
          float gv = y * silu(bf2f(zraw[i][r]));
          YAB[(size_t)(row0 + l) * 2048 + h * 64 + pp] = f2bf(gv);
          ss[r] += gv * gv;
        }
      }
      float* rss = (float*)(p.ws + OFF_ROWSS);
#pragma unroll
      for (int r = 0; r < 4; ++r) {
        float sv = dpp_rowsum(ss[r]);
        if (l15 == 0) rss[(size_t)(row0 + 16 * w + l4 * 4 + r) * 16 + h] = sv;
      }
    }
    __syncthreads();
  }
}

DI void phase_ssd_states_grp(const Params& p, int item, unsigned char* smem) {
  u16* BT = (u16*)smem;
  u16* xTs = BT + 128 * 136;
  float* sdt = (float*)(xTs + 2 * 64 * 136);
  float* scs = sdt + 2048;
  float* sw = scs + 2048;
  float* stot = sw + 2048;
  int tid = threadIdx.x;
  asm volatile("" : "+v"(tid));
  const int lane = tid & 63, w = tid >> 6;
  const int l15 = lane & 15, l4 = lane >> 4;
  const int cgi = item >> 1, grp = item & 1;
  int row0, has_prev, has_next;
  if (cgi < 64) { int seq = cgi >> 1, c = cgi & 1; row0 = seq * 256 + c * 128; has_prev = c > 0; has_next = c < 1; }
  else { int q = cgi - 64; int seq = q >> 5, c = q & 31; row0 = NPROMPT + seq * 4096 + c * 128; has_prev = c > 0; has_next = c < 31; }
  const u16* C0 = (const u16*)(p.ws + OFF_C0A);
  const int xchunk = tid & 7, xrg = tid >> 3;
  const int bchunk = tid & 15, brg = tid >> 4;
  u32x4 rawb[6];
  conv_load<4>(p, row0, brg * 4, 1024 + grp * 128 + bchunk * 8, has_prev, has_next, rawb);
  float rdt[4];
#pragma unroll
  for (int i = 0; i < 4; ++i) {
    const int id = tid + i * NT; const int h8 = id >> 8, d = (id >> 7) & 1, l = id & 127;
    rdt[i] = bf2f(C0[(size_t)(row0 + l) * LDC0 + 2560 + d * 16 + grp * 8 + h8]);
  }
#pragma unroll
  for (int i = 0; i < 4; ++i) {
    const int id = tid + i * NT; const int h8 = id >> 8, d = (id >> 7) & 1;
    const int hh = grp * 8 + h8;
    float x = rdt[i] + p.in[14][d * 16 + hh];
    float dt = x > 20.f ? x : log1pf(expf(x));
    float a = -expf(p.in[15][d * 16 + hh]);
    sdt[id] = dt; scs[id] = a * dt;
  }
  __syncthreads();
#pragma unroll
  for (int k = 0; k < 2; ++k) {
    const int sq = 2 * w + k; const int d = sq & 1;
    float* base = scs + sq * 128;
    int p0 = d == 0 ? 2 * lane : 127 - 2 * lane;
    int p1 = d == 0 ? 2 * lane + 1 : 126 - 2 * lane;
    float v0 = base[p0], v1 = base[p1];
    float sacc = v0 + v1;
#pragma unroll
    for (int off = 1; off < 64; off <<= 1) {
      float tv = __shfl_up(sacc, off);
      if (lane >= off) sacc += tv;
    }
    float excl = sacc - (v0 + v1);
    base[p0] = excl + v0;
    base[p1] = excl + v0 + v1;
    if (lane == 63) stot[sq] = sacc;
  }
  {
    float o[4][8];
    conv_compute<4>(p, 1024 + grp * 128 + bchunk * 8, rawb, o);
#pragma unroll
    for (int e = 0; e < 8; ++e) {
      u32x2 v; v[0] = pk2(o[0][e], o[1][e]); v[1] = pk2(o[2][e], o[3][e]);
      *(u32x2*)(BT + (bchunk * 8 + e) * 136 + brg * 4) = v;
    }
  }
  __syncthreads();
#pragma unroll
  for (int i = 0; i < 4; ++i) {
    const int id = tid + i * NT; const int sq = id >> 7;
    sw[id] = sdt[id] * __expf(stot[sq] - scs[id]);
  }
  if (tid < 16) {
    float* cdec = (float*)(p.ws + OFF_CDEC);
    const int h8 = tid >> 1, d = tid & 1;
    cdec[(cgi * 16 + grp * 8 + h8) * 2 + d] = __expf(stot[tid]);
  }
  __syncthreads();
  const int d = w >> 2, nq = w & 3;
#pragma unroll 1
  for (int h8 = 0; h8 < 8; ++h8) {
    const int h = grp * 8 + h8;
    u32x4 rawx[4];
    conv_load<2>(p, row0, xrg * 2, h * 64 + xchunk * 8, has_prev, has_next, rawx);
    {
      float o[2][8];
      conv_compute<2>(p, h * 64 + xchunk * 8, rawx, o);
#pragma unroll
      for (int dd = 0; dd < 2; ++dd) {
        const float s0 = sw[h8 * 256 + dd * 128 + xrg * 2], s1 = sw[h8 * 256 + dd * 128 + xrg * 2 + 1];
#pragma unroll
        for (int e = 0; e < 8; ++e) *(unsigned*)(xTs + dd * 64 * 136 + (xchunk * 8 + e) * 136 + xrg * 2) = pk2(o[0][e] * s0, o[1][e] * s1);
      }
    }
    __syncthreads();
    f32x4 acc[4][2];
#pragma unroll
    for (int i = 0; i < 4; ++i) { acc[i][0] = (f32x4){0.f, 0.f, 0.f, 0.f}; acc[i][1] = (f32x4){0.f, 0.f, 0.f, 0.f}; }
#pragma unroll
    for (int ks = 0; ks < 4; ++ks) {
      bf16x8 a[4], b[2];
#pragma unroll
      for (int i = 0; i < 4; ++i) a[i] = *(const bf16x8*)(xTs + d * 64 * 136 + (i * 16 + l15) * 136 + ks * 32 + l4 * 8);
#pragma unroll
      for (int j = 0; j < 2; ++j) b[j] = *(const bf16x8*)(BT + (nq * 32 + j * 16 + l15) * 136 + ks * 32 + l4 * 8);
#pragma unroll
      for (int i = 0; i < 4; ++i)
#pragma unroll
        for (int j = 0; j < 2; ++j) acc[i][j] = MFMA16(b[j], a[i], acc[i][j]);
    }
    u16* S = (u16*)((unsigned char*)p.out + OUT_SBUF) + ((size_t)(cgi * 16 + h) * 2 + d) * 8192;
#pragma unroll
    for (int i = 0; i < 4; ++i)
#pragma unroll
      for (int j = 0; j < 2; ++j) {
        const int pp = i * 16 + l15, n = nq * 32 + j * 16 + l4 * 4;
        u32x2 o; o[0] = pk2(acc[i][j][0], acc[i][j][1]); o[1] = pk2(acc[i][j][2], acc[i][j][3]);
        *(u32x2*)(S + pp * 128 + n) = o;
      }
    __syncthreads();
  }
}
#define OFF_BAR 268419072ul
#define XB_TMO      128
#define XB_XCNT(j)  (256  + 64 * (j))
#define XB_XSUB(j)  (1280 + 64 * (j))
#define XB_XGEN(j)  (2304 + 64 * (j))
#define XB_TOP      3328
#define XB_TOPGEN   3392
#define XCD_BAR_WORDS 3456
#define XB_SPIN_CAP (1u << 18)
#define LAS __attribute__((address_space(3)))
DI unsigned xb_ld(unsigned* p) { return __hip_atomic_load(p, __ATOMIC_RELAXED, __HIP_MEMORY_SCOPE_AGENT); }
DI unsigned xb_add(unsigned* p, unsigned v) { return __hip_atomic_fetch_add(p, v, __ATOMIC_RELAXED, __HIP_MEMORY_SCOPE_AGENT); }
DI unsigned xb_xcc_id() { return (unsigned)__builtin_amdgcn_s_getreg((3 << 11) | 20) & 0xFu; }
#define XB_SPIN(cond, bar) do { unsigned _sp = 0; while (cond) { __builtin_amdgcn_s_sleep(1); \
    if ((++_sp & 255u) == 0u) { if (xb_ld(&(bar)[XB_TMO])) break; if (_sp > XB_SPIN_CAP) { atomicAdd(&(bar)[XB_TMO], 1u); break; } } } } while (0)
struct XcdBarrier { unsigned* bar; unsigned x; volatile LAS unsigned* st; };
DI XcdBarrier xcd_barrier_post(unsigned* bar, volatile LAS unsigned* st) {
  XcdBarrier b; b.bar = bar; b.x = xb_xcc_id(); b.st = st;
  if (threadIdx.x == 0) (void)xb_add(&bar[XB_XCNT(b.x)], 1u);
  return b;
}
DI void xcd_barrier_complete(unsigned* bar, unsigned x, unsigned& nloc, unsigned& nx) {
  const unsigned G = gridDim.x * gridDim.y * gridDim.z;
  unsigned sum, cnt, mine, sp = 0u;
  for (;;) {
    sum = 0u; cnt = 0u; mine = 0u;
#pragma unroll
    for (unsigned j = 0; j < 16; ++j) { const unsigned c = xb_ld(&bar[XB_XCNT(j)]); sum += c; cnt += (c > 0u) ? 1u : 0u; mine = (j == x) ? c : mine; }
    if (sum == G) break;
    __builtin_amdgcn_s_sleep(1);
    if ((++sp & 255u) == 0u) { if (xb_ld(&bar[XB_TMO])) break; if (sp > XB_SPIN_CAP) { atomicAdd(&bar[XB_TMO], 1u); break; } }
  }
  nloc = mine > 0u ? mine : 1u; nx = cnt > 0u ? cnt : 1u;
}
DI void xcd_barrier(const XcdBarrier& b) {
  asm volatile("s_waitcnt vmcnt(0)" ::: "memory");
  __syncthreads();
  if (threadIdx.x == 0) {
    unsigned* bar = b.bar;
    __builtin_amdgcn_s_waitcnt(0);
    unsigned nloc = b.st[0], nx = b.st[1];
    if (nloc == 0u) { xcd_barrier_complete(bar, b.x, nloc, nx); b.st[0] = nloc; b.st[1] = nx; }
    const unsigned old = xb_add(&bar[XB_XSUB(b.x)], 1u);
    const unsigned gen = old / nloc;
    if (old + 1u == (gen + 1u) * nloc) {
      __builtin_amdgcn_fence(__ATOMIC_RELEASE, "agent");
      asm volatile("s_waitcnt vmcnt(0)" ::: "memory");
      const unsigned og = xb_add(&bar[XB_TOP], 1u);
      const unsigned tg = og / nx;
      if (og + 1u == (tg + 1u) * nx) xb_add(&bar[XB_TOPGEN], 1u);
      else XB_SPIN(xb_ld(&bar[XB_TOPGEN]) == tg, bar);
      __builtin_amdgcn_fence(__ATOMIC_ACQUIRE, "agent");
      xb_add(&bar[XB_XGEN(b.x)], 1u);
      asm volatile("s_waitcnt vmcnt(0)" ::: "memory");
    } else {
      XB_SPIN(xb_ld(&bar[XB_XGEN(b.x)]) == gen, bar);
      __builtin_amdgcn_fence(__ATOMIC_ACQUIRE, "agent");
      asm volatile("s_waitcnt vmcnt(0)" ::: "memory");
    }
  }
  __syncthreads();
}

DI int xcd_item(int t) {
  return (gridDim.x == 256) ? ((t & ~255) | ((t & 7) << 5) | ((t & 255) >> 3)) : t;
}
#define NPHASE 12
__global__ void __launch_bounds__(NT) mega(Params p, int ph0, int ph1) {
  __shared__ __attribute__((aligned(16))) unsigned char smem[SMEM_BYTES];
  __shared__ __attribute__((aligned(16))) unsigned xb_st[4];
  const int nb = gridDim.x, bid = blockIdx.x;
  if (threadIdx.x < 4) xb_st[threadIdx.x] = 0u;
  __syncthreads();
  const XcdBarrier xb = xcd_barrier_post((unsigned*)(p.ws + OFF_BAR), (volatile LAS unsigned*)xb_st);
  if (ph1 > 4096) cg::this_grid().sync();
#define PH_BEGIN(k) if (ph0 <= (k) && (k) < ph1) { if ((k) > ph0) xcd_barrier(xb); \
  for (int rep = (REP_MASK >> (k)) & 1; rep >= 0; --rep) { const bool dry = rep > 0; (void)dry;
#define PH_END if (rep > 0) xcd_barrier(xb); } }
  {
    {
      PH_BEGIN(0) {
        for (int ft = bid; ft < 256; ft += nb) phase_filter(p, ft, smem);
        {
          int lim0 = 192 + 432;
          asm volatile("" : "+s"(lim0));
          for (int q0 = bid; q0 < lim0; q0 += nb) {
            if (q0 < 192) phase_ada(p, q0, smem);
            else {
              int q = q0 - 192;
              if (q < 432) transpose_tile<float>(p.in[10], 6688, 6688, (u16*)(p.ws + OFF_WINE), 1024, q & 15, q >> 4, nullptr, 0, smem);
              else if (q < 560) { q -= 432; transpose_tile<float>(p.in[11], 1024, 1024, (u16*)(p.ws + OFF_WOUTE), 2048, q & 31, q >> 5, p.in[17], 1024, smem); }
              else if (q < 816) { q -= 560; transpose_tile<float>(p.in[27], 4096, 4096, (u16*)(p.ws + OFF_WINO), 1024, q & 15, q >> 4, nullptr, 0, smem); }
              else { q -= 816; transpose_tile<float>(p.in[28], 1024, 1024, (u16*)(p.ws + OFF_WOUTO), 1024, q & 15, q >> 4, nullptr, 0, smem); }
            }
          }
        }
      } PH_END
      PH_BEGIN(1) {
        for (int t = bid; t < 512; t += nb) phase_norm(p, t, 0, p.in[0], p.in[1], (u16*)((unsigned char*)p.out + OUT_H0));
      } PH_END
      PH_BEGIN(2) {
        GemmArgs g; g.A1 = (const u16*)((const unsigned char*)p.out + OUT_H0); g.lda1 = 1024; g.A2 = g.A1; g.lda2 = 1024; g.ksplit = 1 << 30;
        g.Bt = (const u16*)(p.ws + OFF_WINE); g.K = 1024;
        for (int rd = 0; rd * 256 < 64 * 27; ++rd) { int pm, pn; if (gemm_tile_coord(rd, 27, 64 * 27, pm, pn)) { if (pn <= 9) gemm256<0, true>(p, g, pm * 256, pn * 256, smem); else gemm256<0, false>(p, g, pm * 256, pn * 256, smem); } }
        {
          int q0, qstep;
          if (nb == 256) { q0 = ((bid & 7) >= 6) ? ((bid & 7) - 6) * 32 + (bid >> 3) : 448; qstep = 64; }
          else { q0 = bid; qstep = nb; }
#pragma unroll 1
          for (int q = q0; q < 448; q += qstep) {
            const float* src; u16* dst; int N, ldd, kt, nt4, ksn; const float* ksc = nullptr;
            if (q < 128) { src = p.in[11]; dst = (u16*)(p.ws + OFF_WOUTE); N = 1024; ldd = 2048; kt = q & 31; nt4 = q >> 5; ksc = p.in[17]; ksn = 1024; }
            else if (q < 384) { const int r = q - 128; src = p.in[27]; dst = (u16*)(p.ws + OFF_WINO); N = 4096; ldd = 1024; kt = r & 15; nt4 = r >> 4; ksn = 0; }
            else { const int r = q - 384; src = p.in[28]; dst = (u16*)(p.ws + OFF_WOUTO); N = 1024; ldd = 1024; kt = r & 15; nt4 = r >> 4; ksn = 0; }
            transpose_tile<float>(src, N, N, dst, ldd, kt, nt4, ksc, ksn, smem);
          }
        }
      } PH_END
      PH_BEGIN(3) {
        for (int t = bid; t < 512 + 256; t += nb) {
          if (dry && (REP_SUB == 1 || REP_SUB == 4) && t >= 256) continue;
          if (dry && REP_SUB == 2 && (t < 256 || t >= 512)) continue;
          if (dry && REP_SUB == 3 && t < 512) continue;
          if (t < 512) phase_hyena(p, t, smem, dry);
          else phase_ssd_states_grp(p, xcd_item(t - 512), smem);
        }
      } PH_END
      PH_BEGIN(4) {
        for (int t = 2048 + bid; t < 34 * 64; t += nb) phase_scan(p, t);
        {
          int t = bid;
          for (; t + 3 * nb < 2048; t += 4 * nb) phase_scan_prompt4(p, t, nb);
          for (; t < 2048; t += nb) phase_scan(p, t);
        }
      } PH_END
      PH_BEGIN(5) {
        for (int t = bid; t < 256 + 1024; t += nb) {
          if (t < 256) phase_ssd_out_grp(p, xcd_item(t), smem, dry);
          else {
            int q = t - 256;
            transpose_tile<u16>((const u16*)(p.ws + OFF_UT) + (size_t)3072 * UTP, MROWS, UTP,
                                (u16*)((unsigned char*)p.out + OUT_YB) + 1024, 2048, q & 15, q >> 4, nullptr, 0, smem);
          }
        }
      } PH_END
      PH_BEGIN(6) {
        GemmArgs g; g.A1 = (const u16*)((const unsigned char*)p.out + OUT_YB); g.lda1 = 2048;
        g.A2 = g.A1; g.lda2 = 2048; g.ksplit = 1024;
        g.Bt = (const u16*)(p.ws + OFF_WOUTE); g.K = 2048;
        for (int rd = 0; rd * 256 < 64 * 4; ++rd) { int pm, pn; if (gemm_tile_coord(rd, 4, 64 * 4, pm, pn)) gemm256<1, true>(p, g, pm * 256, pn * 256, smem); }
      } PH_END
      PH_BEGIN(7) {
        const u16* x1 = (const u16*)(p.ws + OFF_X1);
        for (int t = bid; t < 512 + 256; t += nb) { if (t < 512) phase_norm_b(p, t, x1, (u16*)(p.ws + OFF_H1)); else phase_ckv(p, t - 512); }
      } PH_END
      PH_BEGIN(8) {
        GemmArgs g; g.A1 = (const u16*)(p.ws + OFF_H1); g.lda1 = 1024; g.A2 = g.A1; g.lda2 = 1024; g.ksplit = 1 << 30;
        g.Bt = (const u16*)(p.ws + OFF_WINO); g.K = 1024;
        for (int rd = 0; rd * 256 < 64 * 16; ++rd) { int pm, pn; if (gemm_tile_coord(rd, 16, 64 * 16, pm, pn)) gemm256<2, true>(p, g, pm * 256, pn * 256, smem); }
      } PH_END
      PH_BEGIN(9) {
        for (int t = bid; t < 2048; t += nb) phase_attn(p, xcd_item(t), smem, dry);
      } PH_END
      PH_BEGIN(10) {
        GemmArgs g; g.A1 = (const u16*)(p.ws + OFF_C1); g.lda1 = LDC1; g.A2 = g.A1; g.lda2 = LDC1; g.ksplit = 1 << 30;
        g.Bt = (const u16*)(p.ws + OFF_WOUTO); g.K = 1024;
        for (int rd = 0; rd * 256 < 64 * 4; ++rd) { int pm, pn; if (gemm_tile_coord(rd, 4, 64 * 4, pm, pn)) gemm256<3, true>(p, g, pm * 256, pn * 256, smem); }
      } PH_END
      PH_BEGIN(11) {
        for (int t = bid; t < 512; t += nb) phase_final_norm(p, t);
      } PH_END
    }
  }
}

extern "C" void kernel_launch(void* const* d_in, const int* in_sizes, int n_in, void* d_out, int out_size,
                              void* d_ws, size_t ws_size, hipStream_t stream) {
  static int grid_blocks = 0;
  if (!grid_blocks) {
    int dev = 0, cus = 0, per_cu = 0;
    hipGetDevice(&dev);
    hipDeviceGetAttribute(&cus, hipDeviceAttributeMultiprocessorCount, dev);
    hipOccupancyMaxActiveBlocksPerMultiprocessor(&per_cu, mega, NT, 0);
    if (per_cu < 1) per_cu = 1;
    grid_blocks = cus * per_cu;
  }
  Params p{};
  for (int i = 0; i < 31; ++i) p.in[i] = (const float*)d_in[i];
  p.out = (float*)d_out;
  p.ws = (unsigned char*)d_ws;
#if MULTI
  for (int ph = 0; ph < NPHASE; ++ph) {
    hipLaunchKernelGGL(mega, dim3(grid_blocks), dim3(NT), 0, stream, p, ph, ph + 1);
  }
#else
  hipMemsetAsync((unsigned char*)d_ws + OFF_BAR, 0, XCD_BAR_WORDS * sizeof(unsigned), stream);
  int ph0 = 0, ph1 = NPHASE;
  void* args[] = {&p, &ph0, &ph1};
  hipError_t e = hipLaunchCooperativeKernel((void*)mega, dim3(grid_blocks), dim3(NT), args, 0, stream);
  if (e != hipSuccess) fprintf(stderr, "cooperative launch failed: %s (grid %d)\n", hipGetErrorString(e), grid_blocks);
#endif
}
```
